# Optimizing an MI355X kernel written in HIP

```python
import math
import jax, jax.numpy as jnp
from jax import lax
import numpy as np

D_MODEL = 1024
BATCH = 2
SEQ = 8192
DEPTH = 2

N_BRANCHES = 4
BRANCH_WIDTH = D_MODEL // 2
D_FF = 2816
ROPE_THETA = 10000.0
NORM_EPS = 1e-6

M2_HEAD_DIM = 64
M2_HEADS = BRANCH_WIDTH // M2_HEAD_DIM
M2_GROUPS = 2
M2_STATE = 64
M2_CONV = 4
M2_CHUNK = 128
M2_CONV_DIM = BRANCH_WIDTH + 2 * M2_GROUPS * M2_STATE
M2_IN = BRANCH_WIDTH + M2_CONV_DIM + M2_HEADS

S5_GROUP = 16
S5_GROUPS = BRANCH_WIDTH // S5_GROUP
S5_STATE = 64
S5_IN = BRANCH_WIDTH

DSA_HEAD_DIM = 64
DSA_HEADS = BRANCH_WIDTH // DSA_HEAD_DIM
DSA_IDX_HEADS = 4
DSA_IDX_DIM = 64
DSA_TOPK = 256
DSA_QBLOCK = 128
DSA_IN = 3 * BRANCH_WIDTH + DSA_IDX_HEADS * DSA_IDX_DIM + DSA_IDX_DIM + DSA_IDX_HEADS

HG_HEADS = 4
HG_KDIM = 128
HG_VDIM = BRANCH_WIDTH // HG_HEADS
HG_CHUNK = 32
HG_IN = 2 * HG_HEADS * HG_KDIM + 2 * BRANCH_WIDTH

D_IN = M2_IN + S5_IN + DSA_IN + HG_IN
IN_SPLITS = [M2_IN, M2_IN + S5_IN, M2_IN + S5_IN + DSA_IN]

kernel_name = "hybrid_gated_ssd_s5_dsa_hgrn2_macaron"


def rms_norm(x, gain):
    xf = x.astype(jnp.float32)
    xf = xf * lax.rsqrt(jnp.mean(xf * xf, axis=-1, keepdims=True) + NORM_EPS)
    return (xf * gain.astype(jnp.float32)).astype(x.dtype)


def swiglu(x, w1, w3, w2):
    return (jax.nn.silu(x @ w1) * (x @ w3)) @ w2


def rope(x, positions):
    half = x.shape[-1] // 2
    inv_freq = ROPE_THETA ** (-jnp.arange(half, dtype=jnp.float32) / half)
    ang = positions.astype(jnp.float32)[..., None] * inv_freq
    cos = jnp.cos(ang)[:, :, None, :]
    sin = jnp.sin(ang)[:, :, None, :]
    xf = x.astype(jnp.float32)
    x1, x2 = xf[..., :half], xf[..., half:]
    return jnp.concatenate([x1 * cos - x2 * sin, x2 * cos + x1 * sin], axis=-1).astype(x.dtype)


def ssd_chunked(xh, dt, a, bg, cg):
    b, L, H, P = xh.shape
    nc = L // M2_CHUNK
    rep = H // M2_GROUPS
    bh = jnp.repeat(bg, rep, axis=2).reshape(b, nc, M2_CHUNK, H, M2_STATE)
    ch = jnp.repeat(cg, rep, axis=2).reshape(b, nc, M2_CHUNK, H, M2_STATE)
    xdt = (xh * dt[..., None]).reshape(b, nc, M2_CHUNK, H, P)
    ad = (dt * a).reshape(b, nc, M2_CHUNK, H).transpose(0, 3, 1, 2)
    a_cs = jnp.cumsum(ad, axis=-1)
    causal = jnp.tril(jnp.ones((M2_CHUNK, M2_CHUNK), dtype=bool))
    seg = a_cs[..., :, None] - a_cs[..., None, :]
    decay_in = jnp.exp(jnp.where(causal, seg, -jnp.inf))
    scores = jnp.einsum("bcqhn,bcshn->bhcqs", ch, bh) * decay_in
    y_diag = jnp.einsum("bhcqs,bcshp->bcqhp", scores, xdt)
    decay_to_end = jnp.exp(a_cs[..., -1:] - a_cs)
    states = jnp.einsum("bcshn,bhcs,bcshp->bchpn", bh, decay_to_end, xdt)
    a_tot = jnp.pad(a_cs[..., -1], ((0, 0), (0, 0), (1, 0)))
    tot_cs = jnp.cumsum(a_tot, axis=-1)
    causal_c = jnp.tril(jnp.ones((nc + 1, nc + 1), dtype=bool))
    decay_chunk = jnp.exp(jnp.where(causal_c, tot_cs[..., :, None] - tot_cs[..., None, :], -jnp.inf))
    states = jnp.concatenate([jnp.zeros_like(states[:, :1]), states], axis=1)
    states_in = jnp.einsum("bhzc,bchpn->bzhpn", decay_chunk, states)[:, :-1]
    y_off = jnp.einsum("bcqhn,bchpn,bhcq->bcqhp", ch, states_in, jnp.exp(a_cs))
    return (y_diag + y_off).reshape(b, L, H, P)


def mamba2_branch(p_in, conv_w, conv_b, dt_bias, a_log, d_skip, norm_g):
    b, L, _ = p_in.shape
    z, xbc, dt_raw = jnp.split(p_in, [BRANCH_WIDTH, BRANCH_WIDTH + M2_CONV_DIM], axis=-1)
    xbc = lax.conv_general_dilated(xbc, conv_w[:, None, :], window_strides=(1,),
                                   padding=[(M2_CONV - 1, 0)],
                                   dimension_numbers=("NWC", "WIO", "NWC"),
                                   feature_group_count=M2_CONV_DIM)
    xbc = jax.nn.silu(xbc + conv_b)
    xs, bs, cs = jnp.split(xbc, [BRANCH_WIDTH, BRANCH_WIDTH + M2_GROUPS * M2_STATE], axis=-1)
    dt = jax.nn.softplus(dt_raw + dt_bias)
    a = -jnp.exp(a_log)
    xh = xs.reshape(b, L, M2_HEADS, M2_HEAD_DIM)
    y = ssd_chunked(xh, dt, a, bs.reshape(b, L, M2_GROUPS, M2_STATE), cs.reshape(b, L, M2_GROUPS, M2_STATE))
    y = (y + d_skip[:, None] * xh).reshape(b, L, BRANCH_WIDTH)
    return rms_norm(y * jax.nn.silu(z), norm_g)


def _complex_affine_combine(e1, e2):
    a1r, a1i, b1r, b1i = e1
    a2r, a2i, b2r, b2i = e2
    return (a2r * a1r - a2i * a1i, a2r * a1i + a2i * a1r,
            a2r * b1r - a2i * b1i + b2r, a2r * b1i + a2i * b1r + b2i)


def s5_branch(u, lam_re, lam_im, b_re, b_im, c_re, c_im, d_skip, log_dt, w_glu):
    b, L, _ = u.shape
    ug = u.reshape(b, L, S5_GROUPS, S5_GROUP)
    step = jnp.exp(log_dt)[:, None]
    ldt_re, ldt_im = lam_re * step, lam_im * step
    mag = jnp.exp(ldt_re)
    ab_re, ab_im = mag * jnp.cos(ldt_im), mag * jnp.sin(ldt_im)
    den = lam_re * lam_re + lam_im * lam_im
    q_re = ((ab_re - 1.0) * lam_re + ab_im * lam_im) / den
    q_im = (ab_im * lam_re - (ab_re - 1.0) * lam_im) / den
    bb_re = q_re[..., None] * b_re - q_im[..., None] * b_im
    bb_im = q_re[..., None] * b_im + q_im[..., None] * b_re
    bu_re = jnp.einsum("blgi,gpi->blgp", ug, bb_re)
    bu_im = jnp.einsum("blgi,gpi->blgp", ug, bb_im)
    a_re = jnp.broadcast_to(ab_re, (1, L) + ab_re.shape)
    a_im = jnp.broadcast_to(ab_im, (1, L) + ab_im.shape)
    _, _, s_re, s_im = lax.associative_scan(_complex_affine_combine, (a_re, a_im, bu_re, bu_im), axis=1)
    y = jnp.einsum("blgp,gip->blgi", s_re, c_re) - jnp.einsum("blgp,gip->blgi", s_im, c_im)
    y = y.reshape(b, L, BRANCH_WIDTH) + d_skip * u
    y = jax.nn.gelu(y)
    g_lin, g_gate = jnp.split(y @ w_glu, 2, axis=-1)
    return g_lin * jax.nn.sigmoid(g_gate)


def dsa_branch(p_in, positions, q_norm, k_norm):
    b, L, _ = p_in.shape
    bw = BRANCH_WIDTH
    idx_q = DSA_IDX_HEADS * DSA_IDX_DIM
    q, k, v, qi, ki, wi = jnp.split(p_in, [bw, 2 * bw, 3 * bw, 3 * bw + idx_q, 3 * bw + idx_q + DSA_IDX_DIM], axis=-1)
    q = rope(rms_norm(q.reshape(b, L, DSA_HEADS, DSA_HEAD_DIM), q_norm), positions)
    k = rope(rms_norm(k.reshape(b, L, DSA_HEADS, DSA_HEAD_DIM), k_norm), positions).reshape(b, L, bw)
    qi = qi.reshape(b, L, DSA_IDX_HEADS, DSA_IDX_DIM)
    wi = wi * (DSA_IDX_HEADS ** -0.5)
    topk = min(DSA_TOPK, L // 4)
    nb = L // DSA_QBLOCK
    key_pos = jnp.arange(L)
    att_scale = DSA_HEAD_DIM ** -0.5
    gather = jax.vmap(lambda arr, ix: arr[ix])

    def block(args):
        blk, qb, qib, wib = args
        t = blk * DSA_QBLOCK + jnp.arange(DSA_QBLOCK)
        rel = jax.nn.relu(jnp.einsum("bqhd,bsd->bqhs", qib, ki) * (DSA_IDX_DIM ** -0.5))
        score = jnp.einsum("bqh,bqhs->bqs", wib, rel).astype(jnp.float32)
        score = jnp.where((key_pos[None, :] <= t[:, None])[None], score, -jnp.inf)
        _, idx = lax.top_k(score, topk)
        valid = idx <= t[None, :, None]
        k_sel = gather(k, idx).reshape(b, DSA_QBLOCK, topk, DSA_HEADS, DSA_HEAD_DIM)
        v_sel = gather(v, idx).reshape(b, DSA_QBLOCK, topk, DSA_HEADS, DSA_HEAD_DIM)
        logits = jnp.einsum("bqhd,bqkhd->bhqk", qb, k_sel).astype(jnp.float32) * att_scale
        logits = jnp.where(valid[:, None], logits, -jnp.inf)
        prob = jax.nn.softmax(logits, axis=-1).astype(v.dtype)
        return jnp.einsum("bhqk,bqkhd->bqhd", prob, v_sel)

    def to_blocks(t):
        return t.reshape((b, nb, DSA_QBLOCK) + t.shape[2:]).swapaxes(0, 1)

    out = lax.map(block, (jnp.arange(nb), to_blocks(q), to_blocks(qi), to_blocks(wi)))
    return out.swapaxes(0, 1).reshape(b, L, bw)


def hgrn2_chunked(q, k, v, log_f):
    b, L, H, K = q.shape
    V = v.shape[-1]
    nc = L // HG_CHUNK
    dt = v.dtype

    def shp(t):
        return t.reshape((b, nc, HG_CHUNK) + t.shape[2:])

    q, k, v, log_f = shp(q), shp(k), shp(v), shp(log_f)
    cum = jnp.cumsum(log_f, axis=2)
    last = cum[:, :, -1:]
    q_dec = (q * jnp.exp(cum)).astype(dt)
    k_dec = (k * jnp.exp(-cum)).astype(dt)
    k_end = (k * jnp.exp(last - cum)).astype(dt)
    causal = jnp.tril(jnp.ones((HG_CHUNK, HG_CHUNK), dtype=bool))
    att = jnp.where(causal, jnp.einsum("bcqhk,bcshk->bchqs", q_dec, k_dec), 0.0).astype(dt)
    o_intra = jnp.einsum("bchqs,bcshv->bcqhv", att, v)
    chunk_state = jnp.einsum("bcshk,bcshv->bchkv", k_end, v)
    chunk_decay = jnp.exp(last[:, :, 0]).astype(dt)

    def step(state, inp):
        decay, upd = inp
        return decay[..., None] * state + upd, state

    init = jnp.zeros((b, H, K, V), dtype=dt)
    _, states_in = lax.scan(step, init, (chunk_decay.swapaxes(0, 1), chunk_state.swapaxes(0, 1)))
    states_in = states_in.swapaxes(0, 1)
    o_inter = jnp.einsum("bcqhk,bchkv->bcqhv", q_dec, states_in)
    return (o_intra + o_inter).reshape(b, L, H, V)


def hgrn2_branch(p_in, lower_bound, norm_g):
    b, L, _ = p_in.shape
    hk = HG_HEADS * HG_KDIM
    q, f, i, g = jnp.split(p_in, [hk, 2 * hk, 2 * hk + BRANCH_WIDTH], axis=-1)
    q = jax.nn.silu(q).reshape(b, L, HG_HEADS, HG_KDIM)
    f = f.reshape(b, L, HG_HEADS, HG_KDIM)
    lb = lower_bound.reshape(HG_HEADS, HG_KDIM).astype(p_in.dtype)
    forget = lb + (1.0 - lb) * jax.nn.sigmoid(f)
    log_f = jnp.log(forget.astype(jnp.float32))
    key = (1.0 - lb) * jax.nn.sigmoid(-f)
    v = i.reshape(b, L, HG_HEADS, HG_VDIM)
    o = hgrn2_chunked(q, key, v, log_f)
    o = rms_norm(o, norm_g.reshape(HG_HEADS, HG_VDIM)).reshape(b, L, BRANCH_WIDTH)
    return o * jax.nn.sigmoid(g)


def setup_inputs(seed: int = 0) -> dict:
    key = jax.random.key(seed)
    ks = iter(jax.random.split(key, 48))
    f32 = jnp.float32

    def nrm(shape, scale):
        return jax.random.normal(next(ks), shape, f32) * scale

    def gain(shape):
        return 1.0 + nrm(shape, 0.02)

    L = DEPTH
    x = jax.random.normal(next(ks), (BATCH, SEQ, D_MODEL), f32)
    positions = jnp.broadcast_to(jnp.arange(SEQ, dtype=jnp.int32), (BATCH, SEQ))
    ffn1_norm = gain((L, D_MODEL))
    ffn1_w1 = nrm((L, D_MODEL, D_FF), D_MODEL ** -0.5)
    ffn1_w3 = nrm((L, D_MODEL, D_FF), D_MODEL ** -0.5)
    ffn1_w2 = nrm((L, D_FF, D_MODEL), D_FF ** -0.5)
    mix_norm = gain((L, D_MODEL))
    w_in = nrm((L, D_MODEL, D_IN), D_MODEL ** -0.5)
    w_gate = nrm((L, D_MODEL, N_BRANCHES * D_MODEL), D_MODEL ** -0.5)
    w_branch = nrm((L, N_BRANCHES, BRANCH_WIDTH, D_MODEL), BRANCH_WIDTH ** -0.5)
    w_out = nrm((L, D_MODEL, D_MODEL), D_MODEL ** -0.5)
    m2_conv_w = nrm((L, M2_CONV, M2_CONV_DIM), M2_CONV ** -0.5)
    m2_conv_b = nrm((L, M2_CONV_DIM), 0.01)
    dt0 = jnp.exp(jax.random.uniform(next(ks), (L, M2_HEADS), f32, math.log(1e-3), math.log(1e-1)))
    m2_dt_bias = dt0 + jnp.log(-jnp.expm1(-dt0))
    m2_a_log = jnp.log(jax.random.uniform(next(ks), (L, M2_HEADS), f32, 1.0, 16.0))
    m2_d = 1.0 + nrm((L, M2_HEADS), 0.1)
    m2_norm = gain((L, BRANCH_WIDTH))
    s5_lam_re = -0.5 + nrm((L, S5_GROUPS, S5_STATE), 0.01)
    s5_lam_im = math.pi * jnp.arange(S5_STATE, dtype=f32) + nrm((L, S5_GROUPS, S5_STATE), 0.01)
    s5_b_re = nrm((L, S5_GROUPS, S5_STATE, S5_GROUP), (2 * S5_GROUP) ** -0.5)
    s5_b_im = nrm((L, S5_GROUPS, S5_STATE, S5_GROUP), (2 * S5_GROUP) ** -0.5)
    s5_c_re = nrm((L, S5_GROUPS, S5_GROUP, S5_STATE), (2 * S5_STATE) ** -0.5)
    s5_c_im = nrm((L, S5_GROUPS, S5_GROUP, S5_STATE), (2 * S5_STATE) ** -0.5)
    s5_d = nrm((L, BRANCH_WIDTH), 1.0)
    s5_log_dt = jax.random.uniform(next(ks), (L, S5_GROUPS), f32, math.log(1e-3), math.log(1e-1))
    s5_w_glu = nrm((L, BRANCH_WIDTH, 2 * BRANCH_WIDTH), BRANCH_WIDTH ** -0.5)
    dsa_q_norm = gain((L, DSA_HEAD_DIM))
    dsa_k_norm = gain((L, DSA_HEAD_DIM))
    hg_gamma = nrm((L, HG_HEADS * HG_KDIM), 0.1)
    hg_norm = gain((L, BRANCH_WIDTH))
    ffn2_norm = gain((L, D_MODEL))
    ffn2_w1 = nrm((L, D_MODEL, D_FF), D_MODEL ** -0.5)
    ffn2_w3 = nrm((L, D_MODEL, D_FF), D_MODEL ** -0.5)
    ffn2_w2 = nrm((L, D_FF, D_MODEL), D_FF ** -0.5)
    return {"x": x, "positions": positions,
            "ffn1_norm": ffn1_norm, "ffn1_w1": ffn1_w1, "ffn1_w3": ffn1_w3, "ffn1_w2": ffn1_w2,
            "mix_norm": mix_norm, "w_in": w_in, "w_gate": w_gate, "w_branch": w_branch, "w_out": w_out,
            "m2_conv_w": m2_conv_w, "m2_conv_b": m2_conv_b, "m2_dt_bias": m2_dt_bias,
            "m2_a_log": m2_a_log, "m2_d": m2_d, "m2_norm": m2_norm,
            "s5_lam_re": s5_lam_re, "s5_lam_im": s5_lam_im, "s5_b_re": s5_b_re, "s5_b_im": s5_b_im,
            "s5_c_re": s5_c_re, "s5_c_im": s5_c_im, "s5_d": s5_d, "s5_log_dt": s5_log_dt,
            "s5_w_glu": s5_w_glu, "dsa_q_norm": dsa_q_norm, "dsa_k_norm": dsa_k_norm,
            "hg_gamma": hg_gamma, "hg_norm": hg_norm,
            "ffn2_norm": ffn2_norm, "ffn2_w1": ffn2_w1, "ffn2_w3": ffn2_w3, "ffn2_w2": ffn2_w2}


def reference(x, positions, ffn1_norm, ffn1_w1, ffn1_w3, ffn1_w2, mix_norm, w_in, w_gate, w_branch, w_out,
              m2_conv_w, m2_conv_b, m2_dt_bias, m2_a_log, m2_d, m2_norm,
              s5_lam_re, s5_lam_im, s5_b_re, s5_b_im, s5_c_re, s5_c_im, s5_d, s5_log_dt, s5_w_glu,
              dsa_q_norm, dsa_k_norm, hg_gamma, hg_norm, ffn2_norm, ffn2_w1, ffn2_w3, ffn2_w2):
    b, L, _ = x.shape
    lbs = jnp.cumsum(jax.nn.softmax(hg_gamma.astype(jnp.float32), axis=0), axis=0)
    lbs = lbs - lbs[0]
    for l in range(DEPTH):
        x = x + 0.5 * swiglu(rms_norm(x, ffn1_norm[l]), ffn1_w1[l], ffn1_w3[l], ffn1_w2[l])
        h = rms_norm(x, mix_norm[l])
        p = h @ w_in[l]
        p_m2, p_s5, p_dsa, p_hg = jnp.split(p, IN_SPLITS, axis=-1)
        y_a = mamba2_branch(p_m2, m2_conv_w[l], m2_conv_b[l], m2_dt_bias[l], m2_a_log[l], m2_d[l], m2_norm[l])
        y_b = s5_branch(p_s5, s5_lam_re[l], s5_lam_im[l], s5_b_re[l], s5_b_im[l], s5_c_re[l], s5_c_im[l],
                        s5_d[l], s5_log_dt[l], s5_w_glu[l])
        y_c = dsa_branch(p_dsa, positions, dsa_q_norm[l], dsa_k_norm[l])
        y_d = hgrn2_branch(p_hg, lbs[l], hg_norm[l])
        ys = jnp.stack([y_a, y_b, y_c, y_d], axis=2)
        proj = jnp.einsum("blgc,gcd->blgd", ys, w_branch[l])
        gates = jax.nn.sigmoid(h @ w_gate[l]).reshape(b, L, N_BRANCHES, D_MODEL)
        merged = jnp.einsum("blgd,blgd->bld", gates, proj)
        x = x + merged @ w_out[l]
        x = x + 0.5 * swiglu(rms_norm(x, ffn2_norm[l]), ffn2_w1[l], ffn2_w3[l], ffn2_w2[l])
    return x
```

```cpp
#include <hip/hip_runtime.h>
#include <hip/hip_cooperative_groups.h>
#include <cstdio>
#include <cstdint>
namespace cg = cooperative_groups;

#define LAS __attribute__((address_space(3)))
typedef unsigned short bf16_t;
typedef short bf16x8 __attribute__((ext_vector_type(8)));
typedef float f32x4 __attribute__((ext_vector_type(4)));
typedef float f32x16 __attribute__((ext_vector_type(16)));
typedef unsigned u32x4 __attribute__((ext_vector_type(4)));
typedef unsigned u32x2 __attribute__((ext_vector_type(2)));

constexpr int T_TOK = 16384, SEQ = 8192, DM = 1024, DFF = 2816, DIN = 5708, NLAYER = 2;
constexpr float NORM_EPS = 1e-6f;
constexpr int PA_LD = 3328;
constexpr int PB_LD = 1792;
constexpr int U_LD = 384;
constexpr int S5Q = 16;
constexpr int NCHUNK = T_TOK / S5Q;

__device__ __forceinline__ bf16_t f2bf(float f) { unsigned u = __float_as_uint(f); u += 0x7fffu + ((u >> 16) & 1u); return (bf16_t)(u >> 16); }
__device__ __forceinline__ float bf2f(bf16_t h) { return __uint_as_float(((unsigned)h) << 16); }
__device__ __forceinline__ unsigned pack_bf16(float lo, float hi) { return (unsigned)f2bf(lo) | ((unsigned)f2bf(hi) << 16); }
__device__ __forceinline__ float bflo(unsigned w) { return __uint_as_float(w << 16); }
__device__ __forceinline__ float bfhi(unsigned w) { return __uint_as_float(w & 0xffff0000u); }
__device__ __forceinline__ float fast_exp2(float x) { return __builtin_amdgcn_exp2f(x); }
__device__ __forceinline__ float fast_rcp(float x) { return __builtin_amdgcn_rcpf(x); }
__device__ __forceinline__ float sigmoid_f(float x) { return fast_rcp(1.0f + fast_exp2(-1.4426950408889634f * x)); }
__device__ __forceinline__ float silu_f(float x) { return x * sigmoid_f(x); }
__device__ __forceinline__ float gelu_tanh_f(float x) { const float u = 0.7978845608028654f * (x + 0.044715f * x * x * x); return x * sigmoid_f(2.0f * u); }
__device__ __forceinline__ float fast_exp(float x) { return __builtin_amdgcn_exp2f(1.4426950408889634f * x); }
__device__ __forceinline__ float fast_rsq(float x) { return __builtin_amdgcn_rsqf(x); }
__device__ __forceinline__ float softplus_f(float x) {
    if (x > 20.f) return x;
    const float e = fast_exp(x);
    if (e < 0.03125f) return e * (1.0f - e * (0.5f - e * (0.33333333f - 0.25f * e)));
    return 0.6931471805599453f * __builtin_amdgcn_logf(1.0f + e);
}
__device__ __forceinline__ void sincos_rev(float ang, float& sn, float& cs) {
    double rd = (double)ang * 0.15915494309189535; rd -= __builtin_floor(rd);
    const float r = (float)rd; sn = __builtin_amdgcn_sinf(r); cs = __builtin_amdgcn_cosf(r);
}
constexpr int TID_TAB_OFF = 160 * 1024 - 256;
__device__ __forceinline__ unsigned hw_wave_slot() { return __builtin_amdgcn_s_getreg((5 << 11) | 4) & 63u; }
__device__ __forceinline__ void tid_tab_init() { ((LAS int*)(LAS char*)TID_TAB_OFF)[hw_wave_slot()] = (int)(threadIdx.x >> 6); __syncthreads(); }
__device__ __forceinline__ int tid_fresh() {
    unsigned off = (unsigned)TID_TAB_OFF + hw_wave_slot() * 4u; asm volatile("" : "+s"(off));
    const int w = *(const LAS int*)(LAS char*)(uintptr_t)off;
    int t = w * 64 + (int)__builtin_amdgcn_mbcnt_hi(~0u, __builtin_amdgcn_mbcnt_lo(~0u, 0u)); asm volatile("" : "+v"(t)); return t; }
__device__ __forceinline__ int sgpr_fresh(int v) { asm volatile("" : "+s"(v)); return v; }
namespace pg8 {
constexpr int BM = 256, BK = 64, HALF = 128, HTB = HALF * BK * 2  , STAGE_BYTES = 8 * HTB, NXCD = 8, WGM = 8;
__host__ __device__ __forceinline__ int lds_byte(int r, int c) { const int st = (r >> 4) * 2 + (c >> 5), rr = r & 15, cc = c & 31, ob = rr * 64 + cc * 2; return st * 1024 + (ob ^ (((ob >> 9) & 1) << 5)); }
__host__ __device__ __forceinline__ void stage_rc(int b, int& R, int& C) { const int st = b / 1024, sb = b % 1024, swz = sb ^ (((sb >> 9) & 1) << 5); R = (st >> 1) * 16 + swz / 64; C = (st & 1) * 32 + (swz % 64) / 2; }
__host__ __device__ __forceinline__ int perm32(int rho) { const int n = rho >> 4, i = rho & 15; return 8 * (i >> 2) + 4 * n + (i & 3); }

struct Unit { int pm, pn; };
struct Gemm { const bf16_t* A; const bf16_t* Bt; int lda, ldb, K; };

struct StaticOrder {
    int nM, nN, nwg, G, c;
    __device__ void init(int nM_, int nN_, int G_, int c_) { nM = nM_; nN = nN_; nwg = nM * nN; G = G_; c = c_; }
    __device__ bool next(int i, Unit& u) const {
        const long L = (long)i * G + c; if (L >= nwg) return false;
        int wgid = (int)L; { const int q = nwg / NXCD, r = nwg % NXCD, xcd = wgid % NXCD, off = wgid / NXCD; wgid = (xcd < r ? xcd * (q + 1) : r * (q + 1) + (xcd - r) * q) + off; }
        const int nig = WGM * nN, gid = wgid / nig, fm = gid * WGM, gsz = (nM - fm) < WGM ? (nM - fm) : WGM;
        u.pm = fm + ((wgid % nig) % gsz); u.pn = (wgid % nig) / gsz; return true;
    }
};
struct GroupOrder {
    int ng, nMg, nNg, tot, G, c;
    __device__ void init(int ng_, int nMg_, int nNg_, int G_, int c_) { ng = ng_; nMg = nMg_; nNg = nNg_; tot = ng * nMg * nNg; G = G_; c = c_; }
    __device__ bool next(int i, Unit& u) const {
        const int L = i * G + c; if (L >= tot) return false;
        const int per = nMg * nNg, g = L / per, r = L % per; u.pm = g * nMg + r % nMg; u.pn = g * nNg + r / nMg; return true;
    }
};

template <class Epi, class Sched, bool ALIGN_EPI, bool SP2>
__device__ __forceinline__ void gemm_phase(LAS unsigned char* lds, const Gemm g, const Sched& S, const Epi& E) {
    const int tid = tid_fresh(), wid = __builtin_amdgcn_readfirstlane(tid >> 6), lane = tid & 63, wr = wid >> 2, wc = wid & 3, fr = lane & 15, fq = lane >> 4;
    const int K = g.K, nt = K / BK;
    unsigned voffA[2], voffB[2];
#pragma unroll
    for (int i = 0; i < 2; ++i) { int R, C; stage_rc(tid * 16 + i * 8192, R, C); const int Rb = Epi::PERM ? ((R & ~31) + perm32(R & 31)) : R;
        voffA[i] = (unsigned)(R * g.lda + C) * 2u; voffB[i] = (unsigned)(Rb * g.ldb + C) * 2u; }
    const size_t kstep = (size_t)(BK * 2);
    const size_t hstepA = (size_t)HALF * g.lda * 2, hstepB = (size_t)HALF * g.ldb * 2;
    const size_t tstepA = 2 * hstepA, tstepB = 2 * hstepB;
    const unsigned ldsw = (unsigned)wid * 1024u;
    const int aoff = lds_byte(wr * 64 + fr, fq * 8), boff = lds_byte(wc * 32 + fr, fq * 8);
#define PG8_SA(b, h) (((b) * 2 + (h)) * HTB)
#define PG8_SB(b, h) ((4 + (b) * 2 + (h)) * HTB)
#define PG8_STAGE(bufoff, gbase, voff) do { _Pragma("unroll") for (int _i = 0; _i < 2; ++_i) \
        __builtin_amdgcn_global_load_lds((const unsigned*)((const char*)(gbase) + (voff)[_i]), (LAS unsigned*)(lds + (bufoff) + ldsw + _i * 8192), 16, 0, 0); } while (0)
#define PG8_LDA(dst, b, h) do { _Pragma("unroll") for (int m = 0; m < 4; ++m) _Pragma("unroll") for (int k = 0; k < 2; ++k) dst[m][k] = *(const LAS bf16x8*)(lds + PG8_SA(b, h) + aoff + m * 2048 + k * 1024); } while (0)
#define PG8_LDB(dst, b, h) do { _Pragma("unroll") for (int n = 0; n < 2; ++n) _Pragma("unroll") for (int k = 0; k < 2; ++k) dst[n][k] = *(const LAS bf16x8*)(lds + PG8_SB(b, h) + boff + n * 2048 + k * 1024); } while (0)
#define PG8_MMA(ai, bj, At, Bt) do { __builtin_amdgcn_s_setprio(1); _Pragma("unroll") for (int m = 0; m < 4; ++m) _Pragma("unroll") for (int n = 0; n < 2; ++n) _Pragma("unroll") for (int k = 0; k < 2; ++k) \
        acc[ai][bj][m][n] = __builtin_amdgcn_mfma_f32_16x16x32_bf16(Bt[n][k], At[m][k], acc[ai][bj][m][n], 0, 0, 0); __builtin_amdgcn_s_setprio(0); } while (0)
#define PG8_WAIT_V(n) asm volatile("s_waitcnt vmcnt(" #n ")" ::: "memory")
#define PG8_WAIT_L(n) asm volatile("s_waitcnt lgkmcnt(" #n ")" ::: "memory")
#define PG8_BAR __builtin_amdgcn_s_barrier()
#define PG8_SCHED __builtin_amdgcn_sched_barrier(0)
    Unit cur, nxt; int ui = 0;
    if (!S.next(0, cur)) return;
    f32x4 acc[2][2][4][2];
#pragma unroll
    for (int a = 0; a < 2; ++a)
#pragma unroll
        for (int b = 0; b < 2; ++b)
#pragma unroll
            for (int m = 0; m < 4; ++m)
#pragma unroll
                for (int n = 0; n < 2; ++n) acc[a][b][m][n] = (f32x4){0.f, 0.f, 0.f, 0.f};
    bf16x8 At[4][2], B0[2][2], B1[2][2];
    const char* cA = (const char*)g.A + (size_t)cur.pm * tstepA; const char* cB = (const char*)g.Bt + (size_t)cur.pn * tstepB;
    if constexpr (SP2) {
        PG8_STAGE(PG8_SB(0, 0), cB, voffB); PG8_STAGE(PG8_SB(0, 1), cB + hstepB, voffB); PG8_STAGE(PG8_SA(0, 0), cA, voffA); PG8_STAGE(PG8_SA(0, 1), cA + hstepA, voffA);
        if (wr == 1) PG8_BAR;
        PG8_WAIT_V(2); PG8_BAR;
        PG8_STAGE(PG8_SB(1, 0), cB + kstep, voffB); PG8_STAGE(PG8_SA(1, 0), cA + kstep, voffA); PG8_STAGE(PG8_SB(1, 1), cB + hstepB + kstep, voffB);
        PG8_WAIT_V(6); PG8_BAR;
    } else {
        PG8_STAGE(PG8_SB(0, 0), cB, voffB); PG8_STAGE(PG8_SA(0, 0), cA, voffA); PG8_STAGE(PG8_SB(0, 1), cB + hstepB, voffB); PG8_STAGE(PG8_SA(0, 1), cA + hstepA, voffA);
        if (wr == 1) PG8_BAR;
        PG8_WAIT_V(4); PG8_BAR;
        PG8_STAGE(PG8_SB(1, 0), cB + kstep, voffB); PG8_STAGE(PG8_SA(1, 0), cA + kstep, voffA); PG8_STAGE(PG8_SB(1, 1), cB + hstepB + kstep, voffB);
        PG8_WAIT_V(6); PG8_BAR;
    }
    for (;;) {
        const bool has_next = S.next(ui + 1, nxt);
        const char* nA = has_next ? (const char*)g.A + (size_t)nxt.pm * tstepA : cA; const char* nB = has_next ? (const char*)g.Bt + (size_t)nxt.pn * tstepB : cB;
        for (int t = 0; t < nt; t += 2) {
            const bool last = (t == nt - 2);
            const char* a1 = cA + (size_t)(t + 1) * kstep;
            const char* a2 = last ? nA : cA + (size_t)(t + 2) * kstep; const char* b2 = last ? nB : cB + (size_t)(t + 2) * kstep;
            const char* a3 = a2 + kstep; const char* b3 = b2 + kstep;
            if constexpr (SP2) {
            PG8_LDB(B0, 0, 0); PG8_LDB(B1, 0, 1); PG8_SCHED; PG8_LDA(At, 0, 0); PG8_STAGE(PG8_SA(1, 1), a1 + hstepA, voffA);
            PG8_WAIT_V(8); PG8_WAIT_L(0); PG8_BAR; PG8_MMA(0, 0, At, B0); PG8_MMA(0, 1, At, B1); PG8_BAR; PG8_SCHED;
            PG8_LDA(At, 0, 1); PG8_STAGE(PG8_SB(0, 0), b2, voffB); PG8_STAGE(PG8_SB(0, 1), b2 + hstepB, voffB); PG8_STAGE(PG8_SA(0, 0), a2, voffA);
            PG8_WAIT_V(8); PG8_WAIT_L(0); PG8_BAR; PG8_MMA(1, 0, At, B0); PG8_MMA(1, 1, At, B1); PG8_BAR; PG8_SCHED;
            PG8_LDB(B0, 1, 0); PG8_LDB(B1, 1, 1); PG8_SCHED; PG8_LDA(At, 1, 0); PG8_STAGE(PG8_SA(0, 1), a2 + hstepA, voffA);
            PG8_WAIT_V(8); PG8_WAIT_L(0); PG8_BAR; PG8_MMA(0, 0, At, B0); PG8_MMA(0, 1, At, B1); PG8_BAR; PG8_SCHED;
            PG8_LDA(At, 1, 1); PG8_STAGE(PG8_SB(1, 0), b3, voffB); PG8_STAGE(PG8_SB(1, 1), b3 + hstepB, voffB); PG8_STAGE(PG8_SA(1, 0), a3, voffA);
            PG8_WAIT_V(8); PG8_WAIT_L(0); PG8_BAR; PG8_MMA(1, 0, At, B0); PG8_MMA(1, 1, At, B1); PG8_BAR; PG8_SCHED;
            } else {
            PG8_LDB(B0, 0, 0); PG8_SCHED; PG8_LDA(At, 0, 0); PG8_STAGE(PG8_SA(1, 1), a1 + hstepA, voffA);
            PG8_WAIT_L(8); PG8_BAR; PG8_WAIT_L(0); PG8_MMA(0, 0, At, B0); PG8_BAR; PG8_SCHED;
            PG8_LDB(B1, 0, 1); PG8_STAGE(PG8_SB(0, 0), b2, voffB);
            PG8_BAR; PG8_WAIT_L(0); PG8_MMA(0, 1, At, B1); PG8_BAR;
            PG8_LDA(At, 0, 1); PG8_STAGE(PG8_SA(0, 0), a2, voffA);
            PG8_BAR; PG8_WAIT_L(0); PG8_MMA(1, 0, At, B0); PG8_BAR; PG8_SCHED;
            PG8_STAGE(PG8_SB(0, 1), b2 + hstepB, voffB);
            PG8_WAIT_V(6); PG8_BAR; PG8_MMA(1, 1, At, B1); PG8_BAR;
            PG8_LDB(B0, 1, 0); PG8_SCHED; PG8_LDA(At, 1, 0); PG8_STAGE(PG8_SA(0, 1), a2 + hstepA, voffA);
            PG8_WAIT_L(8); PG8_BAR; PG8_WAIT_L(0); PG8_MMA(0, 0, At, B0); PG8_BAR; PG8_SCHED;
            PG8_LDB(B1, 1, 1); PG8_STAGE(PG8_SB(1, 0), b3, voffB);
            PG8_BAR; PG8_WAIT_L(0); PG8_MMA(0, 1, At, B1); PG8_BAR;
            PG8_LDA(At, 1, 1); PG8_STAGE(PG8_SA(1, 0), a3, voffA);
            PG8_BAR; PG8_WAIT_L(0); PG8_MMA(1, 0, At, B0); PG8_BAR; PG8_SCHED;
            PG8_STAGE(PG8_SB(1, 1), b3 + hstepB, voffB);
            PG8_WAIT_V(6); PG8_BAR; PG8_MMA(1, 1, At, B1); PG8_BAR;
            }
        }
        if constexpr (ALIGN_EPI) { if (wr == 0) PG8_BAR; }
        { const unsigned ln_ = __builtin_amdgcn_mbcnt_hi(~0u, __builtin_amdgcn_mbcnt_lo(~0u, 0u)); int efr = (int)(ln_ & 15u), efq = (int)(ln_ >> 4); asm volatile("" : "+v"(efr), "+v"(efq)); E(acc, cur, wr, wc, efr, efq); }
        if (!has_next) break;
#pragma unroll
        for (int a = 0; a < 2; ++a)
#pragma unroll
            for (int b = 0; b < 2; ++b)
#pragma unroll
                for (int m = 0; m < 4; ++m)
#pragma unroll
                    for (int n = 0; n < 2; ++n) acc[a][b][m][n] = (f32x4){0.f, 0.f, 0.f, 0.f};
        cur = nxt; cA = nA; cB = nB; ++ui;
        if constexpr (ALIGN_EPI) { if (wr == 1) PG8_BAR; }
    }
    PG8_WAIT_V(0);
    if constexpr (!ALIGN_EPI) { if (wr == 0) PG8_BAR; }
    PG8_BAR;
#undef PG8_SA
#undef PG8_SB
#undef PG8_STAGE
#undef PG8_LDA
#undef PG8_LDB
#undef PG8_MMA
#undef PG8_WAIT_V
#undef PG8_WAIT_L
#undef PG8_BAR
#undef PG8_SCHED
}

typedef f32x4 Acc[2][2][4][2];

__device__ __forceinline__ float row_rstd16(const float* SS, unsigned row, int fq) {
    const f32x4 a = *(const f32x4*)(SS + row * 16u + (unsigned)fq * 4u);
    float s = (a[0] + a[1]) + (a[2] + a[3]);
    s += __shfl_xor(s, 16); s += __shfl_xor(s, 32);
    return fast_rsq(s * (1.0f / 1024.0f) + NORM_EPS);
}
__device__ __forceinline__ u32x4 pack8(const f32x4 v0, const f32x4 v1) { u32x4 w; w.x = pack_bf16(v0[0], v0[1]); w.y = pack_bf16(v0[2], v0[3]); w.z = pack_bf16(v1[0], v1[1]); w.w = pack_bf16(v1[2], v1[3]); return w; }

#define EPI_SB __builtin_amdgcn_sched_barrier(0)
#define EPI_RSTD(rs, SS, rowbase) float rs[2][4]; _Pragma("unroll") for (int ai = 0; ai < 2; ++ai) _Pragma("unroll") for (int m = 0; m < 4; ++m) rs[ai][m] = row_rstd16(SS, (unsigned)((rowbase) + ai * HALF + m * 16), fq); EPI_SB;
struct EpiSwiGLU {
    static constexpr bool PERM = true;
    bf16_t* H; int ldh; const float* SS;
    __device__ __forceinline__ void operator()(const Acc& acc, const Unit& u, int wr, int wc, int fr, int fq) const {
        const int row0 = u.pm * BM + wr * 64 + fr, col0 = u.pn * HALF + wc * 32 + 8 * fq;
        EPI_RSTD(rs, SS, row0)
#pragma unroll
        for (int ai = 0; ai < 2; ++ai)
#pragma unroll
            for (int m = 0; m < 4; ++m) { const int row = row0 + ai * HALF + m * 16; const float r = rs[ai][m];
                f32x4 o[2];
#pragma unroll
                for (int n = 0; n < 2; ++n)
#pragma unroll
                    for (int e = 0; e < 4; ++e) o[n][e] = silu_f(r * acc[ai][0][m][n][e]) * (r * acc[ai][1][m][n][e]);
                *(u32x4*)(H + (unsigned)row * (unsigned)ldh + col0) = pack8(o[0], o[1]); EPI_SB; }
    }
};
struct EpiGLU {
    static constexpr bool PERM = true;
    bf16_t* Y; int ldy;
    __device__ __forceinline__ void operator()(const Acc& acc, const Unit& u, int wr, int wc, int fr, int fq) const {
        const int row0 = u.pm * BM + wr * 64 + fr, col0 = u.pn * HALF + wc * 32 + 8 * fq;
#pragma unroll
        for (int ai = 0; ai < 2; ++ai)
#pragma unroll
            for (int m = 0; m < 4; ++m) { const int row = row0 + ai * HALF + m * 16;
                f32x4 o[2];
#pragma unroll
                for (int n = 0; n < 2; ++n)
#pragma unroll
                    for (int e = 0; e < 4; ++e) o[n][e] = acc[ai][0][m][n][e] * sigmoid_f(acc[ai][1][m][n][e]);
                *(u32x4*)(Y + (unsigned)row * (unsigned)ldy + col0) = pack8(o[0], o[1]); EPI_SB; }
    }
};
struct EpiResid {
    static constexpr bool PERM = false;
    float* X; bf16_t* XB; float* SS; float scale;
    __device__ __forceinline__ void operator()(const Acc& acc, const Unit& u, int wr, int wc, int fr, int fq) const {
        const int row0 = u.pm * BM + wr * 64 + fr, col0 = u.pn * BM + wc * 32 + 4 * fq;
#pragma unroll
        for (int ai = 0; ai < 2; ++ai) {
#pragma unroll
            for (int m = 0; m < 4; ++m) { const int row = row0 + ai * HALF + m * 16; float ssq = 0.f;
#pragma unroll
                for (int bj = 0; bj < 2; ++bj)
#pragma unroll
                    for (int n = 0; n < 2; ++n) { const unsigned off = (unsigned)row * DM + col0 + bj * HALF + n * 16;
                        f32x4 xv = *(const f32x4*)(X + off); xv = xv + acc[ai][bj][m][n] * scale; *(f32x4*)(X + off) = xv;
                        u32x2 w; w.x = pack_bf16(xv[0], xv[1]); w.y = pack_bf16(xv[2], xv[3]); *(u32x2*)(XB + off) = w;
                        ssq += (xv[0] * xv[0] + xv[1] * xv[1]) + (xv[2] * xv[2] + xv[3] * xv[3]); }
                ssq += __shfl_xor(ssq, 16); ssq += __shfl_xor(ssq, 32);
                if (fq == 0) SS[(unsigned)row * 16 + u.pn * 4 + wc] = ssq; }
            EPI_SB; }
    }
};
struct EpiInA {
    static constexpr bool PERM = true;
    bf16_t* PA; bf16_t* U; float* MISCA; const float* SS;
    __device__ __forceinline__ void operator()(const Acc& acc, const Unit& u, int wr, int wc, int fr, int fq) const {
        const int row0 = u.pm * BM + wr * 64 + fr, tile = u.pn;
        EPI_RSTD(rs, SS, row0)
#pragma unroll
        for (int ai = 0; ai < 2; ++ai)
#pragma unroll
            for (int m = 0; m < 4; ++m) { const int row = row0 + ai * HALF + m * 16; const float r = rs[ai][m];
#pragma unroll
                for (int bj = 0; bj < 2; ++bj) { const int lc = bj * HALF + wc * 32 + 8 * fq; const f32x4 v0 = acc[ai][bj][m][0] * r, v1 = acc[ai][bj][m][1] * r;
                    if (tile < 13) *(u32x4*)(PA + (unsigned)row * PA_LD + tile * BM + lc) = pack8(v0, v1);
                    else if (tile < 15) { const int ch = (tile - 13) * BM + lc, grp = ch >> 4, k0 = ch & 15, chunk = row >> 4, tau = row & 15;
                        *(u32x4*)(U + ((unsigned)(grp * NCHUNK + chunk)) * U_LD + tau * 16 + k0) = pack8(v0, v1); }
                    else if (lc == 0) { *(f32x4*)(MISCA + (unsigned)row * 8) = v0; *(f32x4*)(MISCA + (unsigned)row * 8 + 4) = v1; } }
                EPI_SB; }
    }
};
struct EpiInB {
    static constexpr bool PERM = true;
    bf16_t* PB; float* MISCB; const float* SS;
    __device__ __forceinline__ void operator()(const Acc& acc, const Unit& u, int wr, int wc, int fr, int fq) const {
        const int row0 = u.pm * BM + wr * 64 + fr, tile = u.pn;
        EPI_RSTD(rs, SS, row0)
#pragma unroll
        for (int ai = 0; ai < 2; ++ai)
#pragma unroll
            for (int m = 0; m < 4; ++m) { const int row = row0 + ai * HALF + m * 16; const float r = rs[ai][m];
#pragma unroll
                for (int bj = 0; bj < 2; ++bj) { const int lc = bj * HALF + wc * 32 + 8 * fq; const f32x4 v0 = acc[ai][bj][m][0] * r, v1 = acc[ai][bj][m][1] * r;
                    if (tile < 7) *(u32x4*)(PB + (unsigned)row * PB_LD + tile * BM + lc) = pack8(v0, v1);
                    else if (bj == 0) { *(f32x4*)(MISCB + (unsigned)row * 128 + lc) = v0; *(f32x4*)(MISCB + (unsigned)row * 128 + lc + 4) = v1; } }
                EPI_SB; }
    }
};
struct EpiGate {
    static constexpr bool PERM = true;
    bf16_t* G; const float* SS;
    __device__ __forceinline__ void operator()(const Acc& acc, const Unit& u, int wr, int wc, int fr, int fq) const {
        const int lr0 = wr * 64 + fr;
        EPI_RSTD(rs, SS, u.pm * BM + lr0)
#pragma unroll
        for (int ai = 0; ai < 2; ++ai)
#pragma unroll
            for (int m = 0; m < 4; ++m) { const int lr = lr0 + ai * HALF + m * 16; const float r = rs[ai][m];
#pragma unroll
                for (int bj = 0; bj < 2; ++bj) { const int lc = bj * HALF + wc * 32 + 8 * fq; f32x4 v0, v1;
#pragma unroll
                    for (int e = 0; e < 4; ++e) { v0[e] = sigmoid_f(r * acc[ai][bj][m][0][e]); v1[e] = sigmoid_f(r * acc[ai][bj][m][1][e]); }
                    *(u32x4*)(G + lr * BM + lc) = pack8(v0, v1); }
                EPI_SB; }
    }
};
struct EpiBranch {
    static constexpr bool PERM = true;
    const bf16_t* G; bf16_t* MG; const float* SSA; int first;
    __device__ __forceinline__ void operator()(const Acc& acc, const Unit& u, int wr, int wc, int fr, int fq) const {
        const int lr0 = wr * 64 + fr;
        float rs[2][4];
#pragma unroll
        for (int ai = 0; ai < 2; ++ai)
#pragma unroll
            for (int m = 0; m < 4; ++m) { rs[ai][m] = 1.0f;
                if (SSA) { const unsigned row = (unsigned)(u.pm * BM + lr0 + ai * HALF + m * 16); const f32x4* p = (const f32x4*)(SSA + row * 8u); const f32x4 a = p[0], b = p[1];
                    rs[ai][m] = fast_rsq((((a[0] + a[1]) + (a[2] + a[3])) + ((b[0] + b[1]) + (b[2] + b[3]))) * (1.0f / 512.0f) + NORM_EPS); } }
        EPI_SB;
#pragma unroll
        for (int ai = 0; ai < 2; ++ai)
#pragma unroll
            for (int m = 0; m < 4; ++m) { const int lr = lr0 + ai * HALF + m * 16, row = u.pm * BM + lr; const float r = rs[ai][m];
#pragma unroll
                for (int bj = 0; bj < 2; ++bj) { const int lc = bj * HALF + wc * 32 + 8 * fq;
                    const u32x4 gw = *(const u32x4*)(G + lr * BM + lc); bf16_t* mp = MG + (unsigned)row * DM + u.pn * BM + lc;
                    u32x4 pw = (u32x4){0u, 0u, 0u, 0u}; if (!first) pw = *(const u32x4*)mp;
                    f32x4 v0, v1;
                    v0[0] = bflo(pw.x) + bflo(gw.x) * r * acc[ai][bj][m][0][0]; v0[1] = bfhi(pw.x) + bfhi(gw.x) * r * acc[ai][bj][m][0][1];
                    v0[2] = bflo(pw.y) + bflo(gw.y) * r * acc[ai][bj][m][0][2]; v0[3] = bfhi(pw.y) + bfhi(gw.y) * r * acc[ai][bj][m][0][3];
                    v1[0] = bflo(pw.z) + bflo(gw.z) * r * acc[ai][bj][m][1][0]; v1[1] = bfhi(pw.z) + bfhi(gw.z) * r * acc[ai][bj][m][1][1];
                    v1[2] = bflo(pw.w) + bflo(gw.w) * r * acc[ai][bj][m][1][2]; v1[3] = bfhi(pw.w) + bfhi(gw.w) * r * acc[ai][bj][m][1][3];
                    *(u32x4*)mp = pack8(v0, v1); }
                if (m & 1) EPI_SB; }
    }
};
struct EpiS5State {
    static constexpr bool PERM = false;
    float* SC;
    __device__ __forceinline__ void operator()(const Acc& acc, const Unit& u, int wr, int wc, int fr, int fq) const {
        const int row0 = u.pm * BM + wr * 64 + fr, col0 = wc * 32 + 4 * fq;
#pragma unroll
        for (int ai = 0; ai < 2; ++ai)
#pragma unroll
            for (int m = 0; m < 4; ++m) { const int row = row0 + ai * HALF + m * 16;
#pragma unroll
                for (int n = 0; n < 2; ++n) *(f32x4*)(SC + (unsigned)row * 128 + col0 + n * 16) = acc[ai][0][m][n]; }
    }
};
struct EpiS5Y {
    static constexpr bool PERM = true;
    bf16_t* S5Y;
    __device__ __forceinline__ void operator()(const Acc& acc, const Unit& u, int wr, int wc, int fr, int fq) const {
        const int row0 = u.pm * BM + wr * 64 + fr;
#pragma unroll
        for (int ai = 0; ai < 2; ++ai)
#pragma unroll
            for (int m = 0; m < 4; ++m) { const int grow = row0 + ai * HALF + m * 16, grp = grow / NCHUNK, chunk = grow % NCHUNK;
#pragma unroll
                for (int bj = 0; bj < 2; ++bj) { const int lc = bj * HALF + wc * 32 + 8 * fq, tau = lc >> 4, i0 = lc & 15; f32x4 v0, v1;
#pragma unroll
                    for (int e = 0; e < 4; ++e) { v0[e] = gelu_tanh_f(acc[ai][bj][m][0][e]); v1[e] = gelu_tanh_f(acc[ai][bj][m][1][e]); }
                    *(u32x4*)(S5Y + (unsigned)(chunk * 16 + tau) * 512 + grp * 16 + i0) = pack8(v0, v1); }
                EPI_SB; }
    }
};
#undef EPI_SB
#undef EPI_RSTD
}
enum { MAP_PLAIN = 0, MAP_IL2 = 1, MAP_INA = 2, MAP_INB = 3 };
struct CvtJob { const float* s0; const float* s1; const float* gain; bf16_t* dst; int ld, R, K, kind, half_off; };
__device__ __forceinline__ void cvt_map(const CvtJob& j, int r, const float*& base, int& col) {
    base = j.s0; col = r;
    if (j.kind == MAP_IL2) { const int pn = r >> 8, w = r & 255; if (w < 128) col = pn * 128 + w; else { base = j.s1; col = j.half_off + pn * 128 + (w - 128); } }
    else if (j.kind == MAP_INA) { if (r < 1280) col = r; else if (r < 3328) col = 3660 + (r - 1280); else if (r < 3840) col = 1288 + (r - 3328); else if (r < 3848) col = 1280 + (r - 3840); else base = nullptr; }
    else if (j.kind == MAP_INB) { if (r < 1792) col = 1800 + r; else if (r < 1860) col = 3592 + (r - 1792); else base = nullptr; }
}
__device__ __forceinline__ void cvt_run(LAS unsigned char* lds, const CvtJob& j, int bid, int nb, int& rot) {
    LAS float* tile = (LAS float*)lds;
    const int tid = tid_fresh(), ntk = j.K / 64, ntr = j.R / 64, ntiles = ntk * ntr;
    int first = (bid - rot % nb + nb) % nb;
    for (int t = first; t < ntiles; t += nb) {
        const int tr = t / ntk, tk = t % ntk, r0 = tr * 64, k0 = tk * 64;
        { const int rr = tid & 63; const float* base; int col; cvt_map(j, r0 + rr, base, col);
#pragma unroll
          for (int i = 0; i < 8; ++i) { const int kk = (tid >> 6) + 8 * i; float v = 0.f; if (base) v = base[(size_t)(k0 + kk) * j.ld + col]; if (j.gain) v *= j.gain[k0 + kk]; tile[kk * 65 + rr] = v; } }
        __syncthreads();
        { const int rr = tid >> 3, kc = (tid & 7) * 8; float v[8];
#pragma unroll
          for (int i = 0; i < 8; ++i) v[i] = tile[(kc + i) * 65 + rr];
          u32x4 w; w.x = pack_bf16(v[0], v[1]); w.y = pack_bf16(v[2], v[3]); w.z = pack_bf16(v[4], v[5]); w.w = pack_bf16(v[6], v[7]);
          *(u32x4*)(j.dst + (size_t)(r0 + rr) * j.K + k0 + kc) = w; }
        __syncthreads();
    }
    rot += ntiles;
}

__device__ __forceinline__ void s5_tables(LAS unsigned char* lds, int g, int part, const float* lam_re, const float* lam_im, const float* b_re, const float* b_im,
                          const float* c_re, const float* c_im, const float* dsk, const float* log_dt, bf16_t* TY, bf16_t* WST, float* AQ) {
    LAS float* ap_re = (LAS float*)lds;
    LAS float* ap_im = ap_re + 17 * 64;
    LAS float* bb_re = ap_im + 17 * 64;
    LAS float* bb_im = bb_re + 1024;
    LAS float* km = bb_im + 1024;
    const int tid = tid_fresh();
    const float step = fast_exp(log_dt[g]);
    for (int idx = tid; idx < 17 * 64; idx += 512) { const int m = idx / 64, p = idx % 64; const float lr = lam_re[g * 64 + p] * step, li = lam_im[g * 64 + p] * step;
        const float mag = fast_exp(lr * (float)m); float sn, cs; sincos_rev(li * (float)m, sn, cs); ap_re[idx] = mag * cs; ap_im[idx] = mag * sn; }
    __syncthreads();
    for (int idx = tid; idx < 1024; idx += 512) { const int p = idx / 16; const float lr = lam_re[g * 64 + p], li = lam_im[g * 64 + p], den = lr * lr + li * li;
        const float ar = ap_re[64 + p], ai = ap_im[64 + p];
        const float rden = fast_rcp(den); const float qr = ((ar - 1.0f) * lr + ai * li) * rden, qi = (ai * lr - (ar - 1.0f) * li) * rden;
        const float br = b_re[(size_t)g * 1024 + idx], bi = b_im[(size_t)g * 1024 + idx];
        bb_re[idx] = qr * br - qi * bi; bb_im[idx] = qr * bi + qi * br; }
    __syncthreads();
    for (int idx = tid; idx < 4096; idx += 512) { const int m = idx >> 8, i = (idx >> 4) & 15, k = idx & 15; float s = 0.f;
        for (int p = 0; p < 64; ++p) { const float cr = c_re[((size_t)g * 16 + i) * 64 + p], ci = c_im[((size_t)g * 16 + i) * 64 + p];
            const float wr_ = cr * ap_re[m * 64 + p] - ci * ap_im[m * 64 + p], wi_ = cr * ap_im[m * 64 + p] + ci * ap_re[m * 64 + p];
            s += wr_ * bb_re[p * 16 + k] - wi_ * bb_im[p * 16 + k]; }
        if (m == 0 && i == k) s += dsk[g * 16 + i];
        km[idx] = s; }
    __syncthreads();
    for (int idx = tid; idx < 32 * 384; idx += 512) { const int rr = part * 32 + idx / 384, cc = idx % 384, tau = rr >> 4, i = rr & 15; float v;
        if (cc < 256) { const int jj = cc >> 4, k = cc & 15; v = (jj <= tau) ? km[((tau - jj) << 8) + (i << 4) + k] : 0.f; }
        else { const int p = (cc - 256) & 63; const float cr = c_re[((size_t)g * 16 + i) * 64 + p], ci = c_im[((size_t)g * 16 + i) * 64 + p];
            const float ar = ap_re[(tau + 1) * 64 + p], ai = ap_im[(tau + 1) * 64 + p];
            v = (cc < 320) ? (cr * ar - ci * ai) : -(cr * ai + ci * ar); }
        TY[((size_t)g * 256 + rr) * 384 + cc] = f2bf(v); }
    for (int idx = tid; idx < 32 * 256; idx += 512) { const int rr = part * 32 + idx / 256, cc = idx % 256, jj = cc >> 4, k = cc & 15; float v = 0.f;
        if (rr < 128) { const int p = rr & 63; const float ar = ap_re[(15 - jj) * 64 + p], ai = ap_im[(15 - jj) * 64 + p], br = bb_re[p * 16 + k], bi = bb_im[p * 16 + k];
            v = (rr < 64) ? (ar * br - ai * bi) : (ar * bi + ai * br); }
        WST[((size_t)g * 256 + rr) * 256 + cc] = f2bf(v); }
    if (part == 0 && tid < 128) AQ[g * 128 + tid] = (tid < 64) ? ap_re[16 * 64 + tid] : ap_im[16 * 64 + (tid - 64)];
    __syncthreads();
}

__device__ __forceinline__ void x_prologue(const float* xin, float* X, bf16_t* XB, float* SS, int bid, int nb) {
    const int tid_ = tid_fresh(), wid = tid_ >> 6, lane = tid_ & 63;
    for (int row = bid * 8 + wid; row < T_TOK; row += nb * 8) {
        float ssq = 0.f;
#pragma unroll
        for (int i = 0; i < 4; ++i) { const size_t off = (size_t)row * DM + i * 256 + lane * 4; const f32x4 v = *(const f32x4*)(xin + off); *(f32x4*)(X + off) = v;
            u32x2 w; w.x = pack_bf16(v[0], v[1]); w.y = pack_bf16(v[2], v[3]); *(u32x2*)(XB + off) = w; ssq += (v[0] * v[0] + v[1] * v[1]) + (v[2] * v[2] + v[3] * v[3]); }
#pragma unroll
        for (int o = 32; o >= 1; o >>= 1) ssq += __shfl_xor(ssq, o);
        if (lane < 16) SS[(size_t)row * 16 + lane] = (lane == 0) ? ssq : 0.f;
    }
}
struct M2Params { const float* conv_w; const float* conv_b; const float* dt_bias; const float* a_log; const float* dskip; };
template <bool OUT>
__device__ __forceinline__ void m2_segment(LAS unsigned char* lds, int item, bf16_t* PA, const float* MISCA, float* ST, float* DEC, float* SSA, const M2Params P) {
    LAS float* xc = (LAS float*)lds;
    LAS float* Bc = xc + 4096;
    LAS float* Cc = Bc + 4096;
    LAS float* zs = Cc + 4096;
    LAS float* yo = zs + 4096;
    LAS float* dtl = yo + 4096;
    LAS float* dal = dtl + 64;
    const int tid = tid_fresh(), p = tid >> 3, nq = tid & 7;
    const int b = item >> 8, h = (item >> 5) & 7, seg = item & 31, grp = h >> 2;
    const int t_base = b * SEQ + seg * 256, tl_base = seg * 256;
    const float a_h = -fast_exp(P.a_log[h]), dtb = P.dt_bias[h], dsk = P.dskip[h];
    float hs[8];
#pragma unroll
    for (int j = 0; j < 8; ++j) hs[j] = OUT ? ST[(size_t)item * 4096 + p * 64 + nq * 8 + j] : 0.f;
    float dtsum = 0.f;
    for (int sub = 0; sub < 4; ++sub) {
        const int t0 = t_base + sub * 64, tl0 = tl_base + sub * 64;
        for (int idx = tid; idx < 4096; idx += 512) { const int tl = idx >> 6, ch = idx & 63, t = t0 + tl, tloc = tl0 + tl;
            const int cx = h * 64 + ch, cb = 512 + grp * 64 + ch, cc = 640 + grp * 64 + ch;
            float ax = P.conv_b[cx], ab = P.conv_b[cb], ac = P.conv_b[cc];
#pragma unroll
            for (int w = 0; w < 4; ++w) { if (tloc - 3 + w >= 0) { const bf16_t* rp = PA + (size_t)(t - 3 + w) * PA_LD + 512;
                ax += P.conv_w[w * 768 + cx] * bf2f(rp[cx]); ab += P.conv_w[w * 768 + cb] * bf2f(rp[cb]); if (OUT) ac += P.conv_w[w * 768 + cc] * bf2f(rp[cc]); } }
            xc[idx] = silu_f(ax); Bc[idx] = silu_f(ab);
            if (OUT) { Cc[idx] = silu_f(ac); zs[idx] = silu_f(bf2f(PA[(size_t)t * PA_LD + cx])); } }
        if (tid < 64) { const float dtv = softplus_f(MISCA[(size_t)(t0 + tid) * 8 + h] + dtb); dtl[tid] = dtv; dal[tid] = fast_exp(dtv * a_h); dtsum += dtv; }
        __syncthreads();
        for (int tl = 0; tl < 64; ++tl) {
            const float xv = xc[tl * 64 + p], dtx = dtl[tl] * xv, da = dal[tl];
            const f32x4 b0 = *(const LAS f32x4*)(Bc + tl * 64 + nq * 8), b1 = *(const LAS f32x4*)(Bc + tl * 64 + nq * 8 + 4);
#pragma unroll
            for (int j = 0; j < 4; ++j) { hs[j] = da * hs[j] + dtx * b0[j]; hs[4 + j] = da * hs[4 + j] + dtx * b1[j]; }
            if (OUT) {
                const f32x4 c0 = *(const LAS f32x4*)(Cc + tl * 64 + nq * 8), c1 = *(const LAS f32x4*)(Cc + tl * 64 + nq * 8 + 4);
                float y = 0.f;
#pragma unroll
                for (int j = 0; j < 4; ++j) y += c0[j] * hs[j] + c1[j] * hs[4 + j];
                y += __shfl_xor(y, 1); y += __shfl_xor(y, 2); y += __shfl_xor(y, 4);
                if (nq == 0) yo[tl * 64 + p] = (y + dsk * xv) * zs[tl * 64 + p];
            }
        }
        __syncthreads();
        if (OUT) {
            for (int idx = tid; idx < 4096; idx += 512) { const int tl = idx >> 6, ch = idx & 63; PA[(size_t)(t0 + tl) * PA_LD + h * 64 + ch] = f2bf(yo[idx]); }
            if (tid < 64) { float s = 0.f; for (int ch = 0; ch < 64; ++ch) { const float v = yo[tid * 64 + ((ch + tid) & 63)]; s += v * v; } SSA[(size_t)(t0 + tid) * 8 + h] = s; }
            __syncthreads();
        }
    }
    if (!OUT) {
#pragma unroll
        for (int j = 0; j < 8; ++j) ST[(size_t)item * 4096 + p * 64 + nq * 8 + j] = hs[j];
        if (tid < 64) {
#pragma unroll
            for (int o = 32; o >= 1; o >>= 1) dtsum += __shfl_xor(dtsum, o);
            if (tid == 0) DEC[item] = fast_exp(a_h * dtsum); }
    }
}
__device__ __forceinline__ void m2_scan(float* ST, const float* DEC, int e) {
    const int bh = e >> 12, pn = e & 4095; float s = 0.f;
    for (int seg = 0; seg < 32; ++seg) { const int item = bh * 32 + seg; const float he = ST[(size_t)item * 4096 + pn]; ST[(size_t)item * 4096 + pn] = s; s = DEC[item] * s + he; }
}

struct HgParams { const float* gamma0; const float* gamma1; const float* norm_g; int layer; };
template <bool OUT>
__device__ __forceinline__ void hg_segment(LAS unsigned char* lds, int item, bf16_t* PA, float* ST, float* DECK, const HgParams P) {
    LAS float* qs = (LAS float*)lds;
    LAS float* fg = qs + 4096;
    LAS float* kk = fg + 4096;
    LAS float* vv = kk + 4096;
    LAS float* op = vv + 4096;
    LAS float* lbl = op + 16384;
    const int tid = tid_fresh(), v = tid & 127, ks = tid >> 7, wid = tid >> 6, lane = tid & 63;
    const int b = item >> 7, hh = (item >> 5) & 3, seg = item & 31;
    const int t_base = b * SEQ + seg * 256;
    if (tid < 128) lbl[tid] = (P.layer == 0) ? 0.f : sigmoid_f(P.gamma1[hh * 128 + tid] - P.gamma0[hh * 128 + tid]);
    float S[32];
#pragma unroll
    for (int j = 0; j < 32; ++j) S[j] = OUT ? ST[(size_t)item * 16384 + (ks * 32 + j) * 128 + v] : 0.f;
    float dk = 1.0f;
    __syncthreads();
    for (int c = 0; c < 8; ++c) {
        const int t0 = t_base + c * 32;
        for (int idx = tid; idx < 4096; idx += 512) { const int tl = idx >> 7, k = idx & 127; const bf16_t* rp = PA + (size_t)(t0 + tl) * PA_LD + 1280 + hh * 128 + k;
            const float lb = lbl[k], sg = sigmoid_f(bf2f(rp[512]));
            fg[idx] = lb + (1.0f - lb) * sg; kk[idx] = (1.0f - lb) * (1.0f - sg); vv[idx] = bf2f(rp[1024]);
            if (OUT) qs[idx] = silu_f(bf2f(rp[0])); }
        __syncthreads();
        if (!OUT && tid < 128) { for (int tl = 0; tl < 32; ++tl) dk *= fg[tl * 128 + tid]; }
        for (int tl = 0; tl < 32; ++tl) {
            const float vval = vv[tl * 128 + v]; float o = 0.f;
#pragma unroll
            for (int j4 = 0; j4 < 8; ++j4) {
                const f32x4 f4 = *(const LAS f32x4*)(fg + tl * 128 + ks * 32 + j4 * 4), k4 = *(const LAS f32x4*)(kk + tl * 128 + ks * 32 + j4 * 4);
#pragma unroll
                for (int e = 0; e < 4; ++e) S[j4 * 4 + e] = f4[e] * S[j4 * 4 + e] + k4[e] * vval;
                if (OUT) { const f32x4 q4 = *(const LAS f32x4*)(qs + tl * 128 + ks * 32 + j4 * 4);
#pragma unroll
                    for (int e = 0; e < 4; ++e) o += q4[e] * S[j4 * 4 + e]; }
            }
            if (OUT) op[(tl * 4 + ks) * 128 + v] = o;
        }
        __syncthreads();
        if (OUT) {
            for (int tl = wid; tl < 32; tl += 8) {
                const float o0 = (op[(tl * 4 + 0) * 128 + lane] + op[(tl * 4 + 1) * 128 + lane]) + (op[(tl * 4 + 2) * 128 + lane] + op[(tl * 4 + 3) * 128 + lane]);
                const float o1 = (op[(tl * 4 + 0) * 128 + 64 + lane] + op[(tl * 4 + 1) * 128 + 64 + lane]) + (op[(tl * 4 + 2) * 128 + 64 + lane] + op[(tl * 4 + 3) * 128 + 64 + lane]);
                float ss = o0 * o0 + o1 * o1;
#pragma unroll
                for (int o = 32; o >= 1; o >>= 1) ss += __shfl_xor(ss, o);
                const float r = fast_rsq(ss * (1.0f / 128.0f) + NORM_EPS);
                bf16_t* gp = PA + (size_t)(t0 + tl) * PA_LD + 2816 + hh * 128;
                const float g0 = sigmoid_f(bf2f(gp[lane])), g1 = sigmoid_f(bf2f(gp[64 + lane]));
                gp[lane] = f2bf(o0 * r * P.norm_g[hh * 128 + lane] * g0); gp[64 + lane] = f2bf(o1 * r * P.norm_g[hh * 128 + 64 + lane] * g1);
            }
            __syncthreads();
        }
    }
    if (!OUT) {
#pragma unroll
        for (int j = 0; j < 32; ++j) ST[(size_t)item * 16384 + (ks * 32 + j) * 128 + v] = S[j];
        if (tid < 128) DECK[item * 128 + tid] = dk;
    }
}
__device__ __forceinline__ void hg_scan(float* ST, const float* DECK, int e) {
    const int bh = e >> 14, kv = e & 16383, k = kv >> 7; float s = 0.f;
    for (int seg = 0; seg < 32; ++seg) { const int item = bh * 32 + seg; const float se = ST[(size_t)item * 16384 + kv]; ST[(size_t)item * 16384 + kv] = s; s = DECK[item * 128 + k] * s + se; }
}

__device__ __forceinline__ void s5_scan(LAS unsigned char* lds, int bg, const float* SC, const float* AQ, bf16_t* U) {
    LAS float* Ere = (LAS float*)lds;
    LAS float* Eim = Ere + 512;
    const int tid = tid_fresh(), p = tid & 63, blk = tid >> 6, b = bg >> 5, g = bg & 31;
    const float ar = AQ[g * 128 + p], ai = AQ[g * 128 + 64 + p];
    const size_t row0 = (size_t)g * NCHUNK + b * 512 + blk * 64;
    float er = 0.f, ei = 0.f, pr = 1.f, pi = 0.f;
    for (int i0 = 0; i0 < 64; i0 += 8) { float xr[8], xi[8];
#pragma unroll
        for (int i = 0; i < 8; ++i) { xr[i] = SC[(row0 + i0 + i) * 128 + p]; xi[i] = SC[(row0 + i0 + i) * 128 + 64 + p]; }
#pragma unroll
        for (int i = 0; i < 8; ++i) { const float nr = ar * er - ai * ei + xr[i], ni = ar * ei + ai * er + xi[i]; er = nr; ei = ni; const float qr = ar * pr - ai * pi, qi = ar * pi + ai * pr; pr = qr; pi = qi; } }
    Ere[blk * 64 + p] = er; Eim[blk * 64 + p] = ei;
    __syncthreads();
    float sr = 0.f, si = 0.f;
    for (int bb = 0; bb < blk; ++bb) { const float nr = pr * sr - pi * si + Ere[bb * 64 + p], ni = pr * si + pi * sr + Eim[bb * 64 + p]; sr = nr; si = ni; }
    for (int i0 = 0; i0 < 64; i0 += 8) { float xr[8], xi[8];
#pragma unroll
        for (int i = 0; i < 8; ++i) { xr[i] = SC[(row0 + i0 + i) * 128 + p]; xi[i] = SC[(row0 + i0 + i) * 128 + 64 + p]; }
#pragma unroll
        for (int i = 0; i < 8; ++i) { bf16_t* up = U + (row0 + i0 + i) * U_LD + 256; up[p] = f2bf(sr); up[64 + p] = f2bf(si);
            const float nr = ar * sr - ai * si + xr[i], ni = ar * si + ai * sr + xi[i]; sr = nr; si = ni; } }
    __syncthreads();
}
__device__ __forceinline__ void dsa_prep(bf16_t* PB, const int* positions, const float* qn, const float* kn, int bid, int nb) {
    const int tid_ = tid_fresh(), wid = tid_ >> 6, lane = tid_ & 63, j = lane & 31, half = lane >> 5;
    const float inv_freq = fast_exp2(-(float)j * (13.287712379549449f / 32.0f));
    for (int tok = bid * 8 + wid; tok < T_TOK; tok += nb * 8) {
        const float ang = (float)positions[tok] * inv_freq; float sn, cs; sincos_rev(ang, sn, cs);
#pragma unroll
        for (int i = 0; i < 8; ++i) { const int vec = 2 * i + half; const bool isq = vec < 8;
            bf16_t* p = PB + (size_t)tok * PB_LD + (isq ? vec * 64 : 512 + (vec - 8) * 64);
            const float x1 = bf2f(p[j]), x2 = bf2f(p[j + 32]); float ss = x1 * x1 + x2 * x2;
#pragma unroll
            for (int o = 16; o >= 1; o >>= 1) ss += __shfl_xor(ss, o);
            const float r = fast_rsq(ss * (1.0f / 64.0f) + NORM_EPS); const float* gn = isq ? qn : kn;
            const float y1 = x1 * r * gn[j], y2 = x2 * r * gn[j + 32];
            float o1 = y1 * cs - y2 * sn, o2 = y2 * cs + y1 * sn;
            if (isq) { o1 *= 0.125f * 1.4426950408889634f; o2 *= 0.125f * 1.4426950408889634f; }
            p[j] = f2bf(o1); p[j + 32] = f2bf(o2); }
    }
}

constexpr int HS = 1025;
__device__ __forceinline__ bf16x8 cvt8(const f32x4 a, const f32x4 b) { u32x4 w; w.x = pack_bf16(a[0], a[1]); w.y = pack_bf16(a[2], a[3]); w.z = pack_bf16(b[0], b[1]); w.w = pack_bf16(b[2], b[3]); return __builtin_bit_cast(bf16x8, w); }
__device__ __forceinline__ void idx_scores(const float* KIb, int key0, const bf16x8 (&qf)[4][4], const float (&wsc)[4], float (&sc)[16], int lane) {
    const float* kp = KIb + (size_t)(key0 + (lane & 31)) * 128 + 8 * (lane >> 5);
    bf16x8 kf[4];
#pragma unroll
    for (int ks = 0; ks < 4; ++ks) kf[ks] = cvt8(*(const f32x4*)(kp + ks * 16), *(const f32x4*)(kp + ks * 16 + 4));
#pragma unroll
    for (int r = 0; r < 16; ++r) sc[r] = 0.f;
#pragma unroll
    for (int hd = 0; hd < 4; ++hd) { f32x16 d = {0.f, 0.f, 0.f, 0.f, 0.f, 0.f, 0.f, 0.f, 0.f, 0.f, 0.f, 0.f, 0.f, 0.f, 0.f, 0.f};
#pragma unroll
        for (int ks = 0; ks < 4; ++ks) d = __builtin_amdgcn_mfma_f32_32x32x16_bf16(kf[ks], qf[hd][ks], d, 0, 0, 0);
#pragma unroll
        for (int r = 0; r < 16; ++r) sc[r] += wsc[hd] * fmaxf(d[r], 0.f); }
}
__device__ __forceinline__ unsigned sk20_of(float s) { const unsigned u = __float_as_uint(s + 0.0f); const unsigned k = (u & 0x80000000u) ? ~u : (u | 0x80000000u); return k >> 12; }

__device__ __forceinline__ void dsa_topk_tile(LAS unsigned char* lds, int b, int qt, const bf16_t* PB, const float* MISCB, unsigned* MASK) {
    LAS unsigned* hist = (LAS unsigned*)lds;
    LAS unsigned* BND = hist + 32 * HS;
    LAS unsigned* NEED = BND + 96;
    const int tid = tid_fresh(), wid = __builtin_amdgcn_readfirstlane(tid >> 6), lane = tid & 63, qc = lane & 31, hl = lane >> 5;
    const int ql = qt * 32 + qc; const size_t row = (size_t)b * SEQ + ql;
    const float* KIb = MISCB + (size_t)b * SEQ * 128;
    bf16x8 qf[4][4]; float wsc[4];
#pragma unroll
    for (int hd = 0; hd < 4; ++hd) { wsc[hd] = MISCB[row * 128 + 64 + hd] * 0.0625f;
#pragma unroll
        for (int ks = 0; ks < 4; ++ks) qf[hd][ks] = *(const bf16x8*)(PB + row * PB_LD + 1536 + hd * 64 + ks * 16 + 8 * hl); }
    const int nkt = qt + 1;
    const bool full = qt < 8;
    unsigned b1 = 0, b2 = 0;
    if (!full) {
#pragma unroll 1
        for (int level = 0; level < 3; ++level) {
            for (int i = tid; i < 32 * HS; i += 512) hist[i] = 0u;
            if (level == 0 && tid < 32) NEED[tid] = 256u;
            __syncthreads();
            if (level >= 1) b1 = BND[qc]; if (level >= 2) b2 = BND[32 + qc];
#pragma unroll 1
            for (int kt = wid; kt < nkt; kt += 8) { float sc[16]; idx_scores(KIb, kt * 32, qf, wsc, sc, lane);
#pragma unroll
                for (int r = 0; r < 16; ++r) { const int key = kt * 32 + (r & 3) + 8 * (r >> 2) + 4 * hl; const unsigned sk = sk20_of(sc[r]), inv = 8191u - (unsigned)key;
                    const unsigned L1 = sk >> 9, L2 = ((sk & 511u) << 2) | (inv >> 11), L3 = inv & 2047u;
                    bool ok = key <= ql; unsigned bin = L1;
                    if (level == 1) { ok = ok && (L1 == b1); bin = L2; } else if (level == 2) { ok = ok && (L1 == b1) && (L2 == b2); bin = L3; }
                    if (ok) __hip_atomic_fetch_add(hist + qc * HS + (bin >> 1), 1u << (16 * (bin & 1u)), __ATOMIC_RELAXED, __HIP_MEMORY_SCOPE_WORKGROUP); } }
            __syncthreads();
#pragma unroll 1
            for (int qq = 0; qq < 4; ++qq) { const int q = wid * 4 + qq; const unsigned need = NEED[q];
                unsigned s = 0;
#pragma unroll
                for (int i = 0; i < 16; ++i) { const unsigned w = hist[q * HS + 1008 - 16 * lane + i]; s += (w & 0xffffu) + (w >> 16); }
                unsigned pre = s;
#pragma unroll
                for (int o = 1; o < 64; o <<= 1) { const unsigned t = __shfl_up(pre, o); if (lane >= o) pre += t; }
                const unsigned long long bal = __ballot(pre >= need);
                const int lstar = bal ? (int)__builtin_ctzll(bal) : 63;
                if (lane == lstar) { unsigned cum = pre - s, bb = 0, above = cum; bool found = false;
#pragma unroll 1
                    for (int i = 31; i >= 0; --i) { const int bin = 2016 - 32 * lane + i; const unsigned w = hist[q * HS + (bin >> 1)], c = (bin & 1) ? (w >> 16) : (w & 0xffffu);
                        if (!found && cum + c >= need) { found = true; bb = (unsigned)bin; above = cum; } cum += c; }
                    BND[level * 32 + q] = bb; NEED[q] = need - above; }
            }
            __syncthreads();
        }
    }
    unsigned thi = 0, tlo = 0;
    if (!full) { const unsigned c1 = BND[qc], c2 = BND[32 + qc], c3 = BND[64 + qc]; thi = (c1 << 9) | (c2 >> 2); tlo = ((c2 & 3u) << 11) | c3; }
#pragma unroll 1
    for (int kt = wid; kt < nkt; kt += 8) { float sc[16]; unsigned word = 0u;
        if (!full) idx_scores(KIb, kt * 32, qf, wsc, sc, lane);
#pragma unroll
        for (int r = 0; r < 16; ++r) { const int rho = (r & 3) + 8 * (r >> 2) + 4 * hl, key = kt * 32 + rho; bool sel = key <= ql;
            if (!full) { const unsigned sk = sk20_of(sc[r]), inv = 8191u - (unsigned)key; sel = sel && (sk > thi || (sk == thi && inv >= tlo)); }
            word |= (sel ? 1u : 0u) << rho; }
        word |= __shfl_xor(word, 32);
        if (hl == 0) MASK[row * 256 + kt] = word; }
    __syncthreads();
}

__device__ __forceinline__ void dsa_attn_item(LAS unsigned char* lds, int b, int hd, int qb, bf16_t* PB, const unsigned* MASK) {
    LAS bf16_t* Ks = (LAS bf16_t*)lds;
    LAS bf16_t* Vt = Ks + 64 * 72;
    const int tid = tid_fresh(), wid = __builtin_amdgcn_readfirstlane(tid >> 6), lane = tid & 63, qc = lane & 31, hl = lane >> 5;
    const int q0 = qb * 256 + wid * 32, ql = q0 + qc; const size_t row = (size_t)b * SEQ + ql;
    const int my_sb_max = q0 >> 5;
    bf16x8 qf[4];
#pragma unroll
    for (int ks = 0; ks < 4; ++ks) qf[ks] = *(const bf16x8*)(PB + row * PB_LD + hd * 64 + ks * 16 + 8 * hl);
    f32x16 o0, o1;
#pragma unroll
    for (int r = 0; r < 16; ++r) { o0[r] = 0.f; o1[r] = 0.f; }
    float m = -1e30f, l = 0.f;
    const int nkt = 4 * (qb + 1);
    const int skey = tid >> 3, sd = (tid & 7) * 8;
    const int k16 = skey & 15, spos = (skey & ~15) + ((k16 >> 2) & 1) * 8 + (k16 >> 3) * 4 + (k16 & 3);
    for (int kt = 0; kt < nkt; ++kt) {
        { const bf16_t* kp = PB + ((size_t)b * SEQ + kt * 64 + skey) * PB_LD + 512 + hd * 64 + sd;
          const u32x4 kw = *(const u32x4*)kp, vw = *(const u32x4*)(kp + 512);
          *(LAS u32x4*)(Ks + skey * 72 + sd) = kw;
          Vt[(sd + 0) * 72 + spos] = (bf16_t)(vw.x & 0xffffu); Vt[(sd + 1) * 72 + spos] = (bf16_t)(vw.x >> 16);
          Vt[(sd + 2) * 72 + spos] = (bf16_t)(vw.y & 0xffffu); Vt[(sd + 3) * 72 + spos] = (bf16_t)(vw.y >> 16);
          Vt[(sd + 4) * 72 + spos] = (bf16_t)(vw.z & 0xffffu); Vt[(sd + 5) * 72 + spos] = (bf16_t)(vw.z >> 16);
          Vt[(sd + 6) * 72 + spos] = (bf16_t)(vw.w & 0xffffu); Vt[(sd + 7) * 72 + spos] = (bf16_t)(vw.w >> 16); }
        __syncthreads();
        if (2 * kt <= my_sb_max) {
            f32x16 s[2]; unsigned mw[2];
#pragma unroll
            for (int sbi = 0; sbi < 2; ++sbi) { const int sb = 2 * kt + sbi;
#pragma unroll
                for (int r = 0; r < 16; ++r) s[sbi][r] = 0.f;
                mw[sbi] = 0u;
                if (sb <= my_sb_max) {
                    mw[sbi] = MASK[row * 256 + sb];
#pragma unroll
                    for (int ks = 0; ks < 4; ++ks) { const bf16x8 kf = *(const LAS bf16x8*)(Ks + (sbi * 32 + qc) * 72 + ks * 16 + 8 * hl);
                        s[sbi] = __builtin_amdgcn_mfma_f32_32x32x16_bf16(kf, qf[ks], s[sbi], 0, 0, 0); } } }
            float mx = -1e30f;
#pragma unroll
            for (int sbi = 0; sbi < 2; ++sbi)
#pragma unroll
                for (int r = 0; r < 16; ++r) { const int rho = (r & 3) + 8 * (r >> 2) + 4 * hl; if ((mw[sbi] >> rho) & 1u) mx = fmaxf(mx, s[sbi][r]); }
            mx = fmaxf(mx, __shfl_xor(mx, 32));
            const float mn = fmaxf(m, mx), alpha = fast_exp2(m - mn); m = mn;
            float ps = 0.f; bf16x8 pf[2][2];
#pragma unroll
            for (int sbi = 0; sbi < 2; ++sbi) { float pv[16];
#pragma unroll
                for (int r = 0; r < 16; ++r) { const int rho = (r & 3) + 8 * (r >> 2) + 4 * hl; const float p = ((mw[sbi] >> rho) & 1u) ? fast_exp2(s[sbi][r] - mn) : 0.f; pv[r] = p; ps += p; }
#pragma unroll
                for (int s2 = 0; s2 < 2; ++s2) { u32x4 w; w.x = pack_bf16(pv[8 * s2 + 0], pv[8 * s2 + 1]); w.y = pack_bf16(pv[8 * s2 + 2], pv[8 * s2 + 3]);
                    w.z = pack_bf16(pv[8 * s2 + 4], pv[8 * s2 + 5]); w.w = pack_bf16(pv[8 * s2 + 6], pv[8 * s2 + 7]); pf[sbi][s2] = __builtin_bit_cast(bf16x8, w); } }
            l = l * alpha + ps;
#pragma unroll
            for (int r = 0; r < 16; ++r) { o0[r] *= alpha; o1[r] *= alpha; }
#pragma unroll
            for (int sbi = 0; sbi < 2; ++sbi)
#pragma unroll
                for (int s2 = 0; s2 < 2; ++s2) { const int kofs = sbi * 32 + s2 * 16 + hl * 8;
                    const bf16x8 v0 = *(const LAS bf16x8*)(Vt + qc * 72 + kofs), v1 = *(const LAS bf16x8*)(Vt + (32 + qc) * 72 + kofs);
                    o0 = __builtin_amdgcn_mfma_f32_32x32x16_bf16(v0, pf[sbi][s2], o0, 0, 0, 0);
                    o1 = __builtin_amdgcn_mfma_f32_32x32x16_bf16(v1, pf[sbi][s2], o1, 0, 0, 0); }
        }
        __syncthreads();
    }
    l += __shfl_xor(l, 32);
    const float inv = fast_rcp(l);
    bf16_t* op = PB + row * PB_LD + hd * 64;
#pragma unroll
    for (int r4 = 0; r4 < 4; ++r4) { const int d = 8 * r4 + 4 * hl;
        u32x2 w0, w1; w0.x = pack_bf16(o0[4 * r4] * inv, o0[4 * r4 + 1] * inv); w0.y = pack_bf16(o0[4 * r4 + 2] * inv, o0[4 * r4 + 3] * inv);
        w1.x = pack_bf16(o1[4 * r4] * inv, o1[4 * r4 + 1] * inv); w1.y = pack_bf16(o1[4 * r4 + 2] * inv, o1[4 * r4 + 3] * inv);
        *(u32x2*)(op + d) = w0; *(u32x2*)(op + 32 + d) = w1; }
}
constexpr size_t MiB = 1u << 20;
constexpr size_t OFF_CTL = 0, OFF_AQ = 4096, OFF_DEC = 65536, OFF_DECK = 131072;
constexpr size_t OFF_SS = 1 * MiB, OFF_XB = 2 * MiB, OFF_RW = 34 * MiB, OFF_RA = 70 * MiB, OFF_RB = 174 * MiB, WS_NEED = 272 * MiB;
constexpr size_t W_GLU = 0, W_E13 = 1 * MiB, W_E2 = 12 * MiB, W_EINA = 17 * MiB + 512 * 1024, W_ETY = 25 * MiB + 512 * 1024, W_EWST = 31 * MiB + 512 * 1024;
constexpr size_t W_LINB = 1 * MiB, W_LG = 5 * MiB, W_LB = 13 * MiB, W_LO = 17 * MiB, W_L13 = 19 * MiB, W_L2 = 30 * MiB;
constexpr size_t A_H1 = 0, A_PA = 0, A_PB = 0, A_MISCB = 56 * MiB, A_MASK = 64 * MiB;
constexpr size_t B_U = 0, B_SC = 24 * MiB, B_S5Y = 40 * MiB, B_M2ST = 56 * MiB, B_HGST = 64 * MiB, B_MISCA = 80 * MiB, B_SSA = 81 * MiB, B_YB = 82 * MiB;
constexpr size_t B_GSCR = 0, B_MERGED = 32 * MiB;
constexpr int LDS_BYTES = 160 * 1024;
constexpr int NPH_LAYER = 16;
#ifndef SUBMASK
#define SUBMASK 0xffu
#endif
#ifndef PHMASK
#define PHMASK 0xffffu
#endif

struct Args { const void* in[34]; float* out; unsigned char* ws; int ph_lo, ph_hi; };

__global__ void __launch_bounds__(512) hybrid_fwd(Args a) {
    cg::grid_group grid = cg::this_grid();
    extern __shared__ __attribute__((aligned(16))) unsigned char lds_raw[];
    LAS unsigned char* lds = (LAS unsigned char*)lds_raw;
    const int ph_lo = a.ph_lo, ph_hi = a.ph_hi;
    tid_tab_init();
    for (int ph = ph_lo; ph < ph_hi; ++ph) {
    typedef const __attribute__((address_space(4))) Args* KArgsPtr;
    KArgsPtr kargs = (KArgsPtr)__builtin_amdgcn_kernarg_segment_ptr();
    asm volatile("" : "+s"(kargs));
#define A (*kargs)
    unsigned char* ws = A.ws;
    const int bid = sgpr_fresh(blockIdx.x), nb = sgpr_fresh(gridDim.x), tid = tid_fresh();
#define X ((float*)A.out)
#define SS ((float*)(ws + OFF_SS))
#define XB ((bf16_t*)(ws + OFF_XB))
#define RW (ws + OFF_RW)
#define RA (ws + OFF_RA)
#define RB (ws + OFF_RB)
#define AQ ((float*)(ws + OFF_AQ))
#define DEC ((float*)(ws + OFF_DEC))
#define DECK ((float*)(ws + OFF_DECK))
#define H1 ((bf16_t*)(RA + A_H1))
#define PA ((bf16_t*)(RA + A_PA))
#define PB ((bf16_t*)(RA + A_PB))
#define MISCB ((float*)(RA + A_MISCB))
#define MASK ((unsigned*)(RA + A_MASK))
#define U ((bf16_t*)(RB + B_U))
#define SC ((float*)(RB + B_SC))
#define S5Y ((bf16_t*)(RB + B_S5Y))
#define M2ST ((float*)(RB + B_M2ST))
#define HGST ((float*)(RB + B_HGST))
#define MISCA ((float*)(RB + B_MISCA))
#define SSA ((float*)(RB + B_SSA))
#define YB ((bf16_t*)(RB + B_YB))
#define GSCR ((bf16_t*)(RB + B_GSCR) + (size_t)bid * 65536)
#define MERGED ((bf16_t*)(RB + B_MERGED))
    {
        const int l = ph / NPH_LAYER, sp = ph % NPH_LAYER;
#define INF(i, per) (((const float*)A.in[i]) + (size_t)l * (per))
        switch (sp) {
        case 0: if constexpr (PHMASK & (1u<<0)) {
            int rot = 0; CvtJob j;
            j = CvtJob{INF(3, DM * DFF), INF(4, DM * DFF), INF(2, DM), (bf16_t*)(RW + W_E13), DFF, 2 * DFF, DM, MAP_IL2, 0}; cvt_run(lds, j, bid, nb, rot);
            j = CvtJob{INF(5, DFF * DM), nullptr, nullptr, (bf16_t*)(RW + W_E2), DM, DM, DFF, MAP_PLAIN, 0}; cvt_run(lds, j, bid, nb, rot);
            j = CvtJob{INF(7, DM * DIN), nullptr, INF(6, DM), (bf16_t*)(RW + W_EINA), DIN, 4096, DM, MAP_INA, 0}; cvt_run(lds, j, bid, nb, rot);
            j = CvtJob{INF(25, 512 * 1024), INF(25, 512 * 1024), nullptr, (bf16_t*)(RW + W_GLU), 1024, 1024, 512, MAP_IL2, 512}; cvt_run(lds, j, bid, nb, rot);
            for (int it = bid; it < 256; it += nb) s5_tables(lds, it >> 3, it & 7, INF(17, 2048), INF(18, 2048), INF(19, 32768), INF(20, 32768), INF(21, 32768), INF(22, 32768), INF(23, 512), INF(24, 32),
                                                             (bf16_t*)(RW + W_ETY), (bf16_t*)(RW + W_EWST), AQ);
            if (l == 0) x_prologue((const float*)A.in[0], X, XB, SS, bid, nb);
        } break;
        case 1: case 14: if constexpr (PHMASK & (1u<<1)) {
            pg8::Gemm g{XB, (const bf16_t*)(RW + (sp == 1 ? W_E13 : W_L13)), DM, DM, DM}; pg8::StaticOrder S; S.init(64, 22, nb, bid);
            pg8::EpiSwiGLU E{H1, DFF, SS}; pg8::gemm_phase<pg8::EpiSwiGLU, pg8::StaticOrder, true, true>(lds, g, S, E);
        } break;
        case 2: case 15: if constexpr (PHMASK & (1u<<2)) {
            pg8::Gemm g{H1, (const bf16_t*)(RW + (sp == 2 ? W_E2 : W_L2)), DFF, DFF, DFF}; pg8::StaticOrder S; S.init(64, 4, nb, bid);
            pg8::EpiResid E{X, XB, SS, 0.5f}; pg8::gemm_phase<pg8::EpiResid, pg8::StaticOrder, true, true>(lds, g, S, E);
        } break;
        case 3: if constexpr (PHMASK & (1u<<3)) {
            pg8::Gemm g{XB, (const bf16_t*)(RW + W_EINA), DM, DM, DM}; pg8::StaticOrder S; S.init(64, 16, nb, bid);
            pg8::EpiInA E{PA, U, MISCA, SS}; pg8::gemm_phase<pg8::EpiInA, pg8::StaticOrder, true, true>(lds, g, S, E);
        } break;
        case 4: if constexpr (PHMASK & (1u<<4)) {
            { pg8::Gemm g{U, (const bf16_t*)(RW + W_EWST), U_LD, 256, 256}; pg8::GroupOrder S; S.init(32, 4, 1, nb, bid);
              pg8::EpiS5State E{SC}; pg8::gemm_phase<pg8::EpiS5State, pg8::GroupOrder, true, true>(lds, g, S, E); }
            { const HgParams hp{(const float*)A.in[28], (const float*)A.in[28] + 512, INF(29, 512), l};
              for (int it = bid; it < 256; it += nb) hg_segment<false>(lds, it, PA, HGST, DECK, hp); }
            { const M2Params mp{INF(11, 4 * 768), INF(12, 768), INF(13, 8), INF(14, 8), INF(15, 8)};
              for (int it = bid; it < 512; it += nb) m2_segment<false>(lds, it, PA, MISCA, M2ST, DEC, SSA, mp); }
        } break;
        case 5: if constexpr (PHMASK & (1u<<5)) {
            for (int it = bid; it < 64; it += nb) s5_scan(lds, it, SC, AQ, U);
            for (int e = bid * 512 + tid; e < 131072; e += nb * 512) hg_scan(HGST, DECK, e);
            for (int e = (nb - 1 - bid) * 512 + tid; e < 65536; e += nb * 512) m2_scan(M2ST, DEC, e);
        } break;
        case 6: if constexpr (PHMASK & (1u<<6)) {
            if constexpr (SUBMASK & 4) { pg8::Gemm g{U, (const bf16_t*)(RW + W_ETY), U_LD, U_LD, U_LD}; pg8::GroupOrder S; S.init(32, 4, 1, nb, bid);
              pg8::EpiS5Y E{S5Y}; pg8::gemm_phase<pg8::EpiS5Y, pg8::GroupOrder, true, true>(lds, g, S, E); }
            if constexpr (SUBMASK & 2) { const HgParams hp{(const float*)A.in[28], (const float*)A.in[28] + 512, INF(29, 512), l};
              for (int it = bid; it < 256; it += nb) hg_segment<true>(lds, it, PA, HGST, DECK, hp); }
            if constexpr (SUBMASK & 1) { const M2Params mp{INF(11, 4 * 768), INF(12, 768), INF(13, 8), INF(14, 8), INF(15, 8)};
              for (int it = bid; it < 512; it += nb) m2_segment<true>(lds, it, PA, MISCA, M2ST, DEC, SSA, mp); }
        } break;
        case 7: if constexpr (PHMASK & (1u<<7)) {
            { pg8::Gemm g{S5Y, (const bf16_t*)(RW + W_GLU), 512, 512, 512}; pg8::StaticOrder S; S.init(64, 4, nb, bid);
              pg8::EpiGLU E{YB, 512}; pg8::gemm_phase<pg8::EpiGLU, pg8::StaticOrder, true, true>(lds, g, S, E); }
            int rot = 0; CvtJob j;
            j = CvtJob{INF(7, DM * DIN), nullptr, INF(6, DM), (bf16_t*)(RW + W_LINB), DIN, 2048, DM, MAP_INB, 0}; cvt_run(lds, j, bid, nb, rot);
            j = CvtJob{INF(8, DM * 4096), nullptr, INF(6, DM), (bf16_t*)(RW + W_LG), 4096, 4096, DM, MAP_PLAIN, 0}; cvt_run(lds, j, bid, nb, rot);
            for (int gi = 0; gi < 4; ++gi) { j = CvtJob{INF(9, 4 * 512 * 1024) + (size_t)gi * 512 * 1024, nullptr, gi == 0 ? INF(16, 512) : nullptr, (bf16_t*)(RW + W_LB) + (size_t)gi * 1024 * 512, 1024, 1024, 512, MAP_PLAIN, 0}; cvt_run(lds, j, bid, nb, rot); }
            j = CvtJob{INF(10, DM * DM), nullptr, nullptr, (bf16_t*)(RW + W_LO), DM, DM, DM, MAP_PLAIN, 0}; cvt_run(lds, j, bid, nb, rot);
            j = CvtJob{INF(31, DM * DFF), INF(32, DM * DFF), INF(30, DM), (bf16_t*)(RW + W_L13), DFF, 2 * DFF, DM, MAP_IL2, 0}; cvt_run(lds, j, bid, nb, rot);
            j = CvtJob{INF(33, DFF * DM), nullptr, nullptr, (bf16_t*)(RW + W_L2), DM, DM, DFF, MAP_PLAIN, 0}; cvt_run(lds, j, bid, nb, rot);
        } break;
        case 8: case 12: if constexpr (PHMASK & (1u<<8)) {
            pg8::StaticOrder S; S.init(64, 4, nb, bid);
            for (int gi = 0; gi < 4; ++gi) { if ((sp == 8) == (gi == 2)) continue;
                { pg8::Gemm g{XB, (const bf16_t*)(RW + W_LG) + (size_t)gi * 1024 * 1024, DM, DM, DM}; pg8::EpiGate E{GSCR, SS}; pg8::gemm_phase<pg8::EpiGate, pg8::StaticOrder, true, true>(lds, g, S, E); }
                const bf16_t* Ag = gi == 0 ? PA : gi == 1 ? YB : gi == 2 ? PB : PA + 2816; const int lda = gi == 1 ? 512 : gi == 2 ? PB_LD : PA_LD;
                { pg8::Gemm g{Ag, (const bf16_t*)(RW + W_LB) + (size_t)gi * 1024 * 512, lda, 512, 512}; pg8::EpiBranch E{GSCR, MERGED, gi == 0 ? SSA : nullptr, gi == 0 ? 1 : 0};
                  pg8::gemm_phase<pg8::EpiBranch, pg8::StaticOrder, true, true>(lds, g, S, E); } }
        } break;
        case 9: if constexpr (PHMASK & (1u<<9)) {
            pg8::Gemm g{XB, (const bf16_t*)(RW + W_LINB), DM, DM, DM}; pg8::StaticOrder S; S.init(64, 8, nb, bid);
            pg8::EpiInB E{PB, MISCB, SS}; pg8::gemm_phase<pg8::EpiInB, pg8::StaticOrder, true, true>(lds, g, S, E);
        } break;
        case 10: if constexpr (PHMASK & (1u<<10)) {
            if constexpr (SUBMASK & 1) dsa_prep(PB, (const int*)A.in[1], INF(26, 64), INF(27, 64), bid, nb);
            if constexpr (SUBMASK & 2) for (int it = bid; it < 512; it += nb) { const int c = it & 255, bb = it >> 8; dsa_topk_tile(lds, bb, bb == 0 ? c : 255 - c, PB, MISCB, MASK); }
        } break;
        case 11: if constexpr (PHMASK & (1u<<11)) {
            for (int it = bid; it < 512; it += nb) { const int c = it & 255, second = it >> 8, bb = c >> 7, hd = (c >> 4) & 7, jq = c & 15; dsa_attn_item(lds, bb, hd, second ? 31 - jq : jq, PB, MASK); }
        } break;
        case 13: if constexpr (PHMASK & (1u<<13)) {
            pg8::Gemm g{MERGED, (const bf16_t*)(RW + W_LO), DM, DM, DM}; pg8::StaticOrder S; S.init(64, 4, nb, bid);
            pg8::EpiResid E{X, XB, SS, 1.0f}; pg8::gemm_phase<pg8::EpiResid, pg8::StaticOrder, true, true>(lds, g, S, E);
        } break;
        }
#undef INF
        if (ph + 1 < ph_hi) grid.sync();
    }
    }
}

extern "C" void kernel_launch(void* const* d_in, const int* in_sizes, int n_in, void* d_out, int out_size, void* d_ws, size_t ws_size, hipStream_t stream) {
    static int grid_blocks = 0;
    if (!grid_blocks) {
        int dev = 0, cus = 0, per_cu = 0;
        hipGetDevice(&dev);
        hipDeviceGetAttribute(&cus, hipDeviceAttributeMultiprocessorCount, dev);
        hipFuncSetAttribute((const void*)hybrid_fwd, hipFuncAttributeMaxDynamicSharedMemorySize, LDS_BYTES);
        hipOccupancyMaxActiveBlocksPerMultiprocessor(&per_cu, hybrid_fwd, 512, LDS_BYTES);
        if (per_cu < 1) { fprintf(stderr, "occupancy query returned %d\n", per_cu); per_cu = 1; }
        grid_blocks = cus * 1;
        if (grid_blocks > 256) grid_blocks = 256;
        fprintf(stderr, "grid_blocks=%d cus=%d per_cu=%d ws_size=%zu need=%zu\n", grid_blocks, cus, per_cu, ws_size, (size_t)WS_NEED);
    }
    if (ws_size < WS_NEED || n_in < 34) { fprintf(stderr, "workspace too small or bad inputs\n"); return; }
    Args a{};
    for (int i = 0; i < 34; ++i) a.in[i] = d_in[i];
    a.out = (float*)d_out; a.ws = (unsigned char*)d_ws; a.ph_lo = 0; a.ph_hi = NLAYER * NPH_LAYER;
    void* args[] = {&a};
    hipError_t e = hipLaunchCooperativeKernel((void*)hybrid_fwd, dim3(grid_blocks), dim3(512), args, LDS_BYTES, stream);
    if (e != hipSuccess) fprintf(stderr, "cooperative launch failed: %s (grid %d)\n", hipGetErrorString(e), grid_blocks);
}
```

```cpp
#include <hip/hip_runtime.h>
#include <hip/hip_cooperative_groups.h>
#include <cstdio>
#include <cstdint>
namespace cg = cooperative_groups;

#define LAS __attribute__((address_space(3)))
typedef unsigned short bf16_t;
typedef short bf16x8 __attribute__((ext_vector_type(8)));
typedef float f32x4 __attribute__((ext_vector_type(4)));
typedef float f32x16 __attribute__((ext_vector_type(16)));
typedef unsigned u32x4 __attribute__((ext_vector_type(4)));
typedef unsigned u32x2 __attribute__((ext_vector_type(2)));

constexpr int T_TOK = 16384, SEQ = 8192, DM = 1024, DFF = 2816, DIN = 5708, NLAYER = 2;
constexpr float NORM_EPS = 1e-6f;
constexpr int PA_LD = 3328;
constexpr int PB_LD = 1792;
constexpr int U_LD = 384;
constexpr int S5Q = 16;
constexpr int NCHUNK = T_TOK / S5Q;

typedef __bf16 hwbf2 __attribute__((ext_vector_type(2)));
typedef float f32x2_t __attribute__((ext_vector_type(2)));
__device__ __forceinline__ unsigned pack_bf16(float lo, float hi) { const f32x2_t v = {lo, hi}; return __builtin_bit_cast(unsigned, __builtin_convertvector(v, hwbf2)); }
__device__ __forceinline__ bf16_t f2bf(float f) { return (bf16_t)(pack_bf16(f, 0.f) & 0xffffu); }
__device__ __forceinline__ float bf2f(bf16_t h) { return __uint_as_float(((unsigned)h) << 16); }
__device__ __forceinline__ float bflo(unsigned w) { return __uint_as_float(w << 16); }
__device__ __forceinline__ float bfhi(unsigned w) { return __uint_as_float(w & 0xffff0000u); }
__device__ __forceinline__ float fast_exp2(float x) { return __builtin_amdgcn_exp2f(x); }
__device__ __forceinline__ float fast_rcp(float x) { return __builtin_amdgcn_rcpf(x); }
__device__ __forceinline__ float sigmoid_f(float x) { return fast_rcp(1.0f + fast_exp2(-1.4426950408889634f * x)); }
__device__ __forceinline__ float silu_f(float x) { return x * sigmoid_f(x); }
__device__ __forceinline__ float gelu_tanh_f(float x) { const float u = 0.7978845608028654f * (x + 0.044715f * x * x * x); return x * sigmoid_f(2.0f * u); }
__device__ __forceinline__ float fast_exp(float x) { return __builtin_amdgcn_exp2f(1.4426950408889634f * x); }
__device__ __forceinline__ float fast_rsq(float x) { return __builtin_amdgcn_rsqf(x); }
__device__ __forceinline__ float softplus_f(float x) {
    if (x > 20.f) return x;
    const float e = fast_exp(x);
    if (e < 0.03125f) return e * (1.0f - e * (0.5f - e * (0.33333333f - 0.25f * e)));
    return 0.6931471805599453f * __builtin_amdgcn_logf(1.0f + e);
}
__device__ __forceinline__ void sincos_rev(float ang, float& sn, float& cs) {
    double rd = (double)ang * 0.15915494309189535; rd -= __builtin_floor(rd);
    const float r = (float)rd; sn = __builtin_amdgcn_sinf(r); cs = __builtin_amdgcn_cosf(r);
}
constexpr int TID_TAB_OFF = 160 * 1024 - 256;
__device__ __forceinline__ unsigned hw_wave_slot() { return __builtin_amdgcn_s_getreg((5 << 11) | 4) & 63u; }
__device__ __forceinline__ void tid_tab_init() { ((LAS int*)(LAS char*)TID_TAB_OFF)[hw_wave_slot()] = (int)(threadIdx.x >> 6); __syncthreads(); }
__device__ __forceinline__ int tid_fresh() {
    unsigned off = (unsigned)TID_TAB_OFF + hw_wave_slot() * 4u; asm volatile("" : "+s"(off));
    const int w = *(const LAS int*)(LAS char*)(uintptr_t)off;
    int t = w * 64 + (int)__builtin_amdgcn_mbcnt_hi(~0u, __builtin_amdgcn_mbcnt_lo(~0u, 0u)); asm volatile("" : "+v"(t)); return t; }
__device__ __forceinline__ int sgpr_fresh(int v) { asm volatile("" : "+s"(v)); return v; }
template <int M> __device__ __forceinline__ float swz_xor(float x) { return __builtin_bit_cast(float, __builtin_amdgcn_ds_swizzle(__builtin_bit_cast(int, x), (M << 10) | 0x1f)); }
__device__ __forceinline__ void swap32(unsigned u, unsigned& r0, unsigned& r1) { const auto r = __builtin_amdgcn_permlane32_swap(u, u, false, false); r0 = r[0]; r1 = r[1]; asm volatile("" : "+v"(r0), "+v"(r1)); }
__device__ __forceinline__ float sum32(float x) { unsigned r0, r1; swap32(__builtin_bit_cast(unsigned, x), r0, r1); return __builtin_bit_cast(float, r0) + __builtin_bit_cast(float, r1); }
__device__ __forceinline__ float max32(float x) { unsigned r0, r1; swap32(__builtin_bit_cast(unsigned, x), r0, r1); return fmaxf(__builtin_bit_cast(float, r0), __builtin_bit_cast(float, r1)); }
__device__ __forceinline__ unsigned or32(unsigned u) { unsigned r0, r1; swap32(u, r0, r1); return r0 | r1; }
__device__ __forceinline__ float sum_lo32(float x) { x += swz_xor<16>(x); x += swz_xor<8>(x); x += swz_xor<4>(x); x += swz_xor<2>(x); x += swz_xor<1>(x); return x; }
__device__ __forceinline__ float wave_allsum(float x) { return sum32(sum_lo32(x)); }
namespace pg8 {
constexpr int BM = 256, BK = 64, HALF = 128, HTB = HALF * BK * 2  , STAGE_BYTES = 8 * HTB, NXCD = 8, WGM = 8;
__host__ __device__ __forceinline__ int lds_byte(int r, int c) { const int st = (r >> 4) * 2 + (c >> 5), rr = r & 15, cc = c & 31, ob = rr * 64 + cc * 2; return st * 1024 + (ob ^ (((ob >> 9) & 1) << 5)); }
__host__ __device__ __forceinline__ void stage_rc(int b, int& R, int& C) { const int st = b / 1024, sb = b % 1024, swz = sb ^ (((sb >> 9) & 1) << 5); R = (st >> 1) * 16 + swz / 64; C = (st & 1) * 32 + (swz % 64) / 2; }
__host__ __device__ __forceinline__ int perm32(int rho) { const int n = rho >> 4, i = rho & 15; return 8 * (i >> 2) + 4 * n + (i & 3); }

struct Unit { int pm, pn; };
struct Gemm { const bf16_t* A; const bf16_t* Bt; int lda, ldb, K; };

struct StaticOrder {
    int nM, nN, nwg, G, c;
    __device__ void init(int nM_, int nN_, int G_, int c_) { nM = nM_; nN = nN_; nwg = nM * nN; G = G_; c = c_; }
    __device__ bool next(int i, Unit& u) const {
        const long L = (long)i * G + c; if (L >= nwg) return false;
        int wgid = (int)L; { const int q = nwg / NXCD, r = nwg % NXCD, xcd = wgid % NXCD, off = wgid / NXCD; wgid = (xcd < r ? xcd * (q + 1) : r * (q + 1) + (xcd - r) * q) + off; }
        const int nig = WGM * nN, gid = wgid / nig, fm = gid * WGM, gsz = (nM - fm) < WGM ? (nM - fm) : WGM;
        u.pm = fm + ((wgid % nig) % gsz); u.pn = (wgid % nig) / gsz; return true;
    }
};
struct GroupOrder {
    int ng, nMg, nNg, tot, G, c;
    __device__ void init(int ng_, int nMg_, int nNg_, int G_, int c_) { ng = ng_; nMg = nMg_; nNg = nNg_; tot = ng * nMg * nNg; G = G_; c = c_; }
    __device__ bool next(int i, Unit& u) const {
        const int L = i * G + c; if (L >= tot) return false;
        const int per = nMg * nNg, g = L / per, r = L % per; u.pm = g * nMg + r % nMg; u.pn = g * nNg + r / nMg; return true;
    }
};

template <class Epi, class Sched, bool ALIGN_EPI, bool SP2>
__device__ __forceinline__ void gemm_phase(LAS unsigned char* lds, const Gemm g, const Sched& S, const Epi& E) {
    const int tid = tid_fresh(), wid = __builtin_amdgcn_readfirstlane(tid >> 6), lane = tid & 63, wr = wid >> 2, wc = wid & 3, fr = lane & 15, fq = lane >> 4;
    const int K = g.K, nt = K / BK;
    unsigned voffA[2], voffB[2];
#pragma unroll
    for (int i = 0; i < 2; ++i) { int R, C; stage_rc(tid * 16 + i * 8192, R, C); const int Rb = Epi::PERM ? ((R & ~31) + perm32(R & 31)) : R;
        voffA[i] = (unsigned)(R * g.lda + C) * 2u; voffB[i] = (unsigned)(Rb * g.ldb + C) * 2u; }
    const size_t kstep = (size_t)(BK * 2);
    const size_t hstepA = (size_t)HALF * g.lda * 2, hstepB = (size_t)HALF * g.ldb * 2;
    const size_t tstepA = 2 * hstepA, tstepB = 2 * hstepB;
    const unsigned ldsw = (unsigned)wid * 1024u, ldsbase = (unsigned)(uintptr_t)lds;
    const int aoff = lds_byte(wr * 64 + fr, fq * 8), boff = lds_byte(wc * 32 + fr, fq * 8);
#define PG8_SA(b, h) (((b) * 2 + (h)) * HTB)
#define PG8_SB(b, h) ((4 + (b) * 2 + (h)) * HTB)
#define PG8_STAGE(bufoff, gbase, voff) do { _Pragma("unroll") for (int _i = 0; _i < 2; ++_i) { unsigned _keep; const unsigned _dst = ldsbase + (unsigned)(bufoff) + ldsw + (unsigned)_i * 8192u; \
        asm volatile("s_mov_b32 %0, m0\n\ts_mov_b32 m0, %3\n\ts_nop 0\n\tglobal_load_lds_dwordx4 %1, %2\n\ts_mov_b32 m0, %0" : "=&s"(_keep) : "v"((voff)[_i]), "s"(gbase), "s"(_dst) : "memory"); } } while (0)
#define PG8_LDA(dst, b, h) do { _Pragma("unroll") for (int m = 0; m < 4; ++m) _Pragma("unroll") for (int k = 0; k < 2; ++k) dst[m][k] = *(const LAS bf16x8*)(lds + PG8_SA(b, h) + aoff + m * 2048 + k * 1024); } while (0)
#define PG8_LDB(dst, b, h) do { _Pragma("unroll") for (int n = 0; n < 2; ++n) _Pragma("unroll") for (int k = 0; k < 2; ++k) dst[n][k] = *(const LAS bf16x8*)(lds + PG8_SB(b, h) + boff + n * 2048 + k * 1024); } while (0)
#define PG8_MMA(ai, bj, At, Bt) do { __builtin_amdgcn_s_setprio(1); _Pragma("unroll") for (int m = 0; m < 4; ++m) _Pragma("unroll") for (int n = 0; n < 2; ++n) _Pragma("unroll") for (int k = 0; k < 2; ++k) \
        acc[ai][bj][m][n] = __builtin_amdgcn_mfma_f32_16x16x32_bf16(Bt[n][k], At[m][k], acc[ai][bj][m][n], 0, 0, 0); __builtin_amdgcn_s_setprio(0); } while (0)
#define PG8_WAIT_V(n) asm volatile("s_waitcnt vmcnt(" #n ")" ::: "memory")
#define PG8_WAIT_L(n) asm volatile("s_waitcnt lgkmcnt(" #n ")" ::: "memory")
#define PG8_BAR __builtin_amdgcn_s_barrier()
#define PG8_SCHED __builtin_amdgcn_sched_barrier(0)
    Unit cur, nxt; int ui = 0;
    if (!S.next(0, cur)) return;
    f32x4 acc[2][2][4][2];
#pragma unroll
    for (int a = 0; a < 2; ++a)
#pragma unroll
        for (int b = 0; b < 2; ++b)
#pragma unroll
            for (int m = 0; m < 4; ++m)
#pragma unroll
                for (int n = 0; n < 2; ++n) acc[a][b][m][n] = (f32x4){0.f, 0.f, 0.f, 0.f};
    bf16x8 At[4][2], B0[2][2], B1[2][2];
    const char* cA = (const char*)g.A + (size_t)cur.pm * tstepA; const char* cB = (const char*)g.Bt + (size_t)cur.pn * tstepB;
    if constexpr (SP2) {
        PG8_STAGE(PG8_SB(0, 0), cB, voffB); PG8_STAGE(PG8_SB(0, 1), cB + hstepB, voffB); PG8_STAGE(PG8_SA(0, 0), cA, voffA); PG8_STAGE(PG8_SA(0, 1), cA + hstepA, voffA);
        if (wr == 1) PG8_BAR;
        PG8_WAIT_V(2); PG8_BAR;
        PG8_STAGE(PG8_SB(1, 0), cB + kstep, voffB); PG8_STAGE(PG8_SA(1, 0), cA + kstep, voffA); PG8_STAGE(PG8_SB(1, 1), cB + hstepB + kstep, voffB);
        PG8_WAIT_V(6); PG8_BAR;
    } else {
        PG8_STAGE(PG8_SB(0, 0), cB, voffB); PG8_STAGE(PG8_SA(0, 0), cA, voffA); PG8_STAGE(PG8_SB(0, 1), cB + hstepB, voffB); PG8_STAGE(PG8_SA(0, 1), cA + hstepA, voffA);
        if (wr == 1) PG8_BAR;
        PG8_WAIT_V(4); PG8_BAR;
        PG8_STAGE(PG8_SB(1, 0), cB + kstep, voffB); PG8_STAGE(PG8_SA(1, 0), cA + kstep, voffA); PG8_STAGE(PG8_SB(1, 1), cB + hstepB + kstep, voffB);
        PG8_WAIT_V(6); PG8_BAR;
    }
    for (;;) {
        const bool has_next = S.next(ui + 1, nxt);
        const char* nA = has_next ? (const char*)g.A + (size_t)nxt.pm * tstepA : cA; const char* nB = has_next ? (const char*)g.Bt + (size_t)nxt.pn * tstepB : cB;
        for (int t = 0; t < nt; t += 2) {
            const bool last = (t == nt - 2);
            const char* a1 = cA + (size_t)(t + 1) * kstep;
            const char* a2 = last ? nA : cA + (size_t)(t + 2) * kstep; const char* b2 = last ? nB : cB + (size_t)(t + 2) * kstep;
            const char* a3 = a2 + kstep; const char* b3 = b2 + kstep;
            if constexpr (SP2) {
            PG8_LDB(B0, 0, 0); PG8_LDB(B1, 0, 1); PG8_SCHED; PG8_LDA(At, 0, 0); PG8_STAGE(PG8_SA(1, 1), a1 + hstepA, voffA);
            PG8_WAIT_V(8); PG8_WAIT_L(0); PG8_BAR; PG8_MMA(0, 0, At, B0); PG8_MMA(0, 1, At, B1); PG8_BAR; PG8_SCHED;
            PG8_LDA(At, 0, 1); PG8_STAGE(PG8_SB(0, 0), b2, voffB); PG8_STAGE(PG8_SB(0, 1), b2 + hstepB, voffB); PG8_STAGE(PG8_SA(0, 0), a2, voffA);
            PG8_WAIT_V(8); PG8_WAIT_L(0); PG8_BAR; PG8_MMA(1, 0, At, B0); PG8_MMA(1, 1, At, B1); PG8_BAR; PG8_SCHED;
            PG8_LDB(B0, 1, 0); PG8_LDB(B1, 1, 1); PG8_SCHED; PG8_LDA(At, 1, 0); PG8_STAGE(PG8_SA(0, 1), a2 + hstepA, voffA);
            PG8_WAIT_V(8); PG8_WAIT_L(0); PG8_BAR; PG8_MMA(0, 0, At, B0); PG8_MMA(0, 1, At, B1); PG8_BAR; PG8_SCHED;
            PG8_LDA(At, 1, 1); PG8_STAGE(PG8_SB(1, 0), b3, voffB); PG8_STAGE(PG8_SB(1, 1), b3 + hstepB, voffB); PG8_STAGE(PG8_SA(1, 0), a3, voffA);
            PG8_WAIT_V(8); PG8_WAIT_L(0); PG8_BAR; PG8_MMA(1, 0, At, B0); PG8_MMA(1, 1, At, B1); PG8_BAR; PG8_SCHED;
            } else {
            PG8_LDB(B0, 0, 0); PG8_SCHED; PG8_LDA(At, 0, 0); PG8_STAGE(PG8_SA(1, 1), a1 + hstepA, voffA);
            PG8_WAIT_L(8); PG8_BAR; PG8_WAIT_L(0); PG8_MMA(0, 0, At, B0); PG8_BAR; PG8_SCHED;
            PG8_LDB(B1, 0, 1); PG8_STAGE(PG8_SB(0, 0), b2, voffB);
            PG8_BAR; PG8_WAIT_L(0); PG8_MMA(0, 1, At, B1); PG8_BAR;
            PG8_LDA(At, 0, 1); PG8_STAGE(PG8_SA(0, 0), a2, voffA);
            PG8_BAR; PG8_WAIT_L(0); PG8_MMA(1, 0, At, B0); PG8_BAR; PG8_SCHED;
            PG8_STAGE(PG8_SB(0, 1), b2 + hstepB, voffB);
            PG8_WAIT_V(6); PG8_BAR; PG8_MMA(1, 1, At, B1); PG8_BAR;
            PG8_LDB(B0, 1, 0); PG8_SCHED; PG8_LDA(At, 1, 0); PG8_STAGE(PG8_SA(0, 1), a2 + hstepA, voffA);
            PG8_WAIT_L(8); PG8_BAR; PG8_WAIT_L(0); PG8_MMA(0, 0, At, B0); PG8_BAR; PG8_SCHED;
            PG8_LDB(B1, 1, 1); PG8_STAGE(PG8_SB(1, 0), b3, voffB);
            PG8_BAR; PG8_WAIT_L(0); PG8_MMA(0, 1, At, B1); PG8_BAR;
            PG8_LDA(At, 1, 1); PG8_STAGE(PG8_SA(1, 0), a3, voffA);
            PG8_BAR; PG8_WAIT_L(0); PG8_MMA(1, 0, At, B0); PG8_BAR; PG8_SCHED;
            PG8_STAGE(PG8_SB(1, 1), b3 + hstepB, voffB);
            PG8_WAIT_V(6); PG8_BAR; PG8_MMA(1, 1, At, B1); PG8_BAR;
            }
        }
        if constexpr (ALIGN_EPI) { if (wr == 0) PG8_BAR; }
        { const unsigned ln_ = __builtin_amdgcn_mbcnt_hi(~0u, __builtin_amdgcn_mbcnt_lo(~0u, 0u)); int efr = (int)(ln_ & 15u), efq = (int)(ln_ >> 4); asm volatile("" : "+v"(efr), "+v"(efq)); E(acc, cur, wr, wc, efr, efq); }
        if (!has_next) break;
#pragma unroll
        for (int a = 0; a < 2; ++a)
#pragma unroll
            for (int b = 0; b < 2; ++b)
#pragma unroll
                for (int m = 0; m < 4; ++m)
#pragma unroll
                    for (int n = 0; n < 2; ++n) acc[a][b][m][n] = (f32x4){0.f, 0.f, 0.f, 0.f};
        cur = nxt; cA = nA; cB = nB; ++ui;
        if constexpr (ALIGN_EPI) { if (wr == 1) PG8_BAR; }
    }
    PG8_WAIT_V(0);
    if constexpr (!ALIGN_EPI) { if (wr == 0) PG8_BAR; }
    PG8_BAR;
#undef PG8_SA
#undef PG8_SB
#undef PG8_STAGE
#undef PG8_LDA
#undef PG8_LDB
#undef PG8_MMA
#undef PG8_WAIT_V
#undef PG8_WAIT_L
#undef PG8_BAR
#undef PG8_SCHED
}

typedef f32x4 Acc[2][2][4][2];

__device__ __forceinline__ float row_rstd16(const float* SS, unsigned row, int fq) {
    const f32x4 a = *(const f32x4*)(SS + row * 16u + (unsigned)fq * 4u);
    float s = (a[0] + a[1]) + (a[2] + a[3]);
    s += swz_xor<16>(s); s = sum32(s);
    return fast_rsq(s * (1.0f / 1024.0f) + NORM_EPS);
}
__device__ __forceinline__ u32x4 pack8(const f32x4 v0, const f32x4 v1) { u32x4 w; w.x = pack_bf16(v0[0], v0[1]); w.y = pack_bf16(v0[2], v0[3]); w.z = pack_bf16(v1[0], v1[1]); w.w = pack_bf16(v1[2], v1[3]); return w; }

#define EPI_SB __builtin_amdgcn_sched_barrier(0)
#define EPI_RSTD(rs, SS, rowbase) float rs[2][4]; _Pragma("unroll") for (int ai = 0; ai < 2; ++ai) _Pragma("unroll") for (int m = 0; m < 4; ++m) rs[ai][m] = row_rstd16(SS, (unsigned)((rowbase) + ai * HALF + m * 16), fq); EPI_SB;
struct EpiSwiGLU {
    static constexpr bool PERM = true;
    bf16_t* H; int ldh; const float* SS;
    __device__ __forceinline__ void operator()(const Acc& acc, const Unit& u, int wr, int wc, int fr, int fq) const {
        const int row0 = u.pm * BM + wr * 64 + fr, col0 = u.pn * HALF + wc * 32 + 8 * fq;
        EPI_RSTD(rs, SS, row0)
#pragma unroll
        for (int ai = 0; ai < 2; ++ai)
#pragma unroll
            for (int m = 0; m < 4; ++m) { const int row = row0 + ai * HALF + m * 16; const float r = rs[ai][m];
                f32x4 o[2];
#pragma unroll
                for (int n = 0; n < 2; ++n)
#pragma unroll
                    for (int e = 0; e < 4; ++e) o[n][e] = silu_f(r * acc[ai][0][m][n][e]) * (r * acc[ai][1][m][n][e]);
                *(u32x4*)(H + (unsigned)row * (unsigned)ldh + col0) = pack8(o[0], o[1]); EPI_SB; }
    }
};
struct EpiGLU {
    static constexpr bool PERM = true;
    bf16_t* Y; int ldy;
    __device__ __forceinline__ void operator()(const Acc& acc, const Unit& u, int wr, int wc, int fr, int fq) const {
        const int row0 = u.pm * BM + wr * 64 + fr, col0 = u.pn * HALF + wc * 32 + 8 * fq;
#pragma unroll
        for (int ai = 0; ai < 2; ++ai)
#pragma unroll
            for (int m = 0; m < 4; ++m) { const int row = row0 + ai * HALF + m * 16;
                f32x4 o[2];
#pragma unroll
                for (int n = 0; n < 2; ++n)
#pragma unroll
                    for (int e = 0; e < 4; ++e) o[n][e] = acc[ai][0][m][n][e] * sigmoid_f(acc[ai][1][m][n][e]);
                *(u32x4*)(Y + (unsigned)row * (unsigned)ldy + col0) = pack8(o[0], o[1]); EPI_SB; }
    }
};
struct EpiResid {
    static constexpr bool PERM = false;
    float* X; bf16_t* XB; float* SS; float scale;
    __device__ __forceinline__ void operator()(const Acc& acc, const Unit& u, int wr, int wc, int fr, int fq) const {
        const int row0 = u.pm * BM + wr * 64 + fr, col0 = u.pn * BM + wc * 32 + 4 * fq;
#pragma unroll
        for (int ai = 0; ai < 2; ++ai) {
#pragma unroll
            for (int m = 0; m < 4; ++m) { const int row = row0 + ai * HALF + m * 16; float ssq = 0.f;
#pragma unroll
                for (int bj = 0; bj < 2; ++bj)
#pragma unroll
                    for (int n = 0; n < 2; ++n) { const unsigned off = (unsigned)row * DM + col0 + bj * HALF + n * 16;
                        f32x4 xv = *(const f32x4*)(X + off); xv = xv + acc[ai][bj][m][n] * scale; *(f32x4*)(X + off) = xv;
                        u32x2 w; w.x = pack_bf16(xv[0], xv[1]); w.y = pack_bf16(xv[2], xv[3]); *(u32x2*)(XB + off) = w;
                        ssq += (xv[0] * xv[0] + xv[1] * xv[1]) + (xv[2] * xv[2] + xv[3] * xv[3]); }
                ssq += swz_xor<16>(ssq); ssq = sum32(ssq);
                if (fq == 0) SS[(unsigned)row * 16 + u.pn * 4 + wc] = ssq; }
            EPI_SB; }
    }
};
struct EpiInA {
    static constexpr bool PERM = true;
    bf16_t* PA; bf16_t* U; float* MISCA; const float* SS;
    __device__ __forceinline__ void operator()(const Acc& acc, const Unit& u, int wr, int wc, int fr, int fq) const {
        const int row0 = u.pm * BM + wr * 64 + fr, tile = u.pn;
        EPI_RSTD(rs, SS, row0)
#pragma unroll
        for (int ai = 0; ai < 2; ++ai)
#pragma unroll
            for (int m = 0; m < 4; ++m) { const int row = row0 + ai * HALF + m * 16; const float r = rs[ai][m];
#pragma unroll
                for (int bj = 0; bj < 2; ++bj) { const int lc = bj * HALF + wc * 32 + 8 * fq; const f32x4 v0 = acc[ai][bj][m][0] * r, v1 = acc[ai][bj][m][1] * r;
                    if (tile < 13) *(u32x4*)(PA + (unsigned)row * PA_LD + tile * BM + lc) = pack8(v0, v1);
                    else if (tile < 15) { const int ch = (tile - 13) * BM + lc, grp = ch >> 4, k0 = ch & 15, chunk = row >> 4, tau = row & 15;
                        *(u32x4*)(U + ((unsigned)(grp * NCHUNK + chunk)) * U_LD + tau * 16 + k0) = pack8(v0, v1); }
                    else if (lc == 0) { *(f32x4*)(MISCA + (unsigned)row * 8) = v0; *(f32x4*)(MISCA + (unsigned)row * 8 + 4) = v1; } }
                EPI_SB; }
    }
};
struct EpiInB {
    static constexpr bool PERM = true;
    bf16_t* PB; bf16_t* KIB; float* WI; const float* SS;
    __device__ __forceinline__ void operator()(const Acc& acc, const Unit& u, int wr, int wc, int fr, int fq) const {
        const int row0 = u.pm * BM + wr * 64 + fr, tile = u.pn;
        EPI_RSTD(rs, SS, row0)
#pragma unroll
        for (int ai = 0; ai < 2; ++ai)
#pragma unroll
            for (int m = 0; m < 4; ++m) { const int row = row0 + ai * HALF + m * 16; const float r = rs[ai][m];
#pragma unroll
                for (int bj = 0; bj < 2; ++bj) { const int lc = bj * HALF + wc * 32 + 8 * fq; const f32x4 v0 = acc[ai][bj][m][0] * r, v1 = acc[ai][bj][m][1] * r;
                    if (tile < 7) *(u32x4*)(PB + (unsigned)row * PB_LD + tile * BM + lc) = pack8(v0, v1);
                    else if (lc < 64) *(u32x4*)(KIB + (unsigned)row * 64 + lc) = pack8(v0, v1);
                    else if (lc == 64) *(f32x4*)(WI + (unsigned)row * 4) = v0; }
                EPI_SB; }
    }
};
struct EpiGate {
    static constexpr bool PERM = true;
    bf16_t* G; const float* SS;
    __device__ __forceinline__ void operator()(const Acc& acc, const Unit& u, int wr, int wc, int fr, int fq) const {
        const int lr0 = wr * 64 + fr;
        EPI_RSTD(rs, SS, u.pm * BM + lr0)
#pragma unroll
        for (int ai = 0; ai < 2; ++ai)
#pragma unroll
            for (int m = 0; m < 4; ++m) { const int lr = lr0 + ai * HALF + m * 16; const float r = rs[ai][m];
#pragma unroll
                for (int bj = 0; bj < 2; ++bj) { const int lc = bj * HALF + wc * 32 + 8 * fq; f32x4 v0, v1;
#pragma unroll
                    for (int e = 0; e < 4; ++e) { v0[e] = sigmoid_f(r * acc[ai][bj][m][0][e]); v1[e] = sigmoid_f(r * acc[ai][bj][m][1][e]); }
                    *(u32x4*)(G + lr * BM + lc) = pack8(v0, v1); }
                EPI_SB; }
    }
};
struct EpiBranch {
    static constexpr bool PERM = true;
    const bf16_t* G; bf16_t* MG; const float* SSA; int first;
    __device__ __forceinline__ void operator()(const Acc& acc, const Unit& u, int wr, int wc, int fr, int fq) const {
        const int lr0 = wr * 64 + fr;
        float rs[2][4];
#pragma unroll
        for (int ai = 0; ai < 2; ++ai)
#pragma unroll
            for (int m = 0; m < 4; ++m) { rs[ai][m] = 1.0f;
                if (SSA) { const unsigned row = (unsigned)(u.pm * BM + lr0 + ai * HALF + m * 16); const f32x4* p = (const f32x4*)(SSA + row * 8u); const f32x4 a = p[0], b = p[1];
                    rs[ai][m] = fast_rsq((((a[0] + a[1]) + (a[2] + a[3])) + ((b[0] + b[1]) + (b[2] + b[3]))) * (1.0f / 512.0f) + NORM_EPS); } }
        EPI_SB;
#pragma unroll
        for (int ai = 0; ai < 2; ++ai)
#pragma unroll
            for (int m = 0; m < 4; ++m) { const int lr = lr0 + ai * HALF + m * 16, row = u.pm * BM + lr; const float r = rs[ai][m];
#pragma unroll
                for (int bj = 0; bj < 2; ++bj) { const int lc = bj * HALF + wc * 32 + 8 * fq;
                    const u32x4 gw = *(const u32x4*)(G + lr * BM + lc); bf16_t* mp = MG + (unsigned)row * DM + u.pn * BM + lc;
                    u32x4 pw = (u32x4){0u, 0u, 0u, 0u}; if (!first) pw = *(const u32x4*)mp;
                    f32x4 v0, v1;
                    v0[0] = bflo(pw.x) + bflo(gw.x) * r * acc[ai][bj][m][0][0]; v0[1] = bfhi(pw.x) + bfhi(gw.x) * r * acc[ai][bj][m][0][1];
                    v0[2] = bflo(pw.y) + bflo(gw.y) * r * acc[ai][bj][m][0][2]; v0[3] = bfhi(pw.y) + bfhi(gw.y) * r * acc[ai][bj][m][0][3];
                    v1[0] = bflo(pw.z) + bflo(gw.z) * r * acc[ai][bj][m][1][0]; v1[1] = bfhi(pw.z) + bfhi(gw.z) * r * acc[ai][bj][m][1][1];
                    v1[2] = bflo(pw.w) + bflo(gw.w) * r * acc[ai][bj][m][1][2]; v1[3] = bfhi(pw.w) + bfhi(gw.w) * r * acc[ai][bj][m][1][3];
                    *(u32x4*)mp = pack8(v0, v1); }
                if (m & 1) EPI_SB; }
    }
};
struct EpiS5State {
    static constexpr bool PERM = false;
    float* SC;
    __device__ __forceinline__ void operator()(const Acc& acc, const Unit& u, int wr, int wc, int fr, int fq) const {
        const int row0 = u.pm * BM + wr * 64 + fr, col0 = wc * 32 + 4 * fq;
#pragma unroll
        for (int ai = 0; ai < 2; ++ai)
#pragma unroll
            for (int m = 0; m < 4; ++m) { const int row = row0 + ai * HALF + m * 16;
#pragma unroll
                for (int n = 0; n < 2; ++n) *(f32x4*)(SC + (unsigned)row * 128 + col0 + n * 16) = acc[ai][0][m][n]; }
    }
};
struct EpiS5Y {
    static constexpr bool PERM = true;
    bf16_t* S5Y;
    __device__ __forceinline__ void operator()(const Acc& acc, const Unit& u, int wr, int wc, int fr, int fq) const {
        const int row0 = u.pm * BM + wr * 64 + fr;
#pragma unroll
        for (int ai = 0; ai < 2; ++ai)
#pragma unroll
            for (int m = 0; m < 4; ++m) { const int grow = row0 + ai * HALF + m * 16, grp = grow / NCHUNK, chunk = grow % NCHUNK;
#pragma unroll
                for (int bj = 0; bj < 2; ++bj) { const int lc = bj * HALF + wc * 32 + 8 * fq, tau = lc >> 4, i0 = lc & 15; f32x4 v0, v1;
#pragma unroll
                    for (int e = 0; e < 4; ++e) { v0[e] = gelu_tanh_f(acc[ai][bj][m][0][e]); v1[e] = gelu_tanh_f(acc[ai][bj][m][1][e]); }
                    *(u32x4*)(S5Y + (unsigned)(chunk * 16 + tau) * 512 + grp * 16 + i0) = pack8(v0, v1); }
                EPI_SB; }
    }
};
#undef EPI_SB
#undef EPI_RSTD
}
enum { MAP_PLAIN = 0, MAP_IL2 = 1, MAP_INA = 2, MAP_INB = 3 };
struct CvtJob { const float* s0; const float* s1; const float* gain; bf16_t* dst; int ld, R, K, kind, half_off; };
__device__ __forceinline__ void cvt_map(const CvtJob& j, int r, const float*& base, int& col) {
    base = j.s0; col = r;
    if (j.kind == MAP_IL2) { const int pn = r >> 8, w = r & 255; if (w < 128) col = pn * 128 + w; else { base = j.s1; col = j.half_off + pn * 128 + (w - 128); } }
    else if (j.kind == MAP_INA) { if (r < 1280) col = r; else if (r < 3328) col = 3660 + (r - 1280); else if (r < 3840) col = 1288 + (r - 3328); else if (r < 3848) col = 1280 + (r - 3840); else base = nullptr; }
    else if (j.kind == MAP_INB) { if (r < 1792) col = 1800 + r; else if (r < 1860) col = 3592 + (r - 1792); else base = nullptr; }
}
__device__ __forceinline__ void cvt_run(LAS unsigned char* lds, const CvtJob& j, int bid, int nb, int& rot) {
    LAS float* tile = (LAS float*)lds;
    const int tid = tid_fresh(), wid = tid >> 6, lane = tid & 63, ntk = j.K / 64, ntr = j.R / 256, ntiles = ntk * ntr;
    int first = (bid - rot % nb + nb) % nb;
    for (int t = first; t < ntiles; t += nb) {
        const int tr = t / ntk, tk = t % ntk, r0 = tr * 256, k0 = tk * 64;
        { const float* base; int col; cvt_map(j, r0 + lane * 4, base, col);
#pragma unroll
          for (int i = 0; i < 8; ++i) { const int kk = wid + 8 * i; float z_ = 0.f; asm volatile("" : "+v"(z_)); f32x4 v = {z_, z_, z_, z_}; if (base) v = *(const f32x4*)(base + (size_t)(k0 + kk) * j.ld + col);
              if (j.gain) v = v * j.gain[k0 + kk]; *(LAS f32x4*)(tile + kk * 260 + lane * 4) = v; } }
        __syncthreads();
        { const int kc = (tid & 7) * 8;
#pragma unroll
          for (int i = 0; i < 4; ++i) { const int rr = (tid >> 3) + 64 * i; float v[8];
#pragma unroll
              for (int e = 0; e < 8; ++e) v[e] = tile[(kc + e) * 260 + rr];
              u32x4 w; w.x = pack_bf16(v[0], v[1]); w.y = pack_bf16(v[2], v[3]); w.z = pack_bf16(v[4], v[5]); w.w = pack_bf16(v[6], v[7]);
              *(u32x4*)(j.dst + (size_t)(r0 + rr) * j.K + k0 + kc) = w; } }
        __syncthreads();
    }
    rot += ntiles;
}

__device__ __forceinline__ void s5_tables(LAS unsigned char* lds, int g, int part, const float* lam_re, const float* lam_im, const float* b_re, const float* b_im,
                          const float* c_re, const float* c_im, const float* dsk, const float* log_dt, bf16_t* TY, bf16_t* WST, float* AQ) {
    LAS float* ap_re = (LAS float*)lds;
    LAS float* ap_im = ap_re + 17 * 64;
    LAS float* bb_re = ap_im + 17 * 64;
    LAS float* bb_im = bb_re + 1024;
    LAS float* km = bb_im + 1024;
    const int tid = tid_fresh();
    const float step = fast_exp(log_dt[g]);
    for (int idx = tid; idx < 17 * 64; idx += 512) { const int m = idx / 64, p = idx % 64; const float lr = lam_re[g * 64 + p] * step, li = lam_im[g * 64 + p] * step;
        const float mag = fast_exp(lr * (float)m); float sn, cs; sincos_rev(li * (float)m, sn, cs); ap_re[idx] = mag * cs; ap_im[idx] = mag * sn; }
    __syncthreads();
    for (int idx = tid; idx < 1024; idx += 512) { const int p = idx / 16; const float lr = lam_re[g * 64 + p], li = lam_im[g * 64 + p], den = lr * lr + li * li;
        const float ar = ap_re[64 + p], ai = ap_im[64 + p];
        const float rden = fast_rcp(den); const float qr = ((ar - 1.0f) * lr + ai * li) * rden, qi = (ai * lr - (ar - 1.0f) * li) * rden;
        const float br = b_re[(size_t)g * 1024 + idx], bi = b_im[(size_t)g * 1024 + idx];
        bb_re[idx] = qr * br - qi * bi; bb_im[idx] = qr * bi + qi * br; }
    __syncthreads();
    for (int idx = tid; idx < 4096; idx += 512) { const int m = idx >> 8, i = (idx >> 4) & 15, k = idx & 15; float s = 0.f;
        for (int p = 0; p < 64; ++p) { const float cr = c_re[((size_t)g * 16 + i) * 64 + p], ci = c_im[((size_t)g * 16 + i) * 64 + p];
            const float wr_ = cr * ap_re[m * 64 + p] - ci * ap_im[m * 64 + p], wi_ = cr * ap_im[m * 64 + p] + ci * ap_re[m * 64 + p];
            s += wr_ * bb_re[p * 16 + k] - wi_ * bb_im[p * 16 + k]; }
        if (m == 0 && i == k) s += dsk[g * 16 + i];
        km[idx] = s; }
    __syncthreads();
    for (int idx = tid; idx < 32 * 384; idx += 512) { const int rr = part * 32 + idx / 384, cc = idx % 384, tau = rr >> 4, i = rr & 15; float v;
        if (cc < 256) { const int jj = cc >> 4, k = cc & 15; v = (jj <= tau) ? km[((tau - jj) << 8) + (i << 4) + k] : 0.f; }
        else { const int p = (cc - 256) & 63; const float cr = c_re[((size_t)g * 16 + i) * 64 + p], ci = c_im[((size_t)g * 16 + i) * 64 + p];
            const float ar = ap_re[(tau + 1) * 64 + p], ai = ap_im[(tau + 1) * 64 + p];
            v = (cc < 320) ? (cr * ar - ci * ai) : -(cr * ai + ci * ar); }
        TY[((size_t)g * 256 + rr) * 384 + cc] = f2bf(v); }
    for (int idx = tid; idx < 32 * 256; idx += 512) { const int rr = part * 32 + idx / 256, cc = idx % 256, jj = cc >> 4, k = cc & 15; float v = 0.f;
        if (rr < 128) { const int p = rr & 63; const float ar = ap_re[(15 - jj) * 64 + p], ai = ap_im[(15 - jj) * 64 + p], br = bb_re[p * 16 + k], bi = bb_im[p * 16 + k];
            v = (rr < 64) ? (ar * br - ai * bi) : (ar * bi + ai * br); }
        WST[((size_t)g * 256 + rr) * 256 + cc] = f2bf(v); }
    if (part == 0 && tid < 128) AQ[g * 128 + tid] = (tid < 64) ? ap_re[16 * 64 + tid] : ap_im[16 * 64 + (tid - 64)];
    __syncthreads();
}

__device__ __forceinline__ void x_prologue(const float* xin, float* X, bf16_t* XB, float* SS, int bid, int nb) {
    const int tid_ = tid_fresh(), wid = tid_ >> 6, lane = tid_ & 63;
    for (int row = bid * 8 + wid; row < T_TOK; row += nb * 8) {
        float ssq = 0.f;
#pragma unroll
        for (int i = 0; i < 4; ++i) { const size_t off = (size_t)row * DM + i * 256 + lane * 4; const f32x4 v = *(const f32x4*)(xin + off); *(f32x4*)(X + off) = v;
            u32x2 w; w.x = pack_bf16(v[0], v[1]); w.y = pack_bf16(v[2], v[3]); *(u32x2*)(XB + off) = w; ssq += (v[0] * v[0] + v[1] * v[1]) + (v[2] * v[2] + v[3] * v[3]); }
        ssq = wave_allsum(ssq);
        if (lane < 16) SS[(size_t)row * 16 + lane] = (lane == 0) ? ssq : 0.f;
    }
}
struct M2Params { const float* conv_w; const float* conv_b; const float* dt_bias; const float* a_log; const float* dskip; };
template <bool OUT>
__device__ __forceinline__ void m2_segment(LAS unsigned char* lds, int item, bf16_t* PA, const float* MISCA, float* ST, float* DEC, float* SSA, const M2Params P) {
    LAS float* xc = (LAS float*)lds;
    LAS float* Bc = xc + 4096;
    LAS float* Cc = Bc + 4096;
    LAS float* zs = Cc + 4096;
    LAS float* yo = zs + 4096;
    LAS float* dtl = yo + 4096;
    LAS float* dal = dtl + 64;
    LAS bf16_t* raw = (LAS bf16_t*)(dal + 64);
    const int tid = tid_fresh(), p = tid >> 3, nq = tid & 7;
    const int b = item >> 8, h = (item >> 5) & 7, seg = item & 31, grp = h >> 2;
    const int t_base = b * SEQ + seg * 256, tl_base = seg * 256;
    const float a_h = -fast_exp(P.a_log[h]), dtb = P.dt_bias[h], dsk = P.dskip[h];
    float hs[8];
#pragma unroll
    for (int j = 0; j < 8; ++j) hs[j] = OUT ? ST[(size_t)item * 4096 + p * 64 + nq * 8 + j] : 0.f;
    float dtsum = 0.f;
    for (int sub = 0; sub < 4; ++sub) {
        const int t0 = t_base + sub * 64, tl0 = tl_base + sub * 64;
        for (int idx = tid; idx < 67 * 32; idx += 512) { const int r = idx >> 5, piece = idx & 31, arr = piece >> 3, pc = piece & 7;
            if (!OUT && arr >= 2) continue;
            const int col = (arr == 0 ? 512 + h * 64 : arr == 1 ? 1024 + grp * 64 : arr == 2 ? 1152 + grp * 64 : h * 64) + pc * 8;
            u32x4 v = {0u, 0u, 0u, 0u}; if (tl0 - 3 + r >= 0) v = *(const u32x4*)(PA + (size_t)(t0 - 3 + r) * PA_LD + col);
            *(LAS u32x4*)(raw + r * 256 + arr * 64 + pc * 8) = v; }
        __syncthreads();
        for (int idx = tid; idx < 4096; idx += 512) { const int tl = idx >> 6, ch = idx & 63;
            const int cx = h * 64 + ch, cb = 512 + grp * 64 + ch, cc = 640 + grp * 64 + ch;
            float ax = P.conv_b[cx], ab = P.conv_b[cb], ac = P.conv_b[cc];
#pragma unroll
            for (int w = 0; w < 4; ++w) { const LAS bf16_t* rp = raw + (tl + w) * 256 + ch;
                ax += P.conv_w[w * 768 + cx] * bf2f(rp[0]); ab += P.conv_w[w * 768 + cb] * bf2f(rp[64]); if (OUT) ac += P.conv_w[w * 768 + cc] * bf2f(rp[128]); }
            xc[idx] = silu_f(ax); Bc[idx] = silu_f(ab);
            if (OUT) { Cc[idx] = silu_f(ac); zs[idx] = silu_f(bf2f(raw[(tl + 3) * 256 + 192 + ch])); } }
        if (tid < 64) { const float dtv = softplus_f(MISCA[(size_t)(t0 + tid) * 8 + h] + dtb); dtl[tid] = dtv; dal[tid] = fast_exp(dtv * a_h); dtsum += dtv; }
        __syncthreads();
        for (int tl = 0; tl < 64; ++tl) {
            const float xv = xc[tl * 64 + p], dtx = dtl[tl] * xv, da = dal[tl];
            const f32x4 b0 = *(const LAS f32x4*)(Bc + tl * 64 + nq * 8), b1 = *(const LAS f32x4*)(Bc + tl * 64 + nq * 8 + 4);
#pragma unroll
            for (int j = 0; j < 4; ++j) { hs[j] = da * hs[j] + dtx * b0[j]; hs[4 + j] = da * hs[4 + j] + dtx * b1[j]; }
            if (OUT) {
                const f32x4 c0 = *(const LAS f32x4*)(Cc + tl * 64 + nq * 8), c1 = *(const LAS f32x4*)(Cc + tl * 64 + nq * 8 + 4);
                float y = 0.f;
#pragma unroll
                for (int j = 0; j < 4; ++j) y += c0[j] * hs[j] + c1[j] * hs[4 + j];
                y += swz_xor<1>(y); y += swz_xor<2>(y); y += swz_xor<4>(y);
                if (nq == 0) yo[tl * 64 + p] = (y + dsk * xv) * zs[tl * 64 + p];
            }
        }
        __syncthreads();
        if (OUT) {
            for (int idx = tid; idx < 4096; idx += 512) { const int tl = idx >> 6, ch = idx & 63; PA[(size_t)(t0 + tl) * PA_LD + h * 64 + ch] = f2bf(yo[idx]); }
            if (tid < 64) { float s = 0.f; for (int ch = 0; ch < 64; ++ch) { const float v = yo[tid * 64 + ((ch + tid) & 63)]; s += v * v; } SSA[(size_t)(t0 + tid) * 8 + h] = s; }
            __syncthreads();
        }
    }
    if (!OUT) {
#pragma unroll
        for (int j = 0; j < 8; ++j) ST[(size_t)item * 4096 + p * 64 + nq * 8 + j] = hs[j];
        if (tid < 64) {
            dtsum = wave_allsum(dtsum);
            if (tid == 0) DEC[item] = fast_exp(a_h * dtsum); }
    }
}
__device__ __forceinline__ void m2_scan(float* ST, const float* DEC, int e) {
    const int bh = e >> 12, pn = e & 4095; float s = 0.f;
    for (int seg = 0; seg < 32; ++seg) { const int item = bh * 32 + seg; const float he = ST[(size_t)item * 4096 + pn]; ST[(size_t)item * 4096 + pn] = s; s = DEC[item] * s + he; }
}

struct HgParams { const float* gamma0; const float* gamma1; const float* norm_g; int layer; };
template <bool OUT>
__device__ __forceinline__ void hg_segment(LAS unsigned char* lds, int item, bf16_t* PA, float* ST, float* DECK, const HgParams P) {
    LAS float* qs = (LAS float*)lds;
    LAS float* fg = qs + 4096;
    LAS float* kk = fg + 4096;
    LAS float* vv = kk + 4096;
    LAS float* op = vv + 4096;
    LAS float* lbl = op + 16384;
    const int tid = tid_fresh(), v = tid & 127, ks = tid >> 7, wid = tid >> 6, lane = tid & 63;
    const int b = item >> 7, hh = (item >> 5) & 3, seg = item & 31;
    const int t_base = b * SEQ + seg * 256;
    if (tid < 128) lbl[tid] = (P.layer == 0) ? 0.f : sigmoid_f(P.gamma1[hh * 128 + tid] - P.gamma0[hh * 128 + tid]);
    float S[32];
#pragma unroll
    for (int j = 0; j < 32; ++j) S[j] = OUT ? ST[(size_t)item * 16384 + (ks * 32 + j) * 128 + v] : 0.f;
    float dk = 1.0f;
    __syncthreads();
    for (int c = 0; c < 8; ++c) {
        const int t0 = t_base + c * 32;
        for (int idx = tid; idx < 4096; idx += 512) { const int tl = idx >> 7, k = idx & 127; const bf16_t* rp = PA + (size_t)(t0 + tl) * PA_LD + 1280 + hh * 128 + k;
            const float lb = lbl[k], sg = sigmoid_f(bf2f(rp[512]));
            fg[idx] = lb + (1.0f - lb) * sg; kk[idx] = (1.0f - lb) * (1.0f - sg); vv[idx] = bf2f(rp[1024]);
            if (OUT) qs[idx] = silu_f(bf2f(rp[0])); }
        __syncthreads();
        if (!OUT && tid < 128) { for (int tl = 0; tl < 32; ++tl) dk *= fg[tl * 128 + tid]; }
        for (int tl = 0; tl < 32; ++tl) {
            const float vval = vv[tl * 128 + v]; float o = 0.f;
#pragma unroll
            for (int j4 = 0; j4 < 8; ++j4) {
                const f32x4 f4 = *(const LAS f32x4*)(fg + tl * 128 + ks * 32 + j4 * 4), k4 = *(const LAS f32x4*)(kk + tl * 128 + ks * 32 + j4 * 4);
#pragma unroll
                for (int e = 0; e < 4; ++e) S[j4 * 4 + e] = f4[e] * S[j4 * 4 + e] + k4[e] * vval;
                if (OUT) { const f32x4 q4 = *(const LAS f32x4*)(qs + tl * 128 + ks * 32 + j4 * 4);
#pragma unroll
                    for (int e = 0; e < 4; ++e) o += q4[e] * S[j4 * 4 + e]; }
            }
            if (OUT) op[(tl * 4 + ks) * 128 + v] = o;
        }
        __syncthreads();
        if (OUT) {
            for (int tl = wid; tl < 32; tl += 8) {
                const float o0 = (op[(tl * 4 + 0) * 128 + lane] + op[(tl * 4 + 1) * 128 + lane]) + (op[(tl * 4 + 2) * 128 + lane] + op[(tl * 4 + 3) * 128 + lane]);
                const float o1 = (op[(tl * 4 + 0) * 128 + 64 + lane] + op[(tl * 4 + 1) * 128 + 64 + lane]) + (op[(tl * 4 + 2) * 128 + 64 + lane] + op[(tl * 4 + 3) * 128 + 64 + lane]);
                float ss = o0 * o0 + o1 * o1;
                ss = wave_allsum(ss);
                const float r = fast_rsq(ss * (1.0f / 128.0f) + NORM_EPS);
                bf16_t* gp = PA + (size_t)(t0 + tl) * PA_LD + 2816 + hh * 128;
                const float g0 = sigmoid_f(bf2f(gp[lane])), g1 = sigmoid_f(bf2f(gp[64 + lane]));
                gp[lane] = f2bf(o0 * r * P.norm_g[hh * 128 + lane] * g0); gp[64 + lane] = f2bf(o1 * r * P.norm_g[hh * 128 + 64 + lane] * g1);
            }
            __syncthreads();
        }
    }
    if (!OUT) {
#pragma unroll
        for (int j = 0; j < 32; ++j) ST[(size_t)item * 16384 + (ks * 32 + j) * 128 + v] = S[j];
        if (tid < 128) DECK[item * 128 + tid] = dk;
    }
}
__device__ __forceinline__ void hg_scan(float* ST, const float* DECK, int e) {
    const int bh = e >> 14, kv = e & 16383, k = kv >> 7; float s = 0.f;
    for (int seg = 0; seg < 32; ++seg) { const int item = bh * 32 + seg; const float se = ST[(size_t)item * 16384 + kv]; ST[(size_t)item * 16384 + kv] = s; s = DECK[item * 128 + k] * s + se; }
}

__device__ __forceinline__ void s5_scan(LAS unsigned char* lds, int bg, const float* SC, const float* AQ, bf16_t* U) {
    LAS float* Ere = (LAS float*)lds;
    LAS float* Eim = Ere + 512;
    const int tid = tid_fresh(), p = tid & 63, blk = tid >> 6, b = bg >> 5, g = bg & 31;
    const float ar = AQ[g * 128 + p], ai = AQ[g * 128 + 64 + p];
    const size_t row0 = (size_t)g * NCHUNK + b * 512 + blk * 64;
    float er = 0.f, ei = 0.f, pr = 1.f, pi = 0.f;
    for (int i0 = 0; i0 < 64; i0 += 8) { float xr[8], xi[8];
#pragma unroll
        for (int i = 0; i < 8; ++i) { xr[i] = SC[(row0 + i0 + i) * 128 + p]; xi[i] = SC[(row0 + i0 + i) * 128 + 64 + p]; }
#pragma unroll
        for (int i = 0; i < 8; ++i) { const float nr = ar * er - ai * ei + xr[i], ni = ar * ei + ai * er + xi[i]; er = nr; ei = ni; const float qr = ar * pr - ai * pi, qi = ar * pi + ai * pr; pr = qr; pi = qi; } }
    Ere[blk * 64 + p] = er; Eim[blk * 64 + p] = ei;
    __syncthreads();
    float sr = 0.f, si = 0.f;
    for (int bb = 0; bb < blk; ++bb) { const float nr = pr * sr - pi * si + Ere[bb * 64 + p], ni = pr * si + pi * sr + Eim[bb * 64 + p]; sr = nr; si = ni; }
    for (int i0 = 0; i0 < 64; i0 += 8) { float xr[8], xi[8];
#pragma unroll
        for (int i = 0; i < 8; ++i) { xr[i] = SC[(row0 + i0 + i) * 128 + p]; xi[i] = SC[(row0 + i0 + i) * 128 + 64 + p]; }
#pragma unroll
        for (int i = 0; i < 8; ++i) { bf16_t* up = U + (row0 + i0 + i) * U_LD + 256; up[p] = f2bf(sr); up[64 + p] = f2bf(si);
            const float nr = ar * sr - ai * si + xr[i], ni = ar * si + ai * sr + xi[i]; sr = nr; si = ni; } }
    __syncthreads();
}
__device__ __forceinline__ bf16x8 tr8(const LAS bf16_t* p, int second_off) {
    typedef short v4i16_t_ __attribute__((ext_vector_type(4)));
    const v4i16_t_ lo = __builtin_amdgcn_ds_read_tr16_b64_v4i16((LAS v4i16_t_*)p), hi = __builtin_amdgcn_ds_read_tr16_b64_v4i16((LAS v4i16_t_*)(p + second_off));
    return __builtin_shufflevector(lo, hi, 0, 1, 2, 3, 4, 5, 6, 7);
}
constexpr int HG_RS = 136;
constexpr int HG_TS = 160;

__device__ __forceinline__ void hg1_mfma(LAS unsigned char* lds, int item, const bf16_t* PA, float* ST, float* DECK, const HgParams P) {
    LAS bf16_t* Ke = (LAS bf16_t*)lds;
    LAS bf16_t* Vs = Ke + 128 * HG_TS;
    LAS float* tot = (LAS float*)(Vs + 128 * HG_TS);
    const int tid = tid_fresh(), k = tid & 127, part = tid >> 7, wid = __builtin_amdgcn_readfirstlane(tid >> 6), lane = tid & 63, hl = lane >> 5;
    const int b = item >> 7, hh = (item >> 5) & 3, seg = item & 31;
    const size_t t_base = (size_t)b * SEQ + seg * 256;
    const float lb = (P.layer == 0) ? 0.f : sigmoid_f(P.gamma1[hh * 128 + k] - P.gamma0[hh * 128 + k]);
    const bf16_t* fbase = PA + t_base * PA_LD + 1792 + hh * 128;
#define fcol(OFF) fbase[(unsigned)k + (unsigned)(OFF)]
    float fr[2][32];
#pragma unroll
    for (int bb = 0; bb < 2; ++bb)
#pragma unroll
        for (int i0 = 0; i0 < 32; i0 += 16) {
#pragma unroll
            for (int i = i0; i < i0 + 16; ++i) fr[bb][i] = bf2f(fcol((128 * bb + 32 * part + i) * PA_LD));
            asm volatile("" ::: "memory"); }
#pragma unroll
    for (int bb = 0; bb < 2; ++bb) { float s = 0.f;
#pragma unroll
        for (int i = 0; i < 32; ++i) { const float sg = sigmoid_f(fr[bb][i]); s += 0.6931471805599453f * __builtin_amdgcn_logf(lb + (1.0f - lb) * sg); }
        tot[(4 * bb + part) * 128 + k] = s; }
    __syncthreads();
    f32x16 acc[2];
#pragma unroll
    for (int r = 0; r < 16; ++r) { acc[0][r] = 0.f; acc[1][r] = 0.f; }
    const int kb = wid >> 1, vb0 = 2 * (wid & 1);
    const int troff = (8 * hl + ((lane & 15) >> 2)) * HG_TS + 16 * ((lane >> 4) & 1) + 4 * (lane & 3);
#pragma unroll
    for (int half = 0; half < 2; ++half) {
        { const int blk = 4 * half + part; float sfx = 0.f;
          for (int j = blk + 1; j < 8; ++j) sfx += tot[j * 128 + k];
          bf16_t vv[32];
#pragma unroll
          for (int i0 = 0; i0 < 32; i0 += 16) {
#pragma unroll
              for (int i = i0; i < i0 + 16; ++i) vv[i] = fcol((128 * half + 32 * part + i) * PA_LD + 512);
              asm volatile("" ::: "memory"); }
#pragma unroll
          for (int i = 31; i >= 0; --i) { const int sl = 32 * part + i; const float sg = sigmoid_f(fr[half][i]);
              Ke[sl * HG_TS + k] = f2bf((1.0f - lb) * (1.0f - sg) * fast_exp(sfx)); Vs[sl * HG_TS + k] = vv[i];
              sfx += 0.6931471805599453f * __builtin_amdgcn_logf(lb + (1.0f - lb) * sg); } }
        __syncthreads();
#pragma unroll
        for (int ks = 0; ks < 8; ++ks) {
            const bf16x8 a = tr8(Ke + ks * 16 * HG_TS + kb * 32 + troff, 4 * HG_TS);
            const bf16x8 b0 = tr8(Vs + ks * 16 * HG_TS + vb0 * 32 + troff, 4 * HG_TS), b1 = tr8(Vs + ks * 16 * HG_TS + vb0 * 32 + 32 + troff, 4 * HG_TS);
            acc[0] = __builtin_amdgcn_mfma_f32_32x32x16_bf16(a, b0, acc[0], 0, 0, 0); acc[1] = __builtin_amdgcn_mfma_f32_32x32x16_bf16(a, b1, acc[1], 0, 0, 0); }
        __syncthreads();
    }
    float* sp = ST + (size_t)item * 16384;
#pragma unroll
    for (int j = 0; j < 2; ++j)
#pragma unroll
        for (int r = 0; r < 16; ++r) sp[(kb * 32 + (r & 3) + 8 * (r >> 2) + 4 * hl) * 128 + (vb0 + j) * 32 + (lane & 31)] = acc[j][r];
    if (part == 0) { float s = 0.f; for (int j = 0; j < 8; ++j) s += tot[j * 128 + k]; DECK[item * 128 + k] = fast_exp(s); }
    __syncthreads();
#undef fcol
}

__device__ __forceinline__ void hg3_mfma(LAS unsigned char* lds, int item, bf16_t* PA, const float* ST, const HgParams P) {
    LAS bf16_t* Qd = (LAS bf16_t*)lds;
    LAS bf16_t* Kd = Qd + 32 * HG_RS;
    LAS bf16_t* Ke = Kd + 32 * HG_RS;
    LAS bf16_t* Vs = Ke + 32 * HG_TS;
    LAS bf16_t* At = Vs + 32 * HG_TS;
    LAS bf16_t* St = At + 32 * 40;
    LAS float* tot = (LAS float*)(St + 128 * HG_RS);
    LAS float* dk = tot + 512;
    LAS float* ssq = dk + 128;
    const int tid = tid_fresh(), k = tid & 127, part = tid >> 7, wid = __builtin_amdgcn_readfirstlane(tid >> 6), lane = tid & 63, hl = lane >> 5, lc = lane & 31;
    const int b = item >> 7, hh = (item >> 5) & 3, seg = item & 31;
    const size_t t_base = (size_t)b * SEQ + seg * 256;
    const float lb = (P.layer == 0) ? 0.f : sigmoid_f(P.gamma1[hh * 128 + k] - P.gamma0[hh * 128 + k]);
    const int kb = wid >> 1, vb0 = 2 * (wid & 1);
    const int troff = (8 * hl + ((lane & 15) >> 2)) * HG_TS + 16 * ((lane >> 4) & 1) + 4 * (lane & 3);
    f32x16 acc[2];
    { const float* sp = ST + (size_t)item * 16384;
#pragma unroll
      for (int j = 0; j < 2; ++j)
#pragma unroll
        for (int r = 0; r < 16; ++r) acc[j][r] = sp[(kb * 32 + (r & 3) + 8 * (r >> 2) + 4 * hl) * 128 + (vb0 + j) * 32 + lc]; }
    for (int c = 0; c < 8; ++c) {
        const size_t t0 = t_base + c * 32;
        float qv[8], kv[8], cl[8]; bf16_t vv[8];
        { const bf16_t* rp = PA + (t0 + 8 * part) * PA_LD + 1280 + hh * 128 + k; float run = 0.f;
#pragma unroll
          for (int i = 0; i < 8; ++i) { const float sg = sigmoid_f(bf2f(rp[(size_t)i * PA_LD + 512])); const float fg = lb + (1.0f - lb) * sg;
              run += 0.6931471805599453f * __builtin_amdgcn_logf(fg); cl[i] = run; kv[i] = (1.0f - lb) * (1.0f - sg); qv[i] = silu_f(bf2f(rp[(size_t)i * PA_LD])); vv[i] = rp[(size_t)i * PA_LD + 1024]; }
          tot[part * 128 + k] = run; }
        __syncthreads();
        { float off = 0.f, all = 0.f;
#pragma unroll
          for (int p = 0; p < 4; ++p) { const float tp = tot[p * 128 + k]; all += tp; if (p < part) off += tp; }
#pragma unroll
          for (int i = 0; i < 8; ++i) { const int t = 8 * part + i; const float cu = off + cl[i];
              Qd[t * HG_RS + k] = f2bf(qv[i] * fast_exp(cu)); Kd[t * HG_RS + k] = f2bf(kv[i] * fast_exp(-cu)); Ke[t * HG_TS + k] = f2bf(kv[i] * fast_exp(all - cu)); Vs[t * HG_TS + k] = vv[i]; }
          if (part == 0) dk[k] = fast_exp(all); }
#pragma unroll
        for (int j = 0; j < 2; ++j)
#pragma unroll
            for (int g4 = 0; g4 < 4; ++g4) { u32x2 w; w.x = pack_bf16(acc[j][4 * g4], acc[j][4 * g4 + 1]); w.y = pack_bf16(acc[j][4 * g4 + 2], acc[j][4 * g4 + 3]);
                *(LAS u32x2*)(St + ((vb0 + j) * 32 + lc) * HG_RS + kb * 32 + 8 * g4 + 4 * hl) = w; }
        __syncthreads();
        if (wid == 0) {
            f32x16 d;
#pragma unroll
            for (int r = 0; r < 16; ++r) d[r] = 0.f;
#pragma unroll
            for (int ks = 0; ks < 8; ++ks) { const bf16x8 a = *(const LAS bf16x8*)(Kd + lc * HG_RS + ks * 16 + 8 * hl), bq = *(const LAS bf16x8*)(Qd + lc * HG_RS + ks * 16 + 8 * hl);
                d = __builtin_amdgcn_mfma_f32_32x32x16_bf16(a, bq, d, 0, 0, 0); }
#pragma unroll
            for (int g4 = 0; g4 < 4; ++g4) { float e[4];
#pragma unroll
                for (int i = 0; i < 4; ++i) { const int s = 8 * g4 + 4 * hl + i; e[i] = (s <= lc) ? d[4 * g4 + i] : 0.f; }
                u32x2 w; w.x = pack_bf16(e[0], e[1]); w.y = pack_bf16(e[2], e[3]); *(LAS u32x2*)(At + lc * 40 + 8 * g4 + 4 * hl) = w; }
        }
        __syncthreads();
        f32x16 o;
        if (wid < 4) {
#pragma unroll
            for (int r = 0; r < 16; ++r) o[r] = 0.f;
#pragma unroll
            for (int ks = 0; ks < 2; ++ks) { const bf16x8 a = tr8(Vs + ks * 16 * HG_TS + wid * 32 + troff, 4 * HG_TS), bt = *(const LAS bf16x8*)(At + lc * 40 + ks * 16 + 8 * hl);
                o = __builtin_amdgcn_mfma_f32_32x32x16_bf16(a, bt, o, 0, 0, 0); }
#pragma unroll
            for (int ks = 0; ks < 8; ++ks) { const bf16x8 a = *(const LAS bf16x8*)(St + (wid * 32 + lc) * HG_RS + ks * 16 + 8 * hl), bq = *(const LAS bf16x8*)(Qd + lc * HG_RS + ks * 16 + 8 * hl);
                o = __builtin_amdgcn_mfma_f32_32x32x16_bf16(a, bq, o, 0, 0, 0); }
            float s2 = 0.f;
#pragma unroll
            for (int r = 0; r < 16; ++r) s2 += o[r] * o[r];
            s2 = sum32(s2); if (hl == 0) ssq[wid * 32 + lc] = s2;
        }
        { const f32x4* dp = (const f32x4*)0; (void)dp;
#pragma unroll
          for (int g4 = 0; g4 < 4; ++g4) { const f32x4 d4 = *(const LAS f32x4*)(dk + kb * 32 + 8 * g4 + 4 * hl);
#pragma unroll
              for (int i = 0; i < 4; ++i) { acc[0][4 * g4 + i] *= d4[i]; acc[1][4 * g4 + i] *= d4[i]; } }
#pragma unroll
          for (int ks = 0; ks < 2; ++ks) { const bf16x8 a = tr8(Ke + ks * 16 * HG_TS + kb * 32 + troff, 4 * HG_TS);
              const bf16x8 b0 = tr8(Vs + ks * 16 * HG_TS + vb0 * 32 + troff, 4 * HG_TS), b1 = tr8(Vs + ks * 16 * HG_TS + vb0 * 32 + 32 + troff, 4 * HG_TS);
              acc[0] = __builtin_amdgcn_mfma_f32_32x32x16_bf16(a, b0, acc[0], 0, 0, 0); acc[1] = __builtin_amdgcn_mfma_f32_32x32x16_bf16(a, b1, acc[1], 0, 0, 0); } }
        __syncthreads();
        if (wid < 4) {
            const float tq = (ssq[lc] + ssq[32 + lc]) + (ssq[64 + lc] + ssq[96 + lc]);
            const float rr = fast_rsq(tq * (1.0f / 128.0f) + NORM_EPS);
            bf16_t* gp = PA + (t0 + lc) * PA_LD + 2816 + hh * 128 + wid * 32;
#pragma unroll
            for (int g4 = 0; g4 < 4; ++g4) { const int v0 = 8 * g4 + 4 * hl; const u32x2 gw = *(const u32x2*)(gp + v0); const f32x4 gn = *(const f32x4*)(P.norm_g + hh * 128 + wid * 32 + v0);
                const float y0 = o[4 * g4] * rr * gn[0] * sigmoid_f(bflo(gw.x)), y1 = o[4 * g4 + 1] * rr * gn[1] * sigmoid_f(bfhi(gw.x));
                const float y2 = o[4 * g4 + 2] * rr * gn[2] * sigmoid_f(bflo(gw.y)), y3 = o[4 * g4 + 3] * rr * gn[3] * sigmoid_f(bfhi(gw.y));
                u32x2 w; w.x = pack_bf16(y0, y1); w.y = pack_bf16(y2, y3); *(u32x2*)(gp + v0) = w; }
        }
    }
    __syncthreads();
}

constexpr int M2_TS = 96;
__device__ __forceinline__ void m2s1_mfma(LAS unsigned char* lds, int item, const bf16_t* PA, const float* MISCA, float* ST, float* DEC, const M2Params P) {
    LAS bf16_t* raw = (LAS bf16_t*)lds;
    LAS bf16_t* Xc = raw + 131 * 128;
    LAS bf16_t* Bw = Xc + 128 * M2_TS;
    LAS float* wsl = (LAS float*)(Bw + 128 * M2_TS);
    LAS float* wtot = wsl + 256;
    const int tid = tid_fresh(), wid = __builtin_amdgcn_readfirstlane(tid >> 6), lane = tid & 63, hl = lane >> 5;
    const int b = item >> 8, h = (item >> 5) & 7, seg = item & 31, grp = h >> 2;
    const int t_base = b * SEQ + seg * 256, tl_base = seg * 256;
    const float a_h = -fast_exp(P.a_log[h]), dtb = P.dt_bias[h];
    float dtv = 0.f, incl = 0.f;
    if (tid < 256) { dtv = softplus_f(MISCA[(size_t)(t_base + tid) * 8 + h] + dtb); incl = dtv;
#pragma unroll
        for (int o = 1; o < 64; o <<= 1) { const float t = __builtin_bit_cast(float, __builtin_amdgcn_ds_bpermute((lane - o) << 2, __builtin_bit_cast(int, incl))); if (lane >= o) incl += t; }
        if (lane == 63) wtot[wid] = incl; }
    __syncthreads();
    if (tid < 256) { float after = 0.f, all = 0.f;
#pragma unroll
        for (int w = 0; w < 4; ++w) { const float tw = wtot[w]; all += tw; if (w > wid) after += tw; }
        const float wave_tot = wtot[wid];
        wsl[tid] = dtv * fast_exp(a_h * (after + (wave_tot - incl)));
        if (tid == 0) DEC[item] = fast_exp(a_h * all); }
    f32x16 acc;
#pragma unroll
    for (int r = 0; r < 16; ++r) acc[r] = 0.f;
    const int nb_ = wid >> 1, pb_ = wid & 1;
    const int troff = (8 * hl + ((lane & 15) >> 2)) * M2_TS + 16 * ((lane >> 4) & 1) + 4 * (lane & 3);
    for (int half = 0; half < 2; ++half) {
        const int t0 = t_base + half * 128, tl0 = tl_base + half * 128;
        for (int idx = tid; idx < 131 * 16; idx += 512) { const int r = idx >> 4, piece = idx & 15, arr = piece >> 3, pc = piece & 7;
            const int col = (arr == 0 ? 512 + h * 64 : 1024 + grp * 64) + pc * 8;
            u32x4 v = {0u, 0u, 0u, 0u}; if (tl0 - 3 + r >= 0) v = *(const u32x4*)(PA + (size_t)(t0 - 3 + r) * PA_LD + col);
            *(LAS u32x4*)(raw + r * 128 + arr * 64 + pc * 8) = v; }
        __syncthreads();
        for (int idx = tid; idx < 128 * 64; idx += 512) { const int tl = idx >> 6, ch = idx & 63;
            const int cx = h * 64 + ch, cb = 512 + grp * 64 + ch;
            float ax = P.conv_b[cx], ab = P.conv_b[cb];
#pragma unroll
            for (int w = 0; w < 4; ++w) { const LAS bf16_t* rp = raw + (tl + w) * 128 + ch; ax += P.conv_w[w * 768 + cx] * bf2f(rp[0]); ab += P.conv_w[w * 768 + cb] * bf2f(rp[64]); }
            Xc[tl * M2_TS + ch] = f2bf(silu_f(ax)); Bw[tl * M2_TS + ch] = f2bf(silu_f(ab) * wsl[half * 128 + tl]); }
        __syncthreads();
        if (wid < 4) {
#pragma unroll
            for (int ks = 0; ks < 8; ++ks) { const bf16x8 a = tr8(Bw + ks * 16 * M2_TS + nb_ * 32 + troff, 4 * M2_TS), bx = tr8(Xc + ks * 16 * M2_TS + pb_ * 32 + troff, 4 * M2_TS);
                acc = __builtin_amdgcn_mfma_f32_32x32x16_bf16(a, bx, acc, 0, 0, 0); } }
        __syncthreads();
    }
    if (wid < 4) { float* sp = ST + (size_t)item * 4096 + (pb_ * 32 + (lane & 31)) * 64 + nb_ * 32 + 4 * hl;
#pragma unroll
        for (int g4 = 0; g4 < 4; ++g4) { f32x4 v = {acc[4 * g4], acc[4 * g4 + 1], acc[4 * g4 + 2], acc[4 * g4 + 3]}; *(f32x4*)(sp + 8 * g4) = v; } }
}

__device__ __forceinline__ void m2s3_mfma(LAS unsigned char* lds, int item, bf16_t* PA, const float* MISCA, const float* ST, float* SSA, const M2Params P) {
    LAS bf16_t* raw = (LAS bf16_t*)lds;
    LAS bf16_t* Xc = raw + 67 * 256;
    LAS bf16_t* Bw = Xc + 64 * 96;
    LAS bf16_t* Bc = Bw + 64 * 96;
    LAS bf16_t* Cc = Bc + 64 * 72;
    LAS bf16_t* Cd = Cc + 64 * 72;
    LAS bf16_t* Sm = Cd + 64 * 72;
    LAS bf16_t* Hs = Sm + 64 * 72;
    LAS float* cwl = (LAS float*)(Hs + 64 * 72);
    LAS float* dtl = cwl + 5 * 192;
    LAS float* acl = dtl + 64;
    LAS float* ssq = acl + 64;
    const int tid = tid_fresh(), wid = __builtin_amdgcn_readfirstlane(tid >> 6), lane = tid & 63, hl = lane >> 5, lc = lane & 31;
    const int b = item >> 8, h = (item >> 5) & 7, seg = item & 31, grp = h >> 2;
    const int t_base = b * SEQ + seg * 256, tl_base = seg * 256;
    const float a_h = -fast_exp(P.a_log[h]), dtb = P.dt_bias[h], dsk = P.dskip[h];
    for (int i = tid; i < 5 * 192; i += 512) { const int w = i / 192, c = i % 192; const int cc = (c < 64) ? h * 64 + c : (c < 128) ? 512 + grp * 64 + (c - 64) : 640 + grp * 64 + (c - 128);
        cwl[i] = (w < 4) ? P.conv_w[w * 768 + cc] : P.conv_b[cc]; }
    const int w4 = wid & 3, nb_ = w4 >> 1, pb_ = w4 & 1;
    const int troff = (8 * hl + ((lane & 15) >> 2)) * 96 + 16 * ((lane >> 4) & 1) + 4 * (lane & 3);
    f32x16 hacc;
#pragma unroll
    for (int r = 0; r < 16; ++r) hacc[r] = 0.f;
    if (wid >= 4) { const float* sp = ST + (size_t)item * 4096 + (pb_ * 32 + lc) * 64 + nb_ * 32 + 4 * hl;
#pragma unroll
        for (int g4 = 0; g4 < 4; ++g4) { const f32x4 v = *(const f32x4*)(sp + 8 * g4); hacc[4 * g4] = v[0]; hacc[4 * g4 + 1] = v[1]; hacc[4 * g4 + 2] = v[2]; hacc[4 * g4 + 3] = v[3]; } }
    for (int c = 0; c < 4; ++c) {
        const int t0 = t_base + c * 64, tl0 = tl_base + c * 64;
        for (int idx = tid; idx < 67 * 32; idx += 512) { const int r = idx >> 5, piece = idx & 31, arr = piece >> 3, pc = piece & 7;
            const int col = (arr == 0 ? 512 + h * 64 : arr == 1 ? 1024 + grp * 64 : arr == 2 ? 1152 + grp * 64 : h * 64) + pc * 8;
            u32x4 v = {0u, 0u, 0u, 0u}; if (tl0 - 3 + r >= 0) v = *(const u32x4*)(PA + (size_t)(t0 - 3 + r) * PA_LD + col);
            *(LAS u32x4*)(raw + r * 256 + arr * 64 + pc * 8) = v; }
        if (wid == 0) { const float dtv = softplus_f(MISCA[(size_t)(t0 + lane) * 8 + h] + dtb); float incl = dtv * a_h;
#pragma unroll
            for (int o = 1; o < 64; o <<= 1) { const float t = __builtin_bit_cast(float, __builtin_amdgcn_ds_bpermute((lane - o) << 2, __builtin_bit_cast(int, incl))); if (lane >= o) incl += t; }
            dtl[lane] = dtv; acl[lane] = incl; }
        __syncthreads();
        { const float ac63 = acl[63];
          for (int idx = tid; idx < 64 * 192; idx += 512) { const int s = idx / 192, cch = idx % 192;
            float a = cwl[4 * 192 + cch];
#pragma unroll
            for (int w = 0; w < 4; ++w) a += cwl[w * 192 + cch] * bf2f(raw[(s + w) * 256 + cch]);
            a = silu_f(a);
            if (cch < 64) Xc[s * 96 + cch] = f2bf(a);
            else if (cch < 128) { Bc[s * 72 + (cch - 64)] = f2bf(a); Bw[s * 96 + (cch - 64)] = f2bf(a * dtl[s] * fast_exp(ac63 - acl[s])); }
            else { Cc[s * 72 + (cch - 128)] = f2bf(a); Cd[s * 72 + (cch - 128)] = f2bf(a * fast_exp(acl[s])); } }
          if (wid >= 4) {
#pragma unroll
            for (int g4 = 0; g4 < 4; ++g4) { u32x2 w; w.x = pack_bf16(hacc[4 * g4], hacc[4 * g4 + 1]); w.y = pack_bf16(hacc[4 * g4 + 2], hacc[4 * g4 + 3]);
                *(LAS u32x2*)(Hs + (pb_ * 32 + lc) * 72 + nb_ * 32 + 8 * g4 + 4 * hl) = w; }
            const float dch = fast_exp(ac63);
#pragma unroll
            for (int r = 0; r < 16; ++r) hacc[r] *= dch; } }
        __syncthreads();
        if (wid < 3) {
            const int sb = wid >> 1, tb = (wid + 1) >> 1; f32x16 d;
#pragma unroll
            for (int r = 0; r < 16; ++r) d[r] = 0.f;
#pragma unroll
            for (int ks = 0; ks < 4; ++ks) { const bf16x8 a = *(const LAS bf16x8*)(Bc + (sb * 32 + lc) * 72 + ks * 16 + 8 * hl), bq = *(const LAS bf16x8*)(Cc + (tb * 32 + lc) * 72 + ks * 16 + 8 * hl);
                d = __builtin_amdgcn_mfma_f32_32x32x16_bf16(a, bq, d, 0, 0, 0); }
            const int t = tb * 32 + lc; const float act = acl[t];
#pragma unroll
            for (int g4 = 0; g4 < 4; ++g4) { float e[4];
#pragma unroll
                for (int i = 0; i < 4; ++i) { const int s = sb * 32 + 8 * g4 + 4 * hl + i; e[i] = (s <= t) ? d[4 * g4 + i] * dtl[s] * fast_exp(act - acl[s]) : 0.f; }
                u32x2 w; w.x = pack_bf16(e[0], e[1]); w.y = pack_bf16(e[2], e[3]); *(LAS u32x2*)(Sm + t * 72 + sb * 32 + 8 * g4 + 4 * hl) = w; }
        } else if (wid == 3) {
            const u32x2 z2 = {0u, 0u};
#pragma unroll
            for (int g4 = 0; g4 < 4; ++g4) *(LAS u32x2*)(Sm + lc * 72 + 32 + 8 * g4 + 4 * hl) = z2;
        } else {
#pragma unroll
            for (int ks = 0; ks < 4; ++ks) { const bf16x8 a = tr8(Bw + ks * 16 * 96 + nb_ * 32 + troff, 4 * 96), bx = tr8(Xc + ks * 16 * 96 + pb_ * 32 + troff, 4 * 96);
                hacc = __builtin_amdgcn_mfma_f32_32x32x16_bf16(a, bx, hacc, 0, 0, 0); }
        }
        __syncthreads();
        if (wid < 4) {
            const int pb = wid >> 1, tb = wid & 1, t = tb * 32 + lc; f32x16 y;
#pragma unroll
            for (int r = 0; r < 16; ++r) y[r] = 0.f;
#pragma unroll
            for (int ks = 0; ks < 4; ++ks) { const bf16x8 a = tr8(Xc + ks * 16 * 96 + pb * 32 + troff, 4 * 96), bs = *(const LAS bf16x8*)(Sm + t * 72 + ks * 16 + 8 * hl);
                y = __builtin_amdgcn_mfma_f32_32x32x16_bf16(a, bs, y, 0, 0, 0); }
#pragma unroll
            for (int ks = 0; ks < 4; ++ks) { const bf16x8 a = *(const LAS bf16x8*)(Hs + (pb * 32 + lc) * 72 + ks * 16 + 8 * hl), bc = *(const LAS bf16x8*)(Cd + t * 72 + ks * 16 + 8 * hl);
                y = __builtin_amdgcn_mfma_f32_32x32x16_bf16(a, bc, y, 0, 0, 0); }
            float s2 = 0.f; bf16_t* yp = PA + (size_t)(t0 + t) * PA_LD + h * 64 + pb * 32;
#pragma unroll
            for (int g4 = 0; g4 < 4; ++g4) { const int p0 = 8 * g4 + 4 * hl; float o[4];
#pragma unroll
                for (int i = 0; i < 4; ++i) { const int p = pb * 32 + p0 + i; o[i] = (y[4 * g4 + i] + dsk * bf2f(Xc[t * 96 + p])) * silu_f(bf2f(raw[(t + 3) * 256 + 192 + p])); s2 += o[i] * o[i]; }
                u32x2 w; w.x = pack_bf16(o[0], o[1]); w.y = pack_bf16(o[2], o[3]); *(u32x2*)(yp + p0) = w; }
            s2 = sum32(s2); if (hl == 0) ssq[pb * 64 + t] = s2;
        }
        __syncthreads();
        if (tid < 64) SSA[(size_t)(t0 + tid) * 8 + h] = ssq[tid] + ssq[64 + tid];
    }
    __syncthreads();
}
__device__ __forceinline__ void dsa_prep(bf16_t* PB, const int* positions, const float* qn, const float* kn, int bid, int nb) {
    const int tid_ = tid_fresh(), wid = tid_ >> 6, lane = tid_ & 63, j = lane & 31, half = lane >> 5;
    const float inv_freq = fast_exp2(-(float)j * (13.287712379549449f / 32.0f));
    for (int tok = bid * 8 + wid; tok < T_TOK; tok += nb * 8) {
        const float ang = (float)positions[tok] * inv_freq; float sn, cs; sincos_rev(ang, sn, cs);
#pragma unroll
        for (int i = 0; i < 8; ++i) { const int vec = 2 * i + half; const bool isq = vec < 8;
            bf16_t* p = PB + (size_t)tok * PB_LD + (isq ? vec * 64 : 512 + (vec - 8) * 64);
            const float x1 = bf2f(p[j]), x2 = bf2f(p[j + 32]); float ss = x1 * x1 + x2 * x2;
            ss = sum_lo32(ss);
            const float r = fast_rsq(ss * (1.0f / 64.0f) + NORM_EPS); const float* gn = isq ? qn : kn;
            const float y1 = x1 * r * gn[j], y2 = x2 * r * gn[j + 32];
            float o1 = y1 * cs - y2 * sn, o2 = y2 * cs + y1 * sn;
            if (isq) { o1 *= 0.125f * 1.4426950408889634f; o2 *= 0.125f * 1.4426950408889634f; }
            p[j] = f2bf(o1); p[j + 32] = f2bf(o2); }
    }
}

constexpr int HS = 1025;
#ifndef TK_PROBE
#define TK_PROBE 0
#endif
#ifndef TK_FORCE_FAST
#define TK_FORCE_FAST 0
#endif
constexpr int TK_CAP = 960;
constexpr int TK_LIST = 0, TK_MASKL = 32 * TK_CAP * 4, TK_ARR = TK_MASKL + 32 * 256 * 4;
__device__ __forceinline__ float relu_i(float x) { const int i = __builtin_bit_cast(int, x); return __builtin_bit_cast(float, i > 0 ? i : 0); }
__device__ __forceinline__ unsigned sk20_of(float s) { const int u = __builtin_bit_cast(int, s + 0.0f); return ((unsigned)u ^ ((unsigned)(u >> 31) | 0x80000000u)) >> 12; }
__device__ __forceinline__ unsigned fine_bin(float s) { const unsigned u = __float_as_uint(s + 0.0f); const int v = (int)((u >> 19) & 0xfffu) - (96 << 4);
    const int t = (v < -1 ? -1 : (v > 1022 ? 1022 : v)) + 1; return (u >> 31) ? (unsigned)(1023 - t) : (unsigned)(1024 + t); }
__device__ __forceinline__ void idx_load(const bf16_t* KIBb, int key0, int lane, bf16x8 (&kf)[4]) {
    const bf16_t* kp = KIBb + (size_t)(key0 + (lane & 31)) * 64 + 8 * (lane >> 5);
#pragma unroll
    for (int ks = 0; ks < 4; ++ks) kf[ks] = *(const bf16x8*)(kp + ks * 16);
}
__device__ __forceinline__ void idx_scores(const bf16x8 (&kf)[4], const bf16x8 (&qf)[4][4], const float (&wsc)[4], float (&sc)[16]) {
    f32x16 d[4];
#pragma unroll
    for (int hd = 0; hd < 4; ++hd)
#pragma unroll
        for (int r = 0; r < 16; ++r) d[hd][r] = 0.f;
#pragma unroll
    for (int ks = 0; ks < 4; ++ks)
#pragma unroll
        for (int hd = 0; hd < 4; ++hd) d[hd] = __builtin_amdgcn_mfma_f32_32x32x16_bf16(kf[ks], qf[hd][ks], d[hd], 0, 0, 0);
#pragma unroll
    for (int r = 0; r < 16; ++r) { float s = wsc[0] * relu_i(d[0][r]); s += wsc[1] * relu_i(d[1][r]); s += wsc[2] * relu_i(d[2][r]); s += wsc[3] * relu_i(d[3][r]); sc[r] = s; }
}
__device__ __forceinline__ void tk_boundary(const LAS unsigned* hrow, unsigned need, int lane, unsigned& bb, unsigned& above, unsigned& inbin) {
    unsigned s = 0;
#pragma unroll
    for (int i = 0; i < 16; ++i) { const unsigned w = hrow[1008 - 16 * lane + i]; s += (w & 0xffffu) + (w >> 16); }
    unsigned pre = s;
#pragma unroll
    for (int o = 1; o < 64; o <<= 1) { const unsigned t = (unsigned)__builtin_amdgcn_ds_bpermute((lane - o) << 2, (int)pre); if (lane >= o) pre += t; }
    const unsigned long long bal = __ballot(pre >= need);
    const int lstar = bal ? (int)__builtin_ctzll(bal) : 63;
    unsigned cum = pre - s, rb = 0, ra = cum, rc = 0; bool found = false;
    if (lane == lstar) {
#pragma unroll 1
        for (int i = 31; i >= 0; --i) { const int bin = 2016 - 32 * lane + i; const unsigned w = hrow[bin >> 1], c = (bin & 1) ? (w >> 16) : (w & 0xffffu);
            if (!found && cum + c >= need) { found = true; rb = (unsigned)bin; ra = cum; rc = c; } cum += c; }
    }
    bb = (unsigned)__builtin_amdgcn_readlane((int)rb, lstar); above = (unsigned)__builtin_amdgcn_readlane((int)ra, lstar); inbin = (unsigned)__builtin_amdgcn_readlane((int)rc, lstar);
}

__device__ __forceinline__ void dsa_topk_tile(LAS unsigned char* lds, int b, int qt, const bf16_t* PB, const bf16_t* KIB, const float* WI, unsigned* MASK) {
    LAS unsigned* hist = (LAS unsigned*)lds;
    LAS unsigned* list = (LAS unsigned*)(lds + TK_LIST);
    LAS unsigned* maskl = (LAS unsigned*)(lds + TK_MASKL);
    LAS unsigned* B1 = (LAS unsigned*)(lds + TK_ARR);
    LAS unsigned* NEED = B1 + 32;
    LAS unsigned* CNT = NEED + 32;
    LAS unsigned* FLAG = CNT + 32;
    const int tid = tid_fresh(), wid = __builtin_amdgcn_readfirstlane(tid >> 6), lane = tid & 63, qc = lane & 31, hl = lane >> 5;
    const int ql = qt * 32 + qc; const size_t row = (size_t)b * SEQ + ql;
    const bf16_t* KIBb = KIB + (size_t)b * SEQ * 64;
    const int nkt = qt + 1;
    if (qt < 8) {
        for (int kt = wid; kt < nkt; kt += 8) { unsigned word = 0u;
#pragma unroll
            for (int r = 0; r < 16; ++r) { const int rho = (r & 3) + 8 * (r >> 2) + 4 * hl; word |= ((kt * 32 + rho <= ql) ? 1u : 0u) << rho; }
            word = or32(word); if (hl == 0) MASK[row * 256 + kt] = word; }
        return;
    }
    bf16x8 qf[4][4]; float wsc[4];
    { const f32x4 wv = *(const f32x4*)(WI + row * 4);
#pragma unroll
      for (int hd = 0; hd < 4; ++hd) { wsc[hd] = wv[hd] * 0.0625f;
#pragma unroll
        for (int ks = 0; ks < 4; ++ks) qf[hd][ks] = *(const bf16x8*)(PB + row * PB_LD + 1536 + hd * 64 + ks * 16 + 8 * hl); } }
    for (int i = tid; i < 32 * HS; i += 512) hist[i] = 0u;
    if (tid == 0) FLAG[0] = 0u;
    __syncthreads();
    { bf16x8 kf[4], kn[4]; idx_load(KIBb, wid * 32 < nkt * 32 ? wid * 32 : 0, lane, kf);
#pragma unroll 1
      for (int kt = wid; kt < nkt; kt += 8) {
        const int ktn = kt + 8 < nkt ? kt + 8 : kt; idx_load(KIBb, ktn * 32, lane, kn);
        float sc[16]; idx_scores(kf, qf, wsc, sc);
        if (kt == qt) {
#pragma unroll
            for (int r = 0; r < 16; ++r) if ((r & 3) + 8 * (r >> 2) + 4 * hl > qc) sc[r] = -__builtin_inff(); }
#pragma unroll
        for (int r = 0; r < 16; ++r) { const unsigned bin = sk20_of(sc[r]) >> 9;
            __hip_atomic_fetch_add(hist + qc * HS + (bin >> 1), 1u << (16 * (bin & 1u)), __ATOMIC_RELAXED, __HIP_MEMORY_SCOPE_WORKGROUP); }
#pragma unroll
        for (int ks = 0; ks < 4; ++ks) kf[ks] = kn[ks]; } }
    __syncthreads();
#pragma unroll 1
    for (int qq = 0; qq < 4; ++qq) { const int q = wid * 4 + qq; unsigned bb, above, inbin; tk_boundary(hist + q * HS, 256u, lane, bb, above, inbin);
        if (lane == 0) { B1[q] = bb; NEED[q] = 256u - above; CNT[q] = 0u; if (inbin > (unsigned)TK_CAP) FLAG[0] = 1u; } }
    __syncthreads();
    const bool overflow = FLAG[0] != 0u;
    const unsigned b1 = B1[qc];
    __syncthreads();
    if (!overflow) {
        float th_lo, th_hi;
        { const unsigned klo = b1 << 21; th_lo = __uint_as_float((klo & 0x80000000u) ? (klo & 0x7fffffffu) : ~klo);
          const unsigned khi = (b1 + 1u) << 21; th_hi = (b1 >= 2047u) ? __builtin_inff() : __uint_as_float((khi & 0x80000000u) ? (khi & 0x7fffffffu) : ~khi); }
        { bf16x8 kf[4], kn[4]; idx_load(KIBb, wid * 32, lane, kf);
#pragma unroll 1
          for (int kt = wid; kt < nkt; kt += 8) {
            const int ktn = kt + 8 < nkt ? kt + 8 : kt; idx_load(KIBb, ktn * 32, lane, kn);
            float sc[16]; idx_scores(kf, qf, wsc, sc);
            if (kt == qt) {
#pragma unroll
                for (int r = 0; r < 16; ++r) if ((r & 3) + 8 * (r >> 2) + 4 * hl > qc) sc[r] = -__builtin_inff(); }
            unsigned word = 0u, cm = 0u;
#pragma unroll
            for (int r = 0; r < 16; ++r) { const float s = sc[r] + 0.0f; const unsigned hi = s >= th_hi ? 1u : 0u, lo = s >= th_lo ? 1u : 0u;
                word |= hi << ((r & 3) + 8 * (r >> 2)); cm |= (lo & ~hi) << r; }
            word <<= 4 * hl;
            if (cm) { unsigned pos = __hip_atomic_fetch_add(CNT + qc, (unsigned)__builtin_popcount(cm), __ATOMIC_RELAXED, __HIP_MEMORY_SCOPE_WORKGROUP);
#pragma unroll
                for (int r = 0; r < 16; ++r) if ((cm >> r) & 1u) { const int key = kt * 32 + (r & 3) + 8 * (r >> 2) + 4 * hl;
                    if (pos < (unsigned)TK_CAP) list[qc * TK_CAP + pos] = ((sk20_of(sc[r]) & 511u) << 13) | (8191u - (unsigned)key); ++pos; } }
            word = or32(word); if (hl == 0) maskl[qc * 256 + kt] = word;
#pragma unroll
            for (int ks = 0; ks < 4; ++ks) kf[ks] = kn[ks]; } }
        __syncthreads();
#pragma unroll 1
        for (int qq = 0; qq < 4; ++qq) { const int q = wid * 4 + qq; const unsigned n = CNT[q], need = NEED[q];
            unsigned cv[15];
#pragma unroll
            for (int i = 0; i < 15; ++i) { const unsigned p = (unsigned)(i * 64 + lane); cv[i] = p < n ? (list[q * TK_CAP + p] + 1u) : 0u; }
            unsigned T = 0u;
#pragma unroll 1
            for (int bit = 22; bit >= 0; --bit) { const unsigned cand = T | (1u << bit); unsigned c = 0;
#pragma unroll
                for (int i = 0; i < 15; ++i) c += (unsigned)__builtin_popcountll(__ballot(cv[i] >= cand));
                if (c >= need) T = cand; }
#pragma unroll
            for (int i = 0; i < 15; ++i) if (cv[i] >= T && cv[i] != 0u) { const unsigned key = 8191u - ((cv[i] - 1u) & 8191u);
                __hip_atomic_fetch_or(maskl + q * 256 + (key >> 5), 1u << (key & 31u), __ATOMIC_RELAXED, __HIP_MEMORY_SCOPE_WORKGROUP); } }
        __syncthreads();
        for (int i = tid; i < 32 * 256; i += 512) { const int q = i >> 8, kt = i & 255; if (kt < nkt) MASK[((size_t)b * SEQ + qt * 32 + q) * 256 + kt] = maskl[i]; }
        __syncthreads();
        return;
    }
    LAS unsigned* BND = B1 + 128;
    unsigned b2 = 0;
#pragma unroll 1
    for (int level = 1; level < 3; ++level) {
        for (int i = tid; i < 32 * HS; i += 512) hist[i] = 0u;
        __syncthreads();
        if (level == 2) b2 = BND[qc];
#pragma unroll 1
        for (int kt = wid; kt < nkt; kt += 8) { bf16x8 kf[4]; idx_load(KIBb, kt * 32, lane, kf); float sc[16]; idx_scores(kf, qf, wsc, sc);
#pragma unroll
            for (int r = 0; r < 16; ++r) { const int key = kt * 32 + (r & 3) + 8 * (r >> 2) + 4 * hl; const unsigned sk = sk20_of(sc[r]), inv = 8191u - (unsigned)key;
                const unsigned L1 = sk >> 9, L2 = ((sk & 511u) << 2) | (inv >> 11), L3 = inv & 2047u;
                bool ok = (key <= ql) && (L1 == b1); unsigned bin = L2;
                if (level == 2) { ok = ok && (L2 == b2); bin = L3; }
                if (ok) __hip_atomic_fetch_add(hist + qc * HS + (bin >> 1), 1u << (16 * (bin & 1u)), __ATOMIC_RELAXED, __HIP_MEMORY_SCOPE_WORKGROUP); } }
        __syncthreads();
#pragma unroll 1
        for (int qq = 0; qq < 4; ++qq) { const int q = wid * 4 + qq; unsigned bb, above, inbin; tk_boundary(hist + q * HS, NEED[q], lane, bb, above, inbin);
            if (lane == 0) { BND[(level - 1) * 32 + q] = bb; NEED[q] = NEED[q] - above; } }
        __syncthreads();
    }
    { const unsigned c2 = BND[qc], c3 = BND[32 + qc]; const unsigned thi = (b1 << 9) | (c2 >> 2), tlo = ((c2 & 3u) << 11) | c3;
#pragma unroll 1
      for (int kt = wid; kt < nkt; kt += 8) { bf16x8 kf[4]; idx_load(KIBb, kt * 32, lane, kf); float sc[16]; idx_scores(kf, qf, wsc, sc); unsigned word = 0u;
#pragma unroll
        for (int r = 0; r < 16; ++r) { const int rho = (r & 3) + 8 * (r >> 2) + 4 * hl, key = kt * 32 + rho; const unsigned sk = sk20_of(sc[r]), inv = 8191u - (unsigned)key;
            const bool sel = (key <= ql) && (sk > thi || (sk == thi && inv >= tlo)); word |= (sel ? 1u : 0u) << rho; }
        word = or32(word); if (hl == 0) MASK[row * 256 + kt] = word; } }
    __syncthreads();
}

typedef short v4i16_t __attribute__((ext_vector_type(4)));
__device__ __forceinline__ bf16x8 vtr2(const LAS bf16_t* p, int second_off) {
    const v4i16_t lo = __builtin_amdgcn_ds_read_tr16_b64_v4i16((LAS v4i16_t*)p), hi = __builtin_amdgcn_ds_read_tr16_b64_v4i16((LAS v4i16_t*)(p + second_off));
    return __builtin_shufflevector(lo, hi, 0, 1, 2, 3, 4, 5, 6, 7);
}
constexpr int ATT_KS = 72, ATT_VS = 96, ATT_BUF = (64 * ATT_KS + 64 * ATT_VS) * 2;
__device__ __forceinline__ void dsa_attn_item(LAS unsigned char* lds, int b, int hd, int qb, const bf16_t* PB, const unsigned* MASK, bf16_t* YC, const float* qn, const float* kn) {
    const int tid = tid_fresh(), wid = __builtin_amdgcn_readfirstlane(tid >> 6), lane = tid & 63, qc = lane & 31, hl = lane >> 5;
    const int q0 = qb * 256 + wid * 32, ql = q0 + qc; const size_t row = (size_t)b * SEQ + ql;
    const int my_sb_max = q0 >> 5;
    float negC;
    { float gq = fabsf(qn[lane]), gk = fabsf(kn[lane]);
      gq = fmaxf(gq, swz_xor<16>(gq)); gq = fmaxf(gq, swz_xor<8>(gq)); gq = fmaxf(gq, swz_xor<4>(gq)); gq = fmaxf(gq, swz_xor<2>(gq)); gq = fmaxf(gq, swz_xor<1>(gq)); gq = max32(gq);
      gk = fmaxf(gk, swz_xor<16>(gk)); gk = fmaxf(gk, swz_xor<8>(gk)); gk = fmaxf(gk, swz_xor<4>(gk)); gk = fmaxf(gk, swz_xor<2>(gk)); gk = fmaxf(gk, swz_xor<1>(gk)); gk = max32(gk);
      negC = -(8.0f * 1.4426950408889634f * 1.001f) * gq * gk; }
    bf16x8 qf[4];
#pragma unroll
    for (int ks = 0; ks < 4; ++ks) qf[ks] = *(const bf16x8*)(PB + row * PB_LD + hd * 64 + ks * 16 + 8 * hl);
    f32x16 o0, o1;
#pragma unroll
    for (int r = 0; r < 16; ++r) { o0[r] = 0.f; o1[r] = 0.f; }
    float l = 0.f;
    const int nkt = 4 * (qb + 1);
    const int skey = tid >> 3, sd = (tid & 7) * 8;
    const int vtr_off = (4 * hl + ((lane & 15) >> 2)) * ATT_VS + 16 * ((lane >> 4) & 1) + 4 * (lane & 3);
    const bf16_t* kbase = PB + ((size_t)b * SEQ + skey) * PB_LD + 512 + hd * 64 + sd;
    u32x4 kw = *(const u32x4*)kbase, vw = *(const u32x4*)(kbase + 512);
    __syncthreads();
    const unsigned* mrow = MASK + row * 256;
    u32x4 mq0 = *(const u32x4*)mrow, mq1 = *(const u32x4*)(mrow + 4);
#define ATT_TILE(J, MW0, MW1) { const int kt = kt0 + (J); \
        LAS bf16_t* Ks = (LAS bf16_t*)(lds + ((J) & 1) * ATT_BUF); LAS bf16_t* Vs = Ks + 64 * ATT_KS; \
        *(LAS u32x4*)(Ks + skey * ATT_KS + sd) = kw; *(LAS u32x4*)(Vs + skey * ATT_VS + sd) = vw; \
        if (kt + 1 < nkt) { const bf16_t* kp = kbase + (size_t)(kt + 1) * 64 * PB_LD; kw = *(const u32x4*)kp; vw = *(const u32x4*)(kp + 512); } \
        asm volatile("s_waitcnt lgkmcnt(0)" ::: "memory"); __builtin_amdgcn_s_barrier(); asm volatile("" ::: "memory");     \
        if (2 * kt <= my_sb_max) { \
            f32x16 s[2]; int mwh[2]; \
            mwh[0] = (int)((MW0) >> (4 * hl)); mwh[1] = (int)(((2 * kt + 1 <= my_sb_max) ? (MW1) : 0u) >> (4 * hl)); \
            _Pragma("unroll") for (int sbi = 0; sbi < 2; ++sbi) _Pragma("unroll") for (int r = 0; r < 16; ++r) s[sbi][r] = negC; \
            _Pragma("unroll") for (int ks = 0; ks < 4; ++ks) _Pragma("unroll") for (int sbi = 0; sbi < 2; ++sbi) { const bf16x8 kf = *(const LAS bf16x8*)(Ks + (sbi * 32 + qc) * ATT_KS + ks * 16 + 8 * hl); \
                    s[sbi] = __builtin_amdgcn_mfma_f32_32x32x16_bf16(kf, qf[ks], s[sbi], 0, 0, 0); } \
            float ps = 0.f; bf16x8 pf[2][2]; \
            _Pragma("unroll") for (int sbi = 0; sbi < 2; ++sbi) { float pv[16]; \
                _Pragma("unroll") for (int r = 0; r < 16; ++r) { const int sel = __builtin_amdgcn_sbfe(mwh[sbi], (r & 3) + 8 * (r >> 2), 1); \
                    const float p = __builtin_bit_cast(float, __builtin_bit_cast(int, fast_exp2(s[sbi][r])) & sel); pv[r] = p; ps += p; } \
                _Pragma("unroll") for (int s2 = 0; s2 < 2; ++s2) { u32x4 w; w.x = pack_bf16(pv[8 * s2 + 0], pv[8 * s2 + 1]); w.y = pack_bf16(pv[8 * s2 + 2], pv[8 * s2 + 3]); \
                    w.z = pack_bf16(pv[8 * s2 + 4], pv[8 * s2 + 5]); w.w = pack_bf16(pv[8 * s2 + 6], pv[8 * s2 + 7]); pf[sbi][s2] = __builtin_bit_cast(bf16x8, w); } } \
            l += ps; \
            _Pragma("unroll") for (int sbi = 0; sbi < 2; ++sbi) _Pragma("unroll") for (int s2 = 0; s2 < 2; ++s2) { const LAS bf16_t* vp = Vs + (sbi * 32 + s2 * 16) * ATT_VS + vtr_off; \
                    const bf16x8 v0 = vtr2(vp, 8 * ATT_VS), v1 = vtr2(vp + 32, 8 * ATT_VS); \
                    o0 = __builtin_amdgcn_mfma_f32_32x32x16_bf16(v0, pf[sbi][s2], o0, 0, 0, 0); \
                    o1 = __builtin_amdgcn_mfma_f32_32x32x16_bf16(v1, pf[sbi][s2], o1, 0, 0, 0); } \
        } }
    for (int kt0 = 0; kt0 < nkt; kt0 += 4) {
        u32x4 nq0 = mq0, nq1 = mq1;
        if (kt0 + 4 < nkt) { nq0 = *(const u32x4*)(mrow + 2 * kt0 + 8); nq1 = *(const u32x4*)(mrow + 2 * kt0 + 12); }
        ATT_TILE(0, mq0.x, mq0.y) ATT_TILE(1, mq0.z, mq0.w) ATT_TILE(2, mq1.x, mq1.y) ATT_TILE(3, mq1.z, mq1.w)
        mq0 = nq0; mq1 = nq1;
    }
#undef ATT_TILE
    l = sum32(l);
    const float inv = fast_rcp(l);
    bf16_t* op = YC + row * 512 + hd * 64;
#pragma unroll
    for (int r4 = 0; r4 < 4; ++r4) { const int d = 8 * r4 + 4 * hl;
        u32x2 w0, w1; w0.x = pack_bf16(o0[4 * r4] * inv, o0[4 * r4 + 1] * inv); w0.y = pack_bf16(o0[4 * r4 + 2] * inv, o0[4 * r4 + 3] * inv);
        w1.x = pack_bf16(o1[4 * r4] * inv, o1[4 * r4 + 1] * inv); w1.y = pack_bf16(o1[4 * r4 + 2] * inv, o1[4 * r4 + 3] * inv);
        *(u32x2*)(op + d) = w0; *(u32x2*)(op + 32 + d) = w1; }
    __syncthreads();
}
#define XB_TMO      128
#define XB_XCNT(j)  (256  + 64 * (j))
#define XB_XSUB(j)  (1280 + 64 * (j))
#define XB_XGEN(j)  (2304 + 64 * (j))
#define XB_TOP      3328
#define XB_TOPGEN   3392
#define XCD_BAR_WORDS 3456
#define XB_SPIN_CAP (1u << 22)
__device__ __forceinline__ unsigned xb_ld(unsigned* p)              { return __hip_atomic_load(p, __ATOMIC_RELAXED, __HIP_MEMORY_SCOPE_AGENT); }
__device__ __forceinline__ unsigned xb_add(unsigned* p, unsigned v) { return __hip_atomic_fetch_add(p, v, __ATOMIC_RELAXED, __HIP_MEMORY_SCOPE_AGENT); }
__device__ __forceinline__ unsigned xb_xcc_id() { return (unsigned)__builtin_amdgcn_s_getreg((3 << 11) | 20) & 0xFu; }
#define XB_SPIN(cond, bar) do { unsigned _sp = 0; while (cond) { __builtin_amdgcn_s_sleep(1); \
    if ((++_sp & 255u) == 0u) { if (xb_ld(&(bar)[XB_TMO])) break; if (_sp > XB_SPIN_CAP) { atomicAdd(&(bar)[XB_TMO], 1u); break; } } } } while (0)
constexpr int XB_ST_OFF = TID_TAB_OFF - 16;
__device__ __forceinline__ void xcd_barrier_post(unsigned* bar) { if (tid_fresh() == 0) (void)xb_add(&bar[XB_XCNT(xb_xcc_id())], 1u); }
__device__ __forceinline__ void xcd_barrier_complete(unsigned* bar, unsigned x, unsigned G, unsigned& nloc, unsigned& nx) {
    unsigned sum, cnt, mine, sp = 0u;
    for (;;) {
        sum = 0u; cnt = 0u; mine = 0u;
#pragma unroll
        for (unsigned j = 0; j < 16; ++j) { const unsigned c = xb_ld(&bar[XB_XCNT(j)]); sum += c; cnt += (c > 0u) ? 1u : 0u; mine = (j == x) ? c : mine; }
        if (sum == G) break;
        __builtin_amdgcn_s_sleep(1);
        if ((++sp & 255u) == 0u) { if (xb_ld(&bar[XB_TMO])) break; if (sp > XB_SPIN_CAP) { atomicAdd(&bar[XB_TMO], 1u); break; } }
    }
    nloc = mine > 0u ? mine : 1u; nx = cnt > 0u ? cnt : 1u;
}
__device__ __forceinline__ void xcd_barrier(unsigned* bar, unsigned G) {
    asm volatile("s_waitcnt vmcnt(0)" ::: "memory");
    __syncthreads();
    if (tid_fresh() == 0) {
        volatile LAS unsigned* st = (volatile LAS unsigned*)(LAS char*)XB_ST_OFF;
        const unsigned x = xb_xcc_id();
        __builtin_amdgcn_s_waitcnt(0);
        unsigned nloc = st[0], nx = st[1];
        if (nloc == 0u) { xcd_barrier_complete(bar, x, G, nloc, nx); st[0] = nloc; st[1] = nx; }
        const unsigned old = xb_add(&bar[XB_XSUB(x)], 1u);
        const unsigned gen = old / nloc;
        if (old + 1u == (gen + 1u) * nloc) {
            __builtin_amdgcn_fence(__ATOMIC_RELEASE, "agent");
            asm volatile("s_waitcnt vmcnt(0)" ::: "memory");
            const unsigned og = xb_add(&bar[XB_TOP], 1u);
            const unsigned tg = og / nx;
            if (og + 1u == (tg + 1u) * nx) xb_add(&bar[XB_TOPGEN], 1u);
            else XB_SPIN(xb_ld(&bar[XB_TOPGEN]) == tg, bar);
            __builtin_amdgcn_fence(__ATOMIC_ACQUIRE, "agent");
            xb_add(&bar[XB_XGEN(x)], 1u);
            asm volatile("s_waitcnt vmcnt(0)" ::: "memory");
        } else {
            XB_SPIN(xb_ld(&bar[XB_XGEN(x)]) == gen, bar);
            __builtin_amdgcn_fence(__ATOMIC_ACQUIRE, "agent");
            asm volatile("s_waitcnt vmcnt(0)" ::: "memory");
        }
    }
    __syncthreads();
}
constexpr size_t MiB = 1u << 20;
constexpr size_t OFF_CTL = 0, OFF_AQ = 16384, OFF_DEC = 65536, OFF_DECK = 131072;
constexpr size_t OFF_SS = 1 * MiB, OFF_XB = 2 * MiB, OFF_RW = 34 * MiB, OFF_RA = 70 * MiB, OFF_RB = 174 * MiB, WS_NEED = 272 * MiB;
constexpr size_t W_GLU = 0, W_E13 = 1 * MiB, W_E2 = 12 * MiB, W_EINA = 17 * MiB + 512 * 1024, W_ETY = 25 * MiB + 512 * 1024, W_EWST = 31 * MiB + 512 * 1024;
constexpr size_t W_LINB = 1 * MiB, W_LG = 5 * MiB, W_LB = 13 * MiB, W_LO = 17 * MiB, W_L13 = 19 * MiB, W_L2 = 30 * MiB;
constexpr size_t A_H1 = 0, A_PA = 0, A_PB = 0, A_MISCB = 56 * MiB, A_MASK = 64 * MiB, A_YC = 80 * MiB;
constexpr size_t B_U = 0, B_SC = 24 * MiB, B_S5Y = 40 * MiB, B_M2ST = 56 * MiB, B_HGST = 64 * MiB, B_MISCA = 80 * MiB, B_SSA = 81 * MiB, B_YB = 82 * MiB;
constexpr size_t B_GSCR = 0, B_MERGED = 32 * MiB;
constexpr int LDS_BYTES = 160 * 1024;
constexpr int NPH_LAYER = 16;
#ifndef SUBMASK
#define SUBMASK 0xffu
#endif
#ifndef P4SEL
#define P4SEL 7
#endif
#ifndef REPMASK
#define REPMASK 0u
#endif
#ifndef PHMASK
#define PHMASK 0xffffu
#endif

struct Args { const void* in[34]; float* out; unsigned char* ws; int ph_lo, ph_hi; };

__global__ void __launch_bounds__(512) hybrid_fwd(Args a) {
    cg::grid_group grid = cg::this_grid();
    extern __shared__ __attribute__((aligned(16))) unsigned char lds_raw[];
    LAS unsigned char* lds = (LAS unsigned char*)lds_raw;
    const int ph_lo = a.ph_lo, ph_hi = a.ph_hi;
    tid_tab_init();
    if (threadIdx.x < 4) ((LAS unsigned*)(LAS char*)XB_ST_OFF)[threadIdx.x] = 0u;
    __syncthreads();
    xcd_barrier_post((unsigned*)a.ws);
    grid.sync();
    for (int ph = ph_lo; ph < ph_hi; ++ph) {
    typedef const __attribute__((address_space(4))) Args* KArgsPtr;
    KArgsPtr kargs = (KArgsPtr)__builtin_amdgcn_kernarg_segment_ptr();
    asm volatile("" : "+s"(kargs));
#define A (*kargs)
    unsigned char* ws = A.ws;
    const int bid = sgpr_fresh(blockIdx.x), nb = sgpr_fresh(gridDim.x);
#define X ((float*)A.out)
#define SS ((float*)(ws + OFF_SS))
#define XB ((bf16_t*)(ws + OFF_XB))
#define RW (ws + OFF_RW)
#define RA (ws + OFF_RA)
#define RB (ws + OFF_RB)
#define AQ ((float*)(ws + OFF_AQ))
#define DEC ((float*)(ws + OFF_DEC))
#define DECK ((float*)(ws + OFF_DECK))
#define H1 ((bf16_t*)(RA + A_H1))
#define PA ((bf16_t*)(RA + A_PA))
#define PB ((bf16_t*)(RA + A_PB))
#define KIB ((bf16_t*)(RA + A_MISCB))
#define WI ((float*)(RA + A_MISCB + 2 * MiB))
#define MASK ((unsigned*)(RA + A_MASK))
#define YC ((bf16_t*)(RA + A_YC))
#define U ((bf16_t*)(RB + B_U))
#define SC ((float*)(RB + B_SC))
#define S5Y ((bf16_t*)(RB + B_S5Y))
#define M2ST ((float*)(RB + B_M2ST))
#define HGST ((float*)(RB + B_HGST))
#define MISCA ((float*)(RB + B_MISCA))
#define SSA ((float*)(RB + B_SSA))
#define YB ((bf16_t*)(RB + B_YB))
#define GSCR ((bf16_t*)(RB + B_GSCR) + (size_t)bid * 65536)
#define MERGED ((bf16_t*)(RB + B_MERGED))
    {
        const int l = ph / NPH_LAYER, sp = ph % NPH_LAYER;
#define INF(i, per) (((const float*)A.in[i]) + (size_t)l * (per))
        const int reps = ((REPMASK >> sp) & 1u) ? 2 : 1;
        for (int rep = 0; rep < reps; ++rep) {
        if (rep) xcd_barrier((unsigned*)ws, (unsigned)nb);
        switch (sp) {
        case 0: if constexpr (PHMASK & (1u<<0)) {
            int rot = 0; CvtJob j;
            j = CvtJob{INF(3, DM * DFF), INF(4, DM * DFF), INF(2, DM), (bf16_t*)(RW + W_E13), DFF, 2 * DFF, DM, MAP_IL2, 0}; cvt_run(lds, j, bid, nb, rot);
            j = CvtJob{INF(5, DFF * DM), nullptr, nullptr, (bf16_t*)(RW + W_E2), DM, DM, DFF, MAP_PLAIN, 0}; cvt_run(lds, j, bid, nb, rot);
            j = CvtJob{INF(7, DM * DIN), nullptr, INF(6, DM), (bf16_t*)(RW + W_EINA), DIN, 4096, DM, MAP_INA, 0}; cvt_run(lds, j, bid, nb, rot);
            j = CvtJob{INF(25, 512 * 1024), INF(25, 512 * 1024), nullptr, (bf16_t*)(RW + W_GLU), 1024, 1024, 512, MAP_IL2, 512}; cvt_run(lds, j, bid, nb, rot);
            for (int it = bid; it < 256; it += nb) s5_tables(lds, it >> 3, it & 7, INF(17, 2048), INF(18, 2048), INF(19, 32768), INF(20, 32768), INF(21, 32768), INF(22, 32768), INF(23, 512), INF(24, 32),
                                                             (bf16_t*)(RW + W_ETY), (bf16_t*)(RW + W_EWST), AQ);
            if (l == 0) x_prologue((const float*)A.in[0], X, XB, SS, bid, nb);
        } break;
        case 1: case 14: if constexpr (PHMASK & (1u<<1)) {
            pg8::Gemm g{XB, (const bf16_t*)(RW + (sp == 1 ? W_E13 : W_L13)), DM, DM, DM}; pg8::StaticOrder S; S.init(64, 22, nb, bid);
            pg8::EpiSwiGLU E{H1, DFF, SS}; pg8::gemm_phase<pg8::EpiSwiGLU, pg8::StaticOrder, true, true>(lds, g, S, E);
        } break;
        case 2: case 15: if constexpr (PHMASK & (1u<<2)) {
            pg8::Gemm g{H1, (const bf16_t*)(RW + (sp == 2 ? W_E2 : W_L2)), DFF, DFF, DFF}; pg8::StaticOrder S; S.init(64, 4, nb, bid);
            pg8::EpiResid E{X, XB, SS, 0.5f}; pg8::gemm_phase<pg8::EpiResid, pg8::StaticOrder, true, true>(lds, g, S, E);
        } break;
        case 3: if constexpr (PHMASK & (1u<<3)) {
            pg8::Gemm g{XB, (const bf16_t*)(RW + W_EINA), DM, DM, DM}; pg8::StaticOrder S; S.init(64, 16, nb, bid);
            pg8::EpiInA E{PA, U, MISCA, SS}; pg8::gemm_phase<pg8::EpiInA, pg8::StaticOrder, true, true>(lds, g, S, E);
        } break;
        case 4: if constexpr (PHMASK & (1u<<4)) {
            if (rep == 0 || (P4SEL & 1)) { pg8::Gemm g{U, (const bf16_t*)(RW + W_EWST), U_LD, 256, 256}; pg8::GroupOrder S; S.init(32, 4, 1, nb, bid);
              pg8::EpiS5State E{SC}; pg8::gemm_phase<pg8::EpiS5State, pg8::GroupOrder, true, true>(lds, g, S, E); }
            if (rep == 0 || (P4SEL & 2)) { const HgParams hp{(const float*)A.in[28], (const float*)A.in[28] + 512, INF(29, 512), l};
              for (int it = bid; it < 256; it += nb) hg1_mfma(lds, it, PA, HGST, DECK, hp); }
            if (rep == 0 || (P4SEL & 4)) { const M2Params mp{INF(11, 4 * 768), INF(12, 768), INF(13, 8), INF(14, 8), INF(15, 8)};
              for (int it = bid; it < 512; it += nb) m2s1_mfma(lds, it, PA, MISCA, M2ST, DEC, mp); }
        } break;
        case 5: if constexpr (PHMASK & (1u<<5)) {
            for (int it = bid; it < 64; it += nb) s5_scan(lds, it, SC, AQ, U);
            const int tid = tid_fresh();
            for (int e = bid * 512 + tid; e < 131072; e += nb * 512) hg_scan(HGST, DECK, e);
            for (int e = (nb - 1 - bid) * 512 + tid; e < 65536; e += nb * 512) m2_scan(M2ST, DEC, e);
        } break;
        case 6: if constexpr (PHMASK & (1u<<6)) {
            if constexpr (SUBMASK & 4) { pg8::Gemm g{U, (const bf16_t*)(RW + W_ETY), U_LD, U_LD, U_LD}; pg8::GroupOrder S; S.init(32, 4, 1, nb, bid);
              pg8::EpiS5Y E{S5Y}; pg8::gemm_phase<pg8::EpiS5Y, pg8::GroupOrder, true, true>(lds, g, S, E); }
            if constexpr (SUBMASK & 2) { const HgParams hp{(const float*)A.in[28], (const float*)A.in[28] + 512, INF(29, 512), l};
              for (int it = bid; it < 256; it += nb) hg3_mfma(lds, it, PA, HGST, hp); }
            if constexpr (SUBMASK & 1) { const M2Params mp{INF(11, 4 * 768), INF(12, 768), INF(13, 8), INF(14, 8), INF(15, 8)};
              for (int it = bid; it < 512; it += nb) m2s3_mfma(lds, it, PA, MISCA, M2ST, SSA, mp); }
        } break;
        case 7: if constexpr (PHMASK & (1u<<7)) {
            { pg8::Gemm g{S5Y, (const bf16_t*)(RW + W_GLU), 512, 512, 512}; pg8::StaticOrder S; S.init(64, 4, nb, bid);
              pg8::EpiGLU E{YB, 512}; pg8::gemm_phase<pg8::EpiGLU, pg8::StaticOrder, true, true>(lds, g, S, E); }
            int rot = 0; CvtJob j;
            j = CvtJob{INF(7, DM * DIN), nullptr, INF(6, DM), (bf16_t*)(RW + W_LINB), DIN, 2048, DM, MAP_INB, 0}; cvt_run(lds, j, bid, nb, rot);
            j = CvtJob{INF(8, DM * 4096), nullptr, INF(6, DM), (bf16_t*)(RW + W_LG), 4096, 4096, DM, MAP_PLAIN, 0}; cvt_run(lds, j, bid, nb, rot);
            for (int gi = 0; gi < 4; ++gi) { j = CvtJob{INF(9, 4 * 512 * 1024) + (size_t)gi * 512 * 1024, nullptr, gi == 0 ? INF(16, 512) : nullptr, (bf16_t*)(RW + W_LB) + (size_t)gi * 1024 * 512, 1024, 1024, 512, MAP_PLAIN, 0}; cvt_run(lds, j, bid, nb, rot); }
            j = CvtJob{INF(10, DM * DM), nullptr, nullptr, (bf16_t*)(RW + W_LO), DM, DM, DM, MAP_PLAIN, 0}; cvt_run(lds, j, bid, nb, rot);
            j = CvtJob{INF(31, DM * DFF), INF(32, DM * DFF), INF(30, DM), (bf16_t*)(RW + W_L13), DFF, 2 * DFF, DM, MAP_IL2, 0}; cvt_run(lds, j, bid, nb, rot);
            j = CvtJob{INF(33, DFF * DM), nullptr, nullptr, (bf16_t*)(RW + W_L2), DM, DM, DFF, MAP_PLAIN, 0}; cvt_run(lds, j, bid, nb, rot);
        } break;
        case 8: case 12: if constexpr (PHMASK & (1u<<8)) {
            pg8::StaticOrder S; S.init(64, 4, nb, bid);
            for (int gi = 0; gi < 4; ++gi) { if ((sp == 8) == (gi == 2)) continue;
                { pg8::Gemm g{XB, (const bf16_t*)(RW + W_LG) + (size_t)gi * 1024 * 1024, DM, DM, DM}; pg8::EpiGate E{GSCR, SS}; pg8::gemm_phase<pg8::EpiGate, pg8::StaticOrder, true, true>(lds, g, S, E); }
                const bf16_t* Ag = gi == 0 ? PA : gi == 1 ? YB : gi == 2 ? YC : PA + 2816; const int lda = (gi == 1 || gi == 2) ? 512 : PA_LD;
                { pg8::Gemm g{Ag, (const bf16_t*)(RW + W_LB) + (size_t)gi * 1024 * 512, lda, 512, 512}; pg8::EpiBranch E{GSCR, MERGED, gi == 0 ? SSA : nullptr, gi == 0 ? 1 : 0};
                  pg8::gemm_phase<pg8::EpiBranch, pg8::StaticOrder, true, true>(lds, g, S, E); } }
        } break;
        case 9: if constexpr (PHMASK & (1u<<9)) {
            pg8::Gemm g{XB, (const bf16_t*)(RW + W_LINB), DM, DM, DM}; pg8::StaticOrder S; S.init(64, 8, nb, bid);
            pg8::EpiInB E{PB, KIB, WI, SS}; pg8::gemm_phase<pg8::EpiInB, pg8::StaticOrder, true, true>(lds, g, S, E);
        } break;
        case 10: if constexpr (PHMASK & (1u<<10)) {
            if (rep == 0) dsa_prep(PB, (const int*)A.in[1], INF(26, 64), INF(27, 64), bid, nb);
            if constexpr (SUBMASK & 2) for (int it = bid; it < 512; it += nb) { const int c = it & 255, bb = it >> 8; dsa_topk_tile(lds, bb, bb == 0 ? c : 255 - c, PB, KIB, WI, MASK); }
        } break;
        case 11: if constexpr (PHMASK & (1u<<11)) {
            for (int it = bid; it < 512; it += nb) { const int c = it & 255, second = it >> 8, pair = (c & 7) * 2 + (c >> 7), bb = pair >> 3, hd = pair & 7, jq = (c >> 3) & 15;     dsa_attn_item(lds, bb, hd, second ? 31 - jq : jq, PB, MASK, YC, INF(26, 64), INF(27, 64)); }
        } break;
        case 13: if constexpr (PHMASK & (1u<<13)) {
            pg8::Gemm g{MERGED, (const bf16_t*)(RW + W_LO), DM, DM, DM}; pg8::StaticOrder S; S.init(64, 4, nb, bid);
            pg8::EpiResid E{X, XB, SS, 1.0f}; pg8::gemm_phase<pg8::EpiResid, pg8::StaticOrder, true, true>(lds, g, S, E);
        } break;
        }
        }
#undef INF
        if (ph + 1 < ph_hi) xcd_barrier((unsigned*)ws, (unsigned)nb);
    }
    }
}

extern "C" void kernel_launch(void* const* d_in, const int* in_sizes, int n_in, void* d_out, int out_size, void* d_ws, size_t ws_size, hipStream_t stream) {
    static int grid_blocks = 0;
    if (!grid_blocks) {
        int dev = 0, cus = 0, per_cu = 0;
        hipGetDevice(&dev);
        hipDeviceGetAttribute(&cus, hipDeviceAttributeMultiprocessorCount, dev);
        hipFuncSetAttribute((const void*)hybrid_fwd, hipFuncAttributeMaxDynamicSharedMemorySize, LDS_BYTES);
        hipOccupancyMaxActiveBlocksPerMultiprocessor(&per_cu, hybrid_fwd, 512, LDS_BYTES);
        if (per_cu < 1) { fprintf(stderr, "occupancy query returned %d\n", per_cu); per_cu = 1; }
        grid_blocks = cus * 1;
        if (grid_blocks > 256) grid_blocks = 256;
        fprintf(stderr, "grid_blocks=%d cus=%d per_cu=%d ws_size=%zu need=%zu\n", grid_blocks, cus, per_cu, ws_size, (size_t)WS_NEED);
    }
    if (ws_size < WS_NEED || n_in < 34) { fprintf(stderr, "workspace too small or bad inputs\n"); return; }
    hipMemsetAsync(d_ws, 0, XCD_BAR_WORDS * 4, stream);
    Args a{};
    for (int i = 0; i < 34; ++i) a.in[i] = d_in[i];
    a.out = (float*)d_out; a.ws = (unsigned char*)d_ws; a.ph_lo = 0; a.ph_hi = NLAYER * NPH_LAYER;
    void* args[] = {&a};
    hipError_t e = hipLaunchCooperativeKernel((void*)hybrid_fwd, dim3(grid_blocks), dim3(512), args, LDS_BYTES, stream);
    if (e != hipSuccess) fprintf(stderr, "cooperative launch failed: %s (grid %d)\n", hipGetErrorString(e), grid_blocks);
}
```

```cpp
#include <hip/hip_runtime.h>
#include <hip/hip_cooperative_groups.h>
#include <cstdio>
#include <cstdint>
namespace cg = cooperative_groups;

#define LAS __attribute__((address_space(3)))
typedef unsigned short bf16_t;
typedef short bf16x8 __attribute__((ext_vector_type(8)));
typedef float f32x4 __attribute__((ext_vector_type(4)));
typedef float f32x16 __attribute__((ext_vector_type(16)));
typedef unsigned u32x4 __attribute__((ext_vector_type(4)));
typedef unsigned u32x2 __attribute__((ext_vector_type(2)));

constexpr int T_TOK = 16384, SEQ = 8192, DM = 1024, DFF = 2816, DIN = 5708, NLAYER = 2;
constexpr float NORM_EPS = 1e-6f;
constexpr int PA_LD = 3328;
constexpr int PB_LD = 1792;
constexpr int U_LD = 384;
constexpr int S5Q = 16;
constexpr int NCHUNK = T_TOK / S5Q;

typedef __bf16 hwbf2 __attribute__((ext_vector_type(2)));
typedef float f32x2_t __attribute__((ext_vector_type(2)));
__device__ __forceinline__ unsigned pack_bf16(float lo, float hi) { const f32x2_t v = {lo, hi}; return __builtin_bit_cast(unsigned, __builtin_convertvector(v, hwbf2)); }
__device__ __forceinline__ bf16_t f2bf(float f) { return (bf16_t)(pack_bf16(f, 0.f) & 0xffffu); }
__device__ __forceinline__ float bf2f(bf16_t h) { return __uint_as_float(((unsigned)h) << 16); }
__device__ __forceinline__ float bflo(unsigned w) { return __uint_as_float(w << 16); }
__device__ __forceinline__ float bfhi(unsigned w) { return __uint_as_float(w & 0xffff0000u); }
__device__ __forceinline__ float fast_exp2(float x) { return __builtin_amdgcn_exp2f(x); }
__device__ __forceinline__ float fast_rcp(float x) { return __builtin_amdgcn_rcpf(x); }
__device__ __forceinline__ float sigmoid_f(float x) { return fast_rcp(1.0f + fast_exp2(-1.4426950408889634f * x)); }
__device__ __forceinline__ float silu_f(float x) { return x * sigmoid_f(x); }
__device__ __forceinline__ float gelu_tanh_f(float x) { const float u = 0.7978845608028654f * (x + 0.044715f * x * x * x); return x * sigmoid_f(2.0f * u); }
__device__ __forceinline__ float fast_exp(float x) { return __builtin_amdgcn_exp2f(1.4426950408889634f * x); }
__device__ __forceinline__ float fast_rsq(float x) { return __builtin_amdgcn_rsqf(x); }
__device__ __forceinline__ float softplus_f(float x) {
    if (x > 20.f) return x;
    const float e = fast_exp(x);
    if (e < 0.03125f) return e * (1.0f - e * (0.5f - e * (0.33333333f - 0.25f * e)));
    return 0.6931471805599453f * __builtin_amdgcn_logf(1.0f + e);
}
__device__ __forceinline__ void sincos_rev(float ang, float& sn, float& cs) {
    double rd = (double)ang * 0.15915494309189535; rd -= __builtin_floor(rd);
    const float r = (float)rd; sn = __builtin_amdgcn_sinf(r); cs = __builtin_amdgcn_cosf(r);
}
constexpr int TID_TAB_OFF = 160 * 1024 - 256;
__device__ __forceinline__ unsigned hw_wave_slot() { return __builtin_amdgcn_s_getreg((5 << 11) | 4) & 63u; }
__device__ __forceinline__ void tid_tab_init() { ((LAS int*)(LAS char*)TID_TAB_OFF)[hw_wave_slot()] = (int)(threadIdx.x >> 6); __syncthreads(); }
__device__ __forceinline__ int tid_fresh() {
    unsigned off = (unsigned)TID_TAB_OFF + hw_wave_slot() * 4u; asm volatile("" : "+s"(off));
    const int w = *(const LAS int*)(LAS char*)(uintptr_t)off;
    unsigned z_ = 0u; asm volatile("" : "+v"(z_));
    int t = w * 64 + (int)__builtin_amdgcn_mbcnt_hi(~0u, __builtin_amdgcn_mbcnt_lo(~0u, z_)); asm volatile("" : "+v"(t)); return t; }
__device__ __forceinline__ int sgpr_fresh(int v) { asm volatile("" : "+s"(v)); return v; }
template <int M> __device__ __forceinline__ float swz_xor(float x) { return __builtin_bit_cast(float, __builtin_amdgcn_ds_swizzle(__builtin_bit_cast(int, x), (M << 10) | 0x1f)); }
__device__ __forceinline__ void swap32(unsigned u, unsigned& r0, unsigned& r1) { const auto r = __builtin_amdgcn_permlane32_swap(u, u, false, false); r0 = r[0]; r1 = r[1]; asm volatile("" : "+v"(r0), "+v"(r1)); }
__device__ __forceinline__ float sum32(float x) { unsigned r0, r1; swap32(__builtin_bit_cast(unsigned, x), r0, r1); return __builtin_bit_cast(float, r0) + __builtin_bit_cast(float, r1); }
__device__ __forceinline__ float max32(float x) { unsigned r0, r1; swap32(__builtin_bit_cast(unsigned, x), r0, r1); return fmaxf(__builtin_bit_cast(float, r0), __builtin_bit_cast(float, r1)); }
__device__ __forceinline__ unsigned or32(unsigned u) { unsigned r0, r1; swap32(u, r0, r1); return r0 | r1; }
__device__ __forceinline__ float sum_lo32(float x) { x += swz_xor<16>(x); x += swz_xor<8>(x); x += swz_xor<4>(x); x += swz_xor<2>(x); x += swz_xor<1>(x); return x; }
__device__ __forceinline__ float wave_allsum(float x) { return sum32(sum_lo32(x)); }
namespace pg8 {
constexpr int BM = 256, BK = 64, HALF = 128, HTB = HALF * BK * 2  , STAGE_BYTES = 8 * HTB, NXCD = 8, WGM = 8;
__host__ __device__ __forceinline__ int lds_byte(int r, int c) { const int st = (r >> 4) * 2 + (c >> 5), rr = r & 15, cc = c & 31, ob = rr * 64 + cc * 2; return st * 1024 + (ob ^ (((ob >> 9) & 1) << 5)); }
__host__ __device__ __forceinline__ void stage_rc(int b, int& R, int& C) { const int st = b / 1024, sb = b % 1024, swz = sb ^ (((sb >> 9) & 1) << 5); R = (st >> 1) * 16 + swz / 64; C = (st & 1) * 32 + (swz % 64) / 2; }
__host__ __device__ __forceinline__ int perm32(int rho) { const int n = rho >> 4, i = rho & 15; return 8 * (i >> 2) + 4 * n + (i & 3); }

struct Unit { int pm, pn; };
struct Gemm { const bf16_t* A; const bf16_t* Bt; int lda, ldb, K; };

struct StaticOrder {
    int nM, nN, nwg, G, c;
    __device__ void init(int nM_, int nN_, int G_, int c_) { nM = nM_; nN = nN_; nwg = nM * nN; G = G_; c = c_; }
    __device__ bool next(int i, Unit& u) const {
        const long L = (long)i * G + c; if (L >= nwg) return false;
        int wgid = (int)L; { const int q = nwg / NXCD, r = nwg % NXCD, xcd = wgid % NXCD, off = wgid / NXCD; wgid = (xcd < r ? xcd * (q + 1) : r * (q + 1) + (xcd - r) * q) + off; }
        const int nig = WGM * nN, gid = wgid / nig, fm = gid * WGM, gsz = (nM - fm) < WGM ? (nM - fm) : WGM;
        u.pm = fm + ((wgid % nig) % gsz); u.pn = (wgid % nig) / gsz; return true;
    }
};
struct GroupOrder {
    int ng, nMg, nNg, tot, G, c;
    __device__ void init(int ng_, int nMg_, int nNg_, int G_, int c_) { ng = ng_; nMg = nMg_; nNg = nNg_; tot = ng * nMg * nNg; G = G_; c = c_; }
    __device__ bool next(int i, Unit& u) const {
        const int L = i * G + c; if (L >= tot) return false;
        const int per = nMg * nNg, g = L / per, r = L % per; u.pm = g * nMg + r % nMg; u.pn = g * nNg + r / nMg; return true;
    }
};

template <class Epi, class Sched, bool ALIGN_EPI, bool SP2>
__device__ __forceinline__ void gemm_phase(LAS unsigned char* lds, const Gemm g, const Sched& S, const Epi& E) {
    const int tid = tid_fresh(), wid = __builtin_amdgcn_readfirstlane(tid >> 6), lane = tid & 63, wr = wid >> 2, wc = wid & 3, fr = lane & 15, fq = lane >> 4;
    const int K = g.K, nt = K / BK;
    unsigned voffA[2], voffB[2];
#pragma unroll
    for (int i = 0; i < 2; ++i) { int R, C; stage_rc(tid * 16 + i * 8192, R, C); const int Rb = Epi::PERM ? ((R & ~31) + perm32(R & 31)) : R;
        voffA[i] = (unsigned)(R * g.lda + C) * 2u; voffB[i] = (unsigned)(Rb * g.ldb + C) * 2u; }
    const size_t kstep = (size_t)(BK * 2);
    const size_t hstepA = (size_t)HALF * g.lda * 2, hstepB = (size_t)HALF * g.ldb * 2;
    const size_t tstepA = 2 * hstepA, tstepB = 2 * hstepB;
    const unsigned ldsw = (unsigned)wid * 1024u, ldsbase = (unsigned)(uintptr_t)lds;
    const int aoff = lds_byte(wr * 64 + fr, fq * 8), boff = lds_byte(wc * 32 + fr, fq * 8);
#define PG8_SA(b, h) (((b) * 2 + (h)) * HTB)
#define PG8_SB(b, h) ((4 + (b) * 2 + (h)) * HTB)
#define PG8_STAGE(bufoff, gbase, voff) do { _Pragma("unroll") for (int _i = 0; _i < 2; ++_i) { unsigned _keep; const unsigned _dst = ldsbase + (unsigned)(bufoff) + ldsw + (unsigned)_i * 8192u; \
        asm volatile("s_mov_b32 %0, m0\n\ts_mov_b32 m0, %3\n\ts_nop 0\n\tglobal_load_lds_dwordx4 %1, %2\n\ts_mov_b32 m0, %0" : "=&s"(_keep) : "v"((voff)[_i]), "s"(gbase), "s"(_dst) : "memory"); } } while (0)
#define PG8_LDA(dst, b, h) do { _Pragma("unroll") for (int m = 0; m < 4; ++m) _Pragma("unroll") for (int k = 0; k < 2; ++k) dst[m][k] = *(const LAS bf16x8*)(lds + PG8_SA(b, h) + aoff + m * 2048 + k * 1024); } while (0)
#define PG8_LDB(dst, b, h) do { _Pragma("unroll") for (int n = 0; n < 2; ++n) _Pragma("unroll") for (int k = 0; k < 2; ++k) dst[n][k] = *(const LAS bf16x8*)(lds + PG8_SB(b, h) + boff + n * 2048 + k * 1024); } while (0)
#define PG8_MMA(ai, bj, At, Bt) do { __builtin_amdgcn_s_setprio(1); _Pragma("unroll") for (int m = 0; m < 4; ++m) _Pragma("unroll") for (int n = 0; n < 2; ++n) _Pragma("unroll") for (int k = 0; k < 2; ++k) \
        acc[ai][bj][m][n] = __builtin_amdgcn_mfma_f32_16x16x32_bf16(Bt[n][k], At[m][k], acc[ai][bj][m][n], 0, 0, 0); __builtin_amdgcn_s_setprio(0); } while (0)
#define PG8_WAIT_V(n) asm volatile("s_waitcnt vmcnt(" #n ")" ::: "memory")
#define PG8_WAIT_L(n) asm volatile("s_waitcnt lgkmcnt(" #n ")" ::: "memory")
#define PG8_BAR __builtin_amdgcn_s_barrier()
#define PG8_SCHED __builtin_amdgcn_sched_barrier(0)
    Unit cur, nxt; int ui = 0;
    if (!S.next(0, cur)) return;
    f32x4 acc[2][2][4][2];
#pragma unroll
    for (int a = 0; a < 2; ++a)
#pragma unroll
        for (int b = 0; b < 2; ++b)
#pragma unroll
            for (int m = 0; m < 4; ++m)
#pragma unroll
                for (int n = 0; n < 2; ++n) acc[a][b][m][n] = (f32x4){0.f, 0.f, 0.f, 0.f};
    bf16x8 At[4][2], B0[2][2], B1[2][2];
    const char* cA = (const char*)g.A + (size_t)cur.pm * tstepA; const char* cB = (const char*)g.Bt + (size_t)cur.pn * tstepB;
    if constexpr (SP2) {
        PG8_STAGE(PG8_SB(0, 0), cB, voffB); PG8_STAGE(PG8_SB(0, 1), cB + hstepB, voffB); PG8_STAGE(PG8_SA(0, 0), cA, voffA); PG8_STAGE(PG8_SA(0, 1), cA + hstepA, voffA);
        if (wr == 1) PG8_BAR;
        PG8_WAIT_V(2); PG8_BAR;
        PG8_STAGE(PG8_SB(1, 0), cB + kstep, voffB); PG8_STAGE(PG8_SA(1, 0), cA + kstep, voffA); PG8_STAGE(PG8_SB(1, 1), cB + hstepB + kstep, voffB);
        PG8_WAIT_V(6); PG8_BAR;
    } else {
        PG8_STAGE(PG8_SB(0, 0), cB, voffB); PG8_STAGE(PG8_SA(0, 0), cA, voffA); PG8_STAGE(PG8_SB(0, 1), cB + hstepB, voffB); PG8_STAGE(PG8_SA(0, 1), cA + hstepA, voffA);
        if (wr == 1) PG8_BAR;
        PG8_WAIT_V(4); PG8_BAR;
        PG8_STAGE(PG8_SB(1, 0), cB + kstep, voffB); PG8_STAGE(PG8_SA(1, 0), cA + kstep, voffA); PG8_STAGE(PG8_SB(1, 1), cB + hstepB + kstep, voffB);
        PG8_WAIT_V(6); PG8_BAR;
    }
    for (;;) {
        const bool has_next = S.next(ui + 1, nxt);
        const char* nA = has_next ? (const char*)g.A + (size_t)nxt.pm * tstepA : cA; const char* nB = has_next ? (const char*)g.Bt + (size_t)nxt.pn * tstepB : cB;
        for (int t = 0; t < nt; t += 2) {
            const bool last = (t == nt - 2);
            const char* a1 = cA + (size_t)(t + 1) * kstep;
            const char* a2 = last ? nA : cA + (size_t)(t + 2) * kstep; const char* b2 = last ? nB : cB + (size_t)(t + 2) * kstep;
            const char* a3 = a2 + kstep; const char* b3 = b2 + kstep;
            if constexpr (SP2) {
            PG8_LDB(B0, 0, 0); PG8_LDB(B1, 0, 1); PG8_SCHED; PG8_LDA(At, 0, 0); PG8_STAGE(PG8_SA(1, 1), a1 + hstepA, voffA);
            PG8_WAIT_V(8); PG8_WAIT_L(0); PG8_BAR; PG8_MMA(0, 0, At, B0); PG8_MMA(0, 1, At, B1); PG8_BAR; PG8_SCHED;
            PG8_LDA(At, 0, 1); PG8_STAGE(PG8_SB(0, 0), b2, voffB); PG8_STAGE(PG8_SB(0, 1), b2 + hstepB, voffB); PG8_STAGE(PG8_SA(0, 0), a2, voffA);
            PG8_WAIT_V(8); PG8_WAIT_L(0); PG8_BAR; PG8_MMA(1, 0, At, B0); PG8_MMA(1, 1, At, B1); PG8_BAR; PG8_SCHED;
            PG8_LDB(B0, 1, 0); PG8_LDB(B1, 1, 1); PG8_SCHED; PG8_LDA(At, 1, 0); PG8_STAGE(PG8_SA(0, 1), a2 + hstepA, voffA);
            PG8_WAIT_V(8); PG8_WAIT_L(0); PG8_BAR; PG8_MMA(0, 0, At, B0); PG8_MMA(0, 1, At, B1); PG8_BAR; PG8_SCHED;
            PG8_LDA(At, 1, 1); PG8_STAGE(PG8_SB(1, 0), b3, voffB); PG8_STAGE(PG8_SB(1, 1), b3 + hstepB, voffB); PG8_STAGE(PG8_SA(1, 0), a3, voffA);
            PG8_WAIT_V(8); PG8_WAIT_L(0); PG8_BAR; PG8_MMA(1, 0, At, B0); PG8_MMA(1, 1, At, B1); PG8_BAR; PG8_SCHED;
            } else {
            PG8_LDB(B0, 0, 0); PG8_SCHED; PG8_LDA(At, 0, 0); PG8_STAGE(PG8_SA(1, 1), a1 + hstepA, voffA);
            PG8_WAIT_L(8); PG8_BAR; PG8_WAIT_L(0); PG8_MMA(0, 0, At, B0); PG8_BAR; PG8_SCHED;
            PG8_LDB(B1, 0, 1); PG8_STAGE(PG8_SB(0, 0), b2, voffB);
            PG8_BAR; PG8_WAIT_L(0); PG8_MMA(0, 1, At, B1); PG8_BAR;
            PG8_LDA(At, 0, 1); PG8_STAGE(PG8_SA(0, 0), a2, voffA);
            PG8_BAR; PG8_WAIT_L(0); PG8_MMA(1, 0, At, B0); PG8_BAR; PG8_SCHED;
            PG8_STAGE(PG8_SB(0, 1), b2 + hstepB, voffB);
            PG8_WAIT_V(6); PG8_BAR; PG8_MMA(1, 1, At, B1); PG8_BAR;
            PG8_LDB(B0, 1, 0); PG8_SCHED; PG8_LDA(At, 1, 0); PG8_STAGE(PG8_SA(0, 1), a2 + hstepA, voffA);
            PG8_WAIT_L(8); PG8_BAR; PG8_WAIT_L(0); PG8_MMA(0, 0, At, B0); PG8_BAR; PG8_SCHED;
            PG8_LDB(B1, 1, 1); PG8_STAGE(PG8_SB(1, 0), b3, voffB);
            PG8_BAR; PG8_WAIT_L(0); PG8_MMA(0, 1, At, B1); PG8_BAR;
            PG8_LDA(At, 1, 1); PG8_STAGE(PG8_SA(1, 0), a3, voffA);
            PG8_BAR; PG8_WAIT_L(0); PG8_MMA(1, 0, At, B0); PG8_BAR; PG8_SCHED;
            PG8_STAGE(PG8_SB(1, 1), b3 + hstepB, voffB);
            PG8_WAIT_V(6); PG8_BAR; PG8_MMA(1, 1, At, B1); PG8_BAR;
            }
        }
        if constexpr (ALIGN_EPI) { if (wr == 0) PG8_BAR; }
        { unsigned z_ = 0u; asm volatile("" : "+v"(z_)); const unsigned ln_ = __builtin_amdgcn_mbcnt_hi(~0u, __builtin_amdgcn_mbcnt_lo(~0u, z_)); int efr = (int)(ln_ & 15u), efq = (int)(ln_ >> 4); asm volatile("" : "+v"(efr), "+v"(efq)); E(acc, cur, wr, wc, efr, efq); }
        if (!has_next) break;
#pragma unroll
        for (int a = 0; a < 2; ++a)
#pragma unroll
            for (int b = 0; b < 2; ++b)
#pragma unroll
                for (int m = 0; m < 4; ++m)
#pragma unroll
                    for (int n = 0; n < 2; ++n) acc[a][b][m][n] = (f32x4){0.f, 0.f, 0.f, 0.f};
        cur = nxt; cA = nA; cB = nB; ++ui;
        if constexpr (ALIGN_EPI) { if (wr == 1) PG8_BAR; }
    }
    PG8_WAIT_V(0);
    if constexpr (!ALIGN_EPI) { if (wr == 0) PG8_BAR; }
    PG8_BAR;
#undef PG8_SA
#undef PG8_SB
#undef PG8_STAGE
#undef PG8_LDA
#undef PG8_LDB
#undef PG8_MMA
#undef PG8_WAIT_V
#undef PG8_WAIT_L
#undef PG8_BAR
#undef PG8_SCHED
}

typedef f32x4 Acc[2][2][4][2];

__device__ __forceinline__ float row_rstd16(const float* SS, unsigned row, int fq) {
    const f32x4 a = *(const f32x4*)(SS + row * 16u + (unsigned)fq * 4u);
    float s = (a[0] + a[1]) + (a[2] + a[3]);
    s += swz_xor<16>(s); s = sum32(s);
    return fast_rsq(s * (1.0f / 1024.0f) + NORM_EPS);
}
__device__ __forceinline__ u32x4 pack8(const f32x4 v0, const f32x4 v1) { u32x4 w; w.x = pack_bf16(v0[0], v0[1]); w.y = pack_bf16(v0[2], v0[3]); w.z = pack_bf16(v1[0], v1[1]); w.w = pack_bf16(v1[2], v1[3]); return w; }

#define EPI_SB __builtin_amdgcn_sched_barrier(0)
#define EPI_RSTD(rs, SS, rowbase) float rs[2][4]; _Pragma("unroll") for (int ai = 0; ai < 2; ++ai) _Pragma("unroll") for (int m = 0; m < 4; ++m) rs[ai][m] = row_rstd16(SS, (unsigned)((rowbase) + ai * HALF + m * 16), fq); EPI_SB;
struct EpiSwiGLU {
    static constexpr bool PERM = true;
    bf16_t* H; int ldh; const float* SS;
    __device__ __forceinline__ void operator()(const Acc& acc, const Unit& u, int wr, int wc, int fr, int fq) const {
        const int row0 = u.pm * BM + wr * 64 + fr, col0 = u.pn * HALF + wc * 32 + 8 * fq;
        EPI_RSTD(rs, SS, row0)
#pragma unroll
        for (int ai = 0; ai < 2; ++ai)
#pragma unroll
            for (int m = 0; m < 4; ++m) { const int row = row0 + ai * HALF + m * 16; const float r = rs[ai][m];
                f32x4 o[2];
#pragma unroll
                for (int n = 0; n < 2; ++n)
#pragma unroll
                    for (int e = 0; e < 4; ++e) o[n][e] = silu_f(r * acc[ai][0][m][n][e]) * (r * acc[ai][1][m][n][e]);
                *(u32x4*)(H + (unsigned)row * (unsigned)ldh + col0) = pack8(o[0], o[1]); EPI_SB; }
    }
};
struct EpiGLU {
    static constexpr bool PERM = true;
    bf16_t* Y; int ldy;
    __device__ __forceinline__ void operator()(const Acc& acc, const Unit& u, int wr, int wc, int fr, int fq) const {
        const int row0 = u.pm * BM + wr * 64 + fr, col0 = u.pn * HALF + wc * 32 + 8 * fq;
#pragma unroll
        for (int ai = 0; ai < 2; ++ai)
#pragma unroll
            for (int m = 0; m < 4; ++m) { const int row = row0 + ai * HALF + m * 16;
                f32x4 o[2];
#pragma unroll
                for (int n = 0; n < 2; ++n)
#pragma unroll
                    for (int e = 0; e < 4; ++e) o[n][e] = acc[ai][0][m][n][e] * sigmoid_f(acc[ai][1][m][n][e]);
                *(u32x4*)(Y + (unsigned)row * (unsigned)ldy + col0) = pack8(o[0], o[1]); EPI_SB; }
    }
};
struct EpiResid {
    static constexpr bool PERM = false;
    const float* Xs; float* X; bf16_t* XB; float* SS; float scale;
    __device__ __forceinline__ void operator()(const Acc& acc, const Unit& u, int wr, int wc, int fr, int fq) const {
        const int row0 = u.pm * BM + wr * 64 + fr, col0 = u.pn * BM + wc * 32 + 4 * fq;
#pragma unroll
        for (int ai = 0; ai < 2; ++ai) {
#pragma unroll
            for (int m = 0; m < 4; ++m) { const int row = row0 + ai * HALF + m * 16; float ssq = 0.f;
#pragma unroll
                for (int bj = 0; bj < 2; ++bj)
#pragma unroll
                    for (int n = 0; n < 2; ++n) { const unsigned off = (unsigned)row * DM + col0 + bj * HALF + n * 16;
                        f32x4 xv = *(const f32x4*)(Xs + off); xv = xv + acc[ai][bj][m][n] * scale; *(f32x4*)(X + off) = xv;
                        u32x2 w; w.x = pack_bf16(xv[0], xv[1]); w.y = pack_bf16(xv[2], xv[3]); *(u32x2*)(XB + off) = w;
                        ssq += (xv[0] * xv[0] + xv[1] * xv[1]) + (xv[2] * xv[2] + xv[3] * xv[3]); }
                ssq += swz_xor<16>(ssq); ssq = sum32(ssq);
                if (fq == 0) SS[(unsigned)row * 16 + u.pn * 4 + wc] = ssq; }
            EPI_SB; }
    }
};
struct EpiInA {
    static constexpr bool PERM = true;
    bf16_t* PA; bf16_t* U; float* MISCA; const float* SS;
    __device__ __forceinline__ void operator()(const Acc& acc, const Unit& u, int wr, int wc, int fr, int fq) const {
        const int row0 = u.pm * BM + wr * 64 + fr, tile = u.pn;
        EPI_RSTD(rs, SS, row0)
#pragma unroll
        for (int ai = 0; ai < 2; ++ai)
#pragma unroll
            for (int m = 0; m < 4; ++m) { const int row = row0 + ai * HALF + m * 16; const float r = rs[ai][m];
#pragma unroll
                for (int bj = 0; bj < 2; ++bj) { const int lc = bj * HALF + wc * 32 + 8 * fq; const f32x4 v0 = acc[ai][bj][m][0] * r, v1 = acc[ai][bj][m][1] * r;
                    if (tile < 13) *(u32x4*)(PA + (unsigned)row * PA_LD + tile * BM + lc) = pack8(v0, v1);
                    else if (tile < 15) { const int ch = (tile - 13) * BM + lc, grp = ch >> 4, k0 = ch & 15, chunk = row >> 4, tau = row & 15;
                        *(u32x4*)(U + ((unsigned)(grp * NCHUNK + chunk)) * U_LD + tau * 16 + k0) = pack8(v0, v1); }
                    else if (lc == 0) { *(f32x4*)(MISCA + (unsigned)row * 8) = v0; *(f32x4*)(MISCA + (unsigned)row * 8 + 4) = v1; } }
                EPI_SB; }
    }
};
struct EpiInB {
    static constexpr bool PERM = true;
    bf16_t* PB; bf16_t* KIB; float* WI; const float* SS;
    __device__ __forceinline__ void operator()(const Acc& acc, const Unit& u, int wr, int wc, int fr, int fq) const {
        const int row0 = u.pm * BM + wr * 64 + fr, tile = u.pn;
        EPI_RSTD(rs, SS, row0)
#pragma unroll
        for (int ai = 0; ai < 2; ++ai)
#pragma unroll
            for (int m = 0; m < 4; ++m) { const int row = row0 + ai * HALF + m * 16; const float r = rs[ai][m];
#pragma unroll
                for (int bj = 0; bj < 2; ++bj) { const int lc = bj * HALF + wc * 32 + 8 * fq; const f32x4 v0 = acc[ai][bj][m][0] * r, v1 = acc[ai][bj][m][1] * r;
                    if (tile < 7) *(u32x4*)(PB + (unsigned)row * PB_LD + tile * BM + lc) = pack8(v0, v1);
                    else if (lc < 64) *(u32x4*)(KIB + (unsigned)row * 64 + lc) = pack8(v0, v1);
                    else if (lc == 64) *(f32x4*)(WI + (unsigned)row * 4) = v0; }
                EPI_SB; }
    }
};
struct EpiGate {
    static constexpr bool PERM = true;
    bf16_t* G; const float* SS;
    __device__ __forceinline__ void operator()(const Acc& acc, const Unit& u, int wr, int wc, int fr, int fq) const {
        const int lr0 = wr * 64 + fr;
        EPI_RSTD(rs, SS, u.pm * BM + lr0)
#pragma unroll
        for (int ai = 0; ai < 2; ++ai)
#pragma unroll
            for (int m = 0; m < 4; ++m) { const int lr = lr0 + ai * HALF + m * 16; const float r = rs[ai][m];
#pragma unroll
                for (int bj = 0; bj < 2; ++bj) { const int lc = bj * HALF + wc * 32 + 8 * fq; f32x4 v0, v1;
#pragma unroll
                    for (int e = 0; e < 4; ++e) { v0[e] = sigmoid_f(r * acc[ai][bj][m][0][e]); v1[e] = sigmoid_f(r * acc[ai][bj][m][1][e]); }
                    *(u32x4*)(G + lr * BM + lc) = pack8(v0, v1); }
                EPI_SB; }
    }
};
struct EpiBranch {
    static constexpr bool PERM = true;
    const bf16_t* G; bf16_t* MG; const float* SSA; int first;
    __device__ __forceinline__ void operator()(const Acc& acc, const Unit& u, int wr, int wc, int fr, int fq) const {
        const int lr0 = wr * 64 + fr;
        float rs[2][4];
#pragma unroll
        for (int ai = 0; ai < 2; ++ai)
#pragma unroll
            for (int m = 0; m < 4; ++m) { rs[ai][m] = 1.0f;
                if (SSA) { const unsigned row = (unsigned)(u.pm * BM + lr0 + ai * HALF + m * 16); const f32x4* p = (const f32x4*)(SSA + row * 8u); const f32x4 a = p[0], b = p[1];
                    rs[ai][m] = fast_rsq((((a[0] + a[1]) + (a[2] + a[3])) + ((b[0] + b[1]) + (b[2] + b[3]))) * (1.0f / 512.0f) + NORM_EPS); } }
        EPI_SB;
#pragma unroll
        for (int ai = 0; ai < 2; ++ai)
#pragma unroll
            for (int m = 0; m < 4; ++m) { const int lr = lr0 + ai * HALF + m * 16, row = u.pm * BM + lr; const float r = rs[ai][m];
#pragma unroll
                for (int bj = 0; bj < 2; ++bj) { const int lc = bj * HALF + wc * 32 + 8 * fq;
                    const u32x4 gw = *(const u32x4*)(G + lr * BM + lc); bf16_t* mp = MG + (unsigned)row * DM + u.pn * BM + lc;
                    u32x4 pw = (u32x4){0u, 0u, 0u, 0u}; if (!first) pw = *(const u32x4*)mp;
                    f32x4 v0, v1;
                    v0[0] = bflo(pw.x) + bflo(gw.x) * r * acc[ai][bj][m][0][0]; v0[1] = bfhi(pw.x) + bfhi(gw.x) * r * acc[ai][bj][m][0][1];
                    v0[2] = bflo(pw.y) + bflo(gw.y) * r * acc[ai][bj][m][0][2]; v0[3] = bfhi(pw.y) + bfhi(gw.y) * r * acc[ai][bj][m][0][3];
                    v1[0] = bflo(pw.z) + bflo(gw.z) * r * acc[ai][bj][m][1][0]; v1[1] = bfhi(pw.z) + bfhi(gw.z) * r * acc[ai][bj][m][1][1];
                    v1[2] = bflo(pw.w) + bflo(gw.w) * r * acc[ai][bj][m][1][2]; v1[3] = bfhi(pw.w) + bfhi(gw.w) * r * acc[ai][bj][m][1][3];
                    *(u32x4*)mp = pack8(v0, v1); }
                if (m & 1) EPI_SB; }
    }
};
struct EpiS5State {
    static constexpr bool PERM = false;
    float* SC;
    __device__ __forceinline__ void operator()(const Acc& acc, const Unit& u, int wr, int wc, int fr, int fq) const {
        const int row0 = u.pm * BM + wr * 64 + fr, col0 = wc * 32 + 4 * fq;
#pragma unroll
        for (int ai = 0; ai < 2; ++ai)
#pragma unroll
            for (int m = 0; m < 4; ++m) { const int row = row0 + ai * HALF + m * 16;
#pragma unroll
                for (int n = 0; n < 2; ++n) *(f32x4*)(SC + (unsigned)row * 128 + col0 + n * 16) = acc[ai][0][m][n]; }
    }
};
struct EpiS5Y {
    static constexpr bool PERM = true;
    bf16_t* S5Y;
    __device__ __forceinline__ void operator()(const Acc& acc, const Unit& u, int wr, int wc, int fr, int fq) const {
        const int row0 = u.pm * BM + wr * 64 + fr;
#pragma unroll
        for (int ai = 0; ai < 2; ++ai)
#pragma unroll
            for (int m = 0; m < 4; ++m) { const int grow = row0 + ai * HALF + m * 16, grp = grow / NCHUNK, chunk = grow % NCHUNK;
#pragma unroll
                for (int bj = 0; bj < 2; ++bj) { const int lc = bj * HALF + wc * 32 + 8 * fq, tau = lc >> 4, i0 = lc & 15; f32x4 v0, v1;
#pragma unroll
                    for (int e = 0; e < 4; ++e) { v0[e] = gelu_tanh_f(acc[ai][bj][m][0][e]); v1[e] = gelu_tanh_f(acc[ai][bj][m][1][e]); }
                    *(u32x4*)(S5Y + (unsigned)(chunk * 16 + tau) * 512 + grp * 16 + i0) = pack8(v0, v1); }
                EPI_SB; }
    }
};
#undef EPI_SB
#undef EPI_RSTD
}
enum { MAP_PLAIN = 0, MAP_IL2 = 1, MAP_INA = 2, MAP_INB = 3 };
struct CvtJob { const float* s0; const float* s1; const float* gain; bf16_t* dst; int ld, R, K, kind, half_off; };
__device__ __forceinline__ void cvt_map(const CvtJob& j, int r, const float*& base, int& col) {
    base = j.s0; col = r;
    if (j.kind == MAP_IL2) { const int pn = r >> 8, w = r & 255; if (w < 128) col = pn * 128 + w; else { base = j.s1; col = j.half_off + pn * 128 + (w - 128); } }
    else if (j.kind == MAP_INA) { if (r < 1280) col = r; else if (r < 3328) col = 3660 + (r - 1280); else if (r < 3840) col = 1288 + (r - 3328); else if (r < 3848) col = 1280 + (r - 3840); else base = nullptr; }
    else if (j.kind == MAP_INB) { if (r < 1792) col = 1800 + r; else if (r < 1860) col = 3592 + (r - 1792); else base = nullptr; }
}
__device__ __forceinline__ void cvt_run(LAS unsigned char* lds, const CvtJob& j, int bid, int nb, int& rot) {
    LAS float* tile = (LAS float*)lds;
    const int tid = tid_fresh(), wid = tid >> 6, lane = tid & 63, ntk = j.K / 64, ntr = j.R / 256, ntiles = ntk * ntr;
    const int first = (bid - rot % nb + nb) % nb;
    const int has_gain = __builtin_amdgcn_readfirstlane(j.gain != nullptr ? 1 : 0);
    f32x4 v[8];
#define CVT_LOAD(T) { const int tr_ = (T) / ntk, tk_ = (T) % ntk; const float* base; int col; cvt_map(j, tr_ * 256 + lane * 4, base, col); \
        _Pragma("unroll") for (int i = 0; i < 8; ++i) { const int kk = wid + 8 * i; float z_ = 0.f; asm volatile("" : "+v"(z_)); v[i] = (f32x4){z_, z_, z_, z_}; \
            if (base) v[i] = *(const f32x4*)(base + (size_t)(tk_ * 64 + kk) * j.ld + col); } }
    if (first < ntiles) CVT_LOAD(first)
    for (int t = first; t < ntiles; t += nb) {
        const int tr = t / ntk, tk = t % ntk, r0 = tr * 256, k0 = tk * 64;
#pragma unroll
        for (int i = 0; i < 8; ++i) { const int kk = wid + 8 * i; f32x4 x = v[i]; if (has_gain) x = x * j.gain[k0 + kk];
            *(LAS f32x4*)(tile + kk * 260 + 4 * (lane ^ ((kk >> 3) & 7))) = x; }
        if (t + nb < ntiles) CVT_LOAD(t + nb)
        __syncthreads();
        { const int kc = (tid & 7) * 8;
#pragma unroll
          for (int i = 0; i < 4; ++i) { const int rr = (tid >> 3) + 64 * i; float e8[8];
#pragma unroll
              for (int e = 0; e < 8; ++e) e8[e] = tile[(kc + e) * 260 + (rr ^ ((tid & 7) << 2))];
              u32x4 w; w.x = pack_bf16(e8[0], e8[1]); w.y = pack_bf16(e8[2], e8[3]); w.z = pack_bf16(e8[4], e8[5]); w.w = pack_bf16(e8[6], e8[7]);
              *(u32x4*)(j.dst + (size_t)(r0 + rr) * j.K + k0 + kc) = w; } }
        __syncthreads();
    }
#undef CVT_LOAD
    rot += ntiles;
}

__device__ __forceinline__ void s5_tables(LAS unsigned char* lds, int g, int part, const float* lam_re, const float* lam_im, const float* b_re, const float* b_im,
                          const float* c_re, const float* c_im, const float* dsk, const float* log_dt, bf16_t* TY, bf16_t* WST, float* AQ) {
    LAS float* ap_re = (LAS float*)lds;
    LAS float* ap_im = ap_re + 17 * 64;
    LAS float* bb_re = ap_im + 17 * 64;
    LAS float* bb_im = bb_re + 1024;
    LAS float* km = bb_im + 1024;
    const int tid = tid_fresh();
    const float step = fast_exp(log_dt[g]);
    for (int idx = tid; idx < 17 * 64; idx += 512) { const int m = idx / 64, p = idx % 64; const float lr = lam_re[g * 64 + p] * step, li = lam_im[g * 64 + p] * step;
        const float mag = fast_exp(lr * (float)m); float sn, cs; sincos_rev(li * (float)m, sn, cs); ap_re[idx] = mag * cs; ap_im[idx] = mag * sn; }
    __syncthreads();
    for (int idx = tid; idx < 1024; idx += 512) { const int p = idx / 16; const float lr = lam_re[g * 64 + p], li = lam_im[g * 64 + p], den = lr * lr + li * li;
        const float ar = ap_re[64 + p], ai = ap_im[64 + p];
        const float rden = fast_rcp(den); const float qr = ((ar - 1.0f) * lr + ai * li) * rden, qi = (ai * lr - (ar - 1.0f) * li) * rden;
        const float br = b_re[(size_t)g * 1024 + idx], bi = b_im[(size_t)g * 1024 + idx];
        bb_re[idx] = qr * br - qi * bi; bb_im[idx] = qr * bi + qi * br; }
    __syncthreads();
    for (int idx = tid; idx < 4096; idx += 512) { const int m = idx >> 8, i = (idx >> 4) & 15, k = idx & 15; float s = 0.f;
        for (int p = 0; p < 64; ++p) { const float cr = c_re[((size_t)g * 16 + i) * 64 + p], ci = c_im[((size_t)g * 16 + i) * 64 + p];
            const float wr_ = cr * ap_re[m * 64 + p] - ci * ap_im[m * 64 + p], wi_ = cr * ap_im[m * 64 + p] + ci * ap_re[m * 64 + p];
            s += wr_ * bb_re[p * 16 + k] - wi_ * bb_im[p * 16 + k]; }
        if (m == 0 && i == k) s += dsk[g * 16 + i];
        km[idx] = s; }
    __syncthreads();
    for (int idx = tid; idx < 32 * 384; idx += 512) { const int rr = part * 32 + idx / 384, cc = idx % 384, tau = rr >> 4, i = rr & 15; float v;
        if (cc < 256) { const int jj = cc >> 4, k = cc & 15; v = (jj <= tau) ? km[((tau - jj) << 8) + (i << 4) + k] : 0.f; }
        else { const int p = (cc - 256) & 63; const float cr = c_re[((size_t)g * 16 + i) * 64 + p], ci = c_im[((size_t)g * 16 + i) * 64 + p];
            const float ar = ap_re[(tau + 1) * 64 + p], ai = ap_im[(tau + 1) * 64 + p];
            v = (cc < 320) ? (cr * ar - ci * ai) : -(cr * ai + ci * ar); }
        TY[((size_t)g * 256 + rr) * 384 + cc] = f2bf(v); }
    for (int idx = tid; idx < 32 * 256; idx += 512) { const int rr = part * 32 + idx / 256, cc = idx % 256, jj = cc >> 4, k = cc & 15; float v = 0.f;
        if (rr < 128) { const int p = rr & 63; const float ar = ap_re[(15 - jj) * 64 + p], ai = ap_im[(15 - jj) * 64 + p], br = bb_re[p * 16 + k], bi = bb_im[p * 16 + k];
            v = (rr < 64) ? (ar * br - ai * bi) : (ar * bi + ai * br); }
        WST[((size_t)g * 256 + rr) * 256 + cc] = f2bf(v); }
    if (part == 0 && tid < 128) AQ[g * 128 + tid] = (tid < 64) ? ap_re[16 * 64 + tid] : ap_im[16 * 64 + (tid - 64)];
    __syncthreads();
}

__device__ __forceinline__ void x_prologue(const float* xin, float* X, bf16_t* XB, float* SS, int bid, int nb) {
    const int tid_ = tid_fresh(), wid = tid_ >> 6, lane = tid_ & 63;
    for (int row = bid * 8 + wid; row < T_TOK; row += nb * 8) {
        float ssq = 0.f;
#pragma unroll
        for (int i = 0; i < 4; ++i) { const size_t off = (size_t)row * DM + i * 256 + lane * 4; const f32x4 v = *(const f32x4*)(xin + off);
            u32x2 w; w.x = pack_bf16(v[0], v[1]); w.y = pack_bf16(v[2], v[3]); *(u32x2*)(XB + off) = w; ssq += (v[0] * v[0] + v[1] * v[1]) + (v[2] * v[2] + v[3] * v[3]); }
        ssq = wave_allsum(ssq);
        if (lane < 16) SS[(size_t)row * 16 + lane] = (lane == 0) ? ssq : 0.f;
    }
}
struct M2Params { const float* conv_w; const float* conv_b; const float* dt_bias; const float* a_log; const float* dskip; };
__device__ __forceinline__ void m2_scan(float* ST, const float* DEC, int e) {
    const int bh = e >> 12, pn = e & 4095; float he[32], dc[32];
#pragma unroll
    for (int seg = 0; seg < 32; ++seg) { he[seg] = ST[(size_t)(bh * 32 + seg) * 4096 + pn]; dc[seg] = DEC[bh * 32 + seg]; }
    float s = 0.f;
#pragma unroll
    for (int seg = 0; seg < 32; ++seg) { ST[(size_t)(bh * 32 + seg) * 4096 + pn] = s; s = dc[seg] * s + he[seg]; }
}

struct HgParams { const float* gamma0; const float* gamma1; const float* norm_g; int layer; };
__device__ __forceinline__ void hg_scan(float* ST, const float* DECK, int e) {
    const int bh = e >> 14, kv = e & 16383, k = kv >> 7; float se[32], dc[32];
#pragma unroll
    for (int seg = 0; seg < 32; ++seg) { se[seg] = ST[(size_t)(bh * 32 + seg) * 16384 + kv]; dc[seg] = DECK[(bh * 32 + seg) * 128 + k]; }
    float s = 0.f;
#pragma unroll
    for (int seg = 0; seg < 32; ++seg) { ST[(size_t)(bh * 32 + seg) * 16384 + kv] = s; s = dc[seg] * s + se[seg]; }
}

__device__ __forceinline__ void s5_scan(LAS unsigned char* lds, int bg, const float* SC, const float* AQ, bf16_t* U) {
    LAS float* Ere = (LAS float*)lds;
    LAS float* Eim = Ere + 512;
    const int tid = tid_fresh(), p = tid & 63, blk = __builtin_amdgcn_readfirstlane(tid >> 6), b = bg >> 5, g = bg & 31;
    const float ar = AQ[g * 128 + p], ai = AQ[g * 128 + 64 + p];
    const size_t row0 = (size_t)g * NCHUNK + b * 512 + blk * 64;
    const float* scb = SC + row0 * 128;
    float xr[32], xi[32];
    float er = 0.f, ei = 0.f, pr = 1.f, pi = 0.f;
#pragma unroll
    for (int hf = 0; hf < 2; ++hf) {
#pragma unroll
        for (int i0 = 0; i0 < 32; i0 += 8) { const float* pb = scb + (32 * hf + i0) * 128 + p; asm volatile("" : "+v"(pb));
#pragma unroll
            for (int i = 0; i < 8; ++i) { xr[i0 + i] = pb[i * 128]; xi[i0 + i] = pb[i * 128 + 64]; } }
        asm volatile("" ::: "memory");
#pragma unroll
        for (int i = 0; i < 32; ++i) { const float nr = ar * er - ai * ei + xr[i], ni = ar * ei + ai * er + xi[i]; er = nr; ei = ni; const float qr = ar * pr - ai * pi, qi = ar * pi + ai * pr; pr = qr; pi = qi; } }
    Ere[blk * 64 + p] = er; Eim[blk * 64 + p] = ei;
    __syncthreads();
    float sr = 0.f, si = 0.f;
    for (int bb = 0; bb < blk; ++bb) { const float nr = pr * sr - pi * si + Ere[bb * 64 + p], ni = pr * si + pi * sr + Eim[bb * 64 + p]; sr = nr; si = ni; }
#pragma unroll
    for (int hf = 0; hf < 2; ++hf) {
#pragma unroll
        for (int i0 = 0; i0 < 32; i0 += 8) { const float* pb = scb + (32 * hf + i0) * 128 + p; asm volatile("" : "+v"(pb));
#pragma unroll
            for (int i = 0; i < 8; ++i) { xr[i0 + i] = pb[i * 128]; xi[i0 + i] = pb[i * 128 + 64]; } }
        asm volatile("" ::: "memory");
#pragma unroll
        for (int i = 0; i < 32; ++i) { bf16_t* up = U + (row0 + 32 * hf + i) * U_LD + 256; up[p] = f2bf(sr); up[64 + p] = f2bf(si);
            const float nr = ar * sr - ai * si + xr[i], ni = ar * si + ai * sr + xi[i]; sr = nr; si = ni; } }
    __syncthreads();
}
__device__ __forceinline__ bf16x8 tr8(const LAS bf16_t* p, int second_off) {
    typedef short v4i16_t_ __attribute__((ext_vector_type(4)));
    const v4i16_t_ lo = __builtin_amdgcn_ds_read_tr16_b64_v4i16((LAS v4i16_t_*)p), hi = __builtin_amdgcn_ds_read_tr16_b64_v4i16((LAS v4i16_t_*)(p + second_off));
    return __builtin_shufflevector(lo, hi, 0, 1, 2, 3, 4, 5, 6, 7);
}
constexpr int HG_RS = 136;
constexpr int HG_TS = 160;

__device__ __forceinline__ void hg1_mfma(LAS unsigned char* lds, int item, const bf16_t* PA, float* ST, float* DECK, const HgParams P) {
    LAS bf16_t* Ke = (LAS bf16_t*)lds;
    LAS bf16_t* Vs = Ke + 128 * HG_TS;
    LAS float* tot = (LAS float*)(Vs + 128 * HG_TS);
    const int tid = tid_fresh(), k = tid & 127, part = tid >> 7, wid = __builtin_amdgcn_readfirstlane(tid >> 6), lane = tid & 63, hl = lane >> 5;
    const int b = item >> 7, hh = (item >> 5) & 3, seg = item & 31;
    const size_t t_base = (size_t)b * SEQ + seg * 256;
    const float lb = (P.layer == 0) ? 0.f : sigmoid_f(P.gamma1[hh * 128 + k] - P.gamma0[hh * 128 + k]);
    const bf16_t* fbase = PA + t_base * PA_LD + 1792 + hh * 128;
#define fcol(OFF) fbase[(unsigned)k + (unsigned)(OFF)]
    float fr[2][32];
#pragma unroll
    for (int bb = 0; bb < 2; ++bb)
#pragma unroll
        for (int i0 = 0; i0 < 32; i0 += 16) {
#pragma unroll
            for (int i = i0; i < i0 + 16; ++i) fr[bb][i] = bf2f(fcol((128 * bb + 32 * part + i) * PA_LD));
            asm volatile("" ::: "memory"); }
#pragma unroll
    for (int bb = 0; bb < 2; ++bb) { float s = 0.f;
#pragma unroll
        for (int i = 0; i < 32; ++i) { const float sg = sigmoid_f(fr[bb][i]); s += 0.6931471805599453f * __builtin_amdgcn_logf(lb + (1.0f - lb) * sg); }
        tot[(4 * bb + part) * 128 + k] = s; }
    __syncthreads();
    f32x16 acc[2];
#pragma unroll
    for (int r = 0; r < 16; ++r) { acc[0][r] = 0.f; acc[1][r] = 0.f; }
    const int kb = wid >> 1, vb0 = 2 * (wid & 1);
    const int troff = (8 * hl + ((lane & 15) >> 2)) * HG_TS + 16 * ((lane >> 4) & 1) + 4 * (lane & 3);
#pragma unroll
    for (int half = 0; half < 2; ++half) {
        { const int blk = 4 * half + part; float sfx = 0.f;
          for (int j = blk + 1; j < 8; ++j) sfx += tot[j * 128 + k];
          bf16_t vv[32];
#pragma unroll
          for (int i0 = 0; i0 < 32; i0 += 16) {
#pragma unroll
              for (int i = i0; i < i0 + 16; ++i) vv[i] = fcol((128 * half + 32 * part + i) * PA_LD + 512);
              asm volatile("" ::: "memory"); }
#pragma unroll
          for (int i = 31; i >= 0; --i) { const int sl = 32 * part + i; const float sg = sigmoid_f(fr[half][i]);
              Ke[sl * HG_TS + k] = f2bf((1.0f - lb) * (1.0f - sg) * fast_exp(sfx)); Vs[sl * HG_TS + k] = vv[i];
              sfx += 0.6931471805599453f * __builtin_amdgcn_logf(lb + (1.0f - lb) * sg); } }
        __syncthreads();
#pragma unroll
        for (int ks = 0; ks < 8; ++ks) {
            const bf16x8 a = tr8(Ke + ks * 16 * HG_TS + kb * 32 + troff, 4 * HG_TS);
            const bf16x8 b0 = tr8(Vs + ks * 16 * HG_TS + vb0 * 32 + troff, 4 * HG_TS), b1 = tr8(Vs + ks * 16 * HG_TS + vb0 * 32 + 32 + troff, 4 * HG_TS);
            acc[0] = __builtin_amdgcn_mfma_f32_32x32x16_bf16(a, b0, acc[0], 0, 0, 0); acc[1] = __builtin_amdgcn_mfma_f32_32x32x16_bf16(a, b1, acc[1], 0, 0, 0); }
        __syncthreads();
    }
    float* sp = ST + (size_t)item * 16384;
#pragma unroll
    for (int j = 0; j < 2; ++j)
#pragma unroll
        for (int r = 0; r < 16; ++r) sp[(kb * 32 + (r & 3) + 8 * (r >> 2) + 4 * hl) * 128 + (vb0 + j) * 32 + (lane & 31)] = acc[j][r];
    if (part == 0) { float s = 0.f; for (int j = 0; j < 8; ++j) s += tot[j * 128 + k]; DECK[item * 128 + k] = fast_exp(s); }
    __syncthreads();
#undef fcol
}

__device__ __forceinline__ void hg3_mfma(LAS unsigned char* lds, int item, bf16_t* PA, const float* ST, const HgParams P) {
    LAS bf16_t* Qd = (LAS bf16_t*)lds;
    LAS bf16_t* Kd = Qd + 32 * HG_RS;
    LAS bf16_t* Ke = Kd + 32 * HG_RS;
    LAS bf16_t* Vs = Ke + 32 * HG_TS;
    LAS bf16_t* At = Vs + 32 * HG_TS;
    LAS bf16_t* St = At + 32 * 40;
    LAS float* tot = (LAS float*)(St + 128 * HG_RS);
    LAS float* dk = tot + 512;
    LAS float* ssq = dk + 128;
    const int tid = tid_fresh(), k = tid & 127, part = tid >> 7, wid = __builtin_amdgcn_readfirstlane(tid >> 6), lane = tid & 63, hl = lane >> 5, lc = lane & 31;
    const int b = item >> 7, hh = (item >> 5) & 3, seg = item & 31;
    const size_t t_base = (size_t)b * SEQ + seg * 256;
    const float lb = (P.layer == 0) ? 0.f : sigmoid_f(P.gamma1[hh * 128 + k] - P.gamma0[hh * 128 + k]);
    const int kb = wid >> 1, vb0 = 2 * (wid & 1);
    const int troff = (8 * hl + ((lane & 15) >> 2)) * HG_TS + 16 * ((lane >> 4) & 1) + 4 * (lane & 3);
    f32x16 acc[2];
    { const float* sp = ST + (size_t)item * 16384;
#pragma unroll
      for (int j = 0; j < 2; ++j)
#pragma unroll
        for (int r = 0; r < 16; ++r) acc[j][r] = sp[(kb * 32 + (r & 3) + 8 * (r >> 2) + 4 * hl) * 128 + (vb0 + j) * 32 + lc]; }
    bf16_t rq[8], rf[8], ri[8];
#define HG3_LOAD(C) { const bf16_t* rp_ = PA + (t_base + (C) * 32 + 8 * part) * PA_LD + 1280 + hh * 128 + k; \
        _Pragma("unroll") for (int i = 0; i < 8; ++i) { rq[i] = rp_[(size_t)i * PA_LD]; rf[i] = rp_[(size_t)i * PA_LD + 512]; ri[i] = rp_[(size_t)i * PA_LD + 1024]; } }
    HG3_LOAD(0)
    f32x4 gnv[4];
#pragma unroll
    for (int g4 = 0; g4 < 4; ++g4) gnv[g4] = *(const f32x4*)(P.norm_g + hh * 128 + (wid & 3) * 32 + 8 * g4 + 4 * hl);
    for (int c = 0; c < 8; ++c) {
        const size_t t0 = t_base + c * 32;
        float qv[8], kv[8], cl[8]; bf16_t vv[8];
        { float run = 0.f;
#pragma unroll
          for (int i = 0; i < 8; ++i) { const float sg = sigmoid_f(bf2f(rf[i])); const float fg = lb + (1.0f - lb) * sg;
              run += 0.6931471805599453f * __builtin_amdgcn_logf(fg); cl[i] = run; kv[i] = (1.0f - lb) * (1.0f - sg); qv[i] = silu_f(bf2f(rq[i])); vv[i] = ri[i]; }
          tot[part * 128 + k] = run; }
        if (c + 1 < 8) HG3_LOAD(c + 1)
        u32x2 gwv[4];
        if (wid < 4) { const bf16_t* gp_ = PA + (t0 + lc) * PA_LD + 2816 + hh * 128 + wid * 32;
#pragma unroll
            for (int g4 = 0; g4 < 4; ++g4) gwv[g4] = *(const u32x2*)(gp_ + 8 * g4 + 4 * hl); }
        __syncthreads();
        { float off = 0.f, all = 0.f;
#pragma unroll
          for (int p = 0; p < 4; ++p) { const float tp = tot[p * 128 + k]; all += tp; if (p < part) off += tp; }
#pragma unroll
          for (int i = 0; i < 8; ++i) { const int t = 8 * part + i; const float cu = off + cl[i];
              Qd[t * HG_RS + k] = f2bf(qv[i] * fast_exp(cu)); Kd[t * HG_RS + k] = f2bf(kv[i] * fast_exp(-cu)); Ke[t * HG_TS + k] = f2bf(kv[i] * fast_exp(all - cu)); Vs[t * HG_TS + k] = vv[i]; }
          if (part == 0) dk[k] = fast_exp(all); }
#pragma unroll
        for (int j = 0; j < 2; ++j)
#pragma unroll
            for (int g4 = 0; g4 < 4; ++g4) { u32x2 w; w.x = pack_bf16(acc[j][4 * g4], acc[j][4 * g4 + 1]); w.y = pack_bf16(acc[j][4 * g4 + 2], acc[j][4 * g4 + 3]);
                *(LAS u32x2*)(St + ((vb0 + j) * 32 + lc) * HG_RS + kb * 32 + 8 * g4 + 4 * hl) = w; }
        __syncthreads();
        if (wid == 0) {
            f32x16 d;
#pragma unroll
            for (int r = 0; r < 16; ++r) d[r] = 0.f;
#pragma unroll
            for (int ks = 0; ks < 8; ++ks) { const bf16x8 a = *(const LAS bf16x8*)(Kd + lc * HG_RS + ks * 16 + 8 * hl), bq = *(const LAS bf16x8*)(Qd + lc * HG_RS + ks * 16 + 8 * hl);
                d = __builtin_amdgcn_mfma_f32_32x32x16_bf16(a, bq, d, 0, 0, 0); }
#pragma unroll
            for (int g4 = 0; g4 < 4; ++g4) { float e[4];
#pragma unroll
                for (int i = 0; i < 4; ++i) { const int s = 8 * g4 + 4 * hl + i; e[i] = (s <= lc) ? d[4 * g4 + i] : 0.f; }
                u32x2 w; w.x = pack_bf16(e[0], e[1]); w.y = pack_bf16(e[2], e[3]); *(LAS u32x2*)(At + lc * 40 + 8 * g4 + 4 * hl) = w; }
        }
        __syncthreads();
        f32x16 o;
        if (wid < 4) {
#pragma unroll
            for (int r = 0; r < 16; ++r) o[r] = 0.f;
#pragma unroll
            for (int ks = 0; ks < 2; ++ks) { const bf16x8 a = tr8(Vs + ks * 16 * HG_TS + wid * 32 + troff, 4 * HG_TS), bt = *(const LAS bf16x8*)(At + lc * 40 + ks * 16 + 8 * hl);
                o = __builtin_amdgcn_mfma_f32_32x32x16_bf16(a, bt, o, 0, 0, 0); }
#pragma unroll
            for (int ks = 0; ks < 8; ++ks) { const bf16x8 a = *(const LAS bf16x8*)(St + (wid * 32 + lc) * HG_RS + ks * 16 + 8 * hl), bq = *(const LAS bf16x8*)(Qd + lc * HG_RS + ks * 16 + 8 * hl);
                o = __builtin_amdgcn_mfma_f32_32x32x16_bf16(a, bq, o, 0, 0, 0); }
            float s2 = 0.f;
#pragma unroll
            for (int r = 0; r < 16; ++r) s2 += o[r] * o[r];
            s2 = sum32(s2); if (hl == 0) ssq[wid * 32 + lc] = s2;
        }
        { const f32x4* dp = (const f32x4*)0; (void)dp;
#pragma unroll
          for (int g4 = 0; g4 < 4; ++g4) { const f32x4 d4 = *(const LAS f32x4*)(dk + kb * 32 + 8 * g4 + 4 * hl);
#pragma unroll
              for (int i = 0; i < 4; ++i) { acc[0][4 * g4 + i] *= d4[i]; acc[1][4 * g4 + i] *= d4[i]; } }
#pragma unroll
          for (int ks = 0; ks < 2; ++ks) { const bf16x8 a = tr8(Ke + ks * 16 * HG_TS + kb * 32 + troff, 4 * HG_TS);
              const bf16x8 b0 = tr8(Vs + ks * 16 * HG_TS + vb0 * 32 + troff, 4 * HG_TS), b1 = tr8(Vs + ks * 16 * HG_TS + vb0 * 32 + 32 + troff, 4 * HG_TS);
              acc[0] = __builtin_amdgcn_mfma_f32_32x32x16_bf16(a, b0, acc[0], 0, 0, 0); acc[1] = __builtin_amdgcn_mfma_f32_32x32x16_bf16(a, b1, acc[1], 0, 0, 0); } }
        __syncthreads();
        if (wid < 4) {
            const float tq = (ssq[lc] + ssq[32 + lc]) + (ssq[64 + lc] + ssq[96 + lc]);
            const float rr = fast_rsq(tq * (1.0f / 128.0f) + NORM_EPS);
            bf16_t* gp = PA + (t0 + lc) * PA_LD + 2816 + hh * 128 + wid * 32;
#pragma unroll
            for (int g4 = 0; g4 < 4; ++g4) { const int v0 = 8 * g4 + 4 * hl; const u32x2 gw = gwv[g4]; const f32x4 gn = gnv[g4];
                const float y0 = o[4 * g4] * rr * gn[0] * sigmoid_f(bflo(gw.x)), y1 = o[4 * g4 + 1] * rr * gn[1] * sigmoid_f(bfhi(gw.x));
                const float y2 = o[4 * g4 + 2] * rr * gn[2] * sigmoid_f(bflo(gw.y)), y3 = o[4 * g4 + 3] * rr * gn[3] * sigmoid_f(bfhi(gw.y));
                u32x2 w; w.x = pack_bf16(y0, y1); w.y = pack_bf16(y2, y3); *(u32x2*)(gp + v0) = w; }
        }
    }
    __syncthreads();
#undef HG3_LOAD
}

constexpr int M2_TS = 96;
__device__ __forceinline__ void m2s1_mfma(LAS unsigned char* lds, int item, const bf16_t* PA, const float* MISCA, float* ST, float* DEC, const M2Params P) {
    LAS bf16_t* raw = (LAS bf16_t*)lds;
    LAS bf16_t* Xc = raw + 131 * 128;
    LAS bf16_t* Bw = Xc + 128 * M2_TS;
    LAS float* wsl = (LAS float*)(Bw + 128 * M2_TS);
    LAS float* wtot = wsl + 256;
    const int tid = tid_fresh(), wid = __builtin_amdgcn_readfirstlane(tid >> 6), lane = tid & 63, hl = lane >> 5;
    const int b = item >> 8, h = (item >> 5) & 7, seg = item & 31, grp = h >> 2;
    const int t_base = b * SEQ + seg * 256, tl_base = seg * 256;
    const float a_h = -fast_exp(P.a_log[h]), dtb = P.dt_bias[h];
    float dtv = 0.f, incl = 0.f;
    if (tid < 256) { dtv = softplus_f(MISCA[(size_t)(t_base + tid) * 8 + h] + dtb); incl = dtv;
#pragma unroll
        for (int o = 1; o < 64; o <<= 1) { const float t = __builtin_bit_cast(float, __builtin_amdgcn_ds_bpermute((lane - o) << 2, __builtin_bit_cast(int, incl))); if (lane >= o) incl += t; }
        if (lane == 63) wtot[wid] = incl; }
    __syncthreads();
    if (tid < 256) { float after = 0.f, all = 0.f;
#pragma unroll
        for (int w = 0; w < 4; ++w) { const float tw = wtot[w]; all += tw; if (w > wid) after += tw; }
        const float wave_tot = wtot[wid];
        wsl[tid] = dtv * fast_exp(a_h * (after + (wave_tot - incl)));
        if (tid == 0) DEC[item] = fast_exp(a_h * all); }
    f32x16 acc;
#pragma unroll
    for (int r = 0; r < 16; ++r) acc[r] = 0.f;
    const int nb_ = wid >> 1, pb_ = wid & 1;
    const int troff = (8 * hl + ((lane & 15) >> 2)) * M2_TS + 16 * ((lane >> 4) & 1) + 4 * (lane & 3);
    for (int half = 0; half < 2; ++half) {
        const int t0 = t_base + half * 128, tl0 = tl_base + half * 128;
        for (int idx = tid; idx < 131 * 16; idx += 512) { const int r = idx >> 4, piece = idx & 15, arr = piece >> 3, pc = piece & 7;
            const int col = (arr == 0 ? 512 + h * 64 : 1024 + grp * 64) + pc * 8;
            u32x4 v = {0u, 0u, 0u, 0u}; if (tl0 - 3 + r >= 0) v = *(const u32x4*)(PA + (size_t)(t0 - 3 + r) * PA_LD + col);
            *(LAS u32x4*)(raw + r * 128 + arr * 64 + pc * 8) = v; }
        __syncthreads();
        { const int g4 = tid & 31, run = tid >> 5, ch0 = 4 * g4, arr = ch0 >> 6, cc0 = ch0 & 63;
          const int cbase = (arr == 0 ? h * 64 : 512 + grp * 64) + cc0;
          f32x4 wt[5];
#pragma unroll
          for (int w = 0; w < 4; ++w) wt[w] = *(const f32x4*)(P.conv_w + w * 768 + cbase);
          wt[4] = *(const f32x4*)(P.conv_b + cbase);
          f32x4 xr[11];
#pragma unroll
          for (int r = 0; r < 11; ++r) { const u32x2 u = *(const LAS u32x2*)(raw + (8 * run + r) * 128 + ch0); xr[r] = (f32x4){bflo(u.x), bfhi(u.x), bflo(u.y), bfhi(u.y)}; }
#pragma unroll
          for (int i = 0; i < 8; ++i) { const int tl = 8 * run + i; f32x4 a = wt[4];
#pragma unroll
              for (int w = 0; w < 4; ++w) a = a + wt[w] * xr[i + w];
              const float sc = (arr == 0) ? 1.0f : wsl[half * 128 + tl];
#pragma unroll
              for (int e = 0; e < 4; ++e) a[e] = silu_f(a[e]) * sc;
              u32x2 o; o.x = pack_bf16(a[0], a[1]); o.y = pack_bf16(a[2], a[3]);
              if (arr == 0) *(LAS u32x2*)(Xc + tl * M2_TS + cc0) = o; else *(LAS u32x2*)(Bw + tl * M2_TS + cc0) = o; } }
        __syncthreads();
        if (wid < 4) {
#pragma unroll
            for (int ks = 0; ks < 8; ++ks) { const bf16x8 a = tr8(Bw + ks * 16 * M2_TS + nb_ * 32 + troff, 4 * M2_TS), bx = tr8(Xc + ks * 16 * M2_TS + pb_ * 32 + troff, 4 * M2_TS);
                acc = __builtin_amdgcn_mfma_f32_32x32x16_bf16(a, bx, acc, 0, 0, 0); } }
        __syncthreads();
    }
    if (wid < 4) { float* sp = ST + (size_t)item * 4096 + (pb_ * 32 + (lane & 31)) * 64 + nb_ * 32 + 4 * hl;
#pragma unroll
        for (int g4 = 0; g4 < 4; ++g4) { f32x4 v = {acc[4 * g4], acc[4 * g4 + 1], acc[4 * g4 + 2], acc[4 * g4 + 3]}; *(f32x4*)(sp + 8 * g4) = v; } }
}

__device__ __forceinline__ void m2s3_mfma(LAS unsigned char* lds, int item, bf16_t* PA, const float* MISCA, const float* ST, float* SSA, const M2Params P) {
    LAS bf16_t* raw = (LAS bf16_t*)lds;
    LAS bf16_t* Xc = raw + 67 * 256;
    LAS bf16_t* Bw = Xc + 64 * 96;
    LAS bf16_t* Bc = Bw + 64 * 96;
    LAS bf16_t* Cc = Bc + 64 * 72;
    LAS bf16_t* Cd = Cc + 64 * 72;
    LAS bf16_t* Sm = Cd + 64 * 72;
    LAS bf16_t* Hs = Sm + 64 * 72;
    LAS float* cwl = (LAS float*)(Hs + 64 * 72);
    LAS float* dtl = cwl + 5 * 192;
    LAS float* acl = dtl + 64;
    LAS float* ssq = acl + 64;
    const int tid = tid_fresh(), wid = __builtin_amdgcn_readfirstlane(tid >> 6), lane = tid & 63, hl = lane >> 5, lc = lane & 31;
    const int b = item >> 8, h = (item >> 5) & 7, seg = item & 31, grp = h >> 2;
    const int t_base = b * SEQ + seg * 256, tl_base = seg * 256;
    const float a_h = -fast_exp(P.a_log[h]), dtb = P.dt_bias[h], dsk = P.dskip[h];
    for (int i = tid; i < 5 * 192; i += 512) { const int w = i / 192, c = i % 192; const int cc = (c < 64) ? h * 64 + c : (c < 128) ? 512 + grp * 64 + (c - 64) : 640 + grp * 64 + (c - 128);
        cwl[i] = (w < 4) ? P.conv_w[w * 768 + cc] : P.conv_b[cc]; }
    const int w4 = wid & 3, nb_ = w4 >> 1, pb_ = w4 & 1;
    const int troff = (8 * hl + ((lane & 15) >> 2)) * 96 + 16 * ((lane >> 4) & 1) + 4 * (lane & 3);
    f32x16 hacc;
#pragma unroll
    for (int r = 0; r < 16; ++r) hacc[r] = 0.f;
    if (wid >= 4) { const float* sp = ST + (size_t)item * 4096 + (pb_ * 32 + lc) * 64 + nb_ * 32 + 4 * hl;
#pragma unroll
        for (int g4 = 0; g4 < 4; ++g4) { const f32x4 v = *(const f32x4*)(sp + 8 * g4); hacc[4 * g4] = v[0]; hacc[4 * g4 + 1] = v[1]; hacc[4 * g4 + 2] = v[2]; hacc[4 * g4 + 3] = v[3]; } }
    u32x4 rv[5]; float dtraw;
#define M2S3_LOAD(C) { const int t0_ = t_base + (C) * 64, tl0_ = tl_base + (C) * 64; \
        _Pragma("unroll") for (int q = 0; q < 5; ++q) { const int idx = tid + 512 * q; rv[q] = (u32x4){0u, 0u, 0u, 0u}; \
            if (idx < 67 * 32) { const int r = idx >> 5, piece = idx & 31, arr = piece >> 3, pc = piece & 7; \
                const int col = (arr == 0 ? 512 + h * 64 : arr == 1 ? 1024 + grp * 64 : arr == 2 ? 1152 + grp * 64 : h * 64) + pc * 8; \
                if (tl0_ - 3 + r >= 0) rv[q] = *(const u32x4*)(PA + (size_t)(t0_ - 3 + r) * PA_LD + col); } } \
        dtraw = (wid == 0) ? MISCA[(size_t)(t0_ + lane) * 8 + h] : 0.f; }
    M2S3_LOAD(0)
    for (int c = 0; c < 4; ++c) {
        const int t0 = t_base + c * 64;
#pragma unroll
        for (int q = 0; q < 5; ++q) { const int idx = tid + 512 * q; if (idx < 67 * 32) { const int r = idx >> 5, piece = idx & 31; *(LAS u32x4*)(raw + r * 256 + (piece >> 3) * 64 + (piece & 7) * 8) = rv[q]; } }
        const float dtraw_c = dtraw;
        if (c + 1 < 4) M2S3_LOAD(c + 1)
        if (wid == 0) { const float dtv = softplus_f(dtraw_c + dtb); float incl = dtv * a_h;
#pragma unroll
            for (int o = 1; o < 64; o <<= 1) { const float t = __builtin_bit_cast(float, __builtin_amdgcn_ds_bpermute((lane - o) << 2, __builtin_bit_cast(int, incl))); if (lane >= o) incl += t; }
            dtl[lane] = dtv; acl[lane] = incl; }
        __syncthreads();
        { const float ac63 = acl[63];
          if (tid < 384) {
            const int g4 = tid % 48, run = tid / 48, ch0 = 4 * g4, arr = ch0 >> 6, cc0 = ch0 & 63;
            f32x4 wt[5];
#pragma unroll
            for (int w = 0; w < 5; ++w) wt[w] = *(const LAS f32x4*)(cwl + w * 192 + ch0);
            f32x4 xr[11];
#pragma unroll
            for (int r = 0; r < 11; ++r) { const u32x2 u = *(const LAS u32x2*)(raw + (8 * run + r) * 256 + ch0); xr[r] = (f32x4){bflo(u.x), bfhi(u.x), bflo(u.y), bfhi(u.y)}; }
            const f32x4 ac0 = *(const LAS f32x4*)(acl + 8 * run), ac1 = *(const LAS f32x4*)(acl + 8 * run + 4), dt0 = *(const LAS f32x4*)(dtl + 8 * run), dt1 = *(const LAS f32x4*)(dtl + 8 * run + 4);
#pragma unroll
            for (int i = 0; i < 8; ++i) { const int s = 8 * run + i; f32x4 a = wt[4];
#pragma unroll
                for (int w = 0; w < 4; ++w) a = a + wt[w] * xr[i + w];
#pragma unroll
                for (int e = 0; e < 4; ++e) a[e] = silu_f(a[e]);
                u32x2 o; o.x = pack_bf16(a[0], a[1]); o.y = pack_bf16(a[2], a[3]);
                if (arr == 0) *(LAS u32x2*)(Xc + s * 96 + cc0) = o;
                else { const float acs = i < 4 ? ac0[i & 3] : ac1[i & 3], dts = i < 4 ? dt0[i & 3] : dt1[i & 3];
                    const float sc = (arr == 1) ? dts * fast_exp(ac63 - acs) : fast_exp(acs);
                    u32x2 o2; o2.x = pack_bf16(a[0] * sc, a[1] * sc); o2.y = pack_bf16(a[2] * sc, a[3] * sc);
                    if (arr == 1) { *(LAS u32x2*)(Bc + s * 72 + cc0) = o; *(LAS u32x2*)(Bw + s * 96 + cc0) = o2; }
                    else { *(LAS u32x2*)(Cc + s * 72 + cc0) = o; *(LAS u32x2*)(Cd + s * 72 + cc0) = o2; } } } }
          if (wid >= 4) {
#pragma unroll
            for (int g4 = 0; g4 < 4; ++g4) { u32x2 w; w.x = pack_bf16(hacc[4 * g4], hacc[4 * g4 + 1]); w.y = pack_bf16(hacc[4 * g4 + 2], hacc[4 * g4 + 3]);
                *(LAS u32x2*)(Hs + (pb_ * 32 + lc) * 72 + nb_ * 32 + 8 * g4 + 4 * hl) = w; }
            const float dch = fast_exp(ac63);
#pragma unroll
            for (int r = 0; r < 16; ++r) hacc[r] *= dch; } }
        __syncthreads();
        if (wid < 3) {
            const int sb = wid >> 1, tb = (wid + 1) >> 1; f32x16 d;
#pragma unroll
            for (int r = 0; r < 16; ++r) d[r] = 0.f;
#pragma unroll
            for (int ks = 0; ks < 4; ++ks) { const bf16x8 a = *(const LAS bf16x8*)(Bc + (sb * 32 + lc) * 72 + ks * 16 + 8 * hl), bq = *(const LAS bf16x8*)(Cc + (tb * 32 + lc) * 72 + ks * 16 + 8 * hl);
                d = __builtin_amdgcn_mfma_f32_32x32x16_bf16(a, bq, d, 0, 0, 0); }
            const int t = tb * 32 + lc; const float act = acl[t];
#pragma unroll
            for (int g4 = 0; g4 < 4; ++g4) { float e[4];
#pragma unroll
                for (int i = 0; i < 4; ++i) { const int s = sb * 32 + 8 * g4 + 4 * hl + i; e[i] = (s <= t) ? d[4 * g4 + i] * dtl[s] * fast_exp(act - acl[s]) : 0.f; }
                u32x2 w; w.x = pack_bf16(e[0], e[1]); w.y = pack_bf16(e[2], e[3]); *(LAS u32x2*)(Sm + t * 72 + sb * 32 + 8 * g4 + 4 * hl) = w; }
        } else if (wid == 3) {
            const u32x2 z2 = {0u, 0u};
#pragma unroll
            for (int g4 = 0; g4 < 4; ++g4) *(LAS u32x2*)(Sm + lc * 72 + 32 + 8 * g4 + 4 * hl) = z2;
        } else {
#pragma unroll
            for (int ks = 0; ks < 4; ++ks) { const bf16x8 a = tr8(Bw + ks * 16 * 96 + nb_ * 32 + troff, 4 * 96), bx = tr8(Xc + ks * 16 * 96 + pb_ * 32 + troff, 4 * 96);
                hacc = __builtin_amdgcn_mfma_f32_32x32x16_bf16(a, bx, hacc, 0, 0, 0); }
        }
        __syncthreads();
        if (wid < 4) {
            const int pb = wid >> 1, tb = wid & 1, t = tb * 32 + lc; f32x16 y;
#pragma unroll
            for (int r = 0; r < 16; ++r) y[r] = 0.f;
#pragma unroll
            for (int ks = 0; ks < 4; ++ks) { const bf16x8 a = tr8(Xc + ks * 16 * 96 + pb * 32 + troff, 4 * 96), bs = *(const LAS bf16x8*)(Sm + t * 72 + ks * 16 + 8 * hl);
                y = __builtin_amdgcn_mfma_f32_32x32x16_bf16(a, bs, y, 0, 0, 0); }
#pragma unroll
            for (int ks = 0; ks < 4; ++ks) { const bf16x8 a = *(const LAS bf16x8*)(Hs + (pb * 32 + lc) * 72 + ks * 16 + 8 * hl), bc = *(const LAS bf16x8*)(Cd + t * 72 + ks * 16 + 8 * hl);
                y = __builtin_amdgcn_mfma_f32_32x32x16_bf16(a, bc, y, 0, 0, 0); }
            float s2 = 0.f; bf16_t* yp = PA + (size_t)(t0 + t) * PA_LD + h * 64 + pb * 32;
#pragma unroll
            for (int g4 = 0; g4 < 4; ++g4) { const int p0 = 8 * g4 + 4 * hl; float o[4];
#pragma unroll
                for (int i = 0; i < 4; ++i) { const int p = pb * 32 + p0 + i; o[i] = (y[4 * g4 + i] + dsk * bf2f(Xc[t * 96 + p])) * silu_f(bf2f(raw[(t + 3) * 256 + 192 + p])); s2 += o[i] * o[i]; }
                u32x2 w; w.x = pack_bf16(o[0], o[1]); w.y = pack_bf16(o[2], o[3]); *(u32x2*)(yp + p0) = w; }
            s2 = sum32(s2); if (hl == 0) ssq[pb * 64 + t] = s2;
        }
        __syncthreads();
        if (tid < 64) SSA[(size_t)(t0 + tid) * 8 + h] = ssq[tid] + ssq[64 + tid];
    }
    __syncthreads();
}
__device__ __forceinline__ void dsa_prep(bf16_t* PB, const int* positions, const float* qn, const float* kn, int bid, int nb) {
    const int tid_ = tid_fresh(), wid = tid_ >> 6, lane = tid_ & 63, j = lane & 31, half = lane >> 5;
    const float inv_freq = fast_exp2(-(float)j * (13.287712379549449f / 32.0f));
    for (int tok = bid * 8 + wid; tok < T_TOK; tok += nb * 8) {
        const float ang = (float)positions[tok] * inv_freq; float sn, cs; sincos_rev(ang, sn, cs);
#pragma unroll
        for (int i = 0; i < 8; ++i) { const int vec = 2 * i + half; const bool isq = vec < 8;
            bf16_t* p = PB + (size_t)tok * PB_LD + (isq ? vec * 64 : 512 + (vec - 8) * 64);
            const float x1 = bf2f(p[j]), x2 = bf2f(p[j + 32]); float ss = x1 * x1 + x2 * x2;
            ss = sum_lo32(ss);
            const float r = fast_rsq(ss * (1.0f / 64.0f) + NORM_EPS); const float* gn = isq ? qn : kn;
            const float y1 = x1 * r * gn[j], y2 = x2 * r * gn[j + 32];
            float o1 = y1 * cs - y2 * sn, o2 = y2 * cs + y1 * sn;
            if (isq) { o1 *= 0.125f * 1.4426950408889634f; o2 *= 0.125f * 1.4426950408889634f; }
            p[j] = f2bf(o1); p[j + 32] = f2bf(o2); }
    }
}

constexpr int HS = 1025;
#ifndef TK_PROBE
#define TK_PROBE 0
#endif
#ifndef TK_FORCE_FAST
#define TK_FORCE_FAST 0
#endif
constexpr int TK_CAP = 960;
constexpr int TK_LIST = 0, TK_MASKL = 32 * TK_CAP * 4, TK_ARR = TK_MASKL + 32 * 256 * 4;
__device__ __forceinline__ float relu_i(float x) { const int i = __builtin_bit_cast(int, x); return __builtin_bit_cast(float, i > 0 ? i : 0); }
__device__ __forceinline__ unsigned sk20_of(float s) { const int u = __builtin_bit_cast(int, s + 0.0f); return ((unsigned)u ^ ((unsigned)(u >> 31) | 0x80000000u)) >> 12; }
__device__ __forceinline__ unsigned fine_bin(float s) { const unsigned u = __float_as_uint(s + 0.0f); const int v = (int)((u >> 19) & 0xfffu) - (96 << 4);
    const int t = (v < -1 ? -1 : (v > 1022 ? 1022 : v)) + 1; return (u >> 31) ? (unsigned)(1023 - t) : (unsigned)(1024 + t); }
__device__ __forceinline__ void idx_load(const bf16_t* KIBb, int key0, int lane, bf16x8 (&kf)[4]) {
    const bf16_t* kp = KIBb + (size_t)(key0 + (lane & 31)) * 64 + 8 * (lane >> 5);
#pragma unroll
    for (int ks = 0; ks < 4; ++ks) kf[ks] = *(const bf16x8*)(kp + ks * 16);
}
__device__ __forceinline__ void idx_scores(const bf16x8 (&kf)[4], const bf16x8 (&qf)[4][4], const float (&wsc)[4], float (&sc)[16]) {
    f32x16 d[4];
#pragma unroll
    for (int hd = 0; hd < 4; ++hd)
#pragma unroll
        for (int r = 0; r < 16; ++r) d[hd][r] = 0.f;
#pragma unroll
    for (int ks = 0; ks < 4; ++ks)
#pragma unroll
        for (int hd = 0; hd < 4; ++hd) d[hd] = __builtin_amdgcn_mfma_f32_32x32x16_bf16(kf[ks], qf[hd][ks], d[hd], 0, 0, 0);
#pragma unroll
    for (int r = 0; r < 16; ++r) { float s = wsc[0] * relu_i(d[0][r]); s += wsc[1] * relu_i(d[1][r]); s += wsc[2] * relu_i(d[2][r]); s += wsc[3] * relu_i(d[3][r]); sc[r] = s; }
}
__device__ __forceinline__ void tk_boundary(const LAS unsigned* hrow, unsigned need, int lane, unsigned& bb, unsigned& above, unsigned& inbin) {
    unsigned s = 0;
#pragma unroll
    for (int i = 0; i < 16; ++i) { const unsigned w = hrow[1008 - 16 * lane + i]; s += (w & 0xffffu) + (w >> 16); }
    unsigned pre = s;
#pragma unroll
    for (int o = 1; o < 64; o <<= 1) { const unsigned t = (unsigned)__builtin_amdgcn_ds_bpermute((lane - o) << 2, (int)pre); if (lane >= o) pre += t; }
    const unsigned long long bal = __ballot(pre >= need);
    const int lstar = bal ? (int)__builtin_ctzll(bal) : 63;
    unsigned cum = pre - s, rb = 0, ra = cum, rc = 0; bool found = false;
    if (lane == lstar) {
#pragma unroll 1
        for (int i = 31; i >= 0; --i) { const int bin = 2016 - 32 * lane + i; const unsigned w = hrow[bin >> 1], c = (bin & 1) ? (w >> 16) : (w & 0xffffu);
            if (!found && cum + c >= need) { found = true; rb = (unsigned)bin; ra = cum; rc = c; } cum += c; }
    }
    bb = (unsigned)__builtin_amdgcn_readlane((int)rb, lstar); above = (unsigned)__builtin_amdgcn_readlane((int)ra, lstar); inbin = (unsigned)__builtin_amdgcn_readlane((int)rc, lstar);
}

__device__ __forceinline__ void dsa_topk_tile(LAS unsigned char* lds, int b, int qt, const bf16_t* PB, const bf16_t* KIB, const float* WI, unsigned* MASK) {
    LAS unsigned* hist = (LAS unsigned*)lds;
    LAS unsigned* list = (LAS unsigned*)(lds + TK_LIST);
    LAS unsigned* maskl = (LAS unsigned*)(lds + TK_MASKL);
    LAS unsigned* B1 = (LAS unsigned*)(lds + TK_ARR);
    LAS unsigned* NEED = B1 + 32;
    LAS unsigned* CNT = NEED + 32;
    LAS unsigned* FLAG = CNT + 32;
    const int tid = tid_fresh(), wid = __builtin_amdgcn_readfirstlane(tid >> 6), lane = tid & 63, qc = lane & 31, hl = lane >> 5;
    const int ql = qt * 32 + qc; const size_t row = (size_t)b * SEQ + ql;
    const bf16_t* KIBb = KIB + (size_t)b * SEQ * 64;
    const int nkt = qt + 1;
    if (qt < 8) {
        for (int kt = wid; kt < nkt; kt += 8) { unsigned word = 0u;
#pragma unroll
            for (int r = 0; r < 16; ++r) { const int rho = (r & 3) + 8 * (r >> 2) + 4 * hl; word |= ((kt * 32 + rho <= ql) ? 1u : 0u) << rho; }
            word = or32(word); if (hl == 0) MASK[row * 256 + kt] = word; }
        return;
    }
    bf16x8 qf[4][4]; float wsc[4];
    { const f32x4 wv = *(const f32x4*)(WI + row * 4);
#pragma unroll
      for (int hd = 0; hd < 4; ++hd) { wsc[hd] = wv[hd] * 0.0625f;
#pragma unroll
        for (int ks = 0; ks < 4; ++ks) qf[hd][ks] = *(const bf16x8*)(PB + row * PB_LD + 1536 + hd * 64 + ks * 16 + 8 * hl); } }
    for (int i = tid; i < 32 * HS; i += 512) hist[i] = 0u;
    if (tid == 0) FLAG[0] = 0u;
    __syncthreads();
    { bf16x8 kf[4], kn[4]; idx_load(KIBb, wid * 32 < nkt * 32 ? wid * 32 : 0, lane, kf);
#pragma unroll 1
      for (int kt = wid; kt < nkt; kt += 8) {
        const int ktn = kt + 8 < nkt ? kt + 8 : kt; idx_load(KIBb, ktn * 32, lane, kn);
        float sc[16]; idx_scores(kf, qf, wsc, sc);
        if (kt == qt) {
#pragma unroll
            for (int r = 0; r < 16; ++r) if ((r & 3) + 8 * (r >> 2) + 4 * hl > qc) sc[r] = -__builtin_inff(); }
#pragma unroll
        for (int r = 0; r < 16; ++r) { const unsigned bin = sk20_of(sc[r]) >> 9;
            __hip_atomic_fetch_add(hist + qc * HS + (bin >> 1), 1u << (16 * (bin & 1u)), __ATOMIC_RELAXED, __HIP_MEMORY_SCOPE_WORKGROUP); }
#pragma unroll
        for (int ks = 0; ks < 4; ++ks) kf[ks] = kn[ks]; } }
    __syncthreads();
#pragma unroll 1
    for (int qq = 0; qq < 4; ++qq) { const int q = wid * 4 + qq; unsigned bb, above, inbin; tk_boundary(hist + q * HS, 256u, lane, bb, above, inbin);
        if (lane == 0) { B1[q] = bb; NEED[q] = 256u - above; CNT[q] = 0u; if (inbin > (unsigned)TK_CAP) FLAG[0] = 1u; } }
    __syncthreads();
    const bool overflow = FLAG[0] != 0u;
    const unsigned b1 = B1[qc];
    __syncthreads();
    if (!overflow) {
        float th_lo, th_hi;
        { const unsigned klo = b1 << 21; th_lo = __uint_as_float((klo & 0x80000000u) ? (klo & 0x7fffffffu) : ~klo);
          const unsigned khi = (b1 + 1u) << 21; th_hi = (b1 >= 2047u) ? __builtin_inff() : __uint_as_float((khi & 0x80000000u) ? (khi & 0x7fffffffu) : ~khi); }
        { bf16x8 kf[4], kn[4]; idx_load(KIBb, wid * 32, lane, kf);
#pragma unroll 1
          for (int kt = wid; kt < nkt; kt += 8) {
            const int ktn = kt + 8 < nkt ? kt + 8 : kt; idx_load(KIBb, ktn * 32, lane, kn);
            float sc[16]; idx_scores(kf, qf, wsc, sc);
            if (kt == qt) {
#pragma unroll
                for (int r = 0; r < 16; ++r) if ((r & 3) + 8 * (r >> 2) + 4 * hl > qc) sc[r] = -__builtin_inff(); }
            unsigned word = 0u, cm = 0u;
#pragma unroll
            for (int r = 0; r < 16; ++r) { const float s = sc[r] + 0.0f; const unsigned hi = s >= th_hi ? 1u : 0u, lo = s >= th_lo ? 1u : 0u;
                word |= hi << ((r & 3) + 8 * (r >> 2)); cm |= (lo & ~hi) << r; }
            word <<= 4 * hl;
            if (cm) { unsigned pos = __hip_atomic_fetch_add(CNT + qc, (unsigned)__builtin_popcount(cm), __ATOMIC_RELAXED, __HIP_MEMORY_SCOPE_WORKGROUP);
#pragma unroll
                for (int r = 0; r < 16; ++r) if ((cm >> r) & 1u) { const int key = kt * 32 + (r & 3) + 8 * (r >> 2) + 4 * hl;
                    if (pos < (unsigned)TK_CAP) list[qc * TK_CAP + pos] = ((sk20_of(sc[r]) & 511u) << 13) | (8191u - (unsigned)key); ++pos; } }
            word = or32(word); if (hl == 0) maskl[qc * 256 + kt] = word;
#pragma unroll
            for (int ks = 0; ks < 4; ++ks) kf[ks] = kn[ks]; } }
        __syncthreads();
#pragma unroll 1
        for (int qq = 0; qq < 4; ++qq) { const int q = wid * 4 + qq; const unsigned n = CNT[q], need = NEED[q];
            unsigned cv[15];
#pragma unroll
            for (int i = 0; i < 15; ++i) { const unsigned p = (unsigned)(i * 64 + lane); cv[i] = p < n ? (list[q * TK_CAP + p] + 1u) : 0u; }
            unsigned T = 0u;
#pragma unroll 1
            for (int bit = 22; bit >= 0; --bit) { const unsigned cand = T | (1u << bit); unsigned c = 0;
#pragma unroll
                for (int i = 0; i < 15; ++i) c += (unsigned)__builtin_popcountll(__ballot(cv[i] >= cand));
                if (c >= need) T = cand; }
#pragma unroll
            for (int i = 0; i < 15; ++i) if (cv[i] >= T && cv[i] != 0u) { const unsigned key = 8191u - ((cv[i] - 1u) & 8191u);
                __hip_atomic_fetch_or(maskl + q * 256 + (key >> 5), 1u << (key & 31u), __ATOMIC_RELAXED, __HIP_MEMORY_SCOPE_WORKGROUP); } }
        __syncthreads();
        for (int i = tid; i < 32 * 256; i += 512) { const int q = i >> 8, kt = i & 255; if (kt < nkt) MASK[((size_t)b * SEQ + qt * 32 + q) * 256 + kt] = maskl[i]; }
        __syncthreads();
        return;
    }
    LAS unsigned* BND = B1 + 128;
    unsigned b2 = 0;
#pragma unroll 1
    for (int level = 1; level < 3; ++level) {
        for (int i = tid; i < 32 * HS; i += 512) hist[i] = 0u;
        __syncthreads();
        if (level == 2) b2 = BND[qc];
#pragma unroll 1
        for (int kt = wid; kt < nkt; kt += 8) { bf16x8 kf[4]; idx_load(KIBb, kt * 32, lane, kf); float sc[16]; idx_scores(kf, qf, wsc, sc);
#pragma unroll
            for (int r = 0; r < 16; ++r) { const int key = kt * 32 + (r & 3) + 8 * (r >> 2) + 4 * hl; const unsigned sk = sk20_of(sc[r]), inv = 8191u - (unsigned)key;
                const unsigned L1 = sk >> 9, L2 = ((sk & 511u) << 2) | (inv >> 11), L3 = inv & 2047u;
                bool ok = (key <= ql) && (L1 == b1); unsigned bin = L2;
                if (level == 2) { ok = ok && (L2 == b2); bin = L3; }
                if (ok) __hip_atomic_fetch_add(hist + qc * HS + (bin >> 1), 1u << (16 * (bin & 1u)), __ATOMIC_RELAXED, __HIP_MEMORY_SCOPE_WORKGROUP); } }
        __syncthreads();
#pragma unroll 1
        for (int qq = 0; qq < 4; ++qq) { const int q = wid * 4 + qq; unsigned bb, above, inbin; tk_boundary(hist + q * HS, NEED[q], lane, bb, above, inbin);
            if (lane == 0) { BND[(level - 1) * 32 + q] = bb; NEED[q] = NEED[q] - above; } }
        __syncthreads();
    }
    { const unsigned c2 = BND[qc], c3 = BND[32 + qc]; const unsigned thi = (b1 << 9) | (c2 >> 2), tlo = ((c2 & 3u) << 11) | c3;
#pragma unroll 1
      for (int kt = wid; kt < nkt; kt += 8) { bf16x8 kf[4]; idx_load(KIBb, kt * 32, lane, kf); float sc[16]; idx_scores(kf, qf, wsc, sc); unsigned word = 0u;
#pragma unroll
        for (int r = 0; r < 16; ++r) { const int rho = (r & 3) + 8 * (r >> 2) + 4 * hl, key = kt * 32 + rho; const unsigned sk = sk20_of(sc[r]), inv = 8191u - (unsigned)key;
            const bool sel = (key <= ql) && (sk > thi || (sk == thi && inv >= tlo)); word |= (sel ? 1u : 0u) << rho; }
        word = or32(word); if (hl == 0) MASK[row * 256 + kt] = word; } }
    __syncthreads();
}

typedef short v4i16_t __attribute__((ext_vector_type(4)));
__device__ __forceinline__ bf16x8 vtr2(const LAS bf16_t* p, int second_off) {
    const v4i16_t lo = __builtin_amdgcn_ds_read_tr16_b64_v4i16((LAS v4i16_t*)p), hi = __builtin_amdgcn_ds_read_tr16_b64_v4i16((LAS v4i16_t*)(p + second_off));
    return __builtin_shufflevector(lo, hi, 0, 1, 2, 3, 4, 5, 6, 7);
}
constexpr int ATT_KS = 72, ATT_VS = 96, ATT_BUF = (64 * ATT_KS + 64 * ATT_VS) * 2;
__device__ __forceinline__ void dsa_attn_item(LAS unsigned char* lds, int b, int hd, int qb, const bf16_t* PB, const unsigned* MASK, bf16_t* YC, const float* qn, const float* kn) {
    const int tid = tid_fresh(), wid = __builtin_amdgcn_readfirstlane(tid >> 6), lane = tid & 63, qc = lane & 31, hl = lane >> 5;
    const int q0 = qb * 256 + wid * 32, ql = q0 + qc; const size_t row = (size_t)b * SEQ + ql;
    const int my_sb_max = q0 >> 5;
    float negC;
    { float gq = fabsf(qn[lane]), gk = fabsf(kn[lane]);
      gq = fmaxf(gq, swz_xor<16>(gq)); gq = fmaxf(gq, swz_xor<8>(gq)); gq = fmaxf(gq, swz_xor<4>(gq)); gq = fmaxf(gq, swz_xor<2>(gq)); gq = fmaxf(gq, swz_xor<1>(gq)); gq = max32(gq);
      gk = fmaxf(gk, swz_xor<16>(gk)); gk = fmaxf(gk, swz_xor<8>(gk)); gk = fmaxf(gk, swz_xor<4>(gk)); gk = fmaxf(gk, swz_xor<2>(gk)); gk = fmaxf(gk, swz_xor<1>(gk)); gk = max32(gk);
      negC = -(8.0f * 1.4426950408889634f * 1.001f) * gq * gk; }
    bf16x8 qf[4];
#pragma unroll
    for (int ks = 0; ks < 4; ++ks) qf[ks] = *(const bf16x8*)(PB + row * PB_LD + hd * 64 + ks * 16 + 8 * hl);
    f32x16 o0, o1;
#pragma unroll
    for (int r = 0; r < 16; ++r) { o0[r] = 0.f; o1[r] = 0.f; }
    float l = 0.f;
    const int nkt = 4 * (qb + 1);
    const int skey = tid >> 3, sd = (tid & 7) * 8;
    const int vtr_off = (4 * hl + ((lane & 15) >> 2)) * ATT_VS + 16 * ((lane >> 4) & 1) + 4 * (lane & 3);
    const bf16_t* kbase = PB + ((size_t)b * SEQ + skey) * PB_LD + 512 + hd * 64 + sd;
    u32x4 kw = *(const u32x4*)kbase, vw = *(const u32x4*)(kbase + 512);
    __syncthreads();
    const unsigned* mrow = MASK + row * 256;
    u32x4 mq0 = *(const u32x4*)mrow, mq1 = *(const u32x4*)(mrow + 4);
#define ATT_TILE(J, MW0, MW1) { const int kt = kt0 + (J); \
        LAS bf16_t* Ks = (LAS bf16_t*)(lds + ((J) & 1) * ATT_BUF); LAS bf16_t* Vs = Ks + 64 * ATT_KS; \
        *(LAS u32x4*)(Ks + skey * ATT_KS + sd) = kw; *(LAS u32x4*)(Vs + skey * ATT_VS + sd) = vw; \
        if (kt + 1 < nkt) { const bf16_t* kp = kbase + (size_t)(kt + 1) * 64 * PB_LD; kw = *(const u32x4*)kp; vw = *(const u32x4*)(kp + 512); } \
        asm volatile("s_waitcnt lgkmcnt(0)" ::: "memory"); __builtin_amdgcn_s_barrier(); asm volatile("" ::: "memory");     \
        if (2 * kt <= my_sb_max) { \
            f32x16 s[2]; int mwh[2]; \
            mwh[0] = (int)((MW0) >> (4 * hl)); mwh[1] = (int)(((2 * kt + 1 <= my_sb_max) ? (MW1) : 0u) >> (4 * hl)); \
            _Pragma("unroll") for (int sbi = 0; sbi < 2; ++sbi) _Pragma("unroll") for (int r = 0; r < 16; ++r) s[sbi][r] = negC; \
            _Pragma("unroll") for (int ks = 0; ks < 4; ++ks) _Pragma("unroll") for (int sbi = 0; sbi < 2; ++sbi) { const bf16x8 kf = *(const LAS bf16x8*)(Ks + (sbi * 32 + qc) * ATT_KS + ks * 16 + 8 * hl); \
                    s[sbi] = __builtin_amdgcn_mfma_f32_32x32x16_bf16(kf, qf[ks], s[sbi], 0, 0, 0); } \
            float ps = 0.f; bf16x8 pf[2][2]; \
            _Pragma("unroll") for (int sbi = 0; sbi < 2; ++sbi) { float pv[16]; \
                _Pragma("unroll") for (int r = 0; r < 16; ++r) { const int sel = __builtin_amdgcn_sbfe(mwh[sbi], (r & 3) + 8 * (r >> 2), 1); \
                    const float p = __builtin_bit_cast(float, __builtin_bit_cast(int, fast_exp2(s[sbi][r])) & sel); pv[r] = p; ps += p; } \
                _Pragma("unroll") for (int s2 = 0; s2 < 2; ++s2) { u32x4 w; w.x = pack_bf16(pv[8 * s2 + 0], pv[8 * s2 + 1]); w.y = pack_bf16(pv[8 * s2 + 2], pv[8 * s2 + 3]); \
                    w.z = pack_bf16(pv[8 * s2 + 4], pv[8 * s2 + 5]); w.w = pack_bf16(pv[8 * s2 + 6], pv[8 * s2 + 7]); pf[sbi][s2] = __builtin_bit_cast(bf16x8, w); } } \
            l += ps; \
            _Pragma("unroll") for (int sbi = 0; sbi < 2; ++sbi) _Pragma("unroll") for (int s2 = 0; s2 < 2; ++s2) { const LAS bf16_t* vp = Vs + (sbi * 32 + s2 * 16) * ATT_VS + vtr_off; \
                    const bf16x8 v0 = vtr2(vp, 8 * ATT_VS), v1 = vtr2(vp + 32, 8 * ATT_VS); \
                    o0 = __builtin_amdgcn_mfma_f32_32x32x16_bf16(v0, pf[sbi][s2], o0, 0, 0, 0); \
                    o1 = __builtin_amdgcn_mfma_f32_32x32x16_bf16(v1, pf[sbi][s2], o1, 0, 0, 0); } \
        } }
    for (int kt0 = 0; kt0 < nkt; kt0 += 4) {
        u32x4 nq0 = mq0, nq1 = mq1;
        if (kt0 + 4 < nkt) { nq0 = *(const u32x4*)(mrow + 2 * kt0 + 8); nq1 = *(const u32x4*)(mrow + 2 * kt0 + 12); }
        ATT_TILE(0, mq0.x, mq0.y) ATT_TILE(1, mq0.z, mq0.w) ATT_TILE(2, mq1.x, mq1.y) ATT_TILE(3, mq1.z, mq1.w)
        mq0 = nq0; mq1 = nq1;
    }
#undef ATT_TILE
    l = sum32(l);
    const float inv = fast_rcp(l);
    bf16_t* op = YC + row * 512 + hd * 64;
#pragma unroll
    for (int r4 = 0; r4 < 4; ++r4) { const int d = 8 * r4 + 4 * hl;
        u32x2 w0, w1; w0.x = pack_bf16(o0[4 * r4] * inv, o0[4 * r4 + 1] * inv); w0.y = pack_bf16(o0[4 * r4 + 2] * inv, o0[4 * r4 + 3] * inv);
        w1.x = pack_bf16(o1[4 * r4] * inv, o1[4 * r4 + 1] * inv); w1.y = pack_bf16(o1[4 * r4 + 2] * inv, o1[4 * r4 + 3] * inv);
        *(u32x2*)(op + d) = w0; *(u32x2*)(op + 32 + d) = w1; }
    __syncthreads();
}
#define XB_TMO      128
#define XB_XCNT(j)  (256  + 64 * (j))
#define XB_XSUB(j)  (1280 + 64 * (j))
#define XB_XGEN(j)  (2304 + 64 * (j))
#define XB_TOP      3328
#define XB_TOPGEN   3392
#define XCD_BAR_WORDS 3456
#define XB_SPIN_CAP (1u << 22)
__device__ __forceinline__ unsigned xb_ld(unsigned* p)              { return __hip_atomic_load(p, __ATOMIC_RELAXED, __HIP_MEMORY_SCOPE_AGENT); }
__device__ __forceinline__ unsigned xb_add(unsigned* p, unsigned v) { return __hip_atomic_fetch_add(p, v, __ATOMIC_RELAXED, __HIP_MEMORY_SCOPE_AGENT); }
__device__ __forceinline__ unsigned xb_xcc_id() { return (unsigned)__builtin_amdgcn_s_getreg((3 << 11) | 20) & 0xFu; }
#define XB_SPIN(cond, bar) do { unsigned _sp = 0; while (cond) { __builtin_amdgcn_s_sleep(1); \
    if ((++_sp & 255u) == 0u) { if (xb_ld(&(bar)[XB_TMO])) break; if (_sp > XB_SPIN_CAP) { atomicAdd(&(bar)[XB_TMO], 1u); break; } } } } while (0)
constexpr int XB_ST_OFF = TID_TAB_OFF - 16;
__device__ __forceinline__ void xcd_barrier_post(unsigned* bar) { if (tid_fresh() == 0) (void)xb_add(&bar[XB_XCNT(xb_xcc_id())], 1u); }
__device__ __forceinline__ void xcd_barrier_complete(unsigned* bar, unsigned x, unsigned G, unsigned& nloc, unsigned& nx) {
    unsigned sum, cnt, mine, sp = 0u;
    for (;;) {
        sum = 0u; cnt = 0u; mine = 0u;
#pragma unroll
        for (unsigned j = 0; j < 16; ++j) { const unsigned c = xb_ld(&bar[XB_XCNT(j)]); sum += c; cnt += (c > 0u) ? 1u : 0u; mine = (j == x) ? c : mine; }
        if (sum == G) break;
        __builtin_amdgcn_s_sleep(1);
        if ((++sp & 255u) == 0u) { if (xb_ld(&bar[XB_TMO])) break; if (sp > XB_SPIN_CAP) { atomicAdd(&bar[XB_TMO], 1u); break; } }
    }
    nloc = mine > 0u ? mine : 1u; nx = cnt > 0u ? cnt : 1u;
}
__device__ __forceinline__ void xcd_barrier(unsigned* bar, unsigned G) {
    asm volatile("s_waitcnt vmcnt(0)" ::: "memory");
    __syncthreads();
    if (tid_fresh() == 0) {
        volatile LAS unsigned* st = (volatile LAS unsigned*)(LAS char*)XB_ST_OFF;
        const unsigned x = xb_xcc_id();
        __builtin_amdgcn_s_waitcnt(0);
        unsigned nloc = st[0], nx = st[1];
        if (nloc == 0u) { xcd_barrier_complete(bar, x, G, nloc, nx); st[0] = nloc; st[1] = nx; }
        const unsigned old = xb_add(&bar[XB_XSUB(x)], 1u);
        const unsigned gen = old / nloc;
        if (old + 1u == (gen + 1u) * nloc) {
            __builtin_amdgcn_fence(__ATOMIC_RELEASE, "agent");
            asm volatile("s_waitcnt vmcnt(0)" ::: "memory");
            const unsigned og = xb_add(&bar[XB_TOP], 1u);
            const unsigned tg = og / nx;
            if (og + 1u == (tg + 1u) * nx) xb_add(&bar[XB_TOPGEN], 1u);
            else XB_SPIN(xb_ld(&bar[XB_TOPGEN]) == tg, bar);
            __builtin_amdgcn_fence(__ATOMIC_ACQUIRE, "agent");
            xb_add(&bar[XB_XGEN(x)], 1u);
            asm volatile("s_waitcnt vmcnt(0)" ::: "memory");
        } else {
            XB_SPIN(xb_ld(&bar[XB_XGEN(x)]) == gen, bar);
            __builtin_amdgcn_fence(__ATOMIC_ACQUIRE, "agent");
            asm volatile("s_waitcnt vmcnt(0)" ::: "memory");
        }
    }
    __syncthreads();
}
constexpr size_t MiB = 1u << 20;
constexpr size_t OFF_CTL = 0, OFF_AQ = 16384, OFF_DEC = 65536, OFF_DECK = 131072;
constexpr size_t OFF_SS = 1 * MiB, OFF_XB = 2 * MiB, OFF_RW = 34 * MiB, OFF_RA = 70 * MiB, OFF_RB = 174 * MiB, WS_NEED = 272 * MiB;
constexpr size_t W_GLU = 0, W_E13 = 1 * MiB, W_E2 = 12 * MiB, W_EINA = 17 * MiB + 512 * 1024, W_ETY = 25 * MiB + 512 * 1024, W_EWST = 31 * MiB + 512 * 1024;
constexpr size_t W_LINB = 1 * MiB, W_LG = 5 * MiB, W_LB = 13 * MiB, W_LO = 17 * MiB, W_L13 = 19 * MiB, W_L2 = 30 * MiB;
constexpr size_t A_H1 = 0, A_PA = 0, A_PB = 0, A_MISCB = 56 * MiB, A_MASK = 64 * MiB, A_YC = 80 * MiB;
constexpr size_t B_U = 0, B_SC = 24 * MiB, B_S5Y = 40 * MiB, B_M2ST = 56 * MiB, B_HGST = 64 * MiB, B_MISCA = 80 * MiB, B_SSA = 81 * MiB, B_YB = 82 * MiB;
constexpr size_t B_GSCR = 0, B_MERGED = 32 * MiB;
constexpr int LDS_BYTES = 160 * 1024;
constexpr int NPH_LAYER = 16;
#ifndef SUBMASK
#define SUBMASK 0xffu
#endif
#ifndef P4SEL
#define P4SEL 7
#endif
#ifndef REPMASK
#define REPMASK 0u
#endif
#ifndef PHMASK
#define PHMASK 0xffffu
#endif

struct Args { const void* in[34]; float* out; unsigned char* ws; int ph_lo, ph_hi, nosync, sub; };

template <int L, int SP> __device__ __forceinline__ void do_phase(LAS unsigned char* lds) {
    typedef const __attribute__((address_space(4))) Args* KArgsPtr;
    KArgsPtr kargs = (KArgsPtr)__builtin_amdgcn_kernarg_segment_ptr();
    asm volatile("" : "+s"(kargs));
#define A (*kargs)
    unsigned char* ws = A.ws;
    const int bid = sgpr_fresh(blockIdx.x), nb = sgpr_fresh(gridDim.x);
#define X ((float*)A.out)
#define SS ((float*)(ws + OFF_SS))
#define XB ((bf16_t*)(ws + OFF_XB))
#define RW (ws + OFF_RW)
#define RA (ws + OFF_RA)
#define RB (ws + OFF_RB)
#define AQ ((float*)(ws + OFF_AQ))
#define DEC ((float*)(ws + OFF_DEC))
#define DECK ((float*)(ws + OFF_DECK))
#define H1 ((bf16_t*)(RA + A_H1))
#define PA ((bf16_t*)(RA + A_PA))
#define PB ((bf16_t*)(RA + A_PB))
#define KIB ((bf16_t*)(RA + A_MISCB))
#define WI ((float*)(RA + A_MISCB + 2 * MiB))
#define MASK ((unsigned*)(RA + A_MASK))
#define YC ((bf16_t*)(RA + A_YC))
#define U ((bf16_t*)(RB + B_U))
#define SC ((float*)(RB + B_SC))
#define S5Y ((bf16_t*)(RB + B_S5Y))
#define M2ST ((float*)(RB + B_M2ST))
#define HGST ((float*)(RB + B_HGST))
#define MISCA ((float*)(RB + B_MISCA))
#define SSA ((float*)(RB + B_SSA))
#define YB ((bf16_t*)(RB + B_YB))
#define GSCR ((bf16_t*)(RB + B_GSCR) + (size_t)bid * 65536)
#define MERGED ((bf16_t*)(RB + B_MERGED))
    {
        constexpr int l = L, sp = SP;
#define INF(i, per) (((const float*)A.in[i]) + (size_t)l * (per))
        constexpr int rep = 0;
        {
        switch (sp) {
        case 0: if constexpr (PHMASK & (1u<<0)) {
            int rot = 0; CvtJob j;
            j = CvtJob{INF(3, DM * DFF), INF(4, DM * DFF), INF(2, DM), (bf16_t*)(RW + W_E13), DFF, 2 * DFF, DM, MAP_IL2, 0}; cvt_run(lds, j, bid, nb, rot);
            j = CvtJob{INF(5, DFF * DM), nullptr, nullptr, (bf16_t*)(RW + W_E2), DM, DM, DFF, MAP_PLAIN, 0}; cvt_run(lds, j, bid, nb, rot);
            j = CvtJob{INF(7, DM * DIN), nullptr, INF(6, DM), (bf16_t*)(RW + W_EINA), DIN, 4096, DM, MAP_INA, 0}; cvt_run(lds, j, bid, nb, rot);
            j = CvtJob{INF(25, 512 * 1024), INF(25, 512 * 1024), nullptr, (bf16_t*)(RW + W_GLU), 1024, 1024, 512, MAP_IL2, 512}; cvt_run(lds, j, bid, nb, rot);
            for (int it = bid; it < 256; it += nb) s5_tables(lds, it >> 3, it & 7, INF(17, 2048), INF(18, 2048), INF(19, 32768), INF(20, 32768), INF(21, 32768), INF(22, 32768), INF(23, 512), INF(24, 32),
                                                             (bf16_t*)(RW + W_ETY), (bf16_t*)(RW + W_EWST), AQ);
            if (l == 0) x_prologue((const float*)A.in[0], X, XB, SS, bid, nb);
        } break;
        case 1: case 14: if constexpr (PHMASK & (1u<<1)) {
            pg8::Gemm g{XB, (const bf16_t*)(RW + (sp == 1 ? W_E13 : W_L13)), DM, DM, DM}; pg8::StaticOrder S; S.init(64, 22, nb, bid);
            pg8::EpiSwiGLU E{H1, DFF, SS}; pg8::gemm_phase<pg8::EpiSwiGLU, pg8::StaticOrder, true, true>(lds, g, S, E);
        } break;
        case 2: case 15: if constexpr (PHMASK & (1u<<2)) {
            pg8::Gemm g{H1, (const bf16_t*)(RW + (sp == 2 ? W_E2 : W_L2)), DFF, DFF, DFF}; pg8::StaticOrder S; S.init(64, 4, nb, bid);
            pg8::EpiResid E{(l == 0 && sp == 2) ? (const float*)A.in[0] : (const float*)X, X, XB, SS, 0.5f}; pg8::gemm_phase<pg8::EpiResid, pg8::StaticOrder, true, true>(lds, g, S, E);
        } break;
        case 3: if constexpr (PHMASK & (1u<<3)) {
            pg8::Gemm g{XB, (const bf16_t*)(RW + W_EINA), DM, DM, DM}; pg8::StaticOrder S; S.init(64, 16, nb, bid);
            pg8::EpiInA E{PA, U, MISCA, SS}; pg8::gemm_phase<pg8::EpiInA, pg8::StaticOrder, true, true>(lds, g, S, E);
        } break;
        case 4: if constexpr (PHMASK & (1u<<4)) {
            if (rep == 0 || (P4SEL & 1)) { pg8::Gemm g{U, (const bf16_t*)(RW + W_EWST), U_LD, 256, 256}; pg8::GroupOrder S; S.init(32, 4, 1, nb, bid);
              pg8::EpiS5State E{SC}; pg8::gemm_phase<pg8::EpiS5State, pg8::GroupOrder, true, true>(lds, g, S, E); }
            if (rep == 0 || (P4SEL & 2)) { const HgParams hp{(const float*)A.in[28], (const float*)A.in[28] + 512, INF(29, 512), l};
              for (int it = bid; it < 256; it += nb) hg1_mfma(lds, it, PA, HGST, DECK, hp); }
            if (rep == 0 || (P4SEL & 4)) { const M2Params mp{INF(11, 4 * 768), INF(12, 768), INF(13, 8), INF(14, 8), INF(15, 8)};
              for (int it = bid; it < 512; it += nb) m2s1_mfma(lds, it, PA, MISCA, M2ST, DEC, mp); }
        } break;
        case 5: if constexpr (PHMASK & (1u<<5)) {
            for (int it = bid; it < 64; it += nb) s5_scan(lds, it, SC, AQ, U);
            const int tid = tid_fresh();
            if (rep == 0) for (int e = bid * 512 + tid; e < 131072; e += nb * 512) hg_scan(HGST, DECK, e);
            if (rep == 0) for (int e = (nb - 1 - bid) * 512 + tid; e < 65536; e += nb * 512) m2_scan(M2ST, DEC, e);
        } break;
        case 6: if constexpr (PHMASK & (1u<<6)) {
            if (A.sub & 4) { pg8::Gemm g{U, (const bf16_t*)(RW + W_ETY), U_LD, U_LD, U_LD}; pg8::GroupOrder S; S.init(32, 4, 1, nb, bid);
              pg8::EpiS5Y E{S5Y}; pg8::gemm_phase<pg8::EpiS5Y, pg8::GroupOrder, true, true>(lds, g, S, E); }
            if (A.sub & 2) { const HgParams hp{(const float*)A.in[28], (const float*)A.in[28] + 512, INF(29, 512), l};
              for (int it = bid; it < 256; it += nb) hg3_mfma(lds, it, PA, HGST, hp); }
            if (A.sub & 1) { const M2Params mp{INF(11, 4 * 768), INF(12, 768), INF(13, 8), INF(14, 8), INF(15, 8)};
              for (int it = bid; it < 512; it += nb) m2s3_mfma(lds, it, PA, MISCA, M2ST, SSA, mp); }
        } break;
        case 7: if constexpr (PHMASK & (1u<<7)) {
            { pg8::Gemm g{S5Y, (const bf16_t*)(RW + W_GLU), 512, 512, 512}; pg8::StaticOrder S; S.init(64, 4, nb, bid);
              pg8::EpiGLU E{YB, 512}; pg8::gemm_phase<pg8::EpiGLU, pg8::StaticOrder, true, true>(lds, g, S, E); }
            int rot = 0; CvtJob j;
            j = CvtJob{INF(7, DM * DIN), nullptr, INF(6, DM), (bf16_t*)(RW + W_LINB), DIN, 2048, DM, MAP_INB, 0}; cvt_run(lds, j, bid, nb, rot);
            j = CvtJob{INF(8, DM * 4096), nullptr, INF(6, DM), (bf16_t*)(RW + W_LG), 4096, 4096, DM, MAP_PLAIN, 0}; cvt_run(lds, j, bid, nb, rot);
            for (int gi = 0; gi < 4; ++gi) { j = CvtJob{INF(9, 4 * 512 * 1024) + (size_t)gi * 512 * 1024, nullptr, gi == 0 ? INF(16, 512) : nullptr, (bf16_t*)(RW + W_LB) + (size_t)gi * 1024 * 512, 1024, 1024, 512, MAP_PLAIN, 0}; cvt_run(lds, j, bid, nb, rot); }
            j = CvtJob{INF(10, DM * DM), nullptr, nullptr, (bf16_t*)(RW + W_LO), DM, DM, DM, MAP_PLAIN, 0}; cvt_run(lds, j, bid, nb, rot);
            j = CvtJob{INF(31, DM * DFF), INF(32, DM * DFF), INF(30, DM), (bf16_t*)(RW + W_L13), DFF, 2 * DFF, DM, MAP_IL2, 0}; cvt_run(lds, j, bid, nb, rot);
            j = CvtJob{INF(33, DFF * DM), nullptr, nullptr, (bf16_t*)(RW + W_L2), DM, DM, DFF, MAP_PLAIN, 0}; cvt_run(lds, j, bid, nb, rot);
        } break;
        case 8: case 12: if constexpr (PHMASK & (1u<<8)) {
            pg8::StaticOrder S; S.init(64, 4, nb, bid);
            for (int gi = 0; gi < 4; ++gi) { if ((sp == 8) == (gi == 2)) continue;
                { pg8::Gemm g{XB, (const bf16_t*)(RW + W_LG) + (size_t)gi * 1024 * 1024, DM, DM, DM}; pg8::EpiGate E{GSCR, SS}; pg8::gemm_phase<pg8::EpiGate, pg8::StaticOrder, true, true>(lds, g, S, E); }
                const bf16_t* Ag = gi == 0 ? PA : gi == 1 ? YB : gi == 2 ? YC : PA + 2816; const int lda = (gi == 1 || gi == 2) ? 512 : PA_LD;
                { pg8::Gemm g{Ag, (const bf16_t*)(RW + W_LB) + (size_t)gi * 1024 * 512, lda, 512, 512}; pg8::EpiBranch E{GSCR, MERGED, gi == 0 ? SSA : nullptr, gi == 0 ? 1 : 0};
                  pg8::gemm_phase<pg8::EpiBranch, pg8::StaticOrder, true, true>(lds, g, S, E); } }
        } break;
        case 9: if constexpr (PHMASK & (1u<<9)) {
            pg8::Gemm g{XB, (const bf16_t*)(RW + W_LINB), DM, DM, DM}; pg8::StaticOrder S; S.init(64, 8, nb, bid);
            pg8::EpiInB E{PB, KIB, WI, SS}; pg8::gemm_phase<pg8::EpiInB, pg8::StaticOrder, true, true>(lds, g, S, E);
        } break;
        case 10: if constexpr (PHMASK & (1u<<10)) {
            if (rep == 0) dsa_prep(PB, (const int*)A.in[1], INF(26, 64), INF(27, 64), bid, nb);
            if constexpr (SUBMASK & 2) for (int it = bid; it < 512; it += nb) { const int c = it & 255, bb = it >> 8; dsa_topk_tile(lds, bb, bb == 0 ? c : 255 - c, PB, KIB, WI, MASK); }
        } break;
        case 11: if constexpr (PHMASK & (1u<<11)) {
            for (int it = bid; it < 512; it += nb) { const int c = it & 255, second = it >> 8, pair = (c & 7) * 2 + (c >> 7), bb = pair >> 3, hd = pair & 7, jq = (c >> 3) & 15;     dsa_attn_item(lds, bb, hd, second ? 31 - jq : jq, PB, MASK, YC, INF(26, 64), INF(27, 64)); }
        } break;
        case 13: if constexpr (PHMASK & (1u<<13)) {
            pg8::Gemm g{MERGED, (const bf16_t*)(RW + W_LO), DM, DM, DM}; pg8::StaticOrder S; S.init(64, 4, nb, bid);
            pg8::EpiResid E{(const float*)X, X, XB, SS, 1.0f}; pg8::gemm_phase<pg8::EpiResid, pg8::StaticOrder, true, true>(lds, g, S, E);
        } break;
        }
        }
    }
#undef INF
}
#undef A

__global__ void __launch_bounds__(512) hybrid_fwd(Args a) {
    cg::grid_group grid = cg::this_grid();
    extern __shared__ __attribute__((aligned(16))) unsigned char lds_raw[];
    LAS unsigned char* lds = (LAS unsigned char*)lds_raw;
    const int ph_lo = a.ph_lo, ph_hi = a.ph_hi;
    tid_tab_init();
    if (threadIdx.x < 4) ((LAS unsigned*)(LAS char*)XB_ST_OFF)[threadIdx.x] = 0u;
    __syncthreads();
    xcd_barrier_post((unsigned*)a.ws);
    if (!a.nosync) grid.sync();
#define STEP(L_, SP_) { constexpr int PH_ = (L_) * NPH_LAYER + (SP_); if (ph_lo <= PH_ && PH_ < ph_hi) { do_phase<L_, SP_>(lds); if (PH_ + 1 < ph_hi) xcd_barrier((unsigned*)a.ws, gridDim.x); } }
#define LAYER(L_) STEP(L_, 0) STEP(L_, 1) STEP(L_, 2) STEP(L_, 3) STEP(L_, 4) STEP(L_, 5) STEP(L_, 6) STEP(L_, 7) STEP(L_, 8) STEP(L_, 9) STEP(L_, 10) STEP(L_, 11) STEP(L_, 12) STEP(L_, 13) STEP(L_, 14) STEP(L_, 15)
    LAYER(0) LAYER(1)
#undef LAYER
#undef STEP
}
extern "C" void kernel_launch(void* const* d_in, const int* in_sizes, int n_in, void* d_out, int out_size, void* d_ws, size_t ws_size, hipStream_t stream) {
    static int grid_blocks = 0;
    if (!grid_blocks) {
        int dev = 0, cus = 0, per_cu = 0;
        hipGetDevice(&dev);
        hipDeviceGetAttribute(&cus, hipDeviceAttributeMultiprocessorCount, dev);
        hipFuncSetAttribute((const void*)hybrid_fwd, hipFuncAttributeMaxDynamicSharedMemorySize, LDS_BYTES);
        hipOccupancyMaxActiveBlocksPerMultiprocessor(&per_cu, hybrid_fwd, 512, LDS_BYTES);
        if (per_cu < 1) { fprintf(stderr, "occupancy query returned %d\n", per_cu); per_cu = 1; }
        grid_blocks = cus * 1;
        if (grid_blocks > 256) grid_blocks = 256;
        fprintf(stderr, "grid_blocks=%d cus=%d per_cu=%d ws_size=%zu need=%zu\n", grid_blocks, cus, per_cu, ws_size, (size_t)WS_NEED);
    }
    if (ws_size < WS_NEED || n_in < 34) { fprintf(stderr, "workspace too small or bad inputs\n"); return; }
    hipMemsetAsync(d_ws, 0, XCD_BAR_WORDS * 4, stream);
    Args a{};
    for (int i = 0; i < 34; ++i) a.in[i] = d_in[i];
    a.out = (float*)d_out; a.ws = (unsigned char*)d_ws; a.ph_lo = 0; a.ph_hi = NLAYER * NPH_LAYER; a.nosync = 0; a.sub = 7;
    void* args[] = {&a};
    hipError_t e = hipLaunchCooperativeKernel((void*)hybrid_fwd, dim3(grid_blocks), dim3(512), args, LDS_BYTES, stream);
    if (e != hipSuccess) fprintf(stderr, "cooperative launch failed: %s (grid %d)\n", hipGetErrorString(e), grid_blocks);
#ifdef PROBE_PH
    { Args p = a; p.out = (float*)((unsigned char*)d_ws + OFF_RB + 32 * MiB); p.ph_lo = PROBE_PH; p.ph_hi = PROBE_PH + 1; p.nosync = 1; p.sub = PROBE_SUB;
      for (int r = 0; r < PROBE_N; ++r) hipLaunchKernelGGL(hybrid_fwd, dim3(grid_blocks), dim3(512), LDS_BYTES, stream, p); }
#endif
}
```

```cpp
#include <hip/hip_runtime.h>
#include <hip/hip_cooperative_groups.h>
#include <cstdio>
#include <cstdint>
namespace cg = cooperative_groups;

#define LAS __attribute__((address_space(3)))
typedef unsigned short bf16_t;
typedef short bf16x8 __attribute__((ext_vector_type(8)));
typedef float f32x4 __attribute__((ext_vector_type(4)));
typedef float f32x16 __attribute__((ext_vector_type(16)));
typedef unsigned u32x4 __attribute__((ext_vector_type(4)));
typedef unsigned u32x2 __attribute__((ext_vector_type(2)));

constexpr int T_TOK = 16384, SEQ = 8192, DM = 1024, DFF = 2816, DIN = 5708, NLAYER = 2;
constexpr float NORM_EPS = 1e-6f;
constexpr int PA_LD = 3328;
constexpr int PB_LD = 1792;
constexpr int U_LD = 384;
constexpr int S5Q = 16;
constexpr int NCHUNK = T_TOK / S5Q;

typedef __bf16 hwbf2 __attribute__((ext_vector_type(2)));
typedef float f32x2_t __attribute__((ext_vector_type(2)));
__device__ __forceinline__ unsigned pack_bf16(float lo, float hi) { const f32x2_t v = {lo, hi}; return __builtin_bit_cast(unsigned, __builtin_convertvector(v, hwbf2)); }
__device__ __forceinline__ bf16_t f2bf(float f) { return (bf16_t)(pack_bf16(f, 0.f) & 0xffffu); }
__device__ __forceinline__ float bf2f(bf16_t h) { return __uint_as_float(((unsigned)h) << 16); }
__device__ __forceinline__ float bflo(unsigned w) { return __uint_as_float(w << 16); }
__device__ __forceinline__ float bfhi(unsigned w) { return __uint_as_float(w & 0xffff0000u); }
__device__ __forceinline__ float fast_exp2(float x) { return __builtin_amdgcn_exp2f(x); }
__device__ __forceinline__ float fast_rcp(float x) { return __builtin_amdgcn_rcpf(x); }
__device__ __forceinline__ float sigmoid_f(float x) { return fast_rcp(1.0f + fast_exp2(-1.4426950408889634f * x)); }
__device__ __forceinline__ float silu_f(float x) { return x * sigmoid_f(x); }
__device__ __forceinline__ float gelu_tanh_f(float x) { const float u = 0.7978845608028654f * (x + 0.044715f * x * x * x); return x * sigmoid_f(2.0f * u); }
__device__ __forceinline__ float fast_exp(float x) { return __builtin_amdgcn_exp2f(1.4426950408889634f * x); }
__device__ __forceinline__ float fast_rsq(float x) { return __builtin_amdgcn_rsqf(x); }
__device__ __forceinline__ float softplus_f(float x) {
    if (x > 20.f) return x;
    const float e = fast_exp(x);
    if (e < 0.03125f) return e * (1.0f - e * (0.5f - e * (0.33333333f - 0.25f * e)));
    return 0.6931471805599453f * __builtin_amdgcn_logf(1.0f + e);
}
__device__ __forceinline__ void sincos_rev(float ang, float& sn, float& cs) {
    double rd = (double)ang * 0.15915494309189535; rd -= __builtin_floor(rd);
    const float r = (float)rd; sn = __builtin_amdgcn_sinf(r); cs = __builtin_amdgcn_cosf(r);
}
constexpr int TID_TAB_OFF = 160 * 1024 - 256;
__device__ __forceinline__ unsigned hw_wave_slot() { return __builtin_amdgcn_s_getreg((5 << 11) | 4) & 63u; }
__device__ __forceinline__ void tid_tab_init() { ((LAS int*)(LAS char*)TID_TAB_OFF)[hw_wave_slot()] = (int)(threadIdx.x >> 6); __syncthreads(); }
__device__ __forceinline__ int tid_fresh() {
    unsigned off = (unsigned)TID_TAB_OFF + hw_wave_slot() * 4u; asm volatile("" : "+s"(off));
    const int w = *(const LAS int*)(LAS char*)(uintptr_t)off;
    unsigned z_ = 0u; asm volatile("" : "+v"(z_));
    int t = w * 64 + (int)__builtin_amdgcn_mbcnt_hi(~0u, __builtin_amdgcn_mbcnt_lo(~0u, z_)); asm volatile("" : "+v"(t)); return t; }
__device__ __forceinline__ int sgpr_fresh(int v) { asm volatile("" : "+s"(v)); return v; }
template <int M> __device__ __forceinline__ float swz_xor(float x) { return __builtin_bit_cast(float, __builtin_amdgcn_ds_swizzle(__builtin_bit_cast(int, x), (M << 10) | 0x1f)); }
__device__ __forceinline__ void swap32(unsigned u, unsigned& r0, unsigned& r1) { const auto r = __builtin_amdgcn_permlane32_swap(u, u, false, false); r0 = r[0]; r1 = r[1]; asm volatile("" : "+v"(r0), "+v"(r1)); }
__device__ __forceinline__ float sum32(float x) { unsigned r0, r1; swap32(__builtin_bit_cast(unsigned, x), r0, r1); return __builtin_bit_cast(float, r0) + __builtin_bit_cast(float, r1); }
__device__ __forceinline__ float max32(float x) { unsigned r0, r1; swap32(__builtin_bit_cast(unsigned, x), r0, r1); return fmaxf(__builtin_bit_cast(float, r0), __builtin_bit_cast(float, r1)); }
__device__ __forceinline__ unsigned or32(unsigned u) { unsigned r0, r1; swap32(u, r0, r1); return r0 | r1; }
__device__ __forceinline__ float sum_lo32(float x) { x += swz_xor<16>(x); x += swz_xor<8>(x); x += swz_xor<4>(x); x += swz_xor<2>(x); x += swz_xor<1>(x); return x; }
__device__ __forceinline__ float wave_allsum(float x) { return sum32(sum_lo32(x)); }
namespace pg8 {
constexpr int BM = 256, BK = 64, HALF = 128, HTB = HALF * BK * 2  , STAGE_BYTES = 8 * HTB, NXCD = 8, WGM = 8;
__host__ __device__ __forceinline__ int lds_byte(int r, int c) { const int st = (r >> 4) * 2 + (c >> 5), rr = r & 15, cc = c & 31, ob = rr * 64 + cc * 2; return st * 1024 + (ob ^ (((ob >> 9) & 1) << 5)); }
__host__ __device__ __forceinline__ void stage_rc(int b, int& R, int& C) { const int st = b / 1024, sb = b % 1024, swz = sb ^ (((sb >> 9) & 1) << 5); R = (st >> 1) * 16 + swz / 64; C = (st & 1) * 32 + (swz % 64) / 2; }
__host__ __device__ __forceinline__ int perm32(int rho) { const int n = rho >> 4, i = rho & 15; return 8 * (i >> 2) + 4 * n + (i & 3); }

struct Unit { int pm, pn; };
struct Gemm { const bf16_t* A; const bf16_t* Bt; int lda, ldb, K; };

struct StaticOrder {
    int nM, nN, nwg, G, c;
    __device__ void init(int nM_, int nN_, int G_, int c_) { nM = nM_; nN = nN_; nwg = nM * nN; G = G_; c = c_; }
    __device__ bool next(int i, Unit& u) const {
        const long L = (long)i * G + c; if (L >= nwg) return false;
        int wgid = (int)L; { const int q = nwg / NXCD, r = nwg % NXCD, xcd = wgid % NXCD, off = wgid / NXCD; wgid = (xcd < r ? xcd * (q + 1) : r * (q + 1) + (xcd - r) * q) + off; }
        const int nig = WGM * nN, gid = wgid / nig, fm = gid * WGM, gsz = (nM - fm) < WGM ? (nM - fm) : WGM;
        u.pm = fm + ((wgid % nig) % gsz); u.pn = (wgid % nig) / gsz; return true;
    }
};
struct GroupOrder {
    int ng, nMg, nNg, tot, G, c;
    __device__ void init(int ng_, int nMg_, int nNg_, int G_, int c_) { ng = ng_; nMg = nMg_; nNg = nNg_; tot = ng * nMg * nNg; G = G_; c = c_; }
    __device__ bool next(int i, Unit& u) const {
        const int L = i * G + c; if (L >= tot) return false;
        const int per = nMg * nNg, g = L / per, r = L % per; u.pm = g * nMg + r % nMg; u.pn = g * nNg + r / nMg; return true;
    }
};

template <class Epi, class Sched, bool ALIGN_EPI, bool SP2>
__device__ __forceinline__ void gemm_phase(LAS unsigned char* lds, const Gemm g, const Sched& S, const Epi& E) {
    const int tid = tid_fresh(), wid = __builtin_amdgcn_readfirstlane(tid >> 6), lane = tid & 63, wr = wid >> 2, wc = wid & 3, fr = lane & 15, fq = lane >> 4;
    const int K = g.K, nt = K / BK;
    unsigned voffA[2], voffB[2];
#pragma unroll
    for (int i = 0; i < 2; ++i) { int R, C; stage_rc(tid * 16 + i * 8192, R, C); const int Rb = Epi::PERM ? ((R & ~31) + perm32(R & 31)) : R;
        voffA[i] = (unsigned)(R * g.lda + C) * 2u; voffB[i] = (unsigned)(Rb * g.ldb + C) * 2u; }
    const size_t kstep = (size_t)(BK * 2);
    const size_t hstepA = (size_t)HALF * g.lda * 2, hstepB = (size_t)HALF * g.ldb * 2;
    const size_t tstepA = 2 * hstepA, tstepB = 2 * hstepB;
    const unsigned ldsw = (unsigned)wid * 1024u, ldsbase = (unsigned)(uintptr_t)lds;
    const int aoff = lds_byte(wr * 64 + fr, fq * 8), boff = lds_byte(wc * 32 + fr, fq * 8);
#define PG8_SA(b, h) (((b) * 2 + (h)) * HTB)
#define PG8_SB(b, h) ((4 + (b) * 2 + (h)) * HTB)
#define PG8_STAGE(bufoff, gbase, voff) do { _Pragma("unroll") for (int _i = 0; _i < 2; ++_i) { unsigned _keep; const unsigned _dst = ldsbase + (unsigned)(bufoff) + ldsw + (unsigned)_i * 8192u; \
        asm volatile("s_mov_b32 %0, m0\n\ts_mov_b32 m0, %3\n\ts_nop 0\n\tglobal_load_lds_dwordx4 %1, %2\n\ts_mov_b32 m0, %0" : "=&s"(_keep) : "v"((voff)[_i]), "s"(gbase), "s"(_dst) : "memory"); } } while (0)
#define PG8_LDA(dst, b, h) do { _Pragma("unroll") for (int m = 0; m < 4; ++m) _Pragma("unroll") for (int k = 0; k < 2; ++k) dst[m][k] = *(const LAS bf16x8*)(lds + PG8_SA(b, h) + aoff + m * 2048 + k * 1024); } while (0)
#define PG8_LDB(dst, b, h) do { _Pragma("unroll") for (int n = 0; n < 2; ++n) _Pragma("unroll") for (int k = 0; k < 2; ++k) dst[n][k] = *(const LAS bf16x8*)(lds + PG8_SB(b, h) + boff + n * 2048 + k * 1024); } while (0)
#define PG8_MMA(ai, bj, At, Bt) do { __builtin_amdgcn_s_setprio(1); _Pragma("unroll") for (int m = 0; m < 4; ++m) _Pragma("unroll") for (int n = 0; n < 2; ++n) _Pragma("unroll") for (int k = 0; k < 2; ++k) \
        acc[ai][bj][m][n] = __builtin_amdgcn_mfma_f32_16x16x32_bf16(Bt[n][k], At[m][k], acc[ai][bj][m][n], 0, 0, 0); __builtin_amdgcn_s_setprio(0); } while (0)
#define PG8_WAIT_V(n) asm volatile("s_waitcnt vmcnt(" #n ")" ::: "memory")
#define PG8_WAIT_L(n) asm volatile("s_waitcnt lgkmcnt(" #n ")" ::: "memory")
#define PG8_BAR __builtin_amdgcn_s_barrier()
#define PG8_SCHED __builtin_amdgcn_sched_barrier(0)
    Unit cur, nxt; int ui = 0;
    if (!S.next(0, cur)) return;
    f32x4 acc[2][2][4][2];
#pragma unroll
    for (int a = 0; a < 2; ++a)
#pragma unroll
        for (int b = 0; b < 2; ++b)
#pragma unroll
            for (int m = 0; m < 4; ++m)
#pragma unroll
                for (int n = 0; n < 2; ++n) acc[a][b][m][n] = (f32x4){0.f, 0.f, 0.f, 0.f};
    bf16x8 At[4][2], B0[2][2], B1[2][2];
    const char* cA = (const char*)g.A + (size_t)cur.pm * tstepA; const char* cB = (const char*)g.Bt + (size_t)cur.pn * tstepB;
    if constexpr (SP2) {
        PG8_STAGE(PG8_SB(0, 0), cB, voffB); PG8_STAGE(PG8_SB(0, 1), cB + hstepB, voffB); PG8_STAGE(PG8_SA(0, 0), cA, voffA); PG8_STAGE(PG8_SA(0, 1), cA + hstepA, voffA);
        if (wr == 1) PG8_BAR;
        PG8_WAIT_V(2); PG8_BAR;
        PG8_STAGE(PG8_SB(1, 0), cB + kstep, voffB); PG8_STAGE(PG8_SA(1, 0), cA + kstep, voffA); PG8_STAGE(PG8_SB(1, 1), cB + hstepB + kstep, voffB);
        PG8_WAIT_V(6); PG8_BAR;
    } else {
        PG8_STAGE(PG8_SB(0, 0), cB, voffB); PG8_STAGE(PG8_SA(0, 0), cA, voffA); PG8_STAGE(PG8_SB(0, 1), cB + hstepB, voffB); PG8_STAGE(PG8_SA(0, 1), cA + hstepA, voffA);
        if (wr == 1) PG8_BAR;
        PG8_WAIT_V(4); PG8_BAR;
        PG8_STAGE(PG8_SB(1, 0), cB + kstep, voffB); PG8_STAGE(PG8_SA(1, 0), cA + kstep, voffA); PG8_STAGE(PG8_SB(1, 1), cB + hstepB + kstep, voffB);
        PG8_WAIT_V(6); PG8_BAR;
    }
    for (;;) {
        const bool has_next = S.next(ui + 1, nxt);
        const char* nA = has_next ? (const char*)g.A + (size_t)nxt.pm * tstepA : cA; const char* nB = has_next ? (const char*)g.Bt + (size_t)nxt.pn * tstepB : cB;
        for (int t = 0; t < nt; t += 2) {
            const bool last = (t == nt - 2);
            const char* a1 = cA + (size_t)(t + 1) * kstep;
            const char* a2 = last ? nA : cA + (size_t)(t + 2) * kstep; const char* b2 = last ? nB : cB + (size_t)(t + 2) * kstep;
            const char* a3 = a2 + kstep; const char* b3 = b2 + kstep;
            if constexpr (SP2) {
            PG8_LDB(B0, 0, 0); PG8_LDB(B1, 0, 1); PG8_SCHED; PG8_LDA(At, 0, 0); PG8_STAGE(PG8_SA(1, 1), a1 + hstepA, voffA);
            PG8_WAIT_V(8); PG8_WAIT_L(0); PG8_BAR; PG8_MMA(0, 0, At, B0); PG8_MMA(0, 1, At, B1); PG8_BAR; PG8_SCHED;
            PG8_LDA(At, 0, 1); PG8_STAGE(PG8_SB(0, 0), b2, voffB); PG8_STAGE(PG8_SB(0, 1), b2 + hstepB, voffB); PG8_STAGE(PG8_SA(0, 0), a2, voffA);
            PG8_WAIT_V(8); PG8_WAIT_L(0); PG8_BAR; PG8_MMA(1, 0, At, B0); PG8_MMA(1, 1, At, B1); PG8_BAR; PG8_SCHED;
            PG8_LDB(B0, 1, 0); PG8_LDB(B1, 1, 1); PG8_SCHED; PG8_LDA(At, 1, 0); PG8_STAGE(PG8_SA(0, 1), a2 + hstepA, voffA);
            PG8_WAIT_V(8); PG8_WAIT_L(0); PG8_BAR; PG8_MMA(0, 0, At, B0); PG8_MMA(0, 1, At, B1); PG8_BAR; PG8_SCHED;
            PG8_LDA(At, 1, 1); PG8_STAGE(PG8_SB(1, 0), b3, voffB); PG8_STAGE(PG8_SB(1, 1), b3 + hstepB, voffB); PG8_STAGE(PG8_SA(1, 0), a3, voffA);
            PG8_WAIT_V(8); PG8_WAIT_L(0); PG8_BAR; PG8_MMA(1, 0, At, B0); PG8_MMA(1, 1, At, B1); PG8_BAR; PG8_SCHED;
            } else {
            PG8_LDB(B0, 0, 0); PG8_SCHED; PG8_LDA(At, 0, 0); PG8_STAGE(PG8_SA(1, 1), a1 + hstepA, voffA);
            PG8_WAIT_L(8); PG8_BAR; PG8_WAIT_L(0); PG8_MMA(0, 0, At, B0); PG8_BAR; PG8_SCHED;
            PG8_LDB(B1, 0, 1); PG8_STAGE(PG8_SB(0, 0), b2, voffB);
            PG8_BAR; PG8_WAIT_L(0); PG8_MMA(0, 1, At, B1); PG8_BAR;
            PG8_LDA(At, 0, 1); PG8_STAGE(PG8_SA(0, 0), a2, voffA);
            PG8_BAR; PG8_WAIT_L(0); PG8_MMA(1, 0, At, B0); PG8_BAR; PG8_SCHED;
            PG8_STAGE(PG8_SB(0, 1), b2 + hstepB, voffB);
            PG8_WAIT_V(6); PG8_BAR; PG8_MMA(1, 1, At, B1); PG8_BAR;
            PG8_LDB(B0, 1, 0); PG8_SCHED; PG8_LDA(At, 1, 0); PG8_STAGE(PG8_SA(0, 1), a2 + hstepA, voffA);
            PG8_WAIT_L(8); PG8_BAR; PG8_WAIT_L(0); PG8_MMA(0, 0, At, B0); PG8_BAR; PG8_SCHED;
            PG8_LDB(B1, 1, 1); PG8_STAGE(PG8_SB(1, 0), b3, voffB);
            PG8_BAR; PG8_WAIT_L(0); PG8_MMA(0, 1, At, B1); PG8_BAR;
            PG8_LDA(At, 1, 1); PG8_STAGE(PG8_SA(1, 0), a3, voffA);
            PG8_BAR; PG8_WAIT_L(0); PG8_MMA(1, 0, At, B0); PG8_BAR; PG8_SCHED;
            PG8_STAGE(PG8_SB(1, 1), b3 + hstepB, voffB);
            PG8_WAIT_V(6); PG8_BAR; PG8_MMA(1, 1, At, B1); PG8_BAR;
            }
        }
        if constexpr (ALIGN_EPI) { if (wr == 0) PG8_BAR; }
        { unsigned z_ = 0u; asm volatile("" : "+v"(z_)); const unsigned ln_ = __builtin_amdgcn_mbcnt_hi(~0u, __builtin_amdgcn_mbcnt_lo(~0u, z_)); int efr = (int)(ln_ & 15u), efq = (int)(ln_ >> 4); asm volatile("" : "+v"(efr), "+v"(efq)); E(acc, cur, wr, wc, efr, efq); }
        if (!has_next) break;
#pragma unroll
        for (int a = 0; a < 2; ++a)
#pragma unroll
            for (int b = 0; b < 2; ++b)
#pragma unroll
                for (int m = 0; m < 4; ++m)
#pragma unroll
                    for (int n = 0; n < 2; ++n) acc[a][b][m][n] = (f32x4){0.f, 0.f, 0.f, 0.f};
        cur = nxt; cA = nA; cB = nB; ++ui;
        if constexpr (ALIGN_EPI) { if (wr == 1) PG8_BAR; }
    }
    PG8_WAIT_V(0);
    if constexpr (!ALIGN_EPI) { if (wr == 0) PG8_BAR; }
    PG8_BAR;
#undef PG8_SA
#undef PG8_SB
#undef PG8_STAGE
#undef PG8_LDA
#undef PG8_LDB
#undef PG8_MMA
#undef PG8_WAIT_V
#undef PG8_WAIT_L
#undef PG8_BAR
#undef PG8_SCHED
}

typedef f32x4 Acc[2][2][4][2];

__device__ __forceinline__ float row_rstd16(const float* SS, unsigned row, int fq) {
    const f32x4 a = *(const f32x4*)(SS + row * 16u + (unsigned)fq * 4u);
    float s = (a[0] + a[1]) + (a[2] + a[3]);
    s += swz_xor<16>(s); s = sum32(s);
    return fast_rsq(s * (1.0f / 1024.0f) + NORM_EPS);
}
__device__ __forceinline__ u32x4 pack8(const f32x4 v0, const f32x4 v1) { u32x4 w; w.x = pack_bf16(v0[0], v0[1]); w.y = pack_bf16(v0[2], v0[3]); w.z = pack_bf16(v1[0], v1[1]); w.w = pack_bf16(v1[2], v1[3]); return w; }

#define EPI_SB __builtin_amdgcn_sched_barrier(0)
#define EPI_RSTD(rs, SS, rowbase) float rs[2][4]; _Pragma("unroll") for (int ai = 0; ai < 2; ++ai) _Pragma("unroll") for (int m = 0; m < 4; ++m) rs[ai][m] = row_rstd16(SS, (unsigned)((rowbase) + ai * HALF + m * 16), fq); EPI_SB;
struct EpiSwiGLU {
    static constexpr bool PERM = true;
    bf16_t* H; int ldh; const float* SS;
    __device__ __forceinline__ void operator()(const Acc& acc, const Unit& u, int wr, int wc, int fr, int fq) const {
        const int row0 = u.pm * BM + wr * 64 + fr, col0 = u.pn * HALF + wc * 32 + 8 * fq;
        EPI_RSTD(rs, SS, row0)
#pragma unroll
        for (int ai = 0; ai < 2; ++ai)
#pragma unroll
            for (int m = 0; m < 4; ++m) { const int row = row0 + ai * HALF + m * 16; const float r = rs[ai][m];
                f32x4 o[2];
#pragma unroll
                for (int n = 0; n < 2; ++n)
#pragma unroll
                    for (int e = 0; e < 4; ++e) o[n][e] = silu_f(r * acc[ai][0][m][n][e]) * (r * acc[ai][1][m][n][e]);
                *(u32x4*)(H + (unsigned)row * (unsigned)ldh + col0) = pack8(o[0], o[1]); EPI_SB; }
    }
};
struct EpiGLU {
    static constexpr bool PERM = true;
    bf16_t* Y; int ldy;
    __device__ __forceinline__ void operator()(const Acc& acc, const Unit& u, int wr, int wc, int fr, int fq) const {
        const int row0 = u.pm * BM + wr * 64 + fr, col0 = u.pn * HALF + wc * 32 + 8 * fq;
#pragma unroll
        for (int ai = 0; ai < 2; ++ai)
#pragma unroll
            for (int m = 0; m < 4; ++m) { const int row = row0 + ai * HALF + m * 16;
                f32x4 o[2];
#pragma unroll
                for (int n = 0; n < 2; ++n)
#pragma unroll
                    for (int e = 0; e < 4; ++e) o[n][e] = acc[ai][0][m][n][e] * sigmoid_f(acc[ai][1][m][n][e]);
                *(u32x4*)(Y + (unsigned)row * (unsigned)ldy + col0) = pack8(o[0], o[1]); EPI_SB; }
    }
};
struct EpiResid {
    static constexpr bool PERM = false;
    const float* Xs; float* X; bf16_t* XB; float* SS; float scale;
    __device__ __forceinline__ void operator()(const Acc& acc, const Unit& u, int wr, int wc, int fr, int fq) const {
        const int row0 = u.pm * BM + wr * 64 + fr, col0 = u.pn * BM + wc * 32 + 4 * fq;
#pragma unroll
        for (int ai = 0; ai < 2; ++ai) {
#pragma unroll
            for (int m = 0; m < 4; ++m) { const int row = row0 + ai * HALF + m * 16; float ssq = 0.f;
#pragma unroll
                for (int bj = 0; bj < 2; ++bj)
#pragma unroll
                    for (int n = 0; n < 2; ++n) { const unsigned off = (unsigned)row * DM + col0 + bj * HALF + n * 16;
                        f32x4 xv = *(const f32x4*)(Xs + off); xv = xv + acc[ai][bj][m][n] * scale; *(f32x4*)(X + off) = xv;
                        u32x2 w; w.x = pack_bf16(xv[0], xv[1]); w.y = pack_bf16(xv[2], xv[3]); *(u32x2*)(XB + off) = w;
                        ssq += (xv[0] * xv[0] + xv[1] * xv[1]) + (xv[2] * xv[2] + xv[3] * xv[3]); }
                ssq += swz_xor<16>(ssq); ssq = sum32(ssq);
                if (fq == 0) SS[(unsigned)row * 16 + u.pn * 4 + wc] = ssq; }
            EPI_SB; }
    }
};
struct EpiInA {
    static constexpr bool PERM = true;
    bf16_t* PA; bf16_t* U; float* MISCA; const float* SS;
    __device__ __forceinline__ void operator()(const Acc& acc, const Unit& u, int wr, int wc, int fr, int fq) const {
        const int row0 = u.pm * BM + wr * 64 + fr, tile = u.pn;
        EPI_RSTD(rs, SS, row0)
#pragma unroll
        for (int ai = 0; ai < 2; ++ai)
#pragma unroll
            for (int m = 0; m < 4; ++m) { const int row = row0 + ai * HALF + m * 16; const float r = rs[ai][m];
#pragma unroll
                for (int bj = 0; bj < 2; ++bj) { const int lc = bj * HALF + wc * 32 + 8 * fq; const f32x4 v0 = acc[ai][bj][m][0] * r, v1 = acc[ai][bj][m][1] * r;
                    if (tile < 13) *(u32x4*)(PA + (unsigned)row * PA_LD + tile * BM + lc) = pack8(v0, v1);
                    else if (tile < 15) { const int ch = (tile - 13) * BM + lc, grp = ch >> 4, k0 = ch & 15, chunk = row >> 4, tau = row & 15;
                        *(u32x4*)(U + ((unsigned)(grp * NCHUNK + chunk)) * U_LD + tau * 16 + k0) = pack8(v0, v1); }
                    else if (lc == 0) { *(f32x4*)(MISCA + (unsigned)row * 8) = v0; *(f32x4*)(MISCA + (unsigned)row * 8 + 4) = v1; } }
                EPI_SB; }
    }
};
struct EpiInB {
    static constexpr bool PERM = true;
    bf16_t* PB; bf16_t* KIB; float* WI; const float* SS;
    __device__ __forceinline__ void operator()(const Acc& acc, const Unit& u, int wr, int wc, int fr, int fq) const {
        const int row0 = u.pm * BM + wr * 64 + fr, tile = u.pn;
        EPI_RSTD(rs, SS, row0)
#pragma unroll
        for (int ai = 0; ai < 2; ++ai)
#pragma unroll
            for (int m = 0; m < 4; ++m) { const int row = row0 + ai * HALF + m * 16; const float r = rs[ai][m];
#pragma unroll
                for (int bj = 0; bj < 2; ++bj) { const int lc = bj * HALF + wc * 32 + 8 * fq; const f32x4 v0 = acc[ai][bj][m][0] * r, v1 = acc[ai][bj][m][1] * r;
                    if (tile < 7) *(u32x4*)(PB + (unsigned)row * PB_LD + tile * BM + lc) = pack8(v0, v1);
                    else if (lc < 64) *(u32x4*)(KIB + (unsigned)row * 64 + lc) = pack8(v0, v1);
                    else if (lc == 64) *(f32x4*)(WI + (unsigned)row * 4) = v0; }
                EPI_SB; }
    }
};
struct EpiGate {
    static constexpr bool PERM = true;
    bf16_t* G; const float* SS;
    __device__ __forceinline__ void operator()(const Acc& acc, const Unit& u, int wr, int wc, int fr, int fq) const {
        const int lr0 = wr * 64 + fr;
        EPI_RSTD(rs, SS, u.pm * BM + lr0)
#pragma unroll
        for (int ai = 0; ai < 2; ++ai)
#pragma unroll
            for (int m = 0; m < 4; ++m) { const int lr = lr0 + ai * HALF + m * 16; const float r = rs[ai][m];
#pragma unroll
                for (int bj = 0; bj < 2; ++bj) { const int lc = bj * HALF + wc * 32 + 8 * fq; f32x4 v0, v1;
#pragma unroll
                    for (int e = 0; e < 4; ++e) { v0[e] = sigmoid_f(r * acc[ai][bj][m][0][e]); v1[e] = sigmoid_f(r * acc[ai][bj][m][1][e]); }
                    *(u32x4*)(G + lr * BM + lc) = pack8(v0, v1); }
                EPI_SB; }
    }
};
struct EpiBranch {
    static constexpr bool PERM = true;
    const bf16_t* G; bf16_t* MG; const float* SSA; int first;
    __device__ __forceinline__ void operator()(const Acc& acc, const Unit& u, int wr, int wc, int fr, int fq) const {
        const int lr0 = wr * 64 + fr;
        float rs[2][4];
#pragma unroll
        for (int ai = 0; ai < 2; ++ai)
#pragma unroll
            for (int m = 0; m < 4; ++m) { rs[ai][m] = 1.0f;
                if (SSA) { const unsigned row = (unsigned)(u.pm * BM + lr0 + ai * HALF + m * 16); const f32x4* p = (const f32x4*)(SSA + row * 8u); const f32x4 a = p[0], b = p[1];
                    rs[ai][m] = fast_rsq((((a[0] + a[1]) + (a[2] + a[3])) + ((b[0] + b[1]) + (b[2] + b[3]))) * (1.0f / 512.0f) + NORM_EPS); } }
        EPI_SB;
#pragma unroll
        for (int ai = 0; ai < 2; ++ai)
#pragma unroll
            for (int m = 0; m < 4; ++m) { const int lr = lr0 + ai * HALF + m * 16, row = u.pm * BM + lr; const float r = rs[ai][m];
#pragma unroll
                for (int bj = 0; bj < 2; ++bj) { const int lc = bj * HALF + wc * 32 + 8 * fq;
                    const u32x4 gw = *(const u32x4*)(G + lr * BM + lc); bf16_t* mp = MG + (unsigned)row * DM + u.pn * BM + lc;
                    u32x4 pw = (u32x4){0u, 0u, 0u, 0u}; if (!first) pw = *(const u32x4*)mp;
                    f32x4 v0, v1;
                    v0[0] = bflo(pw.x) + bflo(gw.x) * r * acc[ai][bj][m][0][0]; v0[1] = bfhi(pw.x) + bfhi(gw.x) * r * acc[ai][bj][m][0][1];
                    v0[2] = bflo(pw.y) + bflo(gw.y) * r * acc[ai][bj][m][0][2]; v0[3] = bfhi(pw.y) + bfhi(gw.y) * r * acc[ai][bj][m][0][3];
                    v1[0] = bflo(pw.z) + bflo(gw.z) * r * acc[ai][bj][m][1][0]; v1[1] = bfhi(pw.z) + bfhi(gw.z) * r * acc[ai][bj][m][1][1];
                    v1[2] = bflo(pw.w) + bflo(gw.w) * r * acc[ai][bj][m][1][2]; v1[3] = bfhi(pw.w) + bfhi(gw.w) * r * acc[ai][bj][m][1][3];
                    *(u32x4*)mp = pack8(v0, v1); }
                if (m & 1) EPI_SB; }
    }
};
struct EpiS5State {
    static constexpr bool PERM = false;
    float* SC;
    __device__ __forceinline__ void operator()(const Acc& acc, const Unit& u, int wr, int wc, int fr, int fq) const {
        const int row0 = u.pm * BM + wr * 64 + fr, col0 = wc * 32 + 4 * fq;
#pragma unroll
        for (int ai = 0; ai < 2; ++ai)
#pragma unroll
            for (int m = 0; m < 4; ++m) { const int row = row0 + ai * HALF + m * 16;
#pragma unroll
                for (int n = 0; n < 2; ++n) *(f32x4*)(SC + (unsigned)row * 128 + col0 + n * 16) = acc[ai][0][m][n]; }
    }
};
struct EpiS5Y {
    static constexpr bool PERM = true;
    bf16_t* S5Y;
    __device__ __forceinline__ void operator()(const Acc& acc, const Unit& u, int wr, int wc, int fr, int fq) const {
        const int row0 = u.pm * BM + wr * 64 + fr;
#pragma unroll
        for (int ai = 0; ai < 2; ++ai)
#pragma unroll
            for (int m = 0; m < 4; ++m) { const int grow = row0 + ai * HALF + m * 16, grp = grow / NCHUNK, chunk = grow % NCHUNK;
#pragma unroll
                for (int bj = 0; bj < 2; ++bj) { const int lc = bj * HALF + wc * 32 + 8 * fq, tau = lc >> 4, i0 = lc & 15; f32x4 v0, v1;
#pragma unroll
                    for (int e = 0; e < 4; ++e) { v0[e] = gelu_tanh_f(acc[ai][bj][m][0][e]); v1[e] = gelu_tanh_f(acc[ai][bj][m][1][e]); }
                    *(u32x4*)(S5Y + (unsigned)(chunk * 16 + tau) * 512 + grp * 16 + i0) = pack8(v0, v1); }
                EPI_SB; }
    }
};
#undef EPI_SB
#undef EPI_RSTD
}
enum { MAP_PLAIN = 0, MAP_IL2 = 1, MAP_INA = 2, MAP_INB = 3 };
struct CvtJob { const float* s0; const float* s1; const float* gain; bf16_t* dst; int ld, R, K, kind, half_off; };
__device__ __forceinline__ void cvt_map(const CvtJob& j, int r, const float*& base, int& col) {
    base = j.s0; col = r;
    if (j.kind == MAP_IL2) { const int pn = r >> 8, w = r & 255; if (w < 128) col = pn * 128 + w; else { base = j.s1; col = j.half_off + pn * 128 + (w - 128); } }
    else if (j.kind == MAP_INA) { if (r < 1280) col = r; else if (r < 3328) col = 3660 + (r - 1280); else if (r < 3840) col = 1288 + (r - 3328); else if (r < 3848) col = 1280 + (r - 3840); else base = nullptr; }
    else if (j.kind == MAP_INB) { if (r < 1792) col = 1800 + r; else if (r < 1860) col = 3592 + (r - 1792); else base = nullptr; }
}
__device__ __forceinline__ void cvt_run(LAS unsigned char* lds, const CvtJob& j, int bid, int nb, int& rot) {
    LAS float* tile = (LAS float*)lds;
    const int tid = tid_fresh(), wid = tid >> 6, lane = tid & 63, ntk = j.K / 64, ntr = j.R / 256, ntiles = ntk * ntr;
    const int first = (bid - rot % nb + nb) % nb;
    const int has_gain = __builtin_amdgcn_readfirstlane(j.gain != nullptr ? 1 : 0);
    f32x4 v[8];
#define CVT_LOAD(T) { const int tr_ = (T) / ntk, tk_ = (T) % ntk; const float* base; int col; cvt_map(j, tr_ * 256 + lane * 4, base, col); \
        _Pragma("unroll") for (int i = 0; i < 8; ++i) { const int kk = wid + 8 * i; float z_ = 0.f; asm volatile("" : "+v"(z_)); v[i] = (f32x4){z_, z_, z_, z_}; \
            if (base) v[i] = *(const f32x4*)(base + (size_t)(tk_ * 64 + kk) * j.ld + col); } }
    if (first < ntiles) CVT_LOAD(first)
    for (int t = first; t < ntiles; t += nb) {
        const int tr = t / ntk, tk = t % ntk, r0 = tr * 256, k0 = tk * 64;
#pragma unroll
        for (int i = 0; i < 8; ++i) { const int kk = wid + 8 * i; f32x4 x = v[i]; if (has_gain) x = x * j.gain[k0 + kk];
            *(LAS f32x4*)(tile + kk * 260 + 4 * (lane ^ ((kk >> 3) & 7))) = x; }
        if (t + nb < ntiles) CVT_LOAD(t + nb)
        __syncthreads();
        { const int kc = (tid & 7) * 8;
#pragma unroll
          for (int i = 0; i < 4; ++i) { const int rr = (tid >> 3) + 64 * i; float e8[8];
#pragma unroll
              for (int e = 0; e < 8; ++e) e8[e] = tile[(kc + e) * 260 + (rr ^ ((tid & 7) << 2))];
              u32x4 w; w.x = pack_bf16(e8[0], e8[1]); w.y = pack_bf16(e8[2], e8[3]); w.z = pack_bf16(e8[4], e8[5]); w.w = pack_bf16(e8[6], e8[7]);
              *(u32x4*)(j.dst + (size_t)(r0 + rr) * j.K + k0 + kc) = w; } }
        __syncthreads();
    }
#undef CVT_LOAD
    rot += ntiles;
}

__device__ __forceinline__ void s5_tables(LAS unsigned char* lds, int g, int part, const float* lam_re, const float* lam_im, const float* b_re, const float* b_im,
                          const float* c_re, const float* c_im, const float* dsk, const float* log_dt, bf16_t* TY, bf16_t* WST, float* AQ) {
    LAS float* ap_re = (LAS float*)lds;
    LAS float* ap_im = ap_re + 17 * 64;
    LAS float* bb_re = ap_im + 17 * 64;
    LAS float* bb_im = bb_re + 1024;
    LAS float* km = bb_im + 1024;
    const int tid = tid_fresh();
    const float step = fast_exp(log_dt[g]);
    for (int idx = tid; idx < 17 * 64; idx += 512) { const int m = idx / 64, p = idx % 64; const float lr = lam_re[g * 64 + p] * step, li = lam_im[g * 64 + p] * step;
        const float mag = fast_exp(lr * (float)m); float sn, cs; sincos_rev(li * (float)m, sn, cs); ap_re[idx] = mag * cs; ap_im[idx] = mag * sn; }
    __syncthreads();
    for (int idx = tid; idx < 1024; idx += 512) { const int p = idx / 16; const float lr = lam_re[g * 64 + p], li = lam_im[g * 64 + p], den = lr * lr + li * li;
        const float ar = ap_re[64 + p], ai = ap_im[64 + p];
        const float rden = fast_rcp(den); const float qr = ((ar - 1.0f) * lr + ai * li) * rden, qi = (ai * lr - (ar - 1.0f) * li) * rden;
        const float br = b_re[(size_t)g * 1024 + idx], bi = b_im[(size_t)g * 1024 + idx];
        bb_re[idx] = qr * br - qi * bi; bb_im[idx] = qr * bi + qi * br; }
    __syncthreads();
    for (int idx = tid; idx < 4096; idx += 512) { const int m = idx >> 8, i = (idx >> 4) & 15, k = idx & 15; float s = 0.f;
        for (int p = 0; p < 64; ++p) { const float cr = c_re[((size_t)g * 16 + i) * 64 + p], ci = c_im[((size_t)g * 16 + i) * 64 + p];
            const float wr_ = cr * ap_re[m * 64 + p] - ci * ap_im[m * 64 + p], wi_ = cr * ap_im[m * 64 + p] + ci * ap_re[m * 64 + p];
            s += wr_ * bb_re[p * 16 + k] - wi_ * bb_im[p * 16 + k]; }
        if (m == 0 && i == k) s += dsk[g * 16 + i];
        km[idx] = s; }
    __syncthreads();
    for (int idx = tid; idx < 32 * 384; idx += 512) { const int rr = part * 32 + idx / 384, cc = idx % 384, tau = rr >> 4, i = rr & 15; float v;
        if (cc < 256) { const int jj = cc >> 4, k = cc & 15; v = (jj <= tau) ? km[((tau - jj) << 8) + (i << 4) + k] : 0.f; }
        else { const int p = (cc - 256) & 63; const float cr = c_re[((size_t)g * 16 + i) * 64 + p], ci = c_im[((size_t)g * 16 + i) * 64 + p];
            const float ar = ap_re[(tau + 1) * 64 + p], ai = ap_im[(tau + 1) * 64 + p];
            v = (cc < 320) ? (cr * ar - ci * ai) : -(cr * ai + ci * ar); }
        TY[((size_t)g * 256 + rr) * 384 + cc] = f2bf(v); }
    for (int idx = tid; idx < 32 * 256; idx += 512) { const int rr = part * 32 + idx / 256, cc = idx % 256, jj = cc >> 4, k = cc & 15; float v = 0.f;
        if (rr < 128) { const int p = rr & 63; const float ar = ap_re[(15 - jj) * 64 + p], ai = ap_im[(15 - jj) * 64 + p], br = bb_re[p * 16 + k], bi = bb_im[p * 16 + k];
            v = (rr < 64) ? (ar * br - ai * bi) : (ar * bi + ai * br); }
        WST[((size_t)g * 256 + rr) * 256 + cc] = f2bf(v); }
    if (part == 0 && tid < 128) AQ[g * 128 + tid] = (tid < 64) ? ap_re[16 * 64 + tid] : ap_im[16 * 64 + (tid - 64)];
    __syncthreads();
}

__device__ __forceinline__ void x_prologue(const float* xin, float* X, bf16_t* XB, float* SS, int bid, int nb) {
    const int tid_ = tid_fresh(), wid = tid_ >> 6, lane = tid_ & 63;
    for (int row = bid * 8 + wid; row < T_TOK; row += nb * 8) {
        float ssq = 0.f;
#pragma unroll
        for (int i = 0; i < 4; ++i) { const size_t off = (size_t)row * DM + i * 256 + lane * 4; const f32x4 v = *(const f32x4*)(xin + off);
            u32x2 w; w.x = pack_bf16(v[0], v[1]); w.y = pack_bf16(v[2], v[3]); *(u32x2*)(XB + off) = w; ssq += (v[0] * v[0] + v[1] * v[1]) + (v[2] * v[2] + v[3] * v[3]); }
        ssq = wave_allsum(ssq);
        if (lane < 16) SS[(size_t)row * 16 + lane] = (lane == 0) ? ssq : 0.f;
    }
}
struct M2Params { const float* conv_w; const float* conv_b; const float* dt_bias; const float* a_log; const float* dskip; };
__device__ __forceinline__ void m2_scan(float* ST, const float* DEC, int e) {
    const int bh = e >> 12, pn = e & 4095; float he[32], dc[32];
#pragma unroll
    for (int seg = 0; seg < 32; ++seg) { he[seg] = ST[(size_t)(bh * 32 + seg) * 4096 + pn]; dc[seg] = DEC[bh * 32 + seg]; }
    float s = 0.f;
#pragma unroll
    for (int seg = 0; seg < 32; ++seg) { ST[(size_t)(bh * 32 + seg) * 4096 + pn] = s; s = dc[seg] * s + he[seg]; }
}

struct HgParams { const float* gamma0; const float* gamma1; const float* norm_g; int layer; };
__device__ __forceinline__ void hg_scan(float* ST, const float* DECK, int e) {
    const int bh = e >> 14, kv = e & 16383, k = kv >> 7; float se[32], dc[32];
#pragma unroll
    for (int seg = 0; seg < 32; ++seg) { se[seg] = ST[(size_t)(bh * 32 + seg) * 16384 + kv]; dc[seg] = DECK[(bh * 32 + seg) * 128 + k]; }
    float s = 0.f;
#pragma unroll
    for (int seg = 0; seg < 32; ++seg) { ST[(size_t)(bh * 32 + seg) * 16384 + kv] = s; s = dc[seg] * s + se[seg]; }
}

__device__ __forceinline__ void s5_scan(LAS unsigned char* lds, int bg, const float* SC, const float* AQ, bf16_t* U) {
    LAS float* Ere = (LAS float*)lds;
    LAS float* Eim = Ere + 512;
    const int tid = tid_fresh(), p = tid & 63, blk = __builtin_amdgcn_readfirstlane(tid >> 6), b = bg >> 5, g = bg & 31;
    const float ar = AQ[g * 128 + p], ai = AQ[g * 128 + 64 + p];
    const size_t row0 = (size_t)g * NCHUNK + b * 512 + blk * 64;
    const float* scb = SC + row0 * 128;
    float xr[32], xi[32];
    float er = 0.f, ei = 0.f, pr = 1.f, pi = 0.f;
#pragma unroll
    for (int hf = 0; hf < 2; ++hf) {
#pragma unroll
        for (int i0 = 0; i0 < 32; i0 += 8) { const float* pb = scb + (32 * hf + i0) * 128 + p; asm volatile("" : "+v"(pb));
#pragma unroll
            for (int i = 0; i < 8; ++i) { xr[i0 + i] = pb[i * 128]; xi[i0 + i] = pb[i * 128 + 64]; } }
        asm volatile("" ::: "memory");
#pragma unroll
        for (int i = 0; i < 32; ++i) { const float nr = ar * er - ai * ei + xr[i], ni = ar * ei + ai * er + xi[i]; er = nr; ei = ni; const float qr = ar * pr - ai * pi, qi = ar * pi + ai * pr; pr = qr; pi = qi; } }
    Ere[blk * 64 + p] = er; Eim[blk * 64 + p] = ei;
    __syncthreads();
    float sr = 0.f, si = 0.f;
    for (int bb = 0; bb < blk; ++bb) { const float nr = pr * sr - pi * si + Ere[bb * 64 + p], ni = pr * si + pi * sr + Eim[bb * 64 + p]; sr = nr; si = ni; }
#pragma unroll
    for (int hf = 0; hf < 2; ++hf) {
#pragma unroll
        for (int i0 = 0; i0 < 32; i0 += 8) { const float* pb = scb + (32 * hf + i0) * 128 + p; asm volatile("" : "+v"(pb));
#pragma unroll
            for (int i = 0; i < 8; ++i) { xr[i0 + i] = pb[i * 128]; xi[i0 + i] = pb[i * 128 + 64]; } }
        asm volatile("" ::: "memory");
#pragma unroll
        for (int i = 0; i < 32; ++i) { bf16_t* up = U + (row0 + 32 * hf + i) * U_LD + 256; up[p] = f2bf(sr); up[64 + p] = f2bf(si);
            const float nr = ar * sr - ai * si + xr[i], ni = ar * si + ai * sr + xi[i]; sr = nr; si = ni; } }
    __syncthreads();
}
__device__ __forceinline__ bf16x8 tr8(const LAS bf16_t* p, int second_off) {
    typedef short v4i16_t_ __attribute__((ext_vector_type(4)));
    const v4i16_t_ lo = __builtin_amdgcn_ds_read_tr16_b64_v4i16((LAS v4i16_t_*)p), hi = __builtin_amdgcn_ds_read_tr16_b64_v4i16((LAS v4i16_t_*)(p + second_off));
    return __builtin_shufflevector(lo, hi, 0, 1, 2, 3, 4, 5, 6, 7);
}
constexpr int HG_RS = 136;
constexpr int HG_TS = 160;

__device__ __forceinline__ void hg1_mfma(LAS unsigned char* lds, int item, const bf16_t* PA, float* ST, float* DECK, const HgParams P) {
    LAS bf16_t* Ke = (LAS bf16_t*)lds;
    LAS bf16_t* Vs = Ke + 128 * HG_TS;
    LAS float* tot = (LAS float*)(Vs + 128 * HG_TS);
    const int tid = tid_fresh(), k = tid & 127, part = tid >> 7, wid = __builtin_amdgcn_readfirstlane(tid >> 6), lane = tid & 63, hl = lane >> 5;
    const int b = item >> 7, hh = (item >> 5) & 3, seg = item & 31;
    const size_t t_base = (size_t)b * SEQ + seg * 256;
    const float lb = (P.layer == 0) ? 0.f : sigmoid_f(P.gamma1[hh * 128 + k] - P.gamma0[hh * 128 + k]);
    const bf16_t* fbase = PA + t_base * PA_LD + 1792 + hh * 128;
#define fcol(OFF) fbase[(unsigned)k + (unsigned)(OFF)]
    float fr[2][32];
#pragma unroll
    for (int bb = 0; bb < 2; ++bb)
#pragma unroll
        for (int i0 = 0; i0 < 32; i0 += 16) {
#pragma unroll
            for (int i = i0; i < i0 + 16; ++i) fr[bb][i] = bf2f(fcol((128 * bb + 32 * part + i) * PA_LD));
            asm volatile("" ::: "memory"); }
#pragma unroll
    for (int bb = 0; bb < 2; ++bb) { float s = 0.f;
#pragma unroll
        for (int i = 0; i < 32; ++i) { const float sg = sigmoid_f(fr[bb][i]); s += 0.6931471805599453f * __builtin_amdgcn_logf(lb + (1.0f - lb) * sg); }
        tot[(4 * bb + part) * 128 + k] = s; }
    __syncthreads();
    f32x16 acc[2];
#pragma unroll
    for (int r = 0; r < 16; ++r) { acc[0][r] = 0.f; acc[1][r] = 0.f; }
    const int kb = wid >> 1, vb0 = 2 * (wid & 1);
    const int troff = (8 * hl + ((lane & 15) >> 2)) * HG_TS + 16 * ((lane >> 4) & 1) + 4 * (lane & 3);
#pragma unroll
    for (int half = 0; half < 2; ++half) {
        { const int blk = 4 * half + part; float sfx = 0.f;
          for (int j = blk + 1; j < 8; ++j) sfx += tot[j * 128 + k];
          bf16_t vv[32];
#pragma unroll
          for (int i0 = 0; i0 < 32; i0 += 16) {
#pragma unroll
              for (int i = i0; i < i0 + 16; ++i) vv[i] = fcol((128 * half + 32 * part + i) * PA_LD + 512);
              asm volatile("" ::: "memory"); }
#pragma unroll
          for (int i = 31; i >= 0; --i) { const int sl = 32 * part + i; const float sg = sigmoid_f(fr[half][i]);
              Ke[sl * HG_TS + k] = f2bf((1.0f - lb) * (1.0f - sg) * fast_exp(sfx)); Vs[sl * HG_TS + k] = vv[i];
              sfx += 0.6931471805599453f * __builtin_amdgcn_logf(lb + (1.0f - lb) * sg); } }
        __syncthreads();
#pragma unroll
        for (int ks = 0; ks < 8; ++ks) {
            const bf16x8 a = tr8(Ke + ks * 16 * HG_TS + kb * 32 + troff, 4 * HG_TS);
            const bf16x8 b0 = tr8(Vs + ks * 16 * HG_TS + vb0 * 32 + troff, 4 * HG_TS), b1 = tr8(Vs + ks * 16 * HG_TS + vb0 * 32 + 32 + troff, 4 * HG_TS);
            acc[0] = __builtin_amdgcn_mfma_f32_32x32x16_bf16(a, b0, acc[0], 0, 0, 0); acc[1] = __builtin_amdgcn_mfma_f32_32x32x16_bf16(a, b1, acc[1], 0, 0, 0); }
        __syncthreads();
    }
    float* sp = ST + (size_t)item * 16384;
#pragma unroll
    for (int j = 0; j < 2; ++j)
#pragma unroll
        for (int r = 0; r < 16; ++r) sp[(kb * 32 + (r & 3) + 8 * (r >> 2) + 4 * hl) * 128 + (vb0 + j) * 32 + (lane & 31)] = acc[j][r];
    if (part == 0) { float s = 0.f; for (int j = 0; j < 8; ++j) s += tot[j * 128 + k]; DECK[item * 128 + k] = fast_exp(s); }
    __syncthreads();
#undef fcol
}

__device__ __forceinline__ void hg3_mfma(LAS unsigned char* lds, int item, bf16_t* PA, const float* ST, const HgParams P) {
    LAS bf16_t* Qd = (LAS bf16_t*)lds;
    LAS bf16_t* Kd = Qd + 32 * HG_RS;
    LAS bf16_t* Ke = Kd + 32 * HG_RS;
    LAS bf16_t* Vs = Ke + 32 * HG_TS;
    LAS bf16_t* At = Vs + 32 * HG_TS;
    LAS bf16_t* St = At + 32 * 40;
    LAS float* tot = (LAS float*)(St + 128 * HG_RS);
    LAS float* dk = tot + 512;
    LAS float* ssq = dk + 128;
    const int tid = tid_fresh(), k = tid & 127, part = tid >> 7, wid = __builtin_amdgcn_readfirstlane(tid >> 6), lane = tid & 63, hl = lane >> 5, lc = lane & 31;
    const int b = item >> 7, hh = (item >> 5) & 3, seg = item & 31;
    const size_t t_base = (size_t)b * SEQ + seg * 256;
    const float lb = (P.layer == 0) ? 0.f : sigmoid_f(P.gamma1[hh * 128 + k] - P.gamma0[hh * 128 + k]);
    const int kb = wid >> 1, vb0 = 2 * (wid & 1);
    const int troff = (8 * hl + ((lane & 15) >> 2)) * HG_TS + 16 * ((lane >> 4) & 1) + 4 * (lane & 3);
    f32x16 acc[2];
    { const float* sp = ST + (size_t)item * 16384;
#pragma unroll
      for (int j = 0; j < 2; ++j)
#pragma unroll
        for (int r = 0; r < 16; ++r) acc[j][r] = sp[(kb * 32 + (r & 3) + 8 * (r >> 2) + 4 * hl) * 128 + (vb0 + j) * 32 + lc]; }
    bf16_t rq[8], rf[8], ri[8];
#define HG3_LOAD(C) { const bf16_t* rp_ = PA + (t_base + (C) * 32 + 8 * part) * PA_LD + 1280 + hh * 128 + k; \
        _Pragma("unroll") for (int i = 0; i < 8; ++i) { rq[i] = rp_[(size_t)i * PA_LD]; rf[i] = rp_[(size_t)i * PA_LD + 512]; ri[i] = rp_[(size_t)i * PA_LD + 1024]; } }
    HG3_LOAD(0)
    f32x4 gnv[4];
#pragma unroll
    for (int g4 = 0; g4 < 4; ++g4) gnv[g4] = *(const f32x4*)(P.norm_g + hh * 128 + (wid & 3) * 32 + 8 * g4 + 4 * hl);
    for (int c = 0; c < 8; ++c) {
        const size_t t0 = t_base + c * 32;
        float qv[8], kv[8], cl[8]; bf16_t vv[8];
        { float run = 0.f;
#pragma unroll
          for (int i = 0; i < 8; ++i) { const float sg = sigmoid_f(bf2f(rf[i])); const float fg = lb + (1.0f - lb) * sg;
              run += 0.6931471805599453f * __builtin_amdgcn_logf(fg); cl[i] = run; kv[i] = (1.0f - lb) * (1.0f - sg); qv[i] = silu_f(bf2f(rq[i])); vv[i] = ri[i]; }
          tot[part * 128 + k] = run; }
        if (c + 1 < 8) HG3_LOAD(c + 1)
        u32x2 gwv[4];
        if (wid < 4) { const bf16_t* gp_ = PA + (t0 + lc) * PA_LD + 2816 + hh * 128 + wid * 32;
#pragma unroll
            for (int g4 = 0; g4 < 4; ++g4) gwv[g4] = *(const u32x2*)(gp_ + 8 * g4 + 4 * hl); }
        __syncthreads();
        { float off = 0.f, all = 0.f;
#pragma unroll
          for (int p = 0; p < 4; ++p) { const float tp = tot[p * 128 + k]; all += tp; if (p < part) off += tp; }
#pragma unroll
          for (int i = 0; i < 8; ++i) { const int t = 8 * part + i; const float cu = off + cl[i];
              Qd[t * HG_RS + k] = f2bf(qv[i] * fast_exp(cu)); Kd[t * HG_RS + k] = f2bf(kv[i] * fast_exp(-cu)); Ke[t * HG_TS + k] = f2bf(kv[i] * fast_exp(all - cu)); Vs[t * HG_TS + k] = vv[i]; }
          if (part == 0) dk[k] = fast_exp(all); }
#pragma unroll
        for (int j = 0; j < 2; ++j)
#pragma unroll
            for (int g4 = 0; g4 < 4; ++g4) { u32x2 w; w.x = pack_bf16(acc[j][4 * g4], acc[j][4 * g4 + 1]); w.y = pack_bf16(acc[j][4 * g4 + 2], acc[j][4 * g4 + 3]);
                *(LAS u32x2*)(St + ((vb0 + j) * 32 + lc) * HG_RS + kb * 32 + 8 * g4 + 4 * hl) = w; }
        __syncthreads();
        if (wid == 0) {
            f32x16 d;
#pragma unroll
            for (int r = 0; r < 16; ++r) d[r] = 0.f;
#pragma unroll
            for (int ks = 0; ks < 8; ++ks) { const bf16x8 a = *(const LAS bf16x8*)(Kd + lc * HG_RS + ks * 16 + 8 * hl), bq = *(const LAS bf16x8*)(Qd + lc * HG_RS + ks * 16 + 8 * hl);
                d = __builtin_amdgcn_mfma_f32_32x32x16_bf16(a, bq, d, 0, 0, 0); }
#pragma unroll
            for (int g4 = 0; g4 < 4; ++g4) { float e[4];
#pragma unroll
                for (int i = 0; i < 4; ++i) { const int s = 8 * g4 + 4 * hl + i; e[i] = (s <= lc) ? d[4 * g4 + i] : 0.f; }
                u32x2 w; w.x = pack_bf16(e[0], e[1]); w.y = pack_bf16(e[2], e[3]); *(LAS u32x2*)(At + lc * 40 + 8 * g4 + 4 * hl) = w; }
        }
        __syncthreads();
        f32x16 o;
        if (wid < 4) {
#pragma unroll
            for (int r = 0; r < 16; ++r) o[r] = 0.f;
#pragma unroll
            for (int ks = 0; ks < 2; ++ks) { const bf16x8 a = tr8(Vs + ks * 16 * HG_TS + wid * 32 + troff, 4 * HG_TS), bt = *(const LAS bf16x8*)(At + lc * 40 + ks * 16 + 8 * hl);
                o = __builtin_amdgcn_mfma_f32_32x32x16_bf16(a, bt, o, 0, 0, 0); }
#pragma unroll
            for (int ks = 0; ks < 8; ++ks) { const bf16x8 a = *(const LAS bf16x8*)(St + (wid * 32 + lc) * HG_RS + ks * 16 + 8 * hl), bq = *(const LAS bf16x8*)(Qd + lc * HG_RS + ks * 16 + 8 * hl);
                o = __builtin_amdgcn_mfma_f32_32x32x16_bf16(a, bq, o, 0, 0, 0); }
            float s2 = 0.f;
#pragma unroll
            for (int r = 0; r < 16; ++r) s2 += o[r] * o[r];
            s2 = sum32(s2); if (hl == 0) ssq[wid * 32 + lc] = s2;
        }
        { const f32x4* dp = (const f32x4*)0; (void)dp;
#pragma unroll
          for (int g4 = 0; g4 < 4; ++g4) { const f32x4 d4 = *(const LAS f32x4*)(dk + kb * 32 + 8 * g4 + 4 * hl);
#pragma unroll
              for (int i = 0; i < 4; ++i) { acc[0][4 * g4 + i] *= d4[i]; acc[1][4 * g4 + i] *= d4[i]; } }
#pragma unroll
          for (int ks = 0; ks < 2; ++ks) { const bf16x8 a = tr8(Ke + ks * 16 * HG_TS + kb * 32 + troff, 4 * HG_TS);
              const bf16x8 b0 = tr8(Vs + ks * 16 * HG_TS + vb0 * 32 + troff, 4 * HG_TS), b1 = tr8(Vs + ks * 16 * HG_TS + vb0 * 32 + 32 + troff, 4 * HG_TS);
              acc[0] = __builtin_amdgcn_mfma_f32_32x32x16_bf16(a, b0, acc[0], 0, 0, 0); acc[1] = __builtin_amdgcn_mfma_f32_32x32x16_bf16(a, b1, acc[1], 0, 0, 0); } }
        __syncthreads();
        if (wid < 4) {
            const float tq = (ssq[lc] + ssq[32 + lc]) + (ssq[64 + lc] + ssq[96 + lc]);
            const float rr = fast_rsq(tq * (1.0f / 128.0f) + NORM_EPS);
            bf16_t* gp = PA + (t0 + lc) * PA_LD + 2816 + hh * 128 + wid * 32;
#pragma unroll
            for (int g4 = 0; g4 < 4; ++g4) { const int v0 = 8 * g4 + 4 * hl; const u32x2 gw = gwv[g4]; const f32x4 gn = gnv[g4];
                const float y0 = o[4 * g4] * rr * gn[0] * sigmoid_f(bflo(gw.x)), y1 = o[4 * g4 + 1] * rr * gn[1] * sigmoid_f(bfhi(gw.x));
                const float y2 = o[4 * g4 + 2] * rr * gn[2] * sigmoid_f(bflo(gw.y)), y3 = o[4 * g4 + 3] * rr * gn[3] * sigmoid_f(bfhi(gw.y));
                u32x2 w; w.x = pack_bf16(y0, y1); w.y = pack_bf16(y2, y3); *(u32x2*)(gp + v0) = w; }
        }
    }
    __syncthreads();
#undef HG3_LOAD
}

constexpr int M2_TS = 96;
__device__ __forceinline__ void m2s1_mfma(LAS unsigned char* lds, int item, const bf16_t* PA, const float* MISCA, float* ST, float* DEC, const M2Params P) {
    LAS bf16_t* raw = (LAS bf16_t*)lds;
    LAS bf16_t* Xc = raw + 131 * 128;
    LAS bf16_t* Bw = Xc + 128 * M2_TS;
    LAS float* wsl = (LAS float*)(Bw + 128 * M2_TS);
    LAS float* wtot = wsl + 256;
    const int tid = tid_fresh(), wid = __builtin_amdgcn_readfirstlane(tid >> 6), lane = tid & 63, hl = lane >> 5;
    const int b = item >> 8, h = (item >> 5) & 7, seg = item & 31, grp = h >> 2;
    const int t_base = b * SEQ + seg * 256, tl_base = seg * 256;
    const float a_h = -fast_exp(P.a_log[h]), dtb = P.dt_bias[h];
    float dtv = 0.f, incl = 0.f;
    if (tid < 256) { dtv = softplus_f(MISCA[(size_t)(t_base + tid) * 8 + h] + dtb); incl = dtv;
#pragma unroll
        for (int o = 1; o < 64; o <<= 1) { const float t = __builtin_bit_cast(float, __builtin_amdgcn_ds_bpermute((lane - o) << 2, __builtin_bit_cast(int, incl))); if (lane >= o) incl += t; }
        if (lane == 63) wtot[wid] = incl; }
    __syncthreads();
    if (tid < 256) { float after = 0.f, all = 0.f;
#pragma unroll
        for (int w = 0; w < 4; ++w) { const float tw = wtot[w]; all += tw; if (w > wid) after += tw; }
        const float wave_tot = wtot[wid];
        wsl[tid] = dtv * fast_exp(a_h * (after + (wave_tot - incl)));
        if (tid == 0) DEC[item] = fast_exp(a_h * all); }
    f32x16 acc;
#pragma unroll
    for (int r = 0; r < 16; ++r) acc[r] = 0.f;
    const int nb_ = wid >> 1, pb_ = wid & 1;
    const int troff = (8 * hl + ((lane & 15) >> 2)) * M2_TS + 16 * ((lane >> 4) & 1) + 4 * (lane & 3);
    for (int half = 0; half < 2; ++half) {
        const int t0 = t_base + half * 128, tl0 = tl_base + half * 128;
        for (int idx = tid; idx < 131 * 16; idx += 512) { const int r = idx >> 4, piece = idx & 15, arr = piece >> 3, pc = piece & 7;
            const int col = (arr == 0 ? 512 + h * 64 : 1024 + grp * 64) + pc * 8;
            u32x4 v = {0u, 0u, 0u, 0u}; if (tl0 - 3 + r >= 0) v = *(const u32x4*)(PA + (size_t)(t0 - 3 + r) * PA_LD + col);
            *(LAS u32x4*)(raw + r * 128 + arr * 64 + pc * 8) = v; }
        __syncthreads();
        { const int g4 = tid & 31, run = tid >> 5, ch0 = 4 * g4, arr = ch0 >> 6, cc0 = ch0 & 63;
          const int cbase = (arr == 0 ? h * 64 : 512 + grp * 64) + cc0;
          f32x4 wt[5];
#pragma unroll
          for (int w = 0; w < 4; ++w) wt[w] = *(const f32x4*)(P.conv_w + w * 768 + cbase);
          wt[4] = *(const f32x4*)(P.conv_b + cbase);
          f32x4 xr[11];
#pragma unroll
          for (int r = 0; r < 11; ++r) { const u32x2 u = *(const LAS u32x2*)(raw + (8 * run + r) * 128 + ch0); xr[r] = (f32x4){bflo(u.x), bfhi(u.x), bflo(u.y), bfhi(u.y)}; }
#pragma unroll
          for (int i = 0; i < 8; ++i) { const int tl = 8 * run + i; f32x4 a = wt[4];
#pragma unroll
              for (int w = 0; w < 4; ++w) a = a + wt[w] * xr[i + w];
              const float sc = (arr == 0) ? 1.0f : wsl[half * 128 + tl];
#pragma unroll
              for (int e = 0; e < 4; ++e) a[e] = silu_f(a[e]) * sc;
              u32x2 o; o.x = pack_bf16(a[0], a[1]); o.y = pack_bf16(a[2], a[3]);
              if (arr == 0) *(LAS u32x2*)(Xc + tl * M2_TS + cc0) = o; else *(LAS u32x2*)(Bw + tl * M2_TS + cc0) = o; } }
        __syncthreads();
        if (wid < 4) {
#pragma unroll
            for (int ks = 0; ks < 8; ++ks) { const bf16x8 a = tr8(Bw + ks * 16 * M2_TS + nb_ * 32 + troff, 4 * M2_TS), bx = tr8(Xc + ks * 16 * M2_TS + pb_ * 32 + troff, 4 * M2_TS);
                acc = __builtin_amdgcn_mfma_f32_32x32x16_bf16(a, bx, acc, 0, 0, 0); } }
        __syncthreads();
    }
    if (wid < 4) { float* sp = ST + (size_t)item * 4096 + (pb_ * 32 + (lane & 31)) * 64 + nb_ * 32 + 4 * hl;
#pragma unroll
        for (int g4 = 0; g4 < 4; ++g4) { f32x4 v = {acc[4 * g4], acc[4 * g4 + 1], acc[4 * g4 + 2], acc[4 * g4 + 3]}; *(f32x4*)(sp + 8 * g4) = v; } }
}

__device__ __forceinline__ void m2s3_mfma(LAS unsigned char* lds, int item, bf16_t* PA, const float* MISCA, const float* ST, float* SSA, const M2Params P) {
    LAS bf16_t* raw = (LAS bf16_t*)lds;
    LAS bf16_t* Xc = raw + 67 * 256;
    LAS bf16_t* Bw = Xc + 64 * 96;
    LAS bf16_t* Bc = Bw + 64 * 96;
    LAS bf16_t* Cc = Bc + 64 * 72;
    LAS bf16_t* Cd = Cc + 64 * 72;
    LAS bf16_t* Sm = Cd + 64 * 72;
    LAS bf16_t* Hs = Sm + 64 * 72;
    LAS float* cwl = (LAS float*)(Hs + 64 * 72);
    LAS float* dtl = cwl + 5 * 192;
    LAS float* acl = dtl + 64;
    LAS float* ssq = acl + 64;
    const int tid = tid_fresh(), wid = __builtin_amdgcn_readfirstlane(tid >> 6), lane = tid & 63, hl = lane >> 5, lc = lane & 31;
    const int b = item >> 8, h = (item >> 5) & 7, seg = item & 31, grp = h >> 2;
    const int t_base = b * SEQ + seg * 256, tl_base = seg * 256;
    const float a_h = -fast_exp(P.a_log[h]), dtb = P.dt_bias[h], dsk = P.dskip[h];
    for (int i = tid; i < 5 * 192; i += 512) { const int w = i / 192, c = i % 192; const int cc = (c < 64) ? h * 64 + c : (c < 128) ? 512 + grp * 64 + (c - 64) : 640 + grp * 64 + (c - 128);
        cwl[i] = (w < 4) ? P.conv_w[w * 768 + cc] : P.conv_b[cc]; }
    const int w4 = wid & 3, nb_ = w4 >> 1, pb_ = w4 & 1;
    const int troff = (8 * hl + ((lane & 15) >> 2)) * 96 + 16 * ((lane >> 4) & 1) + 4 * (lane & 3);
    f32x16 hacc;
#pragma unroll
    for (int r = 0; r < 16; ++r) hacc[r] = 0.f;
    if (wid >= 4) { const float* sp = ST + (size_t)item * 4096 + (pb_ * 32 + lc) * 64 + nb_ * 32 + 4 * hl;
#pragma unroll
        for (int g4 = 0; g4 < 4; ++g4) { const f32x4 v = *(const f32x4*)(sp + 8 * g4); hacc[4 * g4] = v[0]; hacc[4 * g4 + 1] = v[1]; hacc[4 * g4 + 2] = v[2]; hacc[4 * g4 + 3] = v[3]; } }
    u32x4 rv[5]; float dtraw;
#define M2S3_LOAD(C) { const int t0_ = t_base + (C) * 64, tl0_ = tl_base + (C) * 64; \
        _Pragma("unroll") for (int q = 0; q < 5; ++q) { const int idx = tid + 512 * q; rv[q] = (u32x4){0u, 0u, 0u, 0u}; \
            if (idx < 67 * 32) { const int r = idx >> 5, piece = idx & 31, arr = piece >> 3, pc = piece & 7; \
                const int col = (arr == 0 ? 512 + h * 64 : arr == 1 ? 1024 + grp * 64 : arr == 2 ? 1152 + grp * 64 : h * 64) + pc * 8; \
                if (tl0_ - 3 + r >= 0) rv[q] = *(const u32x4*)(PA + (size_t)(t0_ - 3 + r) * PA_LD + col); } } \
        dtraw = (wid == 0) ? MISCA[(size_t)(t0_ + lane) * 8 + h] : 0.f; }
    M2S3_LOAD(0)
    for (int c = 0; c < 4; ++c) {
        const int t0 = t_base + c * 64;
#pragma unroll
        for (int q = 0; q < 5; ++q) { const int idx = tid + 512 * q; if (idx < 67 * 32) { const int r = idx >> 5, piece = idx & 31; *(LAS u32x4*)(raw + r * 256 + (piece >> 3) * 64 + (piece & 7) * 8) = rv[q]; } }
        const float dtraw_c = dtraw;
        if (c + 1 < 4) M2S3_LOAD(c + 1)
        if (wid == 0) { const float dtv = softplus_f(dtraw_c + dtb); float incl = dtv * a_h;
#pragma unroll
            for (int o = 1; o < 64; o <<= 1) { const float t = __builtin_bit_cast(float, __builtin_amdgcn_ds_bpermute((lane - o) << 2, __builtin_bit_cast(int, incl))); if (lane >= o) incl += t; }
            dtl[lane] = dtv; acl[lane] = incl; }
        __syncthreads();
        { const float ac63 = acl[63];
          if (tid < 384) {
            const int g4 = tid % 48, run = tid / 48, ch0 = 4 * g4, arr = ch0 >> 6, cc0 = ch0 & 63;
            f32x4 wt[5];
#pragma unroll
            for (int w = 0; w < 5; ++w) wt[w] = *(const LAS f32x4*)(cwl + w * 192 + ch0);
            f32x4 xr[11];
#pragma unroll
            for (int r = 0; r < 11; ++r) { const u32x2 u = *(const LAS u32x2*)(raw + (8 * run + r) * 256 + ch0); xr[r] = (f32x4){bflo(u.x), bfhi(u.x), bflo(u.y), bfhi(u.y)}; }
            const f32x4 ac0 = *(const LAS f32x4*)(acl + 8 * run), ac1 = *(const LAS f32x4*)(acl + 8 * run + 4), dt0 = *(const LAS f32x4*)(dtl + 8 * run), dt1 = *(const LAS f32x4*)(dtl + 8 * run + 4);
#pragma unroll
            for (int i = 0; i < 8; ++i) { const int s = 8 * run + i; f32x4 a = wt[4];
#pragma unroll
                for (int w = 0; w < 4; ++w) a = a + wt[w] * xr[i + w];
#pragma unroll
                for (int e = 0; e < 4; ++e) a[e] = silu_f(a[e]);
                u32x2 o; o.x = pack_bf16(a[0], a[1]); o.y = pack_bf16(a[2], a[3]);
                if (arr == 0) *(LAS u32x2*)(Xc + s * 96 + cc0) = o;
                else { const float acs = i < 4 ? ac0[i & 3] : ac1[i & 3], dts = i < 4 ? dt0[i & 3] : dt1[i & 3];
                    const float sc = (arr == 1) ? dts * fast_exp(ac63 - acs) : fast_exp(acs);
                    u32x2 o2; o2.x = pack_bf16(a[0] * sc, a[1] * sc); o2.y = pack_bf16(a[2] * sc, a[3] * sc);
                    if (arr == 1) { *(LAS u32x2*)(Bc + s * 72 + cc0) = o; *(LAS u32x2*)(Bw + s * 96 + cc0) = o2; }
                    else { *(LAS u32x2*)(Cc + s * 72 + cc0) = o; *(LAS u32x2*)(Cd + s * 72 + cc0) = o2; } } } }
          if (wid >= 4) {
#pragma unroll
            for (int g4 = 0; g4 < 4; ++g4) { u32x2 w; w.x = pack_bf16(hacc[4 * g4], hacc[4 * g4 + 1]); w.y = pack_bf16(hacc[4 * g4 + 2], hacc[4 * g4 + 3]);
                *(LAS u32x2*)(Hs + (pb_ * 32 + lc) * 72 + nb_ * 32 + 8 * g4 + 4 * hl) = w; }
            const float dch = fast_exp(ac63);
#pragma unroll
            for (int r = 0; r < 16; ++r) hacc[r] *= dch; } }
        __syncthreads();
        if (wid < 3) {
            const int sb = wid >> 1, tb = (wid + 1) >> 1; f32x16 d;
#pragma unroll
            for (int r = 0; r < 16; ++r) d[r] = 0.f;
#pragma unroll
            for (int ks = 0; ks < 4; ++ks) { const bf16x8 a = *(const LAS bf16x8*)(Bc + (sb * 32 + lc) * 72 + ks * 16 + 8 * hl), bq = *(const LAS bf16x8*)(Cc + (tb * 32 + lc) * 72 + ks * 16 + 8 * hl);
                d = __builtin_amdgcn_mfma_f32_32x32x16_bf16(a, bq, d, 0, 0, 0); }
            const int t = tb * 32 + lc; const float act = acl[t];
#pragma unroll
            for (int g4 = 0; g4 < 4; ++g4) { float e[4];
#pragma unroll
                for (int i = 0; i < 4; ++i) { const int s = sb * 32 + 8 * g4 + 4 * hl + i; e[i] = (s <= t) ? d[4 * g4 + i] * dtl[s] * fast_exp(act - acl[s]) : 0.f; }
                u32x2 w; w.x = pack_bf16(e[0], e[1]); w.y = pack_bf16(e[2], e[3]); *(LAS u32x2*)(Sm + t * 72 + sb * 32 + 8 * g4 + 4 * hl) = w; }
        } else if (wid == 3) {
            const u32x2 z2 = {0u, 0u};
#pragma unroll
            for (int g4 = 0; g4 < 4; ++g4) *(LAS u32x2*)(Sm + lc * 72 + 32 + 8 * g4 + 4 * hl) = z2;
        } else {
#pragma unroll
            for (int ks = 0; ks < 4; ++ks) { const bf16x8 a = tr8(Bw + ks * 16 * 96 + nb_ * 32 + troff, 4 * 96), bx = tr8(Xc + ks * 16 * 96 + pb_ * 32 + troff, 4 * 96);
                hacc = __builtin_amdgcn_mfma_f32_32x32x16_bf16(a, bx, hacc, 0, 0, 0); }
        }
        __syncthreads();
        if (wid < 4) {
            const int pb = wid >> 1, tb = wid & 1, t = tb * 32 + lc; f32x16 y;
#pragma unroll
            for (int r = 0; r < 16; ++r) y[r] = 0.f;
#pragma unroll
            for (int ks = 0; ks < 4; ++ks) { const bf16x8 a = tr8(Xc + ks * 16 * 96 + pb * 32 + troff, 4 * 96), bs = *(const LAS bf16x8*)(Sm + t * 72 + ks * 16 + 8 * hl);
                y = __builtin_amdgcn_mfma_f32_32x32x16_bf16(a, bs, y, 0, 0, 0); }
#pragma unroll
            for (int ks = 0; ks < 4; ++ks) { const bf16x8 a = *(const LAS bf16x8*)(Hs + (pb * 32 + lc) * 72 + ks * 16 + 8 * hl), bc = *(const LAS bf16x8*)(Cd + t * 72 + ks * 16 + 8 * hl);
                y = __builtin_amdgcn_mfma_f32_32x32x16_bf16(a, bc, y, 0, 0, 0); }
            float s2 = 0.f; bf16_t* yp = PA + (size_t)(t0 + t) * PA_LD + h * 64 + pb * 32;
#pragma unroll
            for (int g4 = 0; g4 < 4; ++g4) { const int p0 = 8 * g4 + 4 * hl; float o[4];
#pragma unroll
                for (int i = 0; i < 4; ++i) { const int p = pb * 32 + p0 + i; o[i] = (y[4 * g4 + i] + dsk * bf2f(Xc[t * 96 + p])) * silu_f(bf2f(raw[(t + 3) * 256 + 192 + p])); s2 += o[i] * o[i]; }
                u32x2 w; w.x = pack_bf16(o[0], o[1]); w.y = pack_bf16(o[2], o[3]); *(u32x2*)(yp + p0) = w; }
            s2 = sum32(s2); if (hl == 0) ssq[pb * 64 + t] = s2;
        }
        __syncthreads();
        if (tid < 64) SSA[(size_t)(t0 + tid) * 8 + h] = ssq[tid] + ssq[64 + tid];
    }
    __syncthreads();
}
__device__ __forceinline__ void dsa_prep(bf16_t* PB, const int* positions, const float* qn, const float* kn, int bid, int nb) {
    const int tid_ = tid_fresh(), wid = tid_ >> 6, lane = tid_ & 63, j = lane & 31, half = lane >> 5;
    const float inv_freq = fast_exp2(-(float)j * (13.287712379549449f / 32.0f));
    for (int tok = bid * 8 + wid; tok < T_TOK; tok += nb * 8) {
        const float ang = (float)positions[tok] * inv_freq; float sn, cs; sincos_rev(ang, sn, cs);
#pragma unroll
        for (int i = 0; i < 8; ++i) { const int vec = 2 * i + half; const bool isq = vec < 8;
            bf16_t* p = PB + (size_t)tok * PB_LD + (isq ? vec * 64 : 512 + (vec - 8) * 64);
            const float x1 = bf2f(p[j]), x2 = bf2f(p[j + 32]); float ss = x1 * x1 + x2 * x2;
            ss = sum_lo32(ss);
            const float r = fast_rsq(ss * (1.0f / 64.0f) + NORM_EPS); const float* gn = isq ? qn : kn;
            const float y1 = x1 * r * gn[j], y2 = x2 * r * gn[j + 32];
            float o1 = y1 * cs - y2 * sn, o2 = y2 * cs + y1 * sn;
            if (isq) { o1 *= 0.125f * 1.4426950408889634f; o2 *= 0.125f * 1.4426950408889634f; }
            p[j] = f2bf(o1); p[j + 32] = f2bf(o2); }
    }
}

constexpr int HS = 1028;
#ifndef TK_PROBE
#define TK_PROBE 0
#endif
#ifndef TK_FORCE_FAST
#define TK_FORCE_FAST 0
#endif
constexpr int TK_CAP = 960;
constexpr int TK_LIST = 0, TK_MASKL = 32 * TK_CAP * 4, TK_ARR = TK_MASKL + 32 * 256 * 4;
__device__ __forceinline__ float relu_i(float x) { const int i = __builtin_bit_cast(int, x); return __builtin_bit_cast(float, i > 0 ? i : 0); }
__device__ __forceinline__ unsigned sk20_of(float s) { const int u = __builtin_bit_cast(int, s + 0.0f); return ((unsigned)u ^ ((unsigned)(u >> 31) | 0x80000000u)) >> 12; }
__device__ __forceinline__ unsigned fine_bin(float s) { const unsigned u = __float_as_uint(s + 0.0f); const int v = (int)((u >> 19) & 0xfffu) - (96 << 4);
    const int t = (v < -1 ? -1 : (v > 1022 ? 1022 : v)) + 1; return (u >> 31) ? (unsigned)(1023 - t) : (unsigned)(1024 + t); }
__device__ __forceinline__ void idx_load(const bf16_t* KIBb, int key0, int lane, bf16x8 (&kf)[4]) {
    const bf16_t* kp = KIBb + (size_t)(key0 + (lane & 31)) * 64 + 8 * (lane >> 5);
#pragma unroll
    for (int ks = 0; ks < 4; ++ks) kf[ks] = *(const bf16x8*)(kp + ks * 16);
}
__device__ __forceinline__ void idx_scores(const bf16x8 (&kf)[4], const bf16x8 (&qf)[4][4], const float (&wsc)[4], float (&sc)[16]) {
    f32x16 d[4];
#pragma unroll
    for (int hd = 0; hd < 4; ++hd)
#pragma unroll
        for (int r = 0; r < 16; ++r) d[hd][r] = 0.f;
#pragma unroll
    for (int ks = 0; ks < 4; ++ks)
#pragma unroll
        for (int hd = 0; hd < 4; ++hd) d[hd] = __builtin_amdgcn_mfma_f32_32x32x16_bf16(kf[ks], qf[hd][ks], d[hd], 0, 0, 0);
#pragma unroll
    for (int r = 0; r < 16; ++r) { float s = wsc[0] * relu_i(d[0][r]); s += wsc[1] * relu_i(d[1][r]); s += wsc[2] * relu_i(d[2][r]); s += wsc[3] * relu_i(d[3][r]); sc[r] = s; }
}
__device__ __forceinline__ void tk_boundary(const LAS unsigned* hrow, unsigned need, int lane, unsigned& bb, unsigned& above, unsigned& inbin) {
    unsigned wv[16]; unsigned s = 0;
#pragma unroll
    for (int i = 0; i < 4; ++i) { const u32x4 q = *(const LAS u32x4*)(hrow + 1008 - 16 * lane + 4 * i); wv[4 * i] = q.x; wv[4 * i + 1] = q.y; wv[4 * i + 2] = q.z; wv[4 * i + 3] = q.w; }
#pragma unroll
    for (int i = 0; i < 16; ++i) s += (wv[i] & 0xffffu) + (wv[i] >> 16);
    unsigned pre = s;
#pragma unroll
    for (int o = 1; o < 64; o <<= 1) { const unsigned t = (unsigned)__builtin_amdgcn_ds_bpermute((lane - o) << 2, (int)pre); if (lane >= o) pre += t; }
    const unsigned long long bal = __ballot(pre >= need);
    const int lstar = bal ? (int)__builtin_ctzll(bal) : 63;
    unsigned cum = pre - s, rb = 0, ra = cum, rc = 0; bool found = false;
#pragma unroll
    for (int i = 31; i >= 0; --i) { const unsigned w = wv[i >> 1], c = (i & 1) ? (w >> 16) : (w & 0xffffu);
        const bool hit = !found && (cum + c >= need); if (hit) { rb = (unsigned)(2016 - 32 * lane + i); ra = cum; rc = c; } found = found || hit; cum += c; }
    bb = (unsigned)__builtin_amdgcn_readlane((int)rb, lstar); above = (unsigned)__builtin_amdgcn_readlane((int)ra, lstar); inbin = (unsigned)__builtin_amdgcn_readlane((int)rc, lstar);
}
__device__ __forceinline__ float fine_edge(unsigned B) {
    if (B >= 2048u) return __builtin_inff();
    if (B >= 1025u) return __uint_as_float((B - 1025u + (96u << 4)) << 19);
    if (B == 1024u) return 0.0f;
    return -__uint_as_float(((1023u - B + (96u << 4)) << 19) - 1u);
}
__device__ __forceinline__ unsigned skey_of(float s) { const int u = __builtin_bit_cast(int, s + 0.0f); return (unsigned)u ^ ((unsigned)(u >> 31) | 0x80000000u); }

__device__ __forceinline__ void dsa_topk_tile(LAS unsigned char* lds, int b, int qt, const bf16_t* PB, const bf16_t* KIB, const float* WI, unsigned* MASK, int abl) {
    LAS unsigned* hist = (LAS unsigned*)lds;
    LAS unsigned* list = (LAS unsigned*)(lds + TK_LIST);
    LAS unsigned* maskl = (LAS unsigned*)(lds + TK_MASKL);
    LAS unsigned* B1 = (LAS unsigned*)(lds + TK_ARR);
    LAS unsigned* NEED = B1 + 32;
    LAS unsigned* CNT = NEED + 32;
    LAS unsigned* FLAG = CNT + 32;
    const int tid = tid_fresh(), wid = __builtin_amdgcn_readfirstlane(tid >> 6), lane = tid & 63, qc = lane & 31, hl = lane >> 5;
    const int ql = qt * 32 + qc; const size_t row = (size_t)b * SEQ + ql;
    const bf16_t* KIBb = KIB + (size_t)b * SEQ * 64;
    const int nkt = qt + 1;
    if (qt < 8) {
        for (int kt = wid; kt < nkt; kt += 8) { unsigned word = 0u;
#pragma unroll
            for (int r = 0; r < 16; ++r) { const int rho = (r & 3) + 8 * (r >> 2) + 4 * hl; word |= ((kt * 32 + rho <= ql) ? 1u : 0u) << rho; }
            word = or32(word); if (hl == 0) MASK[row * 256 + kt] = word; }
        return;
    }
    bf16x8 qf[4][4]; float wsc[4];
    { const f32x4 wv = *(const f32x4*)(WI + row * 4);
#pragma unroll
      for (int hd = 0; hd < 4; ++hd) { wsc[hd] = wv[hd] * 0.0625f;
#pragma unroll
        for (int ks = 0; ks < 4; ++ks) qf[hd][ks] = *(const bf16x8*)(PB + row * PB_LD + 1536 + hd * 64 + ks * 16 + 8 * hl); } }
    for (int i = tid; i < 32 * HS; i += 512) hist[i] = 0u;
    if (tid == 0) FLAG[0] = 0u;
    __syncthreads();
    const int nsA = nkt < 40 ? nkt : 32;
    unsigned floorb = 0u;
#pragma unroll 1
    for (int stage = 0; stage < 2; ++stage) {
        const int k_lo = stage == 0 ? 0 : nsA, k_hi = stage == 0 ? nsA : nkt;
        if (k_lo < k_hi) {
            bf16x8 kf[4], kn[4]; const int k0 = k_lo + wid; idx_load(KIBb, (k0 < k_hi ? k0 : k_lo) * 32, lane, kf);
#pragma unroll 1
            for (int kt = k0; kt < k_hi; kt += 8) {
                const int ktn = kt + 8 < k_hi ? kt + 8 : kt; idx_load(KIBb, ktn * 32, lane, kn);
                float sc[16]; idx_scores(kf, qf, wsc, sc);
                if (kt == qt) {
#pragma unroll
                    for (int r = 0; r < 16; ++r) if ((r & 3) + 8 * (r >> 2) + 4 * hl > qc) sc[r] = -__builtin_inff(); }
#pragma unroll
                for (int r = 0; r < 16; ++r) { const unsigned bin = fine_bin(sc[r]);
                    if (bin >= floorb) __hip_atomic_fetch_add(hist + qc * HS + (bin >> 1), 1u << (16 * (bin & 1u)), __ATOMIC_RELAXED, __HIP_MEMORY_SCOPE_WORKGROUP); }
#pragma unroll
                for (int ks = 0; ks < 4; ++ks) kf[ks] = kn[ks]; } }
        __syncthreads();
        if (stage == 0 && nsA < nkt) {
#pragma unroll 1
            for (int qq = 0; qq < 4; ++qq) { const int q = wid * 4 + qq; unsigned bb, above, inbin; tk_boundary(hist + q * HS, 256u, lane, bb, above, inbin); if (lane == 0) B1[q] = bb; }
            __syncthreads();
            floorb = B1[qc];
        }
    }
    if (abl & 1) return;
#pragma unroll 1
    for (int qq = 0; qq < 4; ++qq) { const int q = wid * 4 + qq; unsigned bb, above, inbin; tk_boundary(hist + q * HS, 256u, lane, bb, above, inbin);
        if (lane == 0) { B1[q] = bb; NEED[q] = 256u - above; CNT[q] = 0u; if (inbin > (unsigned)TK_CAP || bb == 0u) FLAG[0] = 1u; } }
    __syncthreads();
    const bool overflow = FLAG[0] != 0u;
    const unsigned b1 = B1[qc];
    __syncthreads();
    if (!overflow) {
        const float th_lo = fine_edge(b1), th_hi = fine_edge(b1 + 1u);
        { bf16x8 kf[4], kn[4]; idx_load(KIBb, wid * 32, lane, kf);
#pragma unroll 1
          for (int kt = wid; kt < nkt; kt += 8) {
            const int ktn = kt + 8 < nkt ? kt + 8 : kt; idx_load(KIBb, ktn * 32, lane, kn);
            float sc[16]; idx_scores(kf, qf, wsc, sc);
            if (kt == qt) {
#pragma unroll
                for (int r = 0; r < 16; ++r) if ((r & 3) + 8 * (r >> 2) + 4 * hl > qc) sc[r] = -__builtin_inff(); }
            unsigned word = 0u, cm = 0u;
#pragma unroll
            for (int r = 0; r < 16; ++r) { const float s = sc[r] + 0.0f; const unsigned hi = s >= th_hi ? 1u : 0u, lo = s >= th_lo ? 1u : 0u;
                word |= hi << ((r & 3) + 8 * (r >> 2)); cm |= (lo & ~hi) << r; }
            word <<= 4 * hl;
            if (cm && !(abl & 16)) { unsigned pos = __hip_atomic_fetch_add(CNT + qc, (unsigned)__builtin_popcount(cm), __ATOMIC_RELAXED, __HIP_MEMORY_SCOPE_WORKGROUP);
#pragma unroll
                for (int r = 0; r < 16; ++r) if ((cm >> r) & 1u) { const int key = kt * 32 + (r & 3) + 8 * (r >> 2) + 4 * hl;
                    if (pos < (unsigned)TK_CAP) list[qc * TK_CAP + pos] = ((skey_of(sc[r]) & 0x7ffffu) << 13) | (8191u - (unsigned)key); ++pos; } }
            word = or32(word); if (hl == 0) maskl[qc * 256 + kt] = word;
#pragma unroll
            for (int ks = 0; ks < 4; ++ks) kf[ks] = kn[ks]; } }
        __syncthreads();
#pragma unroll 1
        for (int qq = 0; qq < ((abl & 32) ? 0 : 4); ++qq) { const int q = wid * 4 + qq; const unsigned n = CNT[q], need = NEED[q];
            if (n <= 64u) {
                const bool valid = (unsigned)lane < n; const unsigned cv = valid ? list[q * TK_CAP + lane] : 0u;
                unsigned T = 0u;
#pragma unroll 1
                for (int bit = 31; bit >= 0; --bit) { const unsigned cand = T | (1u << bit); if ((unsigned)__builtin_popcountll(__ballot(valid && cv >= cand)) >= need) T = cand; }
                if (valid && cv >= T) { const unsigned key = 8191u - (cv & 8191u);
                    __hip_atomic_fetch_or(maskl + q * 256 + (key >> 5), 1u << (key & 31u), __ATOMIC_RELAXED, __HIP_MEMORY_SCOPE_WORKGROUP); }
            } else {
                unsigned cv[15];
#pragma unroll
                for (int i = 0; i < 15; ++i) { const unsigned p = (unsigned)(i * 64 + lane); cv[i] = p < n ? list[q * TK_CAP + p] : 0u; }
                unsigned T = 0u;
#pragma unroll 1
                for (int bit = 31; bit >= 0; --bit) { const unsigned cand = T | (1u << bit); unsigned c = 0;
#pragma unroll
                    for (int i = 0; i < 15; ++i) c += (unsigned)__builtin_popcountll(__ballot(cv[i] >= cand && (unsigned)(i * 64 + lane) < n));
                    if (c >= need) T = cand; }
#pragma unroll
                for (int i = 0; i < 15; ++i) if ((unsigned)(i * 64 + lane) < n && cv[i] >= T) { const unsigned key = 8191u - (cv[i] & 8191u);
                    __hip_atomic_fetch_or(maskl + q * 256 + (key >> 5), 1u << (key & 31u), __ATOMIC_RELAXED, __HIP_MEMORY_SCOPE_WORKGROUP); } } }
        __syncthreads();
        if (!(abl & 64)) for (int i = tid; i < 32 * 256; i += 512) { const int q = i >> 8, kt = i & 255; if (kt < nkt) MASK[((size_t)b * SEQ + qt * 32 + q) * 256 + kt] = maskl[i]; }
        __syncthreads();
        return;
    }
    LAS unsigned* BND = B1 + 128;
    unsigned c1 = 0, c2 = 0;
#pragma unroll 1
    for (int level = 0; level < 3; ++level) {
        for (int i = tid; i < 32 * HS; i += 512) hist[i] = 0u;
        if (level == 0 && tid < 32) NEED[tid] = 256u;
        __syncthreads();
        if (level >= 1) c1 = BND[qc]; if (level >= 2) c2 = BND[32 + qc];
#pragma unroll 1
        for (int kt = wid; kt < nkt; kt += 8) { bf16x8 kf[4]; idx_load(KIBb, kt * 32, lane, kf); float sc[16]; idx_scores(kf, qf, wsc, sc);
#pragma unroll
            for (int r = 0; r < 16; ++r) { const int key = kt * 32 + (r & 3) + 8 * (r >> 2) + 4 * hl; const unsigned sk = sk20_of(sc[r]), inv = 8191u - (unsigned)key;
                const unsigned L1 = sk >> 9, L2 = ((sk & 511u) << 2) | (inv >> 11), L3 = inv & 2047u;
                bool ok = key <= ql; unsigned bin = L1;
                if (level == 1) { ok = ok && (L1 == c1); bin = L2; } else if (level == 2) { ok = ok && (L1 == c1) && (L2 == c2); bin = L3; }
                if (ok) __hip_atomic_fetch_add(hist + qc * HS + (bin >> 1), 1u << (16 * (bin & 1u)), __ATOMIC_RELAXED, __HIP_MEMORY_SCOPE_WORKGROUP); } }
        __syncthreads();
#pragma unroll 1
        for (int qq = 0; qq < 4; ++qq) { const int q = wid * 4 + qq; unsigned bb, above, inbin; const unsigned need = NEED[q]; tk_boundary(hist + q * HS, need, lane, bb, above, inbin);
            if (lane == 0) { BND[level * 32 + q] = bb; NEED[q] = need - above; } }
        __syncthreads();
    }
    { const unsigned d1 = BND[qc], d2 = BND[32 + qc], d3 = BND[64 + qc]; const unsigned thi = (d1 << 9) | (d2 >> 2), tlo = ((d2 & 3u) << 11) | d3;
#pragma unroll 1
      for (int kt = wid; kt < nkt; kt += 8) { bf16x8 kf[4]; idx_load(KIBb, kt * 32, lane, kf); float sc[16]; idx_scores(kf, qf, wsc, sc); unsigned word = 0u;
#pragma unroll
        for (int r = 0; r < 16; ++r) { const int rho = (r & 3) + 8 * (r >> 2) + 4 * hl, key = kt * 32 + rho; const unsigned sk = sk20_of(sc[r]), inv = 8191u - (unsigned)key;
            const bool sel = (key <= ql) && (sk > thi || (sk == thi && inv >= tlo)); word |= (sel ? 1u : 0u) << rho; }
        word = or32(word); if (hl == 0) MASK[row * 256 + kt] = word; } }
    __syncthreads();
}

typedef short v4i16_t __attribute__((ext_vector_type(4)));
__device__ __forceinline__ bf16x8 vtr2(const LAS bf16_t* p, int second_off) {
    const v4i16_t lo = __builtin_amdgcn_ds_read_tr16_b64_v4i16((LAS v4i16_t*)p), hi = __builtin_amdgcn_ds_read_tr16_b64_v4i16((LAS v4i16_t*)(p + second_off));
    return __builtin_shufflevector(lo, hi, 0, 1, 2, 3, 4, 5, 6, 7);
}
constexpr int ATT_KS = 72, ATT_VS = 96, ATT_BUF = (64 * ATT_KS + 64 * ATT_VS) * 2;
__device__ __forceinline__ void dsa_attn_item(LAS unsigned char* lds, int b, int hd, int qb, const bf16_t* PB, const unsigned* MASK, bf16_t* YC, const float* qn, const float* kn) {
    const int tid = tid_fresh(), wid = __builtin_amdgcn_readfirstlane(tid >> 6), lane = tid & 63, qc = lane & 31, hl = lane >> 5;
    const int q0 = qb * 256 + wid * 32, ql = q0 + qc; const size_t row = (size_t)b * SEQ + ql;
    const int my_sb_max = q0 >> 5;
    float negC;
    { float gq = fabsf(qn[lane]), gk = fabsf(kn[lane]);
      gq = fmaxf(gq, swz_xor<16>(gq)); gq = fmaxf(gq, swz_xor<8>(gq)); gq = fmaxf(gq, swz_xor<4>(gq)); gq = fmaxf(gq, swz_xor<2>(gq)); gq = fmaxf(gq, swz_xor<1>(gq)); gq = max32(gq);
      gk = fmaxf(gk, swz_xor<16>(gk)); gk = fmaxf(gk, swz_xor<8>(gk)); gk = fmaxf(gk, swz_xor<4>(gk)); gk = fmaxf(gk, swz_xor<2>(gk)); gk = fmaxf(gk, swz_xor<1>(gk)); gk = max32(gk);
      negC = -(8.0f * 1.4426950408889634f * 1.001f) * gq * gk; }
    bf16x8 qf[4];
#pragma unroll
    for (int ks = 0; ks < 4; ++ks) qf[ks] = *(const bf16x8*)(PB + row * PB_LD + hd * 64 + ks * 16 + 8 * hl);
    f32x16 o0, o1;
#pragma unroll
    for (int r = 0; r < 16; ++r) { o0[r] = 0.f; o1[r] = 0.f; }
    float l = 0.f;
    const int nkt = 4 * (qb + 1);
    const int skey = tid >> 3, sd = (tid & 7) * 8;
    const int vtr_off = (4 * hl + ((lane & 15) >> 2)) * ATT_VS + 16 * ((lane >> 4) & 1) + 4 * (lane & 3);
    const bf16_t* kbase = PB + ((size_t)b * SEQ + skey) * PB_LD + 512 + hd * 64 + sd;
    u32x4 kw = *(const u32x4*)kbase, vw = *(const u32x4*)(kbase + 512);
    __syncthreads();
    const unsigned* mrow = MASK + row * 256;
    u32x4 mq0 = *(const u32x4*)mrow, mq1 = *(const u32x4*)(mrow + 4);
#define ATT_TILE(J, MW0, MW1) { const int kt = kt0 + (J); \
        LAS bf16_t* Ks = (LAS bf16_t*)(lds + ((J) & 1) * ATT_BUF); LAS bf16_t* Vs = Ks + 64 * ATT_KS; \
        *(LAS u32x4*)(Ks + skey * ATT_KS + sd) = kw; *(LAS u32x4*)(Vs + skey * ATT_VS + sd) = vw; \
        if (kt + 1 < nkt) { const bf16_t* kp = kbase + (size_t)(kt + 1) * 64 * PB_LD; kw = *(const u32x4*)kp; vw = *(const u32x4*)(kp + 512); } \
        asm volatile("s_waitcnt lgkmcnt(0)" ::: "memory"); __builtin_amdgcn_s_barrier(); asm volatile("" ::: "memory");     \
        if (2 * kt <= my_sb_max) { \
            f32x16 s[2]; int mwh[2]; \
            mwh[0] = (int)((MW0) >> (4 * hl)); mwh[1] = (int)(((2 * kt + 1 <= my_sb_max) ? (MW1) : 0u) >> (4 * hl)); \
            _Pragma("unroll") for (int sbi = 0; sbi < 2; ++sbi) _Pragma("unroll") for (int r = 0; r < 16; ++r) s[sbi][r] = negC; \
            _Pragma("unroll") for (int ks = 0; ks < 4; ++ks) _Pragma("unroll") for (int sbi = 0; sbi < 2; ++sbi) { const bf16x8 kf = *(const LAS bf16x8*)(Ks + (sbi * 32 + qc) * ATT_KS + ks * 16 + 8 * hl); \
                    s[sbi] = __builtin_amdgcn_mfma_f32_32x32x16_bf16(kf, qf[ks], s[sbi], 0, 0, 0); } \
            float ps = 0.f; bf16x8 pf[2][2]; \
            _Pragma("unroll") for (int sbi = 0; sbi < 2; ++sbi) { float pv[16]; \
                _Pragma("unroll") for (int r = 0; r < 16; ++r) { const int sel = __builtin_amdgcn_sbfe(mwh[sbi], (r & 3) + 8 * (r >> 2), 1); \
                    const float p = __builtin_bit_cast(float, __builtin_bit_cast(int, fast_exp2(s[sbi][r])) & sel); pv[r] = p; ps += p; } \
                _Pragma("unroll") for (int s2 = 0; s2 < 2; ++s2) { u32x4 w; w.x = pack_bf16(pv[8 * s2 + 0], pv[8 * s2 + 1]); w.y = pack_bf16(pv[8 * s2 + 2], pv[8 * s2 + 3]); \
                    w.z = pack_bf16(pv[8 * s2 + 4], pv[8 * s2 + 5]); w.w = pack_bf16(pv[8 * s2 + 6], pv[8 * s2 + 7]); pf[sbi][s2] = __builtin_bit_cast(bf16x8, w); } } \
            l += ps; \
            _Pragma("unroll") for (int sbi = 0; sbi < 2; ++sbi) _Pragma("unroll") for (int s2 = 0; s2 < 2; ++s2) { const LAS bf16_t* vp = Vs + (sbi * 32 + s2 * 16) * ATT_VS + vtr_off; \
                    const bf16x8 v0 = vtr2(vp, 8 * ATT_VS), v1 = vtr2(vp + 32, 8 * ATT_VS); \
                    o0 = __builtin_amdgcn_mfma_f32_32x32x16_bf16(v0, pf[sbi][s2], o0, 0, 0, 0); \
                    o1 = __builtin_amdgcn_mfma_f32_32x32x16_bf16(v1, pf[sbi][s2], o1, 0, 0, 0); } \
        } }
    for (int kt0 = 0; kt0 < nkt; kt0 += 4) {
        u32x4 nq0 = mq0, nq1 = mq1;
        if (kt0 + 4 < nkt) { nq0 = *(const u32x4*)(mrow + 2 * kt0 + 8); nq1 = *(const u32x4*)(mrow + 2 * kt0 + 12); }
        ATT_TILE(0, mq0.x, mq0.y) ATT_TILE(1, mq0.z, mq0.w) ATT_TILE(2, mq1.x, mq1.y) ATT_TILE(3, mq1.z, mq1.w)
        mq0 = nq0; mq1 = nq1;
    }
#undef ATT_TILE
    l = sum32(l);
    const float inv = fast_rcp(l);
    bf16_t* op = YC + row * 512 + hd * 64;
#pragma unroll
    for (int r4 = 0; r4 < 4; ++r4) { const int d = 8 * r4 + 4 * hl;
        u32x2 w0, w1; w0.x = pack_bf16(o0[4 * r4] * inv, o0[4 * r4 + 1] * inv); w0.y = pack_bf16(o0[4 * r4 + 2] * inv, o0[4 * r4 + 3] * inv);
        w1.x = pack_bf16(o1[4 * r4] * inv, o1[4 * r4 + 1] * inv); w1.y = pack_bf16(o1[4 * r4 + 2] * inv, o1[4 * r4 + 3] * inv);
        *(u32x2*)(op + d) = w0; *(u32x2*)(op + 32 + d) = w1; }
    __syncthreads();
}
#define XB_TMO      128
#define XB_XCNT(j)  (256  + 64 * (j))
#define XB_XSUB(j)  (1280 + 64 * (j))
#define XB_XGEN(j)  (2304 + 64 * (j))
#define XB_TOP      3328
#define XB_TOPGEN   3392
#define XCD_BAR_WORDS 3456
#define XB_SPIN_CAP (1u << 22)
__device__ __forceinline__ unsigned xb_ld(unsigned* p)              { return __hip_atomic_load(p, __ATOMIC_RELAXED, __HIP_MEMORY_SCOPE_AGENT); }
__device__ __forceinline__ unsigned xb_add(unsigned* p, unsigned v) { return __hip_atomic_fetch_add(p, v, __ATOMIC_RELAXED, __HIP_MEMORY_SCOPE_AGENT); }
__device__ __forceinline__ unsigned xb_xcc_id() { return (unsigned)__builtin_amdgcn_s_getreg((3 << 11) | 20) & 0xFu; }
#define XB_SPIN(cond, bar) do { unsigned _sp = 0; while (cond) { __builtin_amdgcn_s_sleep(1); \
    if ((++_sp & 255u) == 0u) { if (xb_ld(&(bar)[XB_TMO])) break; if (_sp > XB_SPIN_CAP) { atomicAdd(&(bar)[XB_TMO], 1u); break; } } } } while (0)
constexpr int XB_ST_OFF = TID_TAB_OFF - 16;
__device__ __forceinline__ void xcd_barrier_post(unsigned* bar) { if (tid_fresh() == 0) (void)xb_add(&bar[XB_XCNT(xb_xcc_id())], 1u); }
__device__ __forceinline__ void xcd_barrier_complete(unsigned* bar, unsigned x, unsigned G, unsigned& nloc, unsigned& nx) {
    unsigned sum, cnt, mine, sp = 0u;
    for (;;) {
        sum = 0u; cnt = 0u; mine = 0u;
#pragma unroll
        for (unsigned j = 0; j < 16; ++j) { const unsigned c = xb_ld(&bar[XB_XCNT(j)]); sum += c; cnt += (c > 0u) ? 1u : 0u; mine = (j == x) ? c : mine; }
        if (sum == G) break;
        __builtin_amdgcn_s_sleep(1);
        if ((++sp & 255u) == 0u) { if (xb_ld(&bar[XB_TMO])) break; if (sp > XB_SPIN_CAP) { atomicAdd(&bar[XB_TMO], 1u); break; } }
    }
    nloc = mine > 0u ? mine : 1u; nx = cnt > 0u ? cnt : 1u;
}
__device__ __forceinline__ void xcd_barrier(unsigned* bar, unsigned G) {
    asm volatile("s_waitcnt vmcnt(0)" ::: "memory");
    __syncthreads();
    if (tid_fresh() == 0) {
        volatile LAS unsigned* st = (volatile LAS unsigned*)(LAS char*)XB_ST_OFF;
        const unsigned x = xb_xcc_id();
        __builtin_amdgcn_s_waitcnt(0);
        unsigned nloc = st[0], nx = st[1];
        if (nloc == 0u) { xcd_barrier_complete(bar, x, G, nloc, nx); st[0] = nloc; st[1] = nx; }
        const unsigned old = xb_add(&bar[XB_XSUB(x)], 1u);
        const unsigned gen = old / nloc;
        if (old + 1u == (gen + 1u) * nloc) {
            __builtin_amdgcn_fence(__ATOMIC_RELEASE, "agent");
            asm volatile("s_waitcnt vmcnt(0)" ::: "memory");
            const unsigned og = xb_add(&bar[XB_TOP], 1u);
            const unsigned tg = og / nx;
            if (og + 1u == (tg + 1u) * nx) xb_add(&bar[XB_TOPGEN], 1u);
            else XB_SPIN(xb_ld(&bar[XB_TOPGEN]) == tg, bar);
            __builtin_amdgcn_fence(__ATOMIC_ACQUIRE, "agent");
            xb_add(&bar[XB_XGEN(x)], 1u);
            asm volatile("s_waitcnt vmcnt(0)" ::: "memory");
        } else {
            XB_SPIN(xb_ld(&bar[XB_XGEN(x)]) == gen, bar);
            __builtin_amdgcn_fence(__ATOMIC_ACQUIRE, "agent");
            asm volatile("s_waitcnt vmcnt(0)" ::: "memory");
        }
    }
    __syncthreads();
}
constexpr size_t MiB = 1u << 20;
constexpr size_t OFF_CTL = 0, OFF_AQ = 16384, OFF_DEC = 65536, OFF_DECK = 131072;
constexpr size_t OFF_SS = 1 * MiB, OFF_XB = 2 * MiB, OFF_RW = 34 * MiB, OFF_RA = 70 * MiB, OFF_RB = 174 * MiB, WS_NEED = 272 * MiB;
constexpr size_t W_GLU = 0, W_E13 = 1 * MiB, W_E2 = 12 * MiB, W_EINA = 17 * MiB + 512 * 1024, W_ETY = 25 * MiB + 512 * 1024, W_EWST = 31 * MiB + 512 * 1024;
constexpr size_t W_LINB = 1 * MiB, W_LG = 5 * MiB, W_LB = 13 * MiB, W_LO = 17 * MiB, W_L13 = 19 * MiB, W_L2 = 30 * MiB;
constexpr size_t A_H1 = 0, A_PA = 0, A_PB = 0, A_MISCB = 56 * MiB, A_MASK = 64 * MiB, A_YC = 80 * MiB;
constexpr size_t B_U = 0, B_SC = 24 * MiB, B_S5Y = 40 * MiB, B_M2ST = 56 * MiB, B_HGST = 64 * MiB, B_MISCA = 80 * MiB, B_SSA = 81 * MiB, B_YB = 82 * MiB;
constexpr size_t B_GSCR = 0, B_MERGED = 32 * MiB;
constexpr int LDS_BYTES = 160 * 1024;
constexpr int NPH_LAYER = 16;
#if defined(PROBE_PH) || defined(PROBE_SPLIT)
#define TK_ABL (A.sub >> 8)
#else
#define TK_ABL 0
#endif
#ifndef SUBMASK
#define SUBMASK 0xffu
#endif
#ifndef P4SEL
#define P4SEL 7
#endif
#ifndef REPMASK
#define REPMASK 0u
#endif
#ifndef PHMASK
#define PHMASK 0xffffu
#endif

struct Args { const void* in[34]; float* out; unsigned char* ws; int ph_lo, ph_hi, nosync, sub; };

template <int L, int SP> __device__ __forceinline__ void do_phase(LAS unsigned char* lds) {
    typedef const __attribute__((address_space(4))) Args* KArgsPtr;
    KArgsPtr kargs = (KArgsPtr)__builtin_amdgcn_kernarg_segment_ptr();
    asm volatile("" : "+s"(kargs));
#define A (*kargs)
    unsigned char* ws = A.ws;
    const int bid = sgpr_fresh(blockIdx.x), nb = sgpr_fresh(gridDim.x);
#define X ((float*)A.out)
#define SS ((float*)(ws + OFF_SS))
#define XB ((bf16_t*)(ws + OFF_XB))
#define RW (ws + OFF_RW)
#define RA (ws + OFF_RA)
#define RB (ws + OFF_RB)
#define AQ ((float*)(ws + OFF_AQ))
#define DEC ((float*)(ws + OFF_DEC))
#define DECK ((float*)(ws + OFF_DECK))
#define H1 ((bf16_t*)(RA + A_H1))
#define PA ((bf16_t*)(RA + A_PA))
#define PB ((bf16_t*)(RA + A_PB))
#define KIB ((bf16_t*)(RA + A_MISCB))
#define WI ((float*)(RA + A_MISCB + 2 * MiB))
#define MASK ((unsigned*)(RA + A_MASK))
#define YC ((bf16_t*)(RA + A_YC))
#define U ((bf16_t*)(RB + B_U))
#define SC ((float*)(RB + B_SC))
#define S5Y ((bf16_t*)(RB + B_S5Y))
#define M2ST ((float*)(RB + B_M2ST))
#define HGST ((float*)(RB + B_HGST))
#define MISCA ((float*)(RB + B_MISCA))
#define SSA ((float*)(RB + B_SSA))
#define YB ((bf16_t*)(RB + B_YB))
#define GSCR ((bf16_t*)(RB + B_GSCR) + (size_t)bid * 65536)
#define MERGED ((bf16_t*)(RB + B_MERGED))
    {
        constexpr int l = L, sp = SP;
#define INF(i, per) (((const float*)A.in[i]) + (size_t)l * (per))
        constexpr int rep = 0;
        {
        switch (sp) {
        case 0: if constexpr (PHMASK & (1u<<0)) {
            int rot = 0; CvtJob j;
            j = CvtJob{INF(3, DM * DFF), INF(4, DM * DFF), INF(2, DM), (bf16_t*)(RW + W_E13), DFF, 2 * DFF, DM, MAP_IL2, 0}; cvt_run(lds, j, bid, nb, rot);
            j = CvtJob{INF(5, DFF * DM), nullptr, nullptr, (bf16_t*)(RW + W_E2), DM, DM, DFF, MAP_PLAIN, 0}; cvt_run(lds, j, bid, nb, rot);
            j = CvtJob{INF(7, DM * DIN), nullptr, INF(6, DM), (bf16_t*)(RW + W_EINA), DIN, 4096, DM, MAP_INA, 0}; cvt_run(lds, j, bid, nb, rot);
            j = CvtJob{INF(25, 512 * 1024), INF(25, 512 * 1024), nullptr, (bf16_t*)(RW + W_GLU), 1024, 1024, 512, MAP_IL2, 512}; cvt_run(lds, j, bid, nb, rot);
            for (int it = bid; it < 256; it += nb) s5_tables(lds, it >> 3, it & 7, INF(17, 2048), INF(18, 2048), INF(19, 32768), INF(20, 32768), INF(21, 32768), INF(22, 32768), INF(23, 512), INF(24, 32),
                                                             (bf16_t*)(RW + W_ETY), (bf16_t*)(RW + W_EWST), AQ);
            if (l == 0) x_prologue((const float*)A.in[0], X, XB, SS, bid, nb);
        } break;
        case 1: case 14: if constexpr (PHMASK & (1u<<1)) {
            pg8::Gemm g{XB, (const bf16_t*)(RW + (sp == 1 ? W_E13 : W_L13)), DM, DM, DM}; pg8::StaticOrder S; S.init(64, 22, nb, bid);
            pg8::EpiSwiGLU E{H1, DFF, SS}; pg8::gemm_phase<pg8::EpiSwiGLU, pg8::StaticOrder, true, true>(lds, g, S, E);
        } break;
        case 2: case 15: if constexpr (PHMASK & (1u<<2)) {
            pg8::Gemm g{H1, (const bf16_t*)(RW + (sp == 2 ? W_E2 : W_L2)), DFF, DFF, DFF}; pg8::StaticOrder S; S.init(64, 4, nb, bid);
            pg8::EpiResid E{(l == 0 && sp == 2) ? (const float*)A.in[0] : (const float*)X, X, XB, SS, 0.5f}; pg8::gemm_phase<pg8::EpiResid, pg8::StaticOrder, true, true>(lds, g, S, E);
        } break;
        case 3: if constexpr (PHMASK & (1u<<3)) {
            pg8::Gemm g{XB, (const bf16_t*)(RW + W_EINA), DM, DM, DM}; pg8::StaticOrder S; S.init(64, 16, nb, bid);
            pg8::EpiInA E{PA, U, MISCA, SS}; pg8::gemm_phase<pg8::EpiInA, pg8::StaticOrder, true, true>(lds, g, S, E);
        } break;
        case 4: if constexpr (PHMASK & (1u<<4)) {
            if (rep == 0 || (P4SEL & 1)) { pg8::Gemm g{U, (const bf16_t*)(RW + W_EWST), U_LD, 256, 256}; pg8::GroupOrder S; S.init(32, 4, 1, nb, bid);
              pg8::EpiS5State E{SC}; pg8::gemm_phase<pg8::EpiS5State, pg8::GroupOrder, true, true>(lds, g, S, E); }
            if (rep == 0 || (P4SEL & 2)) { const HgParams hp{(const float*)A.in[28], (const float*)A.in[28] + 512, INF(29, 512), l};
              for (int it = bid; it < 256; it += nb) hg1_mfma(lds, it, PA, HGST, DECK, hp); }
            if (rep == 0 || (P4SEL & 4)) { const M2Params mp{INF(11, 4 * 768), INF(12, 768), INF(13, 8), INF(14, 8), INF(15, 8)};
              for (int it = bid; it < 512; it += nb) m2s1_mfma(lds, it, PA, MISCA, M2ST, DEC, mp); }
        } break;
        case 5: if constexpr (PHMASK & (1u<<5)) {
            for (int it = bid; it < 64; it += nb) s5_scan(lds, it, SC, AQ, U);
            const int tid = tid_fresh();
            if (rep == 0) for (int e = bid * 512 + tid; e < 131072; e += nb * 512) hg_scan(HGST, DECK, e);
            if (rep == 0) for (int e = (nb - 1 - bid) * 512 + tid; e < 65536; e += nb * 512) m2_scan(M2ST, DEC, e);
        } break;
        case 6: if constexpr (PHMASK & (1u<<6)) {
            if (A.sub & 4) { pg8::Gemm g{U, (const bf16_t*)(RW + W_ETY), U_LD, U_LD, U_LD}; pg8::GroupOrder S; S.init(32, 4, 1, nb, bid);
              pg8::EpiS5Y E{S5Y}; pg8::gemm_phase<pg8::EpiS5Y, pg8::GroupOrder, true, true>(lds, g, S, E); }
            if (A.sub & 2) { const HgParams hp{(const float*)A.in[28], (const float*)A.in[28] + 512, INF(29, 512), l};
              for (int it = bid; it < 256; it += nb) hg3_mfma(lds, it, PA, HGST, hp); }
            if (A.sub & 1) { const M2Params mp{INF(11, 4 * 768), INF(12, 768), INF(13, 8), INF(14, 8), INF(15, 8)};
              for (int it = bid; it < 512; it += nb) m2s3_mfma(lds, it, PA, MISCA, M2ST, SSA, mp); }
        } break;
        case 7: if constexpr (PHMASK & (1u<<7)) {
            { pg8::Gemm g{S5Y, (const bf16_t*)(RW + W_GLU), 512, 512, 512}; pg8::StaticOrder S; S.init(64, 4, nb, bid);
              pg8::EpiGLU E{YB, 512}; pg8::gemm_phase<pg8::EpiGLU, pg8::StaticOrder, true, true>(lds, g, S, E); }
            int rot = 0; CvtJob j;
            j = CvtJob{INF(7, DM * DIN), nullptr, INF(6, DM), (bf16_t*)(RW + W_LINB), DIN, 2048, DM, MAP_INB, 0}; cvt_run(lds, j, bid, nb, rot);
            j = CvtJob{INF(8, DM * 4096), nullptr, INF(6, DM), (bf16_t*)(RW + W_LG), 4096, 4096, DM, MAP_PLAIN, 0}; cvt_run(lds, j, bid, nb, rot);
            for (int gi = 0; gi < 4; ++gi) { j = CvtJob{INF(9, 4 * 512 * 1024) + (size_t)gi * 512 * 1024, nullptr, gi == 0 ? INF(16, 512) : nullptr, (bf16_t*)(RW + W_LB) + (size_t)gi * 1024 * 512, 1024, 1024, 512, MAP_PLAIN, 0}; cvt_run(lds, j, bid, nb, rot); }
            j = CvtJob{INF(10, DM * DM), nullptr, nullptr, (bf16_t*)(RW + W_LO), DM, DM, DM, MAP_PLAIN, 0}; cvt_run(lds, j, bid, nb, rot);
            j = CvtJob{INF(31, DM * DFF), INF(32, DM * DFF), INF(30, DM), (bf16_t*)(RW + W_L13), DFF, 2 * DFF, DM, MAP_IL2, 0}; cvt_run(lds, j, bid, nb, rot);
            j = CvtJob{INF(33, DFF * DM), nullptr, nullptr, (bf16_t*)(RW + W_L2), DM, DM, DFF, MAP_PLAIN, 0}; cvt_run(lds, j, bid, nb, rot);
        } break;
        case 8: case 12: if constexpr (PHMASK & (1u<<8)) {
            pg8::StaticOrder S; S.init(64, 4, nb, bid);
            for (int gi = 0; gi < 4; ++gi) { if ((sp == 8) == (gi == 2)) continue;
                { pg8::Gemm g{XB, (const bf16_t*)(RW + W_LG) + (size_t)gi * 1024 * 1024, DM, DM, DM}; pg8::EpiGate E{GSCR, SS}; pg8::gemm_phase<pg8::EpiGate, pg8::StaticOrder, true, true>(lds, g, S, E); }
                const bf16_t* Ag = gi == 0 ? PA : gi == 1 ? YB : gi == 2 ? YC : PA + 2816; const int lda = (gi == 1 || gi == 2) ? 512 : PA_LD;
                { pg8::Gemm g{Ag, (const bf16_t*)(RW + W_LB) + (size_t)gi * 1024 * 512, lda, 512, 512}; pg8::EpiBranch E{GSCR, MERGED, gi == 0 ? SSA : nullptr, gi == 0 ? 1 : 0};
                  pg8::gemm_phase<pg8::EpiBranch, pg8::StaticOrder, true, true>(lds, g, S, E); } }
        } break;
        case 9: if constexpr (PHMASK & (1u<<9)) {
            pg8::Gemm g{XB, (const bf16_t*)(RW + W_LINB), DM, DM, DM}; pg8::StaticOrder S; S.init(64, 8, nb, bid);
            pg8::EpiInB E{PB, KIB, WI, SS}; pg8::gemm_phase<pg8::EpiInB, pg8::StaticOrder, true, true>(lds, g, S, E);
        } break;
        case 10: if constexpr (PHMASK & (1u<<10)) {
            if (A.sub & 1) dsa_prep(PB, (const int*)A.in[1], INF(26, 64), INF(27, 64), bid, nb);
            if (A.sub & 2) for (int it = bid; it < 512; it += nb) { const int c = it & 255, bb = it >> 8; dsa_topk_tile(lds, bb, bb == 0 ? c : 255 - c, PB, KIB, WI, TK_ABL ? (unsigned*)YC : MASK, TK_ABL); }
        } break;
        case 11: if constexpr (PHMASK & (1u<<11)) {
            for (int it = bid; it < 512; it += nb) { const int c = it & 255, second = it >> 8, pair = (c & 7) * 2 + (c >> 7), bb = pair >> 3, hd = pair & 7, jq = (c >> 3) & 15;     dsa_attn_item(lds, bb, hd, second ? 31 - jq : jq, PB, MASK, YC, INF(26, 64), INF(27, 64)); }
        } break;
        case 13: if constexpr (PHMASK & (1u<<13)) {
            pg8::Gemm g{MERGED, (const bf16_t*)(RW + W_LO), DM, DM, DM}; pg8::StaticOrder S; S.init(64, 4, nb, bid);
            pg8::EpiResid E{(const float*)X, X, XB, SS, 1.0f}; pg8::gemm_phase<pg8::EpiResid, pg8::StaticOrder, true, true>(lds, g, S, E);
        } break;
        }
        }
    }
#undef INF
}
#undef A

__global__ void __launch_bounds__(512) hybrid_fwd(Args a) {
    cg::grid_group grid = cg::this_grid();
    extern __shared__ __attribute__((aligned(16))) unsigned char lds_raw[];
    LAS unsigned char* lds = (LAS unsigned char*)lds_raw;
    const int ph_lo = a.ph_lo, ph_hi = a.ph_hi;
    tid_tab_init();
    if (threadIdx.x < 4) ((LAS unsigned*)(LAS char*)XB_ST_OFF)[threadIdx.x] = 0u;
    __syncthreads();
    xcd_barrier_post((unsigned*)a.ws);
    if (!a.nosync) grid.sync();
#define STEP(L_, SP_) { constexpr int PH_ = (L_) * NPH_LAYER + (SP_); if (ph_lo <= PH_ && PH_ < ph_hi) { do_phase<L_, SP_>(lds); if (PH_ + 1 < ph_hi) xcd_barrier((unsigned*)a.ws, gridDim.x); } }
#define LAYER(L_) STEP(L_, 0) STEP(L_, 1) STEP(L_, 2) STEP(L_, 3) STEP(L_, 4) STEP(L_, 5) STEP(L_, 6) STEP(L_, 7) STEP(L_, 8) STEP(L_, 9) STEP(L_, 10) STEP(L_, 11) STEP(L_, 12) STEP(L_, 13) STEP(L_, 14) STEP(L_, 15)
    LAYER(0) LAYER(1)
#undef LAYER
#undef STEP
}
extern "C" void kernel_launch(void* const* d_in, const int* in_sizes, int n_in, void* d_out, int out_size, void* d_ws, size_t ws_size, hipStream_t stream) {
    static int grid_blocks = 0;
    if (!grid_blocks) {
        int dev = 0, cus = 0, per_cu = 0;
        hipGetDevice(&dev);
        hipDeviceGetAttribute(&cus, hipDeviceAttributeMultiprocessorCount, dev);
        hipFuncSetAttribute((const void*)hybrid_fwd, hipFuncAttributeMaxDynamicSharedMemorySize, LDS_BYTES);
        hipOccupancyMaxActiveBlocksPerMultiprocessor(&per_cu, hybrid_fwd, 512, LDS_BYTES);
        if (per_cu < 1) { fprintf(stderr, "occupancy query returned %d\n", per_cu); per_cu = 1; }
        grid_blocks = cus * 1;
        if (grid_blocks > 256) grid_blocks = 256;
        fprintf(stderr, "grid_blocks=%d cus=%d per_cu=%d ws_size=%zu need=%zu\n", grid_blocks, cus, per_cu, ws_size, (size_t)WS_NEED);
    }
    if (ws_size < WS_NEED || n_in < 34) { fprintf(stderr, "workspace too small or bad inputs\n"); return; }
    hipMemsetAsync(d_ws, 0, XCD_BAR_WORDS * 4, stream);
    Args a{};
    for (int i = 0; i < 34; ++i) a.in[i] = d_in[i];
    a.out = (float*)d_out; a.ws = (unsigned char*)d_ws; a.ph_lo = 0; a.ph_hi = NLAYER * NPH_LAYER; a.nosync = 0; a.sub = 7;
#ifdef PROBE_SPLIT
    { Args p = a; p.ph_hi = PROBE_SPLIT + 1; void* pa[] = {&p};
      hipLaunchCooperativeKernel((void*)hybrid_fwd, dim3(grid_blocks), dim3(512), pa, LDS_BYTES, stream);
      Args q = a; q.ph_lo = PROBE_SPLIT; q.ph_hi = PROBE_SPLIT + 1; q.nosync = 1; q.sub = PROBE_SUB;
      for (int r = 0; r < PROBE_N; ++r) hipLaunchKernelGGL(hybrid_fwd, dim3(grid_blocks), dim3(512), LDS_BYTES, stream, q);
      Args t = a; t.ph_lo = PROBE_SPLIT + 1; t.nosync = 1;
      hipMemsetAsync(d_ws, 0, XCD_BAR_WORDS * 4, stream);
      hipLaunchKernelGGL(hybrid_fwd, dim3(grid_blocks), dim3(512), LDS_BYTES, stream, t); }
    return;
#endif
    void* args[] = {&a};
    hipError_t e = hipLaunchCooperativeKernel((void*)hybrid_fwd, dim3(grid_blocks), dim3(512), args, LDS_BYTES, stream);
    if (e != hipSuccess) fprintf(stderr, "cooperative launch failed: %s (grid %d)\n", hipGetErrorString(e), grid_blocks);
#ifdef PROBE_PH
    { Args p = a; p.out = (float*)((unsigned char*)d_ws + OFF_RB + 32 * MiB); p.ph_lo = PROBE_PH; p.ph_hi = PROBE_PH + 1; p.nosync = 1; p.sub = PROBE_SUB;
      for (int r = 0; r < PROBE_N; ++r) hipLaunchKernelGGL(hybrid_fwd, dim3(grid_blocks), dim3(512), LDS_BYTES, stream, p); }
#endif
}
```

```cpp
#include <hip/hip_runtime.h>
#include <hip/hip_cooperative_groups.h>
#include <cstdio>
#include <cstdint>
namespace cg = cooperative_groups;

#define LAS __attribute__((address_space(3)))
typedef unsigned short bf16_t;
typedef short bf16x8 __attribute__((ext_vector_type(8)));
typedef float f32x4 __attribute__((ext_vector_type(4)));
typedef float f32x16 __attribute__((ext_vector_type(16)));
typedef unsigned u32x4 __attribute__((ext_vector_type(4)));
typedef unsigned u32x2 __attribute__((ext_vector_type(2)));

constexpr int T_TOK = 16384, SEQ = 8192, DM = 1024, DFF = 2816, DIN = 5708, NLAYER = 2;
constexpr float NORM_EPS = 1e-6f;
constexpr int PA_LD = 3328;
constexpr int PB_LD = 1792;
constexpr int U_LD = 384;
constexpr int S5Q = 16;
constexpr int NCHUNK = T_TOK / S5Q;

typedef __bf16 hwbf2 __attribute__((ext_vector_type(2)));
typedef float f32x2_t __attribute__((ext_vector_type(2)));
__device__ __forceinline__ unsigned pack_bf16(float lo, float hi) { const f32x2_t v = {lo, hi}; return __builtin_bit_cast(unsigned, __builtin_convertvector(v, hwbf2)); }
__device__ __forceinline__ bf16_t f2bf(float f) { return (bf16_t)(pack_bf16(f, 0.f) & 0xffffu); }
__device__ __forceinline__ float bf2f(bf16_t h) { return __uint_as_float(((unsigned)h) << 16); }
__device__ __forceinline__ float bflo(unsigned w) { return __uint_as_float(w << 16); }
__device__ __forceinline__ float bfhi(unsigned w) { return __uint_as_float(w & 0xffff0000u); }
__device__ __forceinline__ float fast_exp2(float x) { return __builtin_amdgcn_exp2f(x); }
__device__ __forceinline__ float fast_rcp(float x) { return __builtin_amdgcn_rcpf(x); }
__device__ __forceinline__ float sigmoid_f(float x) { return fast_rcp(1.0f + fast_exp2(-1.4426950408889634f * x)); }
__device__ __forceinline__ float silu_f(float x) { return x * sigmoid_f(x); }
__device__ __forceinline__ float gelu_tanh_f(float x) { const float u = 0.7978845608028654f * (x + 0.044715f * x * x * x); return x * sigmoid_f(2.0f * u); }
__device__ __forceinline__ float fast_exp(float x) { return __builtin_amdgcn_exp2f(1.4426950408889634f * x); }
__device__ __forceinline__ float fast_rsq(float x) { return __builtin_amdgcn_rsqf(x); }
__device__ __forceinline__ float softplus_f(float x) {
    if (x > 20.f) return x;
    const float e = fast_exp(x);
    if (e < 0.03125f) return e * (1.0f - e * (0.5f - e * (0.33333333f - 0.25f * e)));
    return 0.6931471805599453f * __builtin_amdgcn_logf(1.0f + e);
}
__device__ __forceinline__ void sincos_rev(float ang, float& sn, float& cs) {
    double rd = (double)ang * 0.15915494309189535; rd -= __builtin_floor(rd);
    const float r = (float)rd; sn = __builtin_amdgcn_sinf(r); cs = __builtin_amdgcn_cosf(r);
}
constexpr int TID_TAB_OFF = 160 * 1024 - 256;
__device__ __forceinline__ unsigned hw_wave_slot() { return __builtin_amdgcn_s_getreg((5 << 11) | 4) & 63u; }
__device__ __forceinline__ void tid_tab_init() { ((LAS int*)(LAS char*)TID_TAB_OFF)[hw_wave_slot()] = (int)(threadIdx.x >> 6); __syncthreads(); }
__device__ __forceinline__ int tid_fresh() {
    unsigned off = (unsigned)TID_TAB_OFF + hw_wave_slot() * 4u; asm volatile("" : "+s"(off));
    const int w = *(const LAS int*)(LAS char*)(uintptr_t)off;
    unsigned z_ = 0u; asm volatile("" : "+v"(z_));
    int t = w * 64 + (int)__builtin_amdgcn_mbcnt_hi(~0u, __builtin_amdgcn_mbcnt_lo(~0u, z_)); asm volatile("" : "+v"(t)); return t; }
__device__ __forceinline__ int sgpr_fresh(int v) { asm volatile("" : "+s"(v)); return v; }
template <int M> __device__ __forceinline__ float swz_xor(float x) { return __builtin_bit_cast(float, __builtin_amdgcn_ds_swizzle(__builtin_bit_cast(int, x), (M << 10) | 0x1f)); }
__device__ __forceinline__ void swap32(unsigned u, unsigned& r0, unsigned& r1) { const auto r = __builtin_amdgcn_permlane32_swap(u, u, false, false); r0 = r[0]; r1 = r[1]; asm volatile("" : "+v"(r0), "+v"(r1)); }
__device__ __forceinline__ float sum32(float x) { unsigned r0, r1; swap32(__builtin_bit_cast(unsigned, x), r0, r1); return __builtin_bit_cast(float, r0) + __builtin_bit_cast(float, r1); }
__device__ __forceinline__ float max32(float x) { unsigned r0, r1; swap32(__builtin_bit_cast(unsigned, x), r0, r1); return fmaxf(__builtin_bit_cast(float, r0), __builtin_bit_cast(float, r1)); }
__device__ __forceinline__ unsigned or32(unsigned u) { unsigned r0, r1; swap32(u, r0, r1); return r0 | r1; }
__device__ __forceinline__ float sum_lo32(float x) { x += swz_xor<16>(x); x += swz_xor<8>(x); x += swz_xor<4>(x); x += swz_xor<2>(x); x += swz_xor<1>(x); return x; }
__device__ __forceinline__ float wave_allsum(float x) { return sum32(sum_lo32(x)); }
namespace pg8 {
constexpr int BM = 256, BK = 64, HALF = 128, HTB = HALF * BK * 2  , STAGE_BYTES = 8 * HTB, NXCD = 8, WGM = 8;
__host__ __device__ __forceinline__ int lds_byte(int r, int c) { const int st = (r >> 4) * 2 + (c >> 5), rr = r & 15, cc = c & 31, ob = rr * 64 + cc * 2; return st * 1024 + (ob ^ (((ob >> 9) & 1) << 5)); }
__host__ __device__ __forceinline__ void stage_rc(int b, int& R, int& C) { const int st = b / 1024, sb = b % 1024, swz = sb ^ (((sb >> 9) & 1) << 5); R = (st >> 1) * 16 + swz / 64; C = (st & 1) * 32 + (swz % 64) / 2; }
__host__ __device__ __forceinline__ int perm32(int rho) { const int n = rho >> 4, i = rho & 15; return 8 * (i >> 2) + 4 * n + (i & 3); }

struct Unit { int pm, pn; };
struct Gemm { const bf16_t* A; const bf16_t* Bt; int lda, ldb, K; };

struct StaticOrder {
    int nM, nN, nwg, G, c;
    __device__ void init(int nM_, int nN_, int G_, int c_) { nM = nM_; nN = nN_; nwg = nM * nN; G = G_; c = c_; }
    __device__ bool next(int i, Unit& u) const {
        const long L = (long)i * G + c; if (L >= nwg) return false;
        int wgid = (int)L; { const int q = nwg / NXCD, r = nwg % NXCD, xcd = wgid % NXCD, off = wgid / NXCD; wgid = (xcd < r ? xcd * (q + 1) : r * (q + 1) + (xcd - r) * q) + off; }
        const int nig = WGM * nN, gid = wgid / nig, fm = gid * WGM, gsz = (nM - fm) < WGM ? (nM - fm) : WGM;
        u.pm = fm + ((wgid % nig) % gsz); u.pn = (wgid % nig) / gsz; return true;
    }
};
struct GroupOrder {
    int ng, nMg, nNg, tot, G, c;
    __device__ void init(int ng_, int nMg_, int nNg_, int G_, int c_) { ng = ng_; nMg = nMg_; nNg = nNg_; tot = ng * nMg * nNg; G = G_; c = c_; }
    __device__ bool next(int i, Unit& u) const {
        const int L = i * G + c; if (L >= tot) return false;
        const int per = nMg * nNg, g = L / per, r = L % per; u.pm = g * nMg + r % nMg; u.pn = g * nNg + r / nMg; return true;
    }
};

template <class Epi, class Sched, bool ALIGN_EPI, bool SP2>
__device__ __forceinline__ void gemm_phase(LAS unsigned char* lds, const Gemm g, const Sched& S, const Epi& E) {
    const int tid = tid_fresh(), wid = __builtin_amdgcn_readfirstlane(tid >> 6), lane = tid & 63, wr = wid >> 2, wc = wid & 3, fr = lane & 15, fq = lane >> 4;
    const int K = g.K, nt = K / BK;
    unsigned voffA[2], voffB[2];
#pragma unroll
    for (int i = 0; i < 2; ++i) { int R, C; stage_rc(tid * 16 + i * 8192, R, C); const int Rb = Epi::PERM ? ((R & ~31) + perm32(R & 31)) : R;
        voffA[i] = (unsigned)(R * g.lda + C) * 2u; voffB[i] = (unsigned)(Rb * g.ldb + C) * 2u; }
    const size_t kstep = (size_t)(BK * 2);
    const size_t hstepA = (size_t)HALF * g.lda * 2, hstepB = (size_t)HALF * g.ldb * 2;
    const size_t tstepA = 2 * hstepA, tstepB = 2 * hstepB;
    const unsigned ldsw = (unsigned)wid * 1024u, ldsbase = (unsigned)(uintptr_t)lds;
    const int aoff = lds_byte(wr * 64 + fr, fq * 8), boff = lds_byte(wc * 32 + fr, fq * 8);
#define PG8_SA(b, h) (((b) * 2 + (h)) * HTB)
#define PG8_SB(b, h) ((4 + (b) * 2 + (h)) * HTB)
#define PG8_STAGE(bufoff, gbase, voff) do { _Pragma("unroll") for (int _i = 0; _i < 2; ++_i) { unsigned _keep; const unsigned _dst = ldsbase + (unsigned)(bufoff) + ldsw + (unsigned)_i * 8192u; \
        asm volatile("s_mov_b32 %0, m0\n\ts_mov_b32 m0, %3\n\ts_nop 0\n\tglobal_load_lds_dwordx4 %1, %2\n\ts_mov_b32 m0, %0" : "=&s"(_keep) : "v"((voff)[_i]), "s"(gbase), "s"(_dst) : "memory"); } } while (0)
#define PG8_LDA(dst, b, h) do { _Pragma("unroll") for (int m = 0; m < 4; ++m) _Pragma("unroll") for (int k = 0; k < 2; ++k) dst[m][k] = *(const LAS bf16x8*)(lds + PG8_SA(b, h) + aoff + m * 2048 + k * 1024); } while (0)
#define PG8_LDB(dst, b, h) do { _Pragma("unroll") for (int n = 0; n < 2; ++n) _Pragma("unroll") for (int k = 0; k < 2; ++k) dst[n][k] = *(const LAS bf16x8*)(lds + PG8_SB(b, h) + boff + n * 2048 + k * 1024); } while (0)
#define PG8_MMA(ai, bj, At, Bt) do { __builtin_amdgcn_s_setprio(1); _Pragma("unroll") for (int m = 0; m < 4; ++m) _Pragma("unroll") for (int n = 0; n < 2; ++n) _Pragma("unroll") for (int k = 0; k < 2; ++k) \
        acc[ai][bj][m][n] = __builtin_amdgcn_mfma_f32_16x16x32_bf16(Bt[n][k], At[m][k], acc[ai][bj][m][n], 0, 0, 0); __builtin_amdgcn_s_setprio(0); } while (0)
#define PG8_WAIT_V(n) asm volatile("s_waitcnt vmcnt(" #n ")" ::: "memory")
#define PG8_WAIT_L(n) asm volatile("s_waitcnt lgkmcnt(" #n ")" ::: "memory")
#define PG8_BAR __builtin_amdgcn_s_barrier()
#define PG8_SCHED __builtin_amdgcn_sched_barrier(0)
    Unit cur, nxt; int ui = 0;
    if (!S.next(0, cur)) return;
    f32x4 acc[2][2][4][2];
#pragma unroll
    for (int a = 0; a < 2; ++a)
#pragma unroll
        for (int b = 0; b < 2; ++b)
#pragma unroll
            for (int m = 0; m < 4; ++m)
#pragma unroll
                for (int n = 0; n < 2; ++n) acc[a][b][m][n] = (f32x4){0.f, 0.f, 0.f, 0.f};
    bf16x8 At[4][2], B0[2][2], B1[2][2];
    const char* cA = (const char*)g.A + (size_t)cur.pm * tstepA; const char* cB = (const char*)g.Bt + (size_t)cur.pn * tstepB;
    if constexpr (SP2) {
        PG8_STAGE(PG8_SB(0, 0), cB, voffB); PG8_STAGE(PG8_SB(0, 1), cB + hstepB, voffB); PG8_STAGE(PG8_SA(0, 0), cA, voffA); PG8_STAGE(PG8_SA(0, 1), cA + hstepA, voffA);
        if (wr == 1) PG8_BAR;
        PG8_WAIT_V(2); PG8_BAR;
        PG8_STAGE(PG8_SB(1, 0), cB + kstep, voffB); PG8_STAGE(PG8_SA(1, 0), cA + kstep, voffA); PG8_STAGE(PG8_SB(1, 1), cB + hstepB + kstep, voffB);
        PG8_WAIT_V(6); PG8_BAR;
    } else {
        PG8_STAGE(PG8_SB(0, 0), cB, voffB); PG8_STAGE(PG8_SA(0, 0), cA, voffA); PG8_STAGE(PG8_SB(0, 1), cB + hstepB, voffB); PG8_STAGE(PG8_SA(0, 1), cA + hstepA, voffA);
        if (wr == 1) PG8_BAR;
        PG8_WAIT_V(4); PG8_BAR;
        PG8_STAGE(PG8_SB(1, 0), cB + kstep, voffB); PG8_STAGE(PG8_SA(1, 0), cA + kstep, voffA); PG8_STAGE(PG8_SB(1, 1), cB + hstepB + kstep, voffB);
        PG8_WAIT_V(6); PG8_BAR;
    }
    for (;;) {
        const bool has_next = S.next(ui + 1, nxt);
        const char* nA = has_next ? (const char*)g.A + (size_t)nxt.pm * tstepA : cA; const char* nB = has_next ? (const char*)g.Bt + (size_t)nxt.pn * tstepB : cB;
        for (int t = 0; t < nt; t += 2) {
            const bool last = (t == nt - 2);
            const char* a1 = cA + (size_t)(t + 1) * kstep;
            const char* a2 = last ? nA : cA + (size_t)(t + 2) * kstep; const char* b2 = last ? nB : cB + (size_t)(t + 2) * kstep;
            const char* a3 = a2 + kstep; const char* b3 = b2 + kstep;
            if constexpr (SP2) {
            PG8_LDB(B0, 0, 0); PG8_LDB(B1, 0, 1); PG8_SCHED; PG8_LDA(At, 0, 0); PG8_STAGE(PG8_SA(1, 1), a1 + hstepA, voffA);
            PG8_WAIT_V(8); PG8_WAIT_L(0); PG8_BAR; PG8_MMA(0, 0, At, B0); PG8_MMA(0, 1, At, B1); PG8_BAR; PG8_SCHED;
            PG8_LDA(At, 0, 1); PG8_STAGE(PG8_SB(0, 0), b2, voffB); PG8_STAGE(PG8_SB(0, 1), b2 + hstepB, voffB); PG8_STAGE(PG8_SA(0, 0), a2, voffA);
            PG8_WAIT_V(8); PG8_WAIT_L(0); PG8_BAR; PG8_MMA(1, 0, At, B0); PG8_MMA(1, 1, At, B1); PG8_BAR; PG8_SCHED;
            PG8_LDB(B0, 1, 0); PG8_LDB(B1, 1, 1); PG8_SCHED; PG8_LDA(At, 1, 0); PG8_STAGE(PG8_SA(0, 1), a2 + hstepA, voffA);
            PG8_WAIT_V(8); PG8_WAIT_L(0); PG8_BAR; PG8_MMA(0, 0, At, B0); PG8_MMA(0, 1, At, B1); PG8_BAR; PG8_SCHED;
            PG8_LDA(At, 1, 1); PG8_STAGE(PG8_SB(1, 0), b3, voffB); PG8_STAGE(PG8_SB(1, 1), b3 + hstepB, voffB); PG8_STAGE(PG8_SA(1, 0), a3, voffA);
            PG8_WAIT_V(8); PG8_WAIT_L(0); PG8_BAR; PG8_MMA(1, 0, At, B0); PG8_MMA(1, 1, At, B1); PG8_BAR; PG8_SCHED;
            } else {
            PG8_LDB(B0, 0, 0); PG8_SCHED; PG8_LDA(At, 0, 0); PG8_STAGE(PG8_SA(1, 1), a1 + hstepA, voffA);
            PG8_WAIT_L(8); PG8_BAR; PG8_WAIT_L(0); PG8_MMA(0, 0, At, B0); PG8_BAR; PG8_SCHED;
            PG8_LDB(B1, 0, 1); PG8_STAGE(PG8_SB(0, 0), b2, voffB);
            PG8_BAR; PG8_WAIT_L(0); PG8_MMA(0, 1, At, B1); PG8_BAR;
            PG8_LDA(At, 0, 1); PG8_STAGE(PG8_SA(0, 0), a2, voffA);
            PG8_BAR; PG8_WAIT_L(0); PG8_MMA(1, 0, At, B0); PG8_BAR; PG8_SCHED;
            PG8_STAGE(PG8_SB(0, 1), b2 + hstepB, voffB);
            PG8_WAIT_V(6); PG8_BAR; PG8_MMA(1, 1, At, B1); PG8_BAR;
            PG8_LDB(B0, 1, 0); PG8_SCHED; PG8_LDA(At, 1, 0); PG8_STAGE(PG8_SA(0, 1), a2 + hstepA, voffA);
            PG8_WAIT_L(8); PG8_BAR; PG8_WAIT_L(0); PG8_MMA(0, 0, At, B0); PG8_BAR; PG8_SCHED;
            PG8_LDB(B1, 1, 1); PG8_STAGE(PG8_SB(1, 0), b3, voffB);
            PG8_BAR; PG8_WAIT_L(0); PG8_MMA(0, 1, At, B1); PG8_BAR;
            PG8_LDA(At, 1, 1); PG8_STAGE(PG8_SA(1, 0), a3, voffA);
            PG8_BAR; PG8_WAIT_L(0); PG8_MMA(1, 0, At, B0); PG8_BAR; PG8_SCHED;
            PG8_STAGE(PG8_SB(1, 1), b3 + hstepB, voffB);
            PG8_WAIT_V(6); PG8_BAR; PG8_MMA(1, 1, At, B1); PG8_BAR;
            }
        }
        if constexpr (ALIGN_EPI) { if (wr == 0) PG8_BAR; }
        { unsigned z_ = 0u; asm volatile("" : "+v"(z_)); const unsigned ln_ = __builtin_amdgcn_mbcnt_hi(~0u, __builtin_amdgcn_mbcnt_lo(~0u, z_)); int efr = (int)(ln_ & 15u), efq = (int)(ln_ >> 4); asm volatile("" : "+v"(efr), "+v"(efq)); E(acc, cur, wr, wc, efr, efq); }
        if (!has_next) break;
#pragma unroll
        for (int a = 0; a < 2; ++a)
#pragma unroll
            for (int b = 0; b < 2; ++b)
#pragma unroll
                for (int m = 0; m < 4; ++m)
#pragma unroll
                    for (int n = 0; n < 2; ++n) acc[a][b][m][n] = (f32x4){0.f, 0.f, 0.f, 0.f};
        cur = nxt; cA = nA; cB = nB; ++ui;
        if constexpr (ALIGN_EPI) { if (wr == 1) PG8_BAR; }
    }
    PG8_WAIT_V(0);
    if constexpr (!ALIGN_EPI) { if (wr == 0) PG8_BAR; }
    PG8_BAR;
#undef PG8_SA
#undef PG8_SB
#undef PG8_STAGE
#undef PG8_LDA
#undef PG8_LDB
#undef PG8_MMA
#undef PG8_WAIT_V
#undef PG8_WAIT_L
#undef PG8_BAR
#undef PG8_SCHED
}

typedef f32x4 Acc[2][2][4][2];

__device__ __forceinline__ float row_rstd16(const float* SS, unsigned row, int fq) {
    const f32x4 a = *(const f32x4*)(SS + row * 16u + (unsigned)fq * 4u);
    float s = (a[0] + a[1]) + (a[2] + a[3]);
    s += swz_xor<16>(s); s = sum32(s);
    return fast_rsq(s * (1.0f / 1024.0f) + NORM_EPS);
}
__device__ __forceinline__ u32x4 pack8(const f32x4 v0, const f32x4 v1) { u32x4 w; w.x = pack_bf16(v0[0], v0[1]); w.y = pack_bf16(v0[2], v0[3]); w.z = pack_bf16(v1[0], v1[1]); w.w = pack_bf16(v1[2], v1[3]); return w; }

#define EPI_SB __builtin_amdgcn_sched_barrier(0)
#define EPI_RSTD(rs, SS, rowbase) float rs[2][4]; _Pragma("unroll") for (int ai = 0; ai < 2; ++ai) _Pragma("unroll") for (int m = 0; m < 4; ++m) rs[ai][m] = row_rstd16(SS, (unsigned)((rowbase) + ai * HALF + m * 16), fq); EPI_SB;
struct EpiSwiGLU {
    static constexpr bool PERM = true;
    bf16_t* H; int ldh; const float* SS;
    __device__ __forceinline__ void operator()(const Acc& acc, const Unit& u, int wr, int wc, int fr, int fq) const {
        const int row0 = u.pm * BM + wr * 64 + fr, col0 = u.pn * HALF + wc * 32 + 8 * fq;
        EPI_RSTD(rs, SS, row0)
#pragma unroll
        for (int ai = 0; ai < 2; ++ai)
#pragma unroll
            for (int m = 0; m < 4; ++m) { const int row = row0 + ai * HALF + m * 16; const float r = rs[ai][m];
                f32x4 o[2];
#pragma unroll
                for (int n = 0; n < 2; ++n)
#pragma unroll
                    for (int e = 0; e < 4; ++e) o[n][e] = silu_f(r * acc[ai][0][m][n][e]) * (r * acc[ai][1][m][n][e]);
                *(u32x4*)(H + (unsigned)row * (unsigned)ldh + col0) = pack8(o[0], o[1]); EPI_SB; }
    }
};
struct EpiGLU {
    static constexpr bool PERM = true;
    bf16_t* Y; int ldy;
    __device__ __forceinline__ void operator()(const Acc& acc, const Unit& u, int wr, int wc, int fr, int fq) const {
        const int row0 = u.pm * BM + wr * 64 + fr, col0 = u.pn * HALF + wc * 32 + 8 * fq;
#pragma unroll
        for (int ai = 0; ai < 2; ++ai)
#pragma unroll
            for (int m = 0; m < 4; ++m) { const int row = row0 + ai * HALF + m * 16;
                f32x4 o[2];
#pragma unroll
                for (int n = 0; n < 2; ++n)
#pragma unroll
                    for (int e = 0; e < 4; ++e) o[n][e] = acc[ai][0][m][n][e] * sigmoid_f(acc[ai][1][m][n][e]);
                *(u32x4*)(Y + (unsigned)row * (unsigned)ldy + col0) = pack8(o[0], o[1]); EPI_SB; }
    }
};
struct EpiResid {
    static constexpr bool PERM = false;
    const float* Xs; float* X; bf16_t* XB; float* SS; float scale;
    __device__ __forceinline__ void operator()(const Acc& acc, const Unit& u, int wr, int wc, int fr, int fq) const {
        const int row0 = u.pm * BM + wr * 64 + fr, col0 = u.pn * BM + wc * 32 + 4 * fq;
#pragma unroll
        for (int ai = 0; ai < 2; ++ai) {
#pragma unroll
            for (int m = 0; m < 4; ++m) { const int row = row0 + ai * HALF + m * 16; float ssq = 0.f;
#pragma unroll
                for (int bj = 0; bj < 2; ++bj)
#pragma unroll
                    for (int n = 0; n < 2; ++n) { const unsigned off = (unsigned)row * DM + col0 + bj * HALF + n * 16;
                        f32x4 xv = *(const f32x4*)(Xs + off); xv = xv + acc[ai][bj][m][n] * scale; *(f32x4*)(X + off) = xv;
                        u32x2 w; w.x = pack_bf16(xv[0], xv[1]); w.y = pack_bf16(xv[2], xv[3]); *(u32x2*)(XB + off) = w;
                        ssq += (xv[0] * xv[0] + xv[1] * xv[1]) + (xv[2] * xv[2] + xv[3] * xv[3]); }
                ssq += swz_xor<16>(ssq); ssq = sum32(ssq);
                if (fq == 0) SS[(unsigned)row * 16 + u.pn * 4 + wc] = ssq; }
            EPI_SB; }
    }
};
struct EpiInA {
    static constexpr bool PERM = true;
    bf16_t* PA; bf16_t* U; float* MISCA; const float* SS;
    __device__ __forceinline__ void operator()(const Acc& acc, const Unit& u, int wr, int wc, int fr, int fq) const {
        const int row0 = u.pm * BM + wr * 64 + fr, tile = u.pn;
        EPI_RSTD(rs, SS, row0)
#pragma unroll
        for (int ai = 0; ai < 2; ++ai)
#pragma unroll
            for (int m = 0; m < 4; ++m) { const int row = row0 + ai * HALF + m * 16; const float r = rs[ai][m];
#pragma unroll
                for (int bj = 0; bj < 2; ++bj) { const int lc = bj * HALF + wc * 32 + 8 * fq; const f32x4 v0 = acc[ai][bj][m][0] * r, v1 = acc[ai][bj][m][1] * r;
                    if (tile < 13) *(u32x4*)(PA + (unsigned)row * PA_LD + tile * BM + lc) = pack8(v0, v1);
                    else if (tile < 15) { const int ch = (tile - 13) * BM + lc, grp = ch >> 4, k0 = ch & 15, chunk = row >> 4, tau = row & 15;
                        *(u32x4*)(U + ((unsigned)(grp * NCHUNK + chunk)) * U_LD + tau * 16 + k0) = pack8(v0, v1); }
                    else if (lc == 0) { *(f32x4*)(MISCA + (unsigned)row * 8) = v0; *(f32x4*)(MISCA + (unsigned)row * 8 + 4) = v1; } }
                EPI_SB; }
    }
};
struct EpiInB {
    static constexpr bool PERM = true;
    bf16_t* PB; bf16_t* KIB; float* WI; const float* SS;
    __device__ __forceinline__ void operator()(const Acc& acc, const Unit& u, int wr, int wc, int fr, int fq) const {
        const int row0 = u.pm * BM + wr * 64 + fr, tile = u.pn;
        EPI_RSTD(rs, SS, row0)
#pragma unroll
        for (int ai = 0; ai < 2; ++ai)
#pragma unroll
            for (int m = 0; m < 4; ++m) { const int row = row0 + ai * HALF + m * 16; const float r = rs[ai][m];
#pragma unroll
                for (int bj = 0; bj < 2; ++bj) { const int lc = bj * HALF + wc * 32 + 8 * fq; const f32x4 v0 = acc[ai][bj][m][0] * r, v1 = acc[ai][bj][m][1] * r;
                    if (tile < 7) *(u32x4*)(PB + (unsigned)row * PB_LD + tile * BM + lc) = pack8(v0, v1);
                    else if (lc < 64) *(u32x4*)(KIB + (unsigned)row * 64 + lc) = pack8(v0, v1);
                    else if (lc == 64) *(f32x4*)(WI + (unsigned)row * 4) = v0; }
                EPI_SB; }
    }
};
struct EpiGate {
    static constexpr bool PERM = true;
    bf16_t* G; const float* SS;
    __device__ __forceinline__ void operator()(const Acc& acc, const Unit& u, int wr, int wc, int fr, int fq) const {
        const int lr0 = wr * 64 + fr;
        EPI_RSTD(rs, SS, u.pm * BM + lr0)
#pragma unroll
        for (int ai = 0; ai < 2; ++ai)
#pragma unroll
            for (int m = 0; m < 4; ++m) { const int lr = lr0 + ai * HALF + m * 16; const float r = rs[ai][m];
#pragma unroll
                for (int bj = 0; bj < 2; ++bj) { const int lc = bj * HALF + wc * 32 + 8 * fq; f32x4 v0, v1;
#pragma unroll
                    for (int e = 0; e < 4; ++e) { v0[e] = sigmoid_f(r * acc[ai][bj][m][0][e]); v1[e] = sigmoid_f(r * acc[ai][bj][m][1][e]); }
                    *(u32x4*)(G + lr * BM + lc) = pack8(v0, v1); }
                EPI_SB; }
    }
};
struct EpiBranch {
    static constexpr bool PERM = true;
    const bf16_t* G; bf16_t* MG; const float* SSA; int first;
    __device__ __forceinline__ void operator()(const Acc& acc, const Unit& u, int wr, int wc, int fr, int fq) const {
        const int lr0 = wr * 64 + fr;
        float rs[2][4];
#pragma unroll
        for (int ai = 0; ai < 2; ++ai)
#pragma unroll
            for (int m = 0; m < 4; ++m) { rs[ai][m] = 1.0f;
                if (SSA) { const unsigned row = (unsigned)(u.pm * BM + lr0 + ai * HALF + m * 16); const f32x4* p = (const f32x4*)(SSA + row * 8u); const f32x4 a = p[0], b = p[1];
                    rs[ai][m] = fast_rsq((((a[0] + a[1]) + (a[2] + a[3])) + ((b[0] + b[1]) + (b[2] + b[3]))) * (1.0f / 512.0f) + NORM_EPS); } }
        EPI_SB;
#pragma unroll
        for (int ai = 0; ai < 2; ++ai)
#pragma unroll
            for (int m = 0; m < 4; ++m) { const int lr = lr0 + ai * HALF + m * 16, row = u.pm * BM + lr; const float r = rs[ai][m];
#pragma unroll
                for (int bj = 0; bj < 2; ++bj) { const int lc = bj * HALF + wc * 32 + 8 * fq;
                    const u32x4 gw = *(const u32x4*)(G + lr * BM + lc); bf16_t* mp = MG + (unsigned)row * DM + u.pn * BM + lc;
                    u32x4 pw = (u32x4){0u, 0u, 0u, 0u}; if (!first) pw = *(const u32x4*)mp;
                    f32x4 v0, v1;
                    v0[0] = bflo(pw.x) + bflo(gw.x) * r * acc[ai][bj][m][0][0]; v0[1] = bfhi(pw.x) + bfhi(gw.x) * r * acc[ai][bj][m][0][1];
                    v0[2] = bflo(pw.y) + bflo(gw.y) * r * acc[ai][bj][m][0][2]; v0[3] = bfhi(pw.y) + bfhi(gw.y) * r * acc[ai][bj][m][0][3];
                    v1[0] = bflo(pw.z) + bflo(gw.z) * r * acc[ai][bj][m][1][0]; v1[1] = bfhi(pw.z) + bfhi(gw.z) * r * acc[ai][bj][m][1][1];
                    v1[2] = bflo(pw.w) + bflo(gw.w) * r * acc[ai][bj][m][1][2]; v1[3] = bfhi(pw.w) + bfhi(gw.w) * r * acc[ai][bj][m][1][3];
                    *(u32x4*)mp = pack8(v0, v1); }
                if (m & 1) EPI_SB; }
    }
};
struct EpiS5State {
    static constexpr bool PERM = false;
    float* SC;
    __device__ __forceinline__ void operator()(const Acc& acc, const Unit& u, int wr, int wc, int fr, int fq) const {
        const int row0 = u.pm * BM + wr * 64 + fr, col0 = wc * 32 + 4 * fq;
#pragma unroll
        for (int ai = 0; ai < 2; ++ai)
#pragma unroll
            for (int m = 0; m < 4; ++m) { const int row = row0 + ai * HALF + m * 16;
#pragma unroll
                for (int n = 0; n < 2; ++n) *(f32x4*)(SC + (unsigned)row * 128 + col0 + n * 16) = acc[ai][0][m][n]; }
    }
};
struct EpiS5Y {
    static constexpr bool PERM = true;
    bf16_t* S5Y;
    __device__ __forceinline__ void operator()(const Acc& acc, const Unit& u, int wr, int wc, int fr, int fq) const {
        const int row0 = u.pm * BM + wr * 64 + fr;
#pragma unroll
        for (int ai = 0; ai < 2; ++ai)
#pragma unroll
            for (int m = 0; m < 4; ++m) { const int grow = row0 + ai * HALF + m * 16, grp = grow / NCHUNK, chunk = grow % NCHUNK;
#pragma unroll
                for (int bj = 0; bj < 2; ++bj) { const int lc = bj * HALF + wc * 32 + 8 * fq, tau = lc >> 4, i0 = lc & 15; f32x4 v0, v1;
#pragma unroll
                    for (int e = 0; e < 4; ++e) { v0[e] = gelu_tanh_f(acc[ai][bj][m][0][e]); v1[e] = gelu_tanh_f(acc[ai][bj][m][1][e]); }
                    *(u32x4*)(S5Y + (unsigned)(chunk * 16 + tau) * 512 + grp * 16 + i0) = pack8(v0, v1); }
                EPI_SB; }
    }
};
#undef EPI_SB
#undef EPI_RSTD
}
enum { MAP_PLAIN = 0, MAP_IL2 = 1, MAP_INA = 2, MAP_INB = 3 };
struct CvtJob { const float* s0; const float* s1; const float* gain; bf16_t* dst; int ld, R, K, kind, half_off; };
__device__ __forceinline__ void cvt_map(const CvtJob& j, int r, const float*& base, int& col) {
    base = j.s0; col = r;
    if (j.kind == MAP_IL2) { const int pn = r >> 8, w = r & 255; if (w < 128) col = pn * 128 + w; else { base = j.s1; col = j.half_off + pn * 128 + (w - 128); } }
    else if (j.kind == MAP_INA) { if (r < 1280) col = r; else if (r < 3328) col = 3660 + (r - 1280); else if (r < 3840) col = 1288 + (r - 3328); else if (r < 3848) col = 1280 + (r - 3840); else base = nullptr; }
    else if (j.kind == MAP_INB) { if (r < 1792) col = 1800 + r; else if (r < 1860) col = 3592 + (r - 1792); else base = nullptr; }
}
__device__ __forceinline__ void cvt_run(LAS unsigned char* lds, const CvtJob& j, int bid, int nb, int& rot) {
    LAS float* tile = (LAS float*)lds;
    const int tid = tid_fresh(), wid = tid >> 6, lane = tid & 63, ntk = j.K / 64, ntr = j.R / 256, ntiles = ntk * ntr;
    const int first = (bid - rot % nb + nb) % nb;
    const int has_gain = __builtin_amdgcn_readfirstlane(j.gain != nullptr ? 1 : 0);
    f32x4 v[8];
#define CVT_LOAD(T) { const int tr_ = (T) / ntk, tk_ = (T) % ntk; const float* base; int col; cvt_map(j, tr_ * 256 + lane * 4, base, col); \
        _Pragma("unroll") for (int i = 0; i < 8; ++i) { const int kk = wid + 8 * i; float z_ = 0.f; asm volatile("" : "+v"(z_)); v[i] = (f32x4){z_, z_, z_, z_}; \
            if (base) v[i] = *(const f32x4*)(base + (size_t)(tk_ * 64 + kk) * j.ld + col); } }
    if (first < ntiles) CVT_LOAD(first)
    for (int t = first; t < ntiles; t += nb) {
        const int tr = t / ntk, tk = t % ntk, r0 = tr * 256, k0 = tk * 64;
#pragma unroll
        for (int i = 0; i < 8; ++i) { const int kk = wid + 8 * i; f32x4 x = v[i]; if (has_gain) x = x * j.gain[k0 + kk];
            *(LAS f32x4*)(tile + kk * 260 + 4 * (lane ^ ((kk >> 3) & 7))) = x; }
        if (t + nb < ntiles) CVT_LOAD(t + nb)
        __syncthreads();
        { const int kc = (tid & 7) * 8;
#pragma unroll
          for (int i = 0; i < 4; ++i) { const int rr = (tid >> 3) + 64 * i; float e8[8];
#pragma unroll
              for (int e = 0; e < 8; ++e) e8[e] = tile[(kc + e) * 260 + (rr ^ ((tid & 7) << 2))];
              u32x4 w; w.x = pack_bf16(e8[0], e8[1]); w.y = pack_bf16(e8[2], e8[3]); w.z = pack_bf16(e8[4], e8[5]); w.w = pack_bf16(e8[6], e8[7]);
              *(u32x4*)(j.dst + (size_t)(r0 + rr) * j.K + k0 + kc) = w; } }
        __syncthreads();
    }
#undef CVT_LOAD
    rot += ntiles;
}

__device__ __forceinline__ void s5_tables(LAS unsigned char* lds, int g, int part, const float* lam_re, const float* lam_im, const float* b_re, const float* b_im,
                          const float* c_re, const float* c_im, const float* dsk, const float* log_dt, bf16_t* TY, bf16_t* WST, float* AQ) {
    LAS float* ap_re = (LAS float*)lds;
    LAS float* ap_im = ap_re + 17 * 64;
    LAS float* bb_re = ap_im + 17 * 64;
    LAS float* bb_im = bb_re + 1024;
    LAS float* km = bb_im + 1024;
    const int tid = tid_fresh();
    const float step = fast_exp(log_dt[g]);
    for (int idx = tid; idx < 17 * 64; idx += 512) { const int m = idx / 64, p = idx % 64; const float lr = lam_re[g * 64 + p] * step, li = lam_im[g * 64 + p] * step;
        const float mag = fast_exp(lr * (float)m); float sn, cs; sincos_rev(li * (float)m, sn, cs); ap_re[idx] = mag * cs; ap_im[idx] = mag * sn; }
    __syncthreads();
    for (int idx = tid; idx < 1024; idx += 512) { const int p = idx / 16; const float lr = lam_re[g * 64 + p], li = lam_im[g * 64 + p], den = lr * lr + li * li;
        const float ar = ap_re[64 + p], ai = ap_im[64 + p];
        const float rden = fast_rcp(den); const float qr = ((ar - 1.0f) * lr + ai * li) * rden, qi = (ai * lr - (ar - 1.0f) * li) * rden;
        const float br = b_re[(size_t)g * 1024 + idx], bi = b_im[(size_t)g * 1024 + idx];
        bb_re[idx] = qr * br - qi * bi; bb_im[idx] = qr * bi + qi * br; }
    __syncthreads();
    for (int idx = tid; idx < 4096; idx += 512) { const int m = idx >> 8, i = (idx >> 4) & 15, k = idx & 15; float s = 0.f;
        for (int p = 0; p < 64; ++p) { const float cr = c_re[((size_t)g * 16 + i) * 64 + p], ci = c_im[((size_t)g * 16 + i) * 64 + p];
            const float wr_ = cr * ap_re[m * 64 + p] - ci * ap_im[m * 64 + p], wi_ = cr * ap_im[m * 64 + p] + ci * ap_re[m * 64 + p];
            s += wr_ * bb_re[p * 16 + k] - wi_ * bb_im[p * 16 + k]; }
        if (m == 0 && i == k) s += dsk[g * 16 + i];
        km[idx] = s; }
    __syncthreads();
    for (int idx = tid; idx < 32 * 384; idx += 512) { const int rr = part * 32 + idx / 384, cc = idx % 384, tau = rr >> 4, i = rr & 15; float v;
        if (cc < 256) { const int jj = cc >> 4, k = cc & 15; v = (jj <= tau) ? km[((tau - jj) << 8) + (i << 4) + k] : 0.f; }
        else { const int p = (cc - 256) & 63; const float cr = c_re[((size_t)g * 16 + i) * 64 + p], ci = c_im[((size_t)g * 16 + i) * 64 + p];
            const float ar = ap_re[(tau + 1) * 64 + p], ai = ap_im[(tau + 1) * 64 + p];
            v = (cc < 320) ? (cr * ar - ci * ai) : -(cr * ai + ci * ar); }
        TY[((size_t)g * 256 + rr) * 384 + cc] = f2bf(v); }
    for (int idx = tid; idx < 32 * 256; idx += 512) { const int rr = part * 32 + idx / 256, cc = idx % 256, jj = cc >> 4, k = cc & 15; float v = 0.f;
        if (rr < 128) { const int p = rr & 63; const float ar = ap_re[(15 - jj) * 64 + p], ai = ap_im[(15 - jj) * 64 + p], br = bb_re[p * 16 + k], bi = bb_im[p * 16 + k];
            v = (rr < 64) ? (ar * br - ai * bi) : (ar * bi + ai * br); }
        WST[((size_t)g * 256 + rr) * 256 + cc] = f2bf(v); }
    if (part == 0 && tid < 128) AQ[g * 128 + tid] = (tid < 64) ? ap_re[16 * 64 + tid] : ap_im[16 * 64 + (tid - 64)];
    __syncthreads();
}

__device__ __forceinline__ void x_prologue(const float* xin, float* X, bf16_t* XB, float* SS, int bid, int nb) {
    const int tid_ = tid_fresh(), wid = tid_ >> 6, lane = tid_ & 63;
    for (int row = bid * 8 + wid; row < T_TOK; row += nb * 8) {
        float ssq = 0.f;
#pragma unroll
        for (int i = 0; i < 4; ++i) { const size_t off = (size_t)row * DM + i * 256 + lane * 4; const f32x4 v = *(const f32x4*)(xin + off);
            u32x2 w; w.x = pack_bf16(v[0], v[1]); w.y = pack_bf16(v[2], v[3]); *(u32x2*)(XB + off) = w; ssq += (v[0] * v[0] + v[1] * v[1]) + (v[2] * v[2] + v[3] * v[3]); }
        ssq = wave_allsum(ssq);
        if (lane < 16) SS[(size_t)row * 16 + lane] = (lane == 0) ? ssq : 0.f;
    }
}
struct M2Params { const float* conv_w; const float* conv_b; const float* dt_bias; const float* a_log; const float* dskip; };
__device__ __forceinline__ void m2_scan(float* ST, const float* DEC, int e) {
    const int bh = e >> 12, pn = e & 4095; float he[32], dc[32];
#pragma unroll
    for (int seg = 0; seg < 32; ++seg) { he[seg] = ST[(size_t)(bh * 32 + seg) * 4096 + pn]; dc[seg] = DEC[bh * 32 + seg]; }
    float s = 0.f;
#pragma unroll
    for (int seg = 0; seg < 32; ++seg) { ST[(size_t)(bh * 32 + seg) * 4096 + pn] = s; s = dc[seg] * s + he[seg]; }
}

struct HgParams { const float* gamma0; const float* gamma1; const float* norm_g; int layer; };
__device__ __forceinline__ void hg_scan(float* ST, const float* DECK, int e) {
    const int bh = e >> 14, kv = e & 16383, k = kv >> 7; float se[32], dc[32];
#pragma unroll
    for (int seg = 0; seg < 32; ++seg) { se[seg] = ST[(size_t)(bh * 32 + seg) * 16384 + kv]; dc[seg] = DECK[(bh * 32 + seg) * 128 + k]; }
    float s = 0.f;
#pragma unroll
    for (int seg = 0; seg < 32; ++seg) { ST[(size_t)(bh * 32 + seg) * 16384 + kv] = s; s = dc[seg] * s + se[seg]; }
}

__device__ __forceinline__ void s5_scan(LAS unsigned char* lds, int bg, const float* SC, const float* AQ, bf16_t* U) {
    LAS float* Ere = (LAS float*)lds;
    LAS float* Eim = Ere + 512;
    const int tid = tid_fresh(), p = tid & 63, blk = __builtin_amdgcn_readfirstlane(tid >> 6), b = bg >> 5, g = bg & 31;
    const float ar = AQ[g * 128 + p], ai = AQ[g * 128 + 64 + p];
    const size_t row0 = (size_t)g * NCHUNK + b * 512 + blk * 64;
    const float* scb = SC + row0 * 128;
    float xr[32], xi[32];
    float er = 0.f, ei = 0.f, pr = 1.f, pi = 0.f;
#pragma unroll
    for (int hf = 0; hf < 2; ++hf) {
#pragma unroll
        for (int i0 = 0; i0 < 32; i0 += 8) { const float* pb = scb + (32 * hf + i0) * 128 + p; asm volatile("" : "+v"(pb));
#pragma unroll
            for (int i = 0; i < 8; ++i) { xr[i0 + i] = pb[i * 128]; xi[i0 + i] = pb[i * 128 + 64]; } }
        asm volatile("" ::: "memory");
#pragma unroll
        for (int i = 0; i < 32; ++i) { const float nr = ar * er - ai * ei + xr[i], ni = ar * ei + ai * er + xi[i]; er = nr; ei = ni; const float qr = ar * pr - ai * pi, qi = ar * pi + ai * pr; pr = qr; pi = qi; } }
    Ere[blk * 64 + p] = er; Eim[blk * 64 + p] = ei;
    __syncthreads();
    float sr = 0.f, si = 0.f;
    for (int bb = 0; bb < blk; ++bb) { const float nr = pr * sr - pi * si + Ere[bb * 64 + p], ni = pr * si + pi * sr + Eim[bb * 64 + p]; sr = nr; si = ni; }
#pragma unroll
    for (int hf = 0; hf < 2; ++hf) {
#pragma unroll
        for (int i0 = 0; i0 < 32; i0 += 8) { const float* pb = scb + (32 * hf + i0) * 128 + p; asm volatile("" : "+v"(pb));
#pragma unroll
            for (int i = 0; i < 8; ++i) { xr[i0 + i] = pb[i * 128]; xi[i0 + i] = pb[i * 128 + 64]; } }
        asm volatile("" ::: "memory");
#pragma unroll
        for (int i = 0; i < 32; ++i) { bf16_t* up = U + (row0 + 32 * hf + i) * U_LD + 256; up[p] = f2bf(sr); up[64 + p] = f2bf(si);
            const float nr = ar * sr - ai * si + xr[i], ni = ar * si + ai * sr + xi[i]; sr = nr; si = ni; } }
    __syncthreads();
}
__device__ __forceinline__ bf16x8 tr8(const LAS bf16_t* p, int second_off) {
    typedef short v4i16_t_ __attribute__((ext_vector_type(4)));
    const v4i16_t_ lo = __builtin_amdgcn_ds_read_tr16_b64_v4i16((LAS v4i16_t_*)p), hi = __builtin_amdgcn_ds_read_tr16_b64_v4i16((LAS v4i16_t_*)(p + second_off));
    return __builtin_shufflevector(lo, hi, 0, 1, 2, 3, 4, 5, 6, 7);
}
constexpr int HG_RS = 136;
constexpr int HG_TS = 160;

__device__ __forceinline__ void hg1_mfma(LAS unsigned char* lds, int item, const bf16_t* PA, float* ST, float* DECK, const HgParams P) {
    LAS bf16_t* Ke = (LAS bf16_t*)lds;
    LAS bf16_t* Vs = Ke + 128 * HG_TS;
    LAS float* tot = (LAS float*)(Vs + 128 * HG_TS);
    const int tid = tid_fresh(), k = tid & 127, part = tid >> 7, wid = __builtin_amdgcn_readfirstlane(tid >> 6), lane = tid & 63, hl = lane >> 5;
    const int b = item >> 7, hh = (item >> 5) & 3, seg = item & 31;
    const size_t t_base = (size_t)b * SEQ + seg * 256;
    const float lb = (P.layer == 0) ? 0.f : sigmoid_f(P.gamma1[hh * 128 + k] - P.gamma0[hh * 128 + k]);
    const bf16_t* fbase = PA + t_base * PA_LD + 1792 + hh * 128;
#define fcol(OFF) fbase[(unsigned)k + (unsigned)(OFF)]
    float fr[2][32];
#pragma unroll
    for (int bb = 0; bb < 2; ++bb)
#pragma unroll
        for (int i0 = 0; i0 < 32; i0 += 16) {
#pragma unroll
            for (int i = i0; i < i0 + 16; ++i) fr[bb][i] = bf2f(fcol((128 * bb + 32 * part + i) * PA_LD));
            asm volatile("" ::: "memory"); }
#pragma unroll
    for (int bb = 0; bb < 2; ++bb) { float s = 0.f;
#pragma unroll
        for (int i = 0; i < 32; ++i) { const float sg = sigmoid_f(fr[bb][i]); s += 0.6931471805599453f * __builtin_amdgcn_logf(lb + (1.0f - lb) * sg); }
        tot[(4 * bb + part) * 128 + k] = s; }
    __syncthreads();
    f32x16 acc[2];
#pragma unroll
    for (int r = 0; r < 16; ++r) { acc[0][r] = 0.f; acc[1][r] = 0.f; }
    const int kb = wid >> 1, vb0 = 2 * (wid & 1);
    const int troff = (8 * hl + ((lane & 15) >> 2)) * HG_TS + 16 * ((lane >> 4) & 1) + 4 * (lane & 3);
#pragma unroll
    for (int half = 0; half < 2; ++half) {
        { const int blk = 4 * half + part; float sfx = 0.f;
          for (int j = blk + 1; j < 8; ++j) sfx += tot[j * 128 + k];
          bf16_t vv[32];
#pragma unroll
          for (int i0 = 0; i0 < 32; i0 += 16) {
#pragma unroll
              for (int i = i0; i < i0 + 16; ++i) vv[i] = fcol((128 * half + 32 * part + i) * PA_LD + 512);
              asm volatile("" ::: "memory"); }
#pragma unroll
          for (int i = 31; i >= 0; --i) { const int sl = 32 * part + i; const float sg = sigmoid_f(fr[half][i]);
              Ke[sl * HG_TS + k] = f2bf((1.0f - lb) * (1.0f - sg) * fast_exp(sfx)); Vs[sl * HG_TS + k] = vv[i];
              sfx += 0.6931471805599453f * __builtin_amdgcn_logf(lb + (1.0f - lb) * sg); } }
        __syncthreads();
#pragma unroll
        for (int ks = 0; ks < 8; ++ks) {
            const bf16x8 a = tr8(Ke + ks * 16 * HG_TS + kb * 32 + troff, 4 * HG_TS);
            const bf16x8 b0 = tr8(Vs + ks * 16 * HG_TS + vb0 * 32 + troff, 4 * HG_TS), b1 = tr8(Vs + ks * 16 * HG_TS + vb0 * 32 + 32 + troff, 4 * HG_TS);
            acc[0] = __builtin_amdgcn_mfma_f32_32x32x16_bf16(a, b0, acc[0], 0, 0, 0); acc[1] = __builtin_amdgcn_mfma_f32_32x32x16_bf16(a, b1, acc[1], 0, 0, 0); }
        __syncthreads();
    }
    float* sp = ST + (size_t)item * 16384;
#pragma unroll
    for (int j = 0; j < 2; ++j)
#pragma unroll
        for (int r = 0; r < 16; ++r) sp[(kb * 32 + (r & 3) + 8 * (r >> 2) + 4 * hl) * 128 + (vb0 + j) * 32 + (lane & 31)] = acc[j][r];
    if (part == 0) { float s = 0.f; for (int j = 0; j < 8; ++j) s += tot[j * 128 + k]; DECK[item * 128 + k] = fast_exp(s); }
    __syncthreads();
#undef fcol
}

__device__ __forceinline__ void hg3_mfma(LAS unsigned char* lds, int item, bf16_t* PA, const float* ST, const HgParams P) {
    LAS bf16_t* Qd = (LAS bf16_t*)lds;
    LAS bf16_t* Kd = Qd + 32 * HG_RS;
    LAS bf16_t* Ke = Kd + 32 * HG_RS;
    LAS bf16_t* Vs = Ke + 32 * HG_TS;
    LAS bf16_t* At = Vs + 32 * HG_TS;
    LAS bf16_t* St = At + 32 * 40;
    LAS float* tot = (LAS float*)(St + 128 * HG_RS);
    LAS float* dk = tot + 512;
    LAS float* ssq = dk + 128;
    const int tid = tid_fresh(), k = tid & 127, part = tid >> 7, wid = __builtin_amdgcn_readfirstlane(tid >> 6), lane = tid & 63, hl = lane >> 5, lc = lane & 31;
    const int b = item >> 7, hh = (item >> 5) & 3, seg = item & 31;
    const size_t t_base = (size_t)b * SEQ + seg * 256;
    const float lb = (P.layer == 0) ? 0.f : sigmoid_f(P.gamma1[hh * 128 + k] - P.gamma0[hh * 128 + k]);
    const int kb = wid >> 1, vb0 = 2 * (wid & 1);
    const int troff = (8 * hl + ((lane & 15) >> 2)) * HG_TS + 16 * ((lane >> 4) & 1) + 4 * (lane & 3);
    f32x16 acc[2];
    { const float* sp = ST + (size_t)item * 16384;
#pragma unroll
      for (int j = 0; j < 2; ++j)
#pragma unroll
        for (int r = 0; r < 16; ++r) acc[j][r] = sp[(kb * 32 + (r & 3) + 8 * (r >> 2) + 4 * hl) * 128 + (vb0 + j) * 32 + lc]; }
    bf16_t rq[8], rf[8], ri[8];
#define HG3_LOAD(C) { const bf16_t* rp_ = PA + (t_base + (C) * 32 + 8 * part) * PA_LD + 1280 + hh * 128 + k; \
        _Pragma("unroll") for (int i = 0; i < 8; ++i) { rq[i] = rp_[(size_t)i * PA_LD]; rf[i] = rp_[(size_t)i * PA_LD + 512]; ri[i] = rp_[(size_t)i * PA_LD + 1024]; } }
    HG3_LOAD(0)
    f32x4 gnv[4];
#pragma unroll
    for (int g4 = 0; g4 < 4; ++g4) gnv[g4] = *(const f32x4*)(P.norm_g + hh * 128 + (wid & 3) * 32 + 8 * g4 + 4 * hl);
    for (int c = 0; c < 8; ++c) {
        const size_t t0 = t_base + c * 32;
        float qv[8], kv[8], cl[8]; bf16_t vv[8];
        { float run = 0.f;
#pragma unroll
          for (int i = 0; i < 8; ++i) { const float sg = sigmoid_f(bf2f(rf[i])); const float fg = lb + (1.0f - lb) * sg;
              run += 0.6931471805599453f * __builtin_amdgcn_logf(fg); cl[i] = run; kv[i] = (1.0f - lb) * (1.0f - sg); qv[i] = silu_f(bf2f(rq[i])); vv[i] = ri[i]; }
          tot[part * 128 + k] = run; }
        if (c + 1 < 8) HG3_LOAD(c + 1)
        u32x2 gwv[4];
        if (wid < 4) { const bf16_t* gp_ = PA + (t0 + lc) * PA_LD + 2816 + hh * 128 + wid * 32;
#pragma unroll
            for (int g4 = 0; g4 < 4; ++g4) gwv[g4] = *(const u32x2*)(gp_ + 8 * g4 + 4 * hl); }
        __syncthreads();
        { float off = 0.f, all = 0.f;
#pragma unroll
          for (int p = 0; p < 4; ++p) { const float tp = tot[p * 128 + k]; all += tp; if (p < part) off += tp; }
#pragma unroll
          for (int i = 0; i < 8; ++i) { const int t = 8 * part + i; const float cu = off + cl[i];
              Qd[t * HG_RS + k] = f2bf(qv[i] * fast_exp(cu)); Kd[t * HG_RS + k] = f2bf(kv[i] * fast_exp(-cu)); Ke[t * HG_TS + k] = f2bf(kv[i] * fast_exp(all - cu)); Vs[t * HG_TS + k] = vv[i]; }
          if (part == 0) dk[k] = fast_exp(all); }
#pragma unroll
        for (int j = 0; j < 2; ++j)
#pragma unroll
            for (int g4 = 0; g4 < 4; ++g4) { u32x2 w; w.x = pack_bf16(acc[j][4 * g4], acc[j][4 * g4 + 1]); w.y = pack_bf16(acc[j][4 * g4 + 2], acc[j][4 * g4 + 3]);
                *(LAS u32x2*)(St + ((vb0 + j) * 32 + lc) * HG_RS + kb * 32 + 8 * g4 + 4 * hl) = w; }
        __syncthreads();
        if (wid == 0) {
            f32x16 d;
#pragma unroll
            for (int r = 0; r < 16; ++r) d[r] = 0.f;
#pragma unroll
            for (int ks = 0; ks < 8; ++ks) { const bf16x8 a = *(const LAS bf16x8*)(Kd + lc * HG_RS + ks * 16 + 8 * hl), bq = *(const LAS bf16x8*)(Qd + lc * HG_RS + ks * 16 + 8 * hl);
                d = __builtin_amdgcn_mfma_f32_32x32x16_bf16(a, bq, d, 0, 0, 0); }
#pragma unroll
            for (int g4 = 0; g4 < 4; ++g4) { float e[4];
#pragma unroll
                for (int i = 0; i < 4; ++i) { const int s = 8 * g4 + 4 * hl + i; e[i] = (s <= lc) ? d[4 * g4 + i] : 0.f; }
                u32x2 w; w.x = pack_bf16(e[0], e[1]); w.y = pack_bf16(e[2], e[3]); *(LAS u32x2*)(At + lc * 40 + 8 * g4 + 4 * hl) = w; }
        }
        __syncthreads();
        f32x16 o;
        if (wid < 4) {
#pragma unroll
            for (int r = 0; r < 16; ++r) o[r] = 0.f;
#pragma unroll
            for (int ks = 0; ks < 2; ++ks) { const bf16x8 a = tr8(Vs + ks * 16 * HG_TS + wid * 32 + troff, 4 * HG_TS), bt = *(const LAS bf16x8*)(At + lc * 40 + ks * 16 + 8 * hl);
                o = __builtin_amdgcn_mfma_f32_32x32x16_bf16(a, bt, o, 0, 0, 0); }
#pragma unroll
            for (int ks = 0; ks < 8; ++ks) { const bf16x8 a = *(const LAS bf16x8*)(St + (wid * 32 + lc) * HG_RS + ks * 16 + 8 * hl), bq = *(const LAS bf16x8*)(Qd + lc * HG_RS + ks * 16 + 8 * hl);
                o = __builtin_amdgcn_mfma_f32_32x32x16_bf16(a, bq, o, 0, 0, 0); }
            float s2 = 0.f;
#pragma unroll
            for (int r = 0; r < 16; ++r) s2 += o[r] * o[r];
            s2 = sum32(s2); if (hl == 0) ssq[wid * 32 + lc] = s2;
        }
        { const f32x4* dp = (const f32x4*)0; (void)dp;
#pragma unroll
          for (int g4 = 0; g4 < 4; ++g4) { const f32x4 d4 = *(const LAS f32x4*)(dk + kb * 32 + 8 * g4 + 4 * hl);
#pragma unroll
              for (int i = 0; i < 4; ++i) { acc[0][4 * g4 + i] *= d4[i]; acc[1][4 * g4 + i] *= d4[i]; } }
#pragma unroll
          for (int ks = 0; ks < 2; ++ks) { const bf16x8 a = tr8(Ke + ks * 16 * HG_TS + kb * 32 + troff, 4 * HG_TS);
              const bf16x8 b0 = tr8(Vs + ks * 16 * HG_TS + vb0 * 32 + troff, 4 * HG_TS), b1 = tr8(Vs + ks * 16 * HG_TS + vb0 * 32 + 32 + troff, 4 * HG_TS);
              acc[0] = __builtin_amdgcn_mfma_f32_32x32x16_bf16(a, b0, acc[0], 0, 0, 0); acc[1] = __builtin_amdgcn_mfma_f32_32x32x16_bf16(a, b1, acc[1], 0, 0, 0); } }
        __syncthreads();
        if (wid < 4) {
            const float tq = (ssq[lc] + ssq[32 + lc]) + (ssq[64 + lc] + ssq[96 + lc]);
            const float rr = fast_rsq(tq * (1.0f / 128.0f) + NORM_EPS);
            bf16_t* gp = PA + (t0 + lc) * PA_LD + 2816 + hh * 128 + wid * 32;
#pragma unroll
            for (int g4 = 0; g4 < 4; ++g4) { const int v0 = 8 * g4 + 4 * hl; const u32x2 gw = gwv[g4]; const f32x4 gn = gnv[g4];
                const float y0 = o[4 * g4] * rr * gn[0] * sigmoid_f(bflo(gw.x)), y1 = o[4 * g4 + 1] * rr * gn[1] * sigmoid_f(bfhi(gw.x));
                const float y2 = o[4 * g4 + 2] * rr * gn[2] * sigmoid_f(bflo(gw.y)), y3 = o[4 * g4 + 3] * rr * gn[3] * sigmoid_f(bfhi(gw.y));
                u32x2 w; w.x = pack_bf16(y0, y1); w.y = pack_bf16(y2, y3); *(u32x2*)(gp + v0) = w; }
        }
    }
    __syncthreads();
#undef HG3_LOAD
}

constexpr int M2_TS = 96;
__device__ __forceinline__ void m2s1_mfma(LAS unsigned char* lds, int item, const bf16_t* PA, const float* MISCA, float* ST, float* DEC, const M2Params P) {
    LAS bf16_t* raw = (LAS bf16_t*)lds;
    LAS bf16_t* Xc = raw + 131 * 128;
    LAS bf16_t* Bw = Xc + 128 * M2_TS;
    LAS float* wsl = (LAS float*)(Bw + 128 * M2_TS);
    LAS float* wtot = wsl + 256;
    const int tid = tid_fresh(), wid = __builtin_amdgcn_readfirstlane(tid >> 6), lane = tid & 63, hl = lane >> 5;
    const int b = item >> 8, h = (item >> 5) & 7, seg = item & 31, grp = h >> 2;
    const int t_base = b * SEQ + seg * 256, tl_base = seg * 256;
    const float a_h = -fast_exp(P.a_log[h]), dtb = P.dt_bias[h];
    float dtv = 0.f, incl = 0.f;
    if (tid < 256) { dtv = softplus_f(MISCA[(size_t)(t_base + tid) * 8 + h] + dtb); incl = dtv;
#pragma unroll
        for (int o = 1; o < 64; o <<= 1) { const float t = __builtin_bit_cast(float, __builtin_amdgcn_ds_bpermute((lane - o) << 2, __builtin_bit_cast(int, incl))); if (lane >= o) incl += t; }
        if (lane == 63) wtot[wid] = incl; }
    __syncthreads();
    if (tid < 256) { float after = 0.f, all = 0.f;
#pragma unroll
        for (int w = 0; w < 4; ++w) { const float tw = wtot[w]; all += tw; if (w > wid) after += tw; }
        const float wave_tot = wtot[wid];
        wsl[tid] = dtv * fast_exp(a_h * (after + (wave_tot - incl)));
        if (tid == 0) DEC[item] = fast_exp(a_h * all); }
    f32x16 acc;
#pragma unroll
    for (int r = 0; r < 16; ++r) acc[r] = 0.f;
    const int nb_ = wid >> 1, pb_ = wid & 1;
    const int troff = (8 * hl + ((lane & 15) >> 2)) * M2_TS + 16 * ((lane >> 4) & 1) + 4 * (lane & 3);
    for (int half = 0; half < 2; ++half) {
        const int t0 = t_base + half * 128, tl0 = tl_base + half * 128;
        for (int idx = tid; idx < 131 * 16; idx += 512) { const int r = idx >> 4, piece = idx & 15, arr = piece >> 3, pc = piece & 7;
            const int col = (arr == 0 ? 512 + h * 64 : 1024 + grp * 64) + pc * 8;
            u32x4 v = {0u, 0u, 0u, 0u}; if (tl0 - 3 + r >= 0) v = *(const u32x4*)(PA + (size_t)(t0 - 3 + r) * PA_LD + col);
            *(LAS u32x4*)(raw + r * 128 + arr * 64 + pc * 8) = v; }
        __syncthreads();
        { const int g4 = tid & 31, run = tid >> 5, ch0 = 4 * g4, arr = ch0 >> 6, cc0 = ch0 & 63;
          const int cbase = (arr == 0 ? h * 64 : 512 + grp * 64) + cc0;
          f32x4 wt[5];
#pragma unroll
          for (int w = 0; w < 4; ++w) wt[w] = *(const f32x4*)(P.conv_w + w * 768 + cbase);
          wt[4] = *(const f32x4*)(P.conv_b + cbase);
          f32x4 xr[11];
#pragma unroll
          for (int r = 0; r < 11; ++r) { const u32x2 u = *(const LAS u32x2*)(raw + (8 * run + r) * 128 + ch0); xr[r] = (f32x4){bflo(u.x), bfhi(u.x), bflo(u.y), bfhi(u.y)}; }
#pragma unroll
          for (int i = 0; i < 8; ++i) { const int tl = 8 * run + i; f32x4 a = wt[4];
#pragma unroll
              for (int w = 0; w < 4; ++w) a = a + wt[w] * xr[i + w];
              const float sc = (arr == 0) ? 1.0f : wsl[half * 128 + tl];
#pragma unroll
              for (int e = 0; e < 4; ++e) a[e] = silu_f(a[e]) * sc;
              u32x2 o; o.x = pack_bf16(a[0], a[1]); o.y = pack_bf16(a[2], a[3]);
              if (arr == 0) *(LAS u32x2*)(Xc + tl * M2_TS + cc0) = o; else *(LAS u32x2*)(Bw + tl * M2_TS + cc0) = o; } }
        __syncthreads();
        if (wid < 4) {
#pragma unroll
            for (int ks = 0; ks < 8; ++ks) { const bf16x8 a = tr8(Bw + ks * 16 * M2_TS + nb_ * 32 + troff, 4 * M2_TS), bx = tr8(Xc + ks * 16 * M2_TS + pb_ * 32 + troff, 4 * M2_TS);
                acc = __builtin_amdgcn_mfma_f32_32x32x16_bf16(a, bx, acc, 0, 0, 0); } }
        __syncthreads();
    }
    if (wid < 4) { float* sp = ST + (size_t)item * 4096 + (pb_ * 32 + (lane & 31)) * 64 + nb_ * 32 + 4 * hl;
#pragma unroll
        for (int g4 = 0; g4 < 4; ++g4) { f32x4 v = {acc[4 * g4], acc[4 * g4 + 1], acc[4 * g4 + 2], acc[4 * g4 + 3]}; *(f32x4*)(sp + 8 * g4) = v; } }
}

__device__ __forceinline__ void m2s3_mfma(LAS unsigned char* lds, int item, bf16_t* PA, const float* MISCA, const float* ST, float* SSA, const M2Params P) {
    LAS bf16_t* raw = (LAS bf16_t*)lds;
    LAS bf16_t* Xc = raw + 67 * 256;
    LAS bf16_t* Bw = Xc + 64 * 96;
    LAS bf16_t* Bc = Bw + 64 * 96;
    LAS bf16_t* Cc = Bc + 64 * 72;
    LAS bf16_t* Cd = Cc + 64 * 72;
    LAS bf16_t* Sm = Cd + 64 * 72;
    LAS bf16_t* Hs = Sm + 64 * 72;
    LAS float* cwl = (LAS float*)(Hs + 64 * 72);
    LAS float* dtl = cwl + 5 * 192;
    LAS float* acl = dtl + 64;
    LAS float* ssq = acl + 64;
    const int tid = tid_fresh(), wid = __builtin_amdgcn_readfirstlane(tid >> 6), lane = tid & 63, hl = lane >> 5, lc = lane & 31;
    const int b = item >> 8, h = (item >> 5) & 7, seg = item & 31, grp = h >> 2;
    const int t_base = b * SEQ + seg * 256, tl_base = seg * 256;
    const float a_h = -fast_exp(P.a_log[h]), dtb = P.dt_bias[h], dsk = P.dskip[h];
    for (int i = tid; i < 5 * 192; i += 512) { const int w = i / 192, c = i % 192; const int cc = (c < 64) ? h * 64 + c : (c < 128) ? 512 + grp * 64 + (c - 64) : 640 + grp * 64 + (c - 128);
        cwl[i] = (w < 4) ? P.conv_w[w * 768 + cc] : P.conv_b[cc]; }
    const int w4 = wid & 3, nb_ = w4 >> 1, pb_ = w4 & 1;
    const int troff = (8 * hl + ((lane & 15) >> 2)) * 96 + 16 * ((lane >> 4) & 1) + 4 * (lane & 3);
    f32x16 hacc;
#pragma unroll
    for (int r = 0; r < 16; ++r) hacc[r] = 0.f;
    if (wid >= 4) { const float* sp = ST + (size_t)item * 4096 + (pb_ * 32 + lc) * 64 + nb_ * 32 + 4 * hl;
#pragma unroll
        for (int g4 = 0; g4 < 4; ++g4) { const f32x4 v = *(const f32x4*)(sp + 8 * g4); hacc[4 * g4] = v[0]; hacc[4 * g4 + 1] = v[1]; hacc[4 * g4 + 2] = v[2]; hacc[4 * g4 + 3] = v[3]; } }
    u32x4 rv[5]; float dtraw;
#define M2S3_LOAD(C) { const int t0_ = t_base + (C) * 64, tl0_ = tl_base + (C) * 64; \
        _Pragma("unroll") for (int q = 0; q < 5; ++q) { const int idx = tid + 512 * q; rv[q] = (u32x4){0u, 0u, 0u, 0u}; \
            if (idx < 67 * 32) { const int r = idx >> 5, piece = idx & 31, arr = piece >> 3, pc = piece & 7; \
                const int col = (arr == 0 ? 512 + h * 64 : arr == 1 ? 1024 + grp * 64 : arr == 2 ? 1152 + grp * 64 : h * 64) + pc * 8; \
                if (tl0_ - 3 + r >= 0) rv[q] = *(const u32x4*)(PA + (size_t)(t0_ - 3 + r) * PA_LD + col); } } \
        dtraw = (wid == 0) ? MISCA[(size_t)(t0_ + lane) * 8 + h] : 0.f; }
    M2S3_LOAD(0)
    for (int c = 0; c < 4; ++c) {
        const int t0 = t_base + c * 64;
#pragma unroll
        for (int q = 0; q < 5; ++q) { const int idx = tid + 512 * q; if (idx < 67 * 32) { const int r = idx >> 5, piece = idx & 31; *(LAS u32x4*)(raw + r * 256 + (piece >> 3) * 64 + (piece & 7) * 8) = rv[q]; } }
        const float dtraw_c = dtraw;
        if (c + 1 < 4) M2S3_LOAD(c + 1)
        if (wid == 0) { const float dtv = softplus_f(dtraw_c + dtb); float incl = dtv * a_h;
#pragma unroll
            for (int o = 1; o < 64; o <<= 1) { const float t = __builtin_bit_cast(float, __builtin_amdgcn_ds_bpermute((lane - o) << 2, __builtin_bit_cast(int, incl))); if (lane >= o) incl += t; }
            dtl[lane] = dtv; acl[lane] = incl; }
        __syncthreads();
        { const float ac63 = acl[63];
          if (tid < 384) {
            const int g4 = tid % 48, run = tid / 48, ch0 = 4 * g4, arr = ch0 >> 6, cc0 = ch0 & 63;
            f32x4 wt[5];
#pragma unroll
            for (int w = 0; w < 5; ++w) wt[w] = *(const LAS f32x4*)(cwl + w * 192 + ch0);
            f32x4 xr[11];
#pragma unroll
            for (int r = 0; r < 11; ++r) { const u32x2 u = *(const LAS u32x2*)(raw + (8 * run + r) * 256 + ch0); xr[r] = (f32x4){bflo(u.x), bfhi(u.x), bflo(u.y), bfhi(u.y)}; }
            const f32x4 ac0 = *(const LAS f32x4*)(acl + 8 * run), ac1 = *(const LAS f32x4*)(acl + 8 * run + 4), dt0 = *(const LAS f32x4*)(dtl + 8 * run), dt1 = *(const LAS f32x4*)(dtl + 8 * run + 4);
#pragma unroll
            for (int i = 0; i < 8; ++i) { const int s = 8 * run + i; f32x4 a = wt[4];
#pragma unroll
                for (int w = 0; w < 4; ++w) a = a + wt[w] * xr[i + w];
#pragma unroll
                for (int e = 0; e < 4; ++e) a[e] = silu_f(a[e]);
                u32x2 o; o.x = pack_bf16(a[0], a[1]); o.y = pack_bf16(a[2], a[3]);
                if (arr == 0) *(LAS u32x2*)(Xc + s * 96 + cc0) = o;
                else { const float acs = i < 4 ? ac0[i & 3] : ac1[i & 3], dts = i < 4 ? dt0[i & 3] : dt1[i & 3];
                    const float sc = (arr == 1) ? dts * fast_exp(ac63 - acs) : fast_exp(acs);
                    u32x2 o2; o2.x = pack_bf16(a[0] * sc, a[1] * sc); o2.y = pack_bf16(a[2] * sc, a[3] * sc);
                    if (arr == 1) { *(LAS u32x2*)(Bc + s * 72 + cc0) = o; *(LAS u32x2*)(Bw + s * 96 + cc0) = o2; }
                    else { *(LAS u32x2*)(Cc + s * 72 + cc0) = o; *(LAS u32x2*)(Cd + s * 72 + cc0) = o2; } } } }
          if (wid >= 4) {
#pragma unroll
            for (int g4 = 0; g4 < 4; ++g4) { u32x2 w; w.x = pack_bf16(hacc[4 * g4], hacc[4 * g4 + 1]); w.y = pack_bf16(hacc[4 * g4 + 2], hacc[4 * g4 + 3]);
                *(LAS u32x2*)(Hs + (pb_ * 32 + lc) * 72 + nb_ * 32 + 8 * g4 + 4 * hl) = w; }
            const float dch = fast_exp(ac63);
#pragma unroll
            for (int r = 0; r < 16; ++r) hacc[r] *= dch; } }
        __syncthreads();
        if (wid < 3) {
            const int sb = wid >> 1, tb = (wid + 1) >> 1; f32x16 d;
#pragma unroll
            for (int r = 0; r < 16; ++r) d[r] = 0.f;
#pragma unroll
            for (int ks = 0; ks < 4; ++ks) { const bf16x8 a = *(const LAS bf16x8*)(Bc + (sb * 32 + lc) * 72 + ks * 16 + 8 * hl), bq = *(const LAS bf16x8*)(Cc + (tb * 32 + lc) * 72 + ks * 16 + 8 * hl);
                d = __builtin_amdgcn_mfma_f32_32x32x16_bf16(a, bq, d, 0, 0, 0); }
            const int t = tb * 32 + lc; const float act = acl[t];
#pragma unroll
            for (int g4 = 0; g4 < 4; ++g4) { float e[4];
#pragma unroll
                for (int i = 0; i < 4; ++i) { const int s = sb * 32 + 8 * g4 + 4 * hl + i; e[i] = (s <= t) ? d[4 * g4 + i] * dtl[s] * fast_exp(act - acl[s]) : 0.f; }
                u32x2 w; w.x = pack_bf16(e[0], e[1]); w.y = pack_bf16(e[2], e[3]); *(LAS u32x2*)(Sm + t * 72 + sb * 32 + 8 * g4 + 4 * hl) = w; }
        } else if (wid == 3) {
            const u32x2 z2 = {0u, 0u};
#pragma unroll
            for (int g4 = 0; g4 < 4; ++g4) *(LAS u32x2*)(Sm + lc * 72 + 32 + 8 * g4 + 4 * hl) = z2;
        } else {
#pragma unroll
            for (int ks = 0; ks < 4; ++ks) { const bf16x8 a = tr8(Bw + ks * 16 * 96 + nb_ * 32 + troff, 4 * 96), bx = tr8(Xc + ks * 16 * 96 + pb_ * 32 + troff, 4 * 96);
                hacc = __builtin_amdgcn_mfma_f32_32x32x16_bf16(a, bx, hacc, 0, 0, 0); }
        }
        __syncthreads();
        if (wid < 4) {
            const int pb = wid >> 1, tb = wid & 1, t = tb * 32 + lc; f32x16 y;
#pragma unroll
            for (int r = 0; r < 16; ++r) y[r] = 0.f;
#pragma unroll
            for (int ks = 0; ks < 4; ++ks) { const bf16x8 a = tr8(Xc + ks * 16 * 96 + pb * 32 + troff, 4 * 96), bs = *(const LAS bf16x8*)(Sm + t * 72 + ks * 16 + 8 * hl);
                y = __builtin_amdgcn_mfma_f32_32x32x16_bf16(a, bs, y, 0, 0, 0); }
#pragma unroll
            for (int ks = 0; ks < 4; ++ks) { const bf16x8 a = *(const LAS bf16x8*)(Hs + (pb * 32 + lc) * 72 + ks * 16 + 8 * hl), bc = *(const LAS bf16x8*)(Cd + t * 72 + ks * 16 + 8 * hl);
                y = __builtin_amdgcn_mfma_f32_32x32x16_bf16(a, bc, y, 0, 0, 0); }
            float s2 = 0.f; bf16_t* yp = PA + (size_t)(t0 + t) * PA_LD + h * 64 + pb * 32;
#pragma unroll
            for (int g4 = 0; g4 < 4; ++g4) { const int p0 = 8 * g4 + 4 * hl; float o[4];
#pragma unroll
                for (int i = 0; i < 4; ++i) { const int p = pb * 32 + p0 + i; o[i] = (y[4 * g4 + i] + dsk * bf2f(Xc[t * 96 + p])) * silu_f(bf2f(raw[(t + 3) * 256 + 192 + p])); s2 += o[i] * o[i]; }
                u32x2 w; w.x = pack_bf16(o[0], o[1]); w.y = pack_bf16(o[2], o[3]); *(u32x2*)(yp + p0) = w; }
            s2 = sum32(s2); if (hl == 0) ssq[pb * 64 + t] = s2;
        }
        __syncthreads();
        if (tid < 64) SSA[(size_t)(t0 + tid) * 8 + h] = ssq[tid] + ssq[64 + tid];
    }
    __syncthreads();
}
__device__ __forceinline__ void dsa_prep(bf16_t* PB, const int* positions, const float* qn, const float* kn, int bid, int nb) {
    const int tid_ = tid_fresh(), wid = tid_ >> 6, lane = tid_ & 63, j = lane & 31, half = lane >> 5;
    const float inv_freq = fast_exp2(-(float)j * (13.287712379549449f / 32.0f));
    for (int tok = bid * 8 + wid; tok < T_TOK; tok += nb * 8) {
        const float ang = (float)positions[tok] * inv_freq; float sn, cs; sincos_rev(ang, sn, cs);
#pragma unroll
        for (int i = 0; i < 8; ++i) { const int vec = 2 * i + half; const bool isq = vec < 8;
            bf16_t* p = PB + (size_t)tok * PB_LD + (isq ? vec * 64 : 512 + (vec - 8) * 64);
            const float x1 = bf2f(p[j]), x2 = bf2f(p[j + 32]); float ss = x1 * x1 + x2 * x2;
            ss = sum_lo32(ss);
            const float r = fast_rsq(ss * (1.0f / 64.0f) + NORM_EPS); const float* gn = isq ? qn : kn;
            const float y1 = x1 * r * gn[j], y2 = x2 * r * gn[j + 32];
            float o1 = y1 * cs - y2 * sn, o2 = y2 * cs + y1 * sn;
            if (isq) { o1 *= 0.125f * 1.4426950408889634f; o2 *= 0.125f * 1.4426950408889634f; }
            p[j] = f2bf(o1); p[j + 32] = f2bf(o2); }
    }
}

constexpr int HS = 1028;
#ifndef TK_PROBE
#define TK_PROBE 0
#endif
#ifndef TK_FORCE_FAST
#define TK_FORCE_FAST 0
#endif
constexpr int TK_CAP = 960;
constexpr int TK_LIST = 0, TK_MASKL = 32 * TK_CAP * 4, TK_ARR = TK_MASKL + 32 * 256 * 4;
__device__ __forceinline__ float relu_i(float x) { const int i = __builtin_bit_cast(int, x); return __builtin_bit_cast(float, i > 0 ? i : 0); }
__device__ __forceinline__ unsigned sk20_of(float s) { const int u = __builtin_bit_cast(int, s + 0.0f); return ((unsigned)u ^ ((unsigned)(u >> 31) | 0x80000000u)) >> 12; }
__device__ __forceinline__ unsigned fine_bin(float s) { const unsigned u = __float_as_uint(s + 0.0f); const int v = (int)((u >> 19) & 0xfffu) - (96 << 4);
    const int t = (v < -1 ? -1 : (v > 1022 ? 1022 : v)) + 1; return (u >> 31) ? (unsigned)(1023 - t) : (unsigned)(1024 + t); }
__device__ __forceinline__ void idx_load(const bf16_t* KIBb, int key0, int lane, bf16x8 (&kf)[4]) {
    const bf16_t* kp = KIBb + (size_t)(key0 + (lane & 31)) * 64 + 8 * (lane >> 5);
#pragma unroll
    for (int ks = 0; ks < 4; ++ks) kf[ks] = *(const bf16x8*)(kp + ks * 16);
}
__device__ __forceinline__ void idx_scores(const bf16x8 (&kf)[4], const bf16x8 (&qf)[4][4], const float (&wsc)[4], float (&sc)[16]) {
    f32x16 d[4];
#pragma unroll
    for (int hd = 0; hd < 4; ++hd)
#pragma unroll
        for (int r = 0; r < 16; ++r) d[hd][r] = 0.f;
    __builtin_amdgcn_s_setprio(1);
#pragma unroll
    for (int ks = 0; ks < 4; ++ks)
#pragma unroll
        for (int hd = 0; hd < 4; ++hd) d[hd] = __builtin_amdgcn_mfma_f32_32x32x16_bf16(kf[ks], qf[hd][ks], d[hd], 0, 0, 0);
    __builtin_amdgcn_s_setprio(0);
#pragma unroll
    for (int r = 0; r < 16; ++r) { float s = wsc[0] * relu_i(d[0][r]); s += wsc[1] * relu_i(d[1][r]); s += wsc[2] * relu_i(d[2][r]); s += wsc[3] * relu_i(d[3][r]); sc[r] = s; }
}
__device__ __forceinline__ void tk_boundary(const LAS unsigned* hrow, unsigned need, int lane, unsigned& bb, unsigned& above, unsigned& inbin) {
    unsigned wv[16]; unsigned s = 0;
#pragma unroll
    for (int i = 0; i < 4; ++i) { const u32x4 q = *(const LAS u32x4*)(hrow + 1008 - 16 * lane + 4 * i); wv[4 * i] = q.x; wv[4 * i + 1] = q.y; wv[4 * i + 2] = q.z; wv[4 * i + 3] = q.w; }
#pragma unroll
    for (int i = 0; i < 16; ++i) s += (wv[i] & 0xffffu) + (wv[i] >> 16);
    unsigned pre = s;
#pragma unroll
    for (int o = 1; o < 64; o <<= 1) { const unsigned t = (unsigned)__builtin_amdgcn_ds_bpermute((lane - o) << 2, (int)pre); if (lane >= o) pre += t; }
    const unsigned long long bal = __ballot(pre >= need);
    const int lstar = bal ? (int)__builtin_ctzll(bal) : 63;
    unsigned cum = pre - s, rb = 0, ra = cum, rc = 0; bool found = false;
#pragma unroll
    for (int i = 31; i >= 0; --i) { const unsigned w = wv[i >> 1], c = (i & 1) ? (w >> 16) : (w & 0xffffu);
        const bool hit = !found && (cum + c >= need); if (hit) { rb = (unsigned)(2016 - 32 * lane + i); ra = cum; rc = c; } found = found || hit; cum += c; }
    bb = (unsigned)__builtin_amdgcn_readlane((int)rb, lstar); above = (unsigned)__builtin_amdgcn_readlane((int)ra, lstar); inbin = (unsigned)__builtin_amdgcn_readlane((int)rc, lstar);
}
__device__ __forceinline__ float fine_edge(unsigned B) {
    if (B >= 2048u) return __builtin_inff();
    if (B >= 1025u) return __uint_as_float((B - 1025u + (96u << 4)) << 19);
    if (B == 1024u) return 0.0f;
    return -__uint_as_float(((1023u - B + (96u << 4)) << 19) - 1u);
}
__device__ __forceinline__ unsigned skey_of(float s) { const int u = __builtin_bit_cast(int, s + 0.0f); return (unsigned)u ^ ((unsigned)(u >> 31) | 0x80000000u); }

template <int NR> __device__ __forceinline__ void tk_select(const LAS unsigned* lq, LAS unsigned* mq, unsigned n, unsigned need, int lane) {
    unsigned cv[NR]; bool vd[NR];
#pragma unroll
    for (int i = 0; i < NR; ++i) { const unsigned p = (unsigned)(i * 64 + lane); vd[i] = p < n; cv[i] = vd[i] ? lq[p] : 0u; }
    unsigned T = 0u;
#pragma unroll 1
    for (int bit = 31; bit >= 0; --bit) { const unsigned cand = T | (1u << bit); unsigned c = 0;
#pragma unroll
        for (int i = 0; i < NR; ++i) c += (unsigned)__builtin_popcountll(__ballot(vd[i] && cv[i] >= cand));
        if (c >= need) T = cand; }
#pragma unroll
    for (int i = 0; i < NR; ++i) if (vd[i] && cv[i] >= T) { const unsigned key = 8191u - (cv[i] & 8191u);
        __hip_atomic_fetch_or(mq + (key >> 5), 1u << (key & 31u), __ATOMIC_RELAXED, __HIP_MEMORY_SCOPE_WORKGROUP); }
}
__device__ __forceinline__ void dsa_topk_tile(LAS unsigned char* lds, int b, int qt, const bf16_t* PB, const bf16_t* KIB, const float* WI, unsigned* MASK, int abl) {
    LAS unsigned* hist = (LAS unsigned*)lds;
    LAS unsigned* list = (LAS unsigned*)(lds + TK_LIST);
    LAS unsigned* maskl = (LAS unsigned*)(lds + TK_MASKL);
    LAS unsigned* B1 = (LAS unsigned*)(lds + TK_ARR);
    LAS unsigned* NEED = B1 + 32;
    LAS unsigned* CNT = NEED + 32;
    LAS unsigned* FLAG = CNT + 32;
    const int tid = tid_fresh(), wid = __builtin_amdgcn_readfirstlane(tid >> 6), lane = tid & 63, qc = lane & 31, hl = lane >> 5;
    const int ql = qt * 32 + qc; const size_t row = (size_t)b * SEQ + ql;
    const bf16_t* KIBb = KIB + (size_t)b * SEQ * 64;
    const int nkt = qt + 1;
    if (qt < 8) {
        for (int kt = wid; kt < nkt; kt += 8) { unsigned word = 0u;
#pragma unroll
            for (int r = 0; r < 16; ++r) { const int rho = (r & 3) + 8 * (r >> 2) + 4 * hl; word |= ((kt * 32 + rho <= ql) ? 1u : 0u) << rho; }
            word = or32(word); if (hl == 0) MASK[row * 256 + kt] = word; }
        return;
    }
    bf16x8 qf[4][4]; float wsc[4];
    { const f32x4 wv = *(const f32x4*)(WI + row * 4);
#pragma unroll
      for (int hd = 0; hd < 4; ++hd) { wsc[hd] = wv[hd] * 0.0625f;
#pragma unroll
        for (int ks = 0; ks < 4; ++ks) qf[hd][ks] = *(const bf16x8*)(PB + row * PB_LD + 1536 + hd * 64 + ks * 16 + 8 * hl); } }
    for (int i = tid; i < 32 * HS; i += 512) hist[i] = 0u;
    if (tid == 0) FLAG[0] = 0u;
    __syncthreads();
    const int nsA = nkt < 40 ? nkt : 32;
    unsigned floorb = 0u;
#pragma unroll 1
    for (int stage = 0; stage < 2; ++stage) {
        const int k_lo = stage == 0 ? 0 : nsA, k_hi = stage == 0 ? nsA : nkt;
        if (k_lo < k_hi) {
            bf16x8 kf[4], kn[4]; const int k0 = k_lo + wid; idx_load(KIBb, (k0 < k_hi ? k0 : k_lo) * 32, lane, kf);
#pragma unroll 1
            for (int kt = k0; kt < k_hi; kt += 8) {
                const int ktn = kt + 8 < k_hi ? kt + 8 : kt; idx_load(KIBb, ktn * 32, lane, kn);
                float sc[16]; idx_scores(kf, qf, wsc, sc);
                if (kt == qt) {
#pragma unroll
                    for (int r = 0; r < 16; ++r) if ((r & 3) + 8 * (r >> 2) + 4 * hl > qc) sc[r] = -__builtin_inff(); }
#pragma unroll
                for (int r = 0; r < 16; ++r) { const unsigned bin = fine_bin(sc[r]);
                    if (bin >= floorb) __hip_atomic_fetch_add(hist + qc * HS + (bin >> 1), 1u << (16 * (bin & 1u)), __ATOMIC_RELAXED, __HIP_MEMORY_SCOPE_WORKGROUP); }
#pragma unroll
                for (int ks = 0; ks < 4; ++ks) kf[ks] = kn[ks]; } }
        __syncthreads();
        if (stage == 0 && nsA < nkt) {
#pragma unroll 1
            for (int qq = 0; qq < 4; ++qq) { const int q = wid * 4 + qq; unsigned bb, above, inbin; tk_boundary(hist + q * HS, 256u, lane, bb, above, inbin); if (lane == 0) B1[q] = bb; }
            __syncthreads();
            floorb = B1[qc];
        }
    }
    if (abl & 1) return;
#pragma unroll 1
    for (int qq = 0; qq < 4; ++qq) { const int q = wid * 4 + qq; unsigned bb, above, inbin; tk_boundary(hist + q * HS, 256u, lane, bb, above, inbin);
        if (lane == 0) { B1[q] = bb; NEED[q] = 256u - above; CNT[q] = 0u; if (inbin > (unsigned)TK_CAP || bb == 0u) FLAG[0] = 1u; } }
    __syncthreads();
    const bool overflow = FLAG[0] != 0u;
    const unsigned b1 = B1[qc];
    __syncthreads();
    if (!overflow) {
        const float th_lo = fine_edge(b1), th_hi = fine_edge(b1 + 1u);
        { bf16x8 kf[4], kn[4]; idx_load(KIBb, wid * 32, lane, kf);
#pragma unroll 1
          for (int kt = wid; kt < nkt; kt += 8) {
            const int ktn = kt + 8 < nkt ? kt + 8 : kt; idx_load(KIBb, ktn * 32, lane, kn);
            float sc[16]; idx_scores(kf, qf, wsc, sc);
            if (kt == qt) {
#pragma unroll
                for (int r = 0; r < 16; ++r) if ((r & 3) + 8 * (r >> 2) + 4 * hl > qc) sc[r] = -__builtin_inff(); }
            unsigned word = 0u, cm = 0u;
#pragma unroll
            for (int r = 0; r < 16; ++r) { const float s = sc[r] + 0.0f; const unsigned hi = s >= th_hi ? 1u : 0u, lo = s >= th_lo ? 1u : 0u;
                word |= hi << ((r & 3) + 8 * (r >> 2)); cm |= (lo & ~hi) << r; }
            word <<= 4 * hl;
            if (cm && !(abl & 16)) { unsigned pos = __hip_atomic_fetch_add(CNT + qc, (unsigned)__builtin_popcount(cm), __ATOMIC_RELAXED, __HIP_MEMORY_SCOPE_WORKGROUP);
#pragma unroll
                for (int r = 0; r < 16; ++r) if ((cm >> r) & 1u) { const int key = kt * 32 + (r & 3) + 8 * (r >> 2) + 4 * hl;
                    if (pos < (unsigned)TK_CAP) list[qc * TK_CAP + pos] = ((skey_of(sc[r]) & 0x7ffffu) << 13) | (8191u - (unsigned)key); ++pos; } }
            word = or32(word); if (hl == 0) maskl[qc * 256 + kt] = word;
#pragma unroll
            for (int ks = 0; ks < 4; ++ks) kf[ks] = kn[ks]; } }
        __syncthreads();
#pragma unroll 1
        for (int qq = 0; qq < ((abl & 32) ? 0 : 4); ++qq) { const int q = wid * 4 + qq;
            const unsigned n = (unsigned)__builtin_amdgcn_readfirstlane((int)CNT[q]), need = (unsigned)__builtin_amdgcn_readfirstlane((int)NEED[q]);
            if (n <= 64u) tk_select<1>(list + q * TK_CAP, maskl + q * 256, n, need, lane);
            else if (n <= 128u) tk_select<2>(list + q * TK_CAP, maskl + q * 256, n, need, lane);
            else if (n <= 256u) tk_select<4>(list + q * TK_CAP, maskl + q * 256, n, need, lane);
            else tk_select<15>(list + q * TK_CAP, maskl + q * 256, n, need, lane); }
        __syncthreads();
        if (!(abl & 64)) for (int i = tid; i < 32 * 256; i += 512) { const int q = i >> 8, kt = i & 255; if (kt < nkt) MASK[((size_t)b * SEQ + qt * 32 + q) * 256 + kt] = maskl[i]; }
        __syncthreads();
        return;
    }
    LAS unsigned* BND = B1 + 128;
    unsigned c1 = 0, c2 = 0;
#pragma unroll 1
    for (int level = 0; level < 3; ++level) {
        for (int i = tid; i < 32 * HS; i += 512) hist[i] = 0u;
        if (level == 0 && tid < 32) NEED[tid] = 256u;
        __syncthreads();
        if (level >= 1) c1 = BND[qc]; if (level >= 2) c2 = BND[32 + qc];
#pragma unroll 1
        for (int kt = wid; kt < nkt; kt += 8) { bf16x8 kf[4]; idx_load(KIBb, kt * 32, lane, kf); float sc[16]; idx_scores(kf, qf, wsc, sc);
#pragma unroll
            for (int r = 0; r < 16; ++r) { const int key = kt * 32 + (r & 3) + 8 * (r >> 2) + 4 * hl; const unsigned sk = sk20_of(sc[r]), inv = 8191u - (unsigned)key;
                const unsigned L1 = sk >> 9, L2 = ((sk & 511u) << 2) | (inv >> 11), L3 = inv & 2047u;
                bool ok = key <= ql; unsigned bin = L1;
                if (level == 1) { ok = ok && (L1 == c1); bin = L2; } else if (level == 2) { ok = ok && (L1 == c1) && (L2 == c2); bin = L3; }
                if (ok) __hip_atomic_fetch_add(hist + qc * HS + (bin >> 1), 1u << (16 * (bin & 1u)), __ATOMIC_RELAXED, __HIP_MEMORY_SCOPE_WORKGROUP); } }
        __syncthreads();
#pragma unroll 1
        for (int qq = 0; qq < 4; ++qq) { const int q = wid * 4 + qq; unsigned bb, above, inbin; const unsigned need = NEED[q]; tk_boundary(hist + q * HS, need, lane, bb, above, inbin);
            if (lane == 0) { BND[level * 32 + q] = bb; NEED[q] = need - above; } }
        __syncthreads();
    }
    { const unsigned d1 = BND[qc], d2 = BND[32 + qc], d3 = BND[64 + qc]; const unsigned thi = (d1 << 9) | (d2 >> 2), tlo = ((d2 & 3u) << 11) | d3;
#pragma unroll 1
      for (int kt = wid; kt < nkt; kt += 8) { bf16x8 kf[4]; idx_load(KIBb, kt * 32, lane, kf); float sc[16]; idx_scores(kf, qf, wsc, sc); unsigned word = 0u;
#pragma unroll
        for (int r = 0; r < 16; ++r) { const int rho = (r & 3) + 8 * (r >> 2) + 4 * hl, key = kt * 32 + rho; const unsigned sk = sk20_of(sc[r]), inv = 8191u - (unsigned)key;
            const bool sel = (key <= ql) && (sk > thi || (sk == thi && inv >= tlo)); word |= (sel ? 1u : 0u) << rho; }
        word = or32(word); if (hl == 0) MASK[row * 256 + kt] = word; } }
    __syncthreads();
}

typedef short v4i16_t __attribute__((ext_vector_type(4)));
__device__ __forceinline__ bf16x8 vtr2(const LAS bf16_t* p, int second_off) {
    const v4i16_t lo = __builtin_amdgcn_ds_read_tr16_b64_v4i16((LAS v4i16_t*)p), hi = __builtin_amdgcn_ds_read_tr16_b64_v4i16((LAS v4i16_t*)(p + second_off));
    return __builtin_shufflevector(lo, hi, 0, 1, 2, 3, 4, 5, 6, 7);
}
constexpr int ATT_KS = 72, ATT_VS = 96, ATT_BUF = (64 * ATT_KS + 64 * ATT_VS) * 2;
__device__ __forceinline__ void dsa_attn_item(LAS unsigned char* lds, int b, int hd, int qb, const bf16_t* PB, const unsigned* MASK, bf16_t* YC, const float* qn, const float* kn) {
    const int tid = tid_fresh(), wid = __builtin_amdgcn_readfirstlane(tid >> 6), lane = tid & 63, qc = lane & 31, hl = lane >> 5;
    const int q0 = qb * 256 + wid * 32, ql = q0 + qc; const size_t row = (size_t)b * SEQ + ql;
    const int my_sb_max = q0 >> 5;
    float negC;
    { float gq = fabsf(qn[lane]), gk = fabsf(kn[lane]);
      gq = fmaxf(gq, swz_xor<16>(gq)); gq = fmaxf(gq, swz_xor<8>(gq)); gq = fmaxf(gq, swz_xor<4>(gq)); gq = fmaxf(gq, swz_xor<2>(gq)); gq = fmaxf(gq, swz_xor<1>(gq)); gq = max32(gq);
      gk = fmaxf(gk, swz_xor<16>(gk)); gk = fmaxf(gk, swz_xor<8>(gk)); gk = fmaxf(gk, swz_xor<4>(gk)); gk = fmaxf(gk, swz_xor<2>(gk)); gk = fmaxf(gk, swz_xor<1>(gk)); gk = max32(gk);
      negC = -(8.0f * 1.4426950408889634f * 1.001f) * gq * gk; }
    bf16x8 qf[4];
#pragma unroll
    for (int ks = 0; ks < 4; ++ks) qf[ks] = *(const bf16x8*)(PB + row * PB_LD + hd * 64 + ks * 16 + 8 * hl);
    f32x16 o0, o1;
#pragma unroll
    for (int r = 0; r < 16; ++r) { o0[r] = 0.f; o1[r] = 0.f; }
    float l = 0.f;
    const int nkt = 4 * (qb + 1);
    const int skey = tid >> 3, sd = (tid & 7) * 8;
    const int vtr_off = (4 * hl + ((lane & 15) >> 2)) * ATT_VS + 16 * ((lane >> 4) & 1) + 4 * (lane & 3);
    const bf16_t* kbase = PB + ((size_t)b * SEQ + skey) * PB_LD + 512 + hd * 64 + sd;
    u32x4 kw = *(const u32x4*)kbase, vw = *(const u32x4*)(kbase + 512);
    __syncthreads();
    const unsigned* mrow = MASK + row * 256;
    u32x4 mq0 = *(const u32x4*)mrow, mq1 = *(const u32x4*)(mrow + 4);
#define ATT_TILE(J, MW0, MW1) { const int kt = kt0 + (J); \
        LAS bf16_t* Ks = (LAS bf16_t*)(lds + ((J) & 1) * ATT_BUF); LAS bf16_t* Vs = Ks + 64 * ATT_KS; \
        *(LAS u32x4*)(Ks + skey * ATT_KS + sd) = kw; *(LAS u32x4*)(Vs + skey * ATT_VS + sd) = vw; \
        if (kt + 1 < nkt) { const bf16_t* kp = kbase + (size_t)(kt + 1) * 64 * PB_LD; kw = *(const u32x4*)kp; vw = *(const u32x4*)(kp + 512); } \
        asm volatile("s_waitcnt lgkmcnt(0)" ::: "memory"); __builtin_amdgcn_s_barrier(); asm volatile("" ::: "memory");     \
        if (2 * kt <= my_sb_max) { \
            f32x16 s[2]; int mwh[2]; \
            mwh[0] = (int)((MW0) >> (4 * hl)); mwh[1] = (int)(((2 * kt + 1 <= my_sb_max) ? (MW1) : 0u) >> (4 * hl)); \
            _Pragma("unroll") for (int sbi = 0; sbi < 2; ++sbi) _Pragma("unroll") for (int r = 0; r < 16; ++r) s[sbi][r] = negC; \
            __builtin_amdgcn_s_setprio(1); _Pragma("unroll") for (int ks = 0; ks < 4; ++ks) _Pragma("unroll") for (int sbi = 0; sbi < 2; ++sbi) { const bf16x8 kf = *(const LAS bf16x8*)(Ks + (sbi * 32 + qc) * ATT_KS + ks * 16 + 8 * hl); \
                    s[sbi] = __builtin_amdgcn_mfma_f32_32x32x16_bf16(kf, qf[ks], s[sbi], 0, 0, 0); } __builtin_amdgcn_s_setprio(0); \
            float ps = 0.f; bf16x8 pf[2][2]; \
            _Pragma("unroll") for (int sbi = 0; sbi < 2; ++sbi) { float pv[16]; \
                _Pragma("unroll") for (int r = 0; r < 16; ++r) { const int sel = __builtin_amdgcn_sbfe(mwh[sbi], (r & 3) + 8 * (r >> 2), 1); \
                    const float p = __builtin_bit_cast(float, __builtin_bit_cast(int, fast_exp2(s[sbi][r])) & sel); pv[r] = p; ps += p; } \
                _Pragma("unroll") for (int s2 = 0; s2 < 2; ++s2) { u32x4 w; w.x = pack_bf16(pv[8 * s2 + 0], pv[8 * s2 + 1]); w.y = pack_bf16(pv[8 * s2 + 2], pv[8 * s2 + 3]); \
                    w.z = pack_bf16(pv[8 * s2 + 4], pv[8 * s2 + 5]); w.w = pack_bf16(pv[8 * s2 + 6], pv[8 * s2 + 7]); pf[sbi][s2] = __builtin_bit_cast(bf16x8, w); } } \
            l += ps; __builtin_amdgcn_s_setprio(1); \
            _Pragma("unroll") for (int sbi = 0; sbi < 2; ++sbi) _Pragma("unroll") for (int s2 = 0; s2 < 2; ++s2) { const LAS bf16_t* vp = Vs + (sbi * 32 + s2 * 16) * ATT_VS + vtr_off; \
                    const bf16x8 v0 = vtr2(vp, 8 * ATT_VS), v1 = vtr2(vp + 32, 8 * ATT_VS); \
                    o0 = __builtin_amdgcn_mfma_f32_32x32x16_bf16(v0, pf[sbi][s2], o0, 0, 0, 0); \
                    o1 = __builtin_amdgcn_mfma_f32_32x32x16_bf16(v1, pf[sbi][s2], o1, 0, 0, 0); } __builtin_amdgcn_s_setprio(0); \
        } }
    for (int kt0 = 0; kt0 < nkt; kt0 += 4) {
        u32x4 nq0 = mq0, nq1 = mq1;
        if (kt0 + 4 < nkt) { nq0 = *(const u32x4*)(mrow + 2 * kt0 + 8); nq1 = *(const u32x4*)(mrow + 2 * kt0 + 12); }
        ATT_TILE(0, mq0.x, mq0.y) ATT_TILE(1, mq0.z, mq0.w) ATT_TILE(2, mq1.x, mq1.y) ATT_TILE(3, mq1.z, mq1.w)
        mq0 = nq0; mq1 = nq1;
    }
#undef ATT_TILE
    l = sum32(l);
    const float inv = fast_rcp(l);
    bf16_t* op = YC + row * 512 + hd * 64;
#pragma unroll
    for (int r4 = 0; r4 < 4; ++r4) { const int d = 8 * r4 + 4 * hl;
        u32x2 w0, w1; w0.x = pack_bf16(o0[4 * r4] * inv, o0[4 * r4 + 1] * inv); w0.y = pack_bf16(o0[4 * r4 + 2] * inv, o0[4 * r4 + 3] * inv);
        w1.x = pack_bf16(o1[4 * r4] * inv, o1[4 * r4 + 1] * inv); w1.y = pack_bf16(o1[4 * r4 + 2] * inv, o1[4 * r4 + 3] * inv);
        *(u32x2*)(op + d) = w0; *(u32x2*)(op + 32 + d) = w1; }
    __syncthreads();
}
#define XB_TMO      128
#define XB_XCNT(j)  (256  + 64 * (j))
#define XB_XSUB(j)  (1280 + 64 * (j))
#define XB_XGEN(j)  (2304 + 64 * (j))
#define XB_TOP      3328
#define XB_TOPGEN   3392
#define XCD_BAR_WORDS 3456
#define XB_SPIN_CAP (1u << 22)
__device__ __forceinline__ unsigned xb_ld(unsigned* p)              { return __hip_atomic_load(p, __ATOMIC_RELAXED, __HIP_MEMORY_SCOPE_AGENT); }
__device__ __forceinline__ unsigned xb_add(unsigned* p, unsigned v) { return __hip_atomic_fetch_add(p, v, __ATOMIC_RELAXED, __HIP_MEMORY_SCOPE_AGENT); }
__device__ __forceinline__ unsigned xb_xcc_id() { return (unsigned)__builtin_amdgcn_s_getreg((3 << 11) | 20) & 0xFu; }
#define XB_SPIN(cond, bar) do { unsigned _sp = 0; while (cond) { __builtin_amdgcn_s_sleep(1); \
    if ((++_sp & 255u) == 0u) { if (xb_ld(&(bar)[XB_TMO])) break; if (_sp > XB_SPIN_CAP) { atomicAdd(&(bar)[XB_TMO], 1u); break; } } } } while (0)
constexpr int XB_ST_OFF = TID_TAB_OFF - 16;
__device__ __forceinline__ void xcd_barrier_post(unsigned* bar) { if (tid_fresh() == 0) (void)xb_add(&bar[XB_XCNT(xb_xcc_id())], 1u); }
__device__ __forceinline__ void xcd_barrier_complete(unsigned* bar, unsigned x, unsigned G, unsigned& nloc, unsigned& nx) {
    unsigned sum, cnt, mine, sp = 0u;
    for (;;) {
        sum = 0u; cnt = 0u; mine = 0u;
#pragma unroll
        for (unsigned j = 0; j < 16; ++j) { const unsigned c = xb_ld(&bar[XB_XCNT(j)]); sum += c; cnt += (c > 0u) ? 1u : 0u; mine = (j == x) ? c : mine; }
        if (sum == G) break;
        __builtin_amdgcn_s_sleep(1);
        if ((++sp & 255u) == 0u) { if (xb_ld(&bar[XB_TMO])) break; if (sp > XB_SPIN_CAP) { atomicAdd(&bar[XB_TMO], 1u); break; } }
    }
    nloc = mine > 0u ? mine : 1u; nx = cnt > 0u ? cnt : 1u;
}
__device__ __forceinline__ void xcd_barrier(unsigned* bar, unsigned G) {
    asm volatile("s_waitcnt vmcnt(0)" ::: "memory");
    __syncthreads();
    if (tid_fresh() == 0) {
        volatile LAS unsigned* st = (volatile LAS unsigned*)(LAS char*)XB_ST_OFF;
        const unsigned x = xb_xcc_id();
        __builtin_amdgcn_s_waitcnt(0);
        unsigned nloc = st[0], nx = st[1];
        if (nloc == 0u) { xcd_barrier_complete(bar, x, G, nloc, nx); st[0] = nloc; st[1] = nx; }
        const unsigned old = xb_add(&bar[XB_XSUB(x)], 1u);
        const unsigned gen = old / nloc;
        if (old + 1u == (gen + 1u) * nloc) {
            __builtin_amdgcn_fence(__ATOMIC_RELEASE, "agent");
            asm volatile("s_waitcnt vmcnt(0)" ::: "memory");
            const unsigned og = xb_add(&bar[XB_TOP], 1u);
            const unsigned tg = og / nx;
            if (og + 1u == (tg + 1u) * nx) xb_add(&bar[XB_TOPGEN], 1u);
            else XB_SPIN(xb_ld(&bar[XB_TOPGEN]) == tg, bar);
            __builtin_amdgcn_fence(__ATOMIC_ACQUIRE, "agent");
            xb_add(&bar[XB_XGEN(x)], 1u);
            asm volatile("s_waitcnt vmcnt(0)" ::: "memory");
        } else {
            XB_SPIN(xb_ld(&bar[XB_XGEN(x)]) == gen, bar);
            __builtin_amdgcn_fence(__ATOMIC_ACQUIRE, "agent");
            asm volatile("s_waitcnt vmcnt(0)" ::: "memory");
        }
    }
    __syncthreads();
}
constexpr size_t MiB = 1u << 20;
constexpr size_t OFF_CTL = 0, OFF_AQ = 16384, OFF_DEC = 65536, OFF_DECK = 131072;
constexpr size_t OFF_SS = 1 * MiB, OFF_XB = 2 * MiB, OFF_RW = 34 * MiB, OFF_RA = 70 * MiB, OFF_RB = 174 * MiB, WS_NEED = 272 * MiB;
constexpr size_t W_GLU = 0, W_E13 = 1 * MiB, W_E2 = 12 * MiB, W_EINA = 17 * MiB + 512 * 1024, W_ETY = 25 * MiB + 512 * 1024, W_EWST = 31 * MiB + 512 * 1024;
constexpr size_t W_LINB = 1 * MiB, W_LG = 5 * MiB, W_LB = 13 * MiB, W_LO = 17 * MiB, W_L13 = 19 * MiB, W_L2 = 30 * MiB;
constexpr size_t A_H1 = 0, A_PA = 0, A_PB = 0, A_MISCB = 56 * MiB, A_MASK = 64 * MiB, A_YC = 80 * MiB;
constexpr size_t B_U = 0, B_SC = 24 * MiB, B_S5Y = 40 * MiB, B_M2ST = 56 * MiB, B_HGST = 64 * MiB, B_MISCA = 80 * MiB, B_SSA = 81 * MiB, B_YB = 82 * MiB;
constexpr size_t B_GSCR = 0, B_MERGED = 32 * MiB;
constexpr int LDS_BYTES = 160 * 1024;
constexpr int NPH_LAYER = 16;
#if defined(PROBE_PH) || defined(PROBE_SPLIT)
#define TK_ABL (A.sub >> 8)
#else
#define TK_ABL 0
#endif
#ifndef SUBMASK
#define SUBMASK 0xffu
#endif
#ifndef P4SEL
#define P4SEL 7
#endif
#ifndef REPMASK
#define REPMASK 0u
#endif
#ifndef PHMASK
#define PHMASK 0xffffu
#endif

struct Args { const void* in[34]; float* out; unsigned char* ws; int ph_lo, ph_hi, nosync, sub; };

template <int L, int SP> __device__ __forceinline__ void do_phase(LAS unsigned char* lds) {
    typedef const __attribute__((address_space(4))) Args* KArgsPtr;
    KArgsPtr kargs = (KArgsPtr)__builtin_amdgcn_kernarg_segment_ptr();
    asm volatile("" : "+s"(kargs));
#define A (*kargs)
    unsigned char* ws = A.ws;
    const int bid = sgpr_fresh(blockIdx.x), nb = sgpr_fresh(gridDim.x);
#define X ((float*)A.out)
#define SS ((float*)(ws + OFF_SS))
#define XB ((bf16_t*)(ws + OFF_XB))
#define RW (ws + OFF_RW)
#define RA (ws + OFF_RA)
#define RB (ws + OFF_RB)
#define AQ ((float*)(ws + OFF_AQ))
#define DEC ((float*)(ws + OFF_DEC))
#define DECK ((float*)(ws + OFF_DECK))
#define H1 ((bf16_t*)(RA + A_H1))
#define PA ((bf16_t*)(RA + A_PA))
#define PB ((bf16_t*)(RA + A_PB))
#define KIB ((bf16_t*)(RA + A_MISCB))
#define WI ((float*)(RA + A_MISCB + 2 * MiB))
#define MASK ((unsigned*)(RA + A_MASK))
#define YC ((bf16_t*)(RA + A_YC))
#define U ((bf16_t*)(RB + B_U))
#define SC ((float*)(RB + B_SC))
#define S5Y ((bf16_t*)(RB + B_S5Y))
#define M2ST ((float*)(RB + B_M2ST))
#define HGST ((float*)(RB + B_HGST))
#define MISCA ((float*)(RB + B_MISCA))
#define SSA ((float*)(RB + B_SSA))
#define YB ((bf16_t*)(RB + B_YB))
#define GSCR ((bf16_t*)(RB + B_GSCR) + (size_t)bid * 65536)
#define MERGED ((bf16_t*)(RB + B_MERGED))
    {
        constexpr int l = L, sp = SP;
#define INF(i, per) (((const float*)A.in[i]) + (size_t)l * (per))
        constexpr int rep = 0;
        {
        switch (sp) {
        case 0: if constexpr (PHMASK & (1u<<0)) {
            int rot = 0; CvtJob j;
            j = CvtJob{INF(3, DM * DFF), INF(4, DM * DFF), INF(2, DM), (bf16_t*)(RW + W_E13), DFF, 2 * DFF, DM, MAP_IL2, 0}; cvt_run(lds, j, bid, nb, rot);
            j = CvtJob{INF(5, DFF * DM), nullptr, nullptr, (bf16_t*)(RW + W_E2), DM, DM, DFF, MAP_PLAIN, 0}; cvt_run(lds, j, bid, nb, rot);
            j = CvtJob{INF(7, DM * DIN), nullptr, INF(6, DM), (bf16_t*)(RW + W_EINA), DIN, 4096, DM, MAP_INA, 0}; cvt_run(lds, j, bid, nb, rot);
            j = CvtJob{INF(25, 512 * 1024), INF(25, 512 * 1024), nullptr, (bf16_t*)(RW + W_GLU), 1024, 1024, 512, MAP_IL2, 512}; cvt_run(lds, j, bid, nb, rot);
            for (int it = bid; it < 256; it += nb) s5_tables(lds, it >> 3, it & 7, INF(17, 2048), INF(18, 2048), INF(19, 32768), INF(20, 32768), INF(21, 32768), INF(22, 32768), INF(23, 512), INF(24, 32),
                                                             (bf16_t*)(RW + W_ETY), (bf16_t*)(RW + W_EWST), AQ);
            if (l == 0) x_prologue((const float*)A.in[0], X, XB, SS, bid, nb);
        } break;
        case 1: case 14: if constexpr (PHMASK & (1u<<1)) {
            pg8::Gemm g{XB, (const bf16_t*)(RW + (sp == 1 ? W_E13 : W_L13)), DM, DM, DM}; pg8::StaticOrder S; S.init(64, 22, nb, bid);
            pg8::EpiSwiGLU E{H1, DFF, SS}; pg8::gemm_phase<pg8::EpiSwiGLU, pg8::StaticOrder, true, true>(lds, g, S, E);
        } break;
        case 2: case 15: if constexpr (PHMASK & (1u<<2)) {
            pg8::Gemm g{H1, (const bf16_t*)(RW + (sp == 2 ? W_E2 : W_L2)), DFF, DFF, DFF}; pg8::StaticOrder S; S.init(64, 4, nb, bid);
            pg8::EpiResid E{(l == 0 && sp == 2) ? (const float*)A.in[0] : (const float*)X, X, XB, SS, 0.5f}; pg8::gemm_phase<pg8::EpiResid, pg8::StaticOrder, true, true>(lds, g, S, E);
        } break;
        case 3: if constexpr (PHMASK & (1u<<3)) {
            pg8::Gemm g{XB, (const bf16_t*)(RW + W_EINA), DM, DM, DM}; pg8::StaticOrder S; S.init(64, 16, nb, bid);
            pg8::EpiInA E{PA, U, MISCA, SS}; pg8::gemm_phase<pg8::EpiInA, pg8::StaticOrder, true, true>(lds, g, S, E);
        } break;
        case 4: if constexpr (PHMASK & (1u<<4)) {
            if (rep == 0 || (P4SEL & 1)) { pg8::Gemm g{U, (const bf16_t*)(RW + W_EWST), U_LD, 256, 256}; pg8::GroupOrder S; S.init(32, 4, 1, nb, bid);
              pg8::EpiS5State E{SC}; pg8::gemm_phase<pg8::EpiS5State, pg8::GroupOrder, true, true>(lds, g, S, E); }
            if (rep == 0 || (P4SEL & 2)) { const HgParams hp{(const float*)A.in[28], (const float*)A.in[28] + 512, INF(29, 512), l};
              for (int it = bid; it < 256; it += nb) hg1_mfma(lds, it, PA, HGST, DECK, hp); }
            if (rep == 0 || (P4SEL & 4)) { const M2Params mp{INF(11, 4 * 768), INF(12, 768), INF(13, 8), INF(14, 8), INF(15, 8)};
              for (int it = bid; it < 512; it += nb) m2s1_mfma(lds, it, PA, MISCA, M2ST, DEC, mp); }
        } break;
        case 5: if constexpr (PHMASK & (1u<<5)) {
            for (int it = bid; it < 64; it += nb) s5_scan(lds, it, SC, AQ, U);
            const int tid = tid_fresh();
            if (rep == 0) for (int e = bid * 512 + tid; e < 131072; e += nb * 512) hg_scan(HGST, DECK, e);
            if (rep == 0) for (int e = (nb - 1 - bid) * 512 + tid; e < 65536; e += nb * 512) m2_scan(M2ST, DEC, e);
        } break;
        case 6: if constexpr (PHMASK & (1u<<6)) {
            if (A.sub & 4) { pg8::Gemm g{U, (const bf16_t*)(RW + W_ETY), U_LD, U_LD, U_LD}; pg8::GroupOrder S; S.init(32, 4, 1, nb, bid);
              pg8::EpiS5Y E{S5Y}; pg8::gemm_phase<pg8::EpiS5Y, pg8::GroupOrder, true, true>(lds, g, S, E); }
            if (A.sub & 2) { const HgParams hp{(const float*)A.in[28], (const float*)A.in[28] + 512, INF(29, 512), l};
              for (int it = bid; it < 256; it += nb) hg3_mfma(lds, it, PA, HGST, hp); }
            if (A.sub & 1) { const M2Params mp{INF(11, 4 * 768), INF(12, 768), INF(13, 8), INF(14, 8), INF(15, 8)};
              for (int it = bid; it < 512; it += nb) m2s3_mfma(lds, it, PA, MISCA, M2ST, SSA, mp); }
        } break;
        case 7: if constexpr (PHMASK & (1u<<7)) {
            { pg8::Gemm g{S5Y, (const bf16_t*)(RW + W_GLU), 512, 512, 512}; pg8::StaticOrder S; S.init(64, 4, nb, bid);
              pg8::EpiGLU E{YB, 512}; pg8::gemm_phase<pg8::EpiGLU, pg8::StaticOrder, true, true>(lds, g, S, E); }
            int rot = 0; CvtJob j;
            j = CvtJob{INF(7, DM * DIN), nullptr, INF(6, DM), (bf16_t*)(RW + W_LINB), DIN, 2048, DM, MAP_INB, 0}; cvt_run(lds, j, bid, nb, rot);
            j = CvtJob{INF(8, DM * 4096), nullptr, INF(6, DM), (bf16_t*)(RW + W_LG), 4096, 4096, DM, MAP_PLAIN, 0}; cvt_run(lds, j, bid, nb, rot);
            for (int gi = 0; gi < 4; ++gi) { j = CvtJob{INF(9, 4 * 512 * 1024) + (size_t)gi * 512 * 1024, nullptr, gi == 0 ? INF(16, 512) : nullptr, (bf16_t*)(RW + W_LB) + (size_t)gi * 1024 * 512, 1024, 1024, 512, MAP_PLAIN, 0}; cvt_run(lds, j, bid, nb, rot); }
            j = CvtJob{INF(10, DM * DM), nullptr, nullptr, (bf16_t*)(RW + W_LO), DM, DM, DM, MAP_PLAIN, 0}; cvt_run(lds, j, bid, nb, rot);
            j = CvtJob{INF(31, DM * DFF), INF(32, DM * DFF), INF(30, DM), (bf16_t*)(RW + W_L13), DFF, 2 * DFF, DM, MAP_IL2, 0}; cvt_run(lds, j, bid, nb, rot);
            j = CvtJob{INF(33, DFF * DM), nullptr, nullptr, (bf16_t*)(RW + W_L2), DM, DM, DFF, MAP_PLAIN, 0}; cvt_run(lds, j, bid, nb, rot);
        } break;
        case 8: case 12: if constexpr (PHMASK & (1u<<8)) {
            pg8::StaticOrder S; S.init(64, 4, nb, bid);
            for (int gi = 0; gi < 4; ++gi) { if ((sp == 8) == (gi == 2)) continue;
                { pg8::Gemm g{XB, (const bf16_t*)(RW + W_LG) + (size_t)gi * 1024 * 1024, DM, DM, DM}; pg8::EpiGate E{GSCR, SS}; pg8::gemm_phase<pg8::EpiGate, pg8::StaticOrder, true, true>(lds, g, S, E); }
                const bf16_t* Ag = gi == 0 ? PA : gi == 1 ? YB : gi == 2 ? YC : PA + 2816; const int lda = (gi == 1 || gi == 2) ? 512 : PA_LD;
                { pg8::Gemm g{Ag, (const bf16_t*)(RW + W_LB) + (size_t)gi * 1024 * 512, lda, 512, 512}; pg8::EpiBranch E{GSCR, MERGED, gi == 0 ? SSA : nullptr, gi == 0 ? 1 : 0};
                  pg8::gemm_phase<pg8::EpiBranch, pg8::StaticOrder, true, true>(lds, g, S, E); } }
        } break;
        case 9: if constexpr (PHMASK & (1u<<9)) {
            pg8::Gemm g{XB, (const bf16_t*)(RW + W_LINB), DM, DM, DM}; pg8::StaticOrder S; S.init(64, 8, nb, bid);
            pg8::EpiInB E{PB, KIB, WI, SS}; pg8::gemm_phase<pg8::EpiInB, pg8::StaticOrder, true, true>(lds, g, S, E);
        } break;
        case 10: if constexpr (PHMASK & (1u<<10)) {
            if (A.sub & 1) dsa_prep(PB, (const int*)A.in[1], INF(26, 64), INF(27, 64), bid, nb);
            if (A.sub & 2) for (int it = bid; it < 512; it += nb) { const int c = it & 255, bb = it >> 8; dsa_topk_tile(lds, bb, bb == 0 ? c : 255 - c, PB, KIB, WI, TK_ABL ? (unsigned*)YC : MASK, TK_ABL); }
        } break;
        case 11: if constexpr (PHMASK & (1u<<11)) {
            for (int it = bid; it < 512; it += nb) { const int c = it & 255, second = it >> 8, pair = (c & 7) * 2 + (c >> 7), bb = pair >> 3, hd = pair & 7, jq = (c >> 3) & 15;     dsa_attn_item(lds, bb, hd, second ? 31 - jq : jq, PB, MASK, YC, INF(26, 64), INF(27, 64)); }
        } break;
        case 13: if constexpr (PHMASK & (1u<<13)) {
            pg8::Gemm g{MERGED, (const bf16_t*)(RW + W_LO), DM, DM, DM}; pg8::StaticOrder S; S.init(64, 4, nb, bid);
            pg8::EpiResid E{(const float*)X, X, XB, SS, 1.0f}; pg8::gemm_phase<pg8::EpiResid, pg8::StaticOrder, true, true>(lds, g, S, E);
        } break;
        }
        }
    }
#undef INF
}
#undef A

__global__ void __launch_bounds__(512) hybrid_fwd(Args a) {
    cg::grid_group grid = cg::this_grid();
    extern __shared__ __attribute__((aligned(16))) unsigned char lds_raw[];
    LAS unsigned char* lds = (LAS unsigned char*)lds_raw;
    const int ph_lo = a.ph_lo, ph_hi = a.ph_hi;
    tid_tab_init();
    if (threadIdx.x < 4) ((LAS unsigned*)(LAS char*)XB_ST_OFF)[threadIdx.x] = 0u;
    __syncthreads();
    xcd_barrier_post((unsigned*)a.ws);
    if (!a.nosync) grid.sync();
#define STEP(L_, SP_) { constexpr int PH_ = (L_) * NPH_LAYER + (SP_); if (ph_lo <= PH_ && PH_ < ph_hi) { do_phase<L_, SP_>(lds); if (PH_ + 1 < ph_hi) xcd_barrier((unsigned*)a.ws, gridDim.x); } }
#define LAYER(L_) STEP(L_, 0) STEP(L_, 1) STEP(L_, 2) STEP(L_, 3) STEP(L_, 4) STEP(L_, 5) STEP(L_, 6) STEP(L_, 7) STEP(L_, 8) STEP(L_, 9) STEP(L_, 10) STEP(L_, 11) STEP(L_, 12) STEP(L_, 13) STEP(L_, 14) STEP(L_, 15)
    LAYER(0) LAYER(1)
#undef LAYER
#undef STEP
}
extern "C" void kernel_launch(void* const* d_in, const int* in_sizes, int n_in, void* d_out, int out_size, void* d_ws, size_t ws_size, hipStream_t stream) {
    static int grid_blocks = 0;
    if (!grid_blocks) {
        int dev = 0, cus = 0, per_cu = 0;
        hipGetDevice(&dev);
        hipDeviceGetAttribute(&cus, hipDeviceAttributeMultiprocessorCount, dev);
        hipFuncSetAttribute((const void*)hybrid_fwd, hipFuncAttributeMaxDynamicSharedMemorySize, LDS_BYTES);
        hipOccupancyMaxActiveBlocksPerMultiprocessor(&per_cu, hybrid_fwd, 512, LDS_BYTES);
        if (per_cu < 1) { fprintf(stderr, "occupancy query returned %d\n", per_cu); per_cu = 1; }
        grid_blocks = cus * 1;
        if (grid_blocks > 256) grid_blocks = 256;
        fprintf(stderr, "grid_blocks=%d cus=%d per_cu=%d ws_size=%zu need=%zu\n", grid_blocks, cus, per_cu, ws_size, (size_t)WS_NEED);
    }
    if (ws_size < WS_NEED || n_in < 34) { fprintf(stderr, "workspace too small or bad inputs\n"); return; }
    hipMemsetAsync(d_ws, 0, XCD_BAR_WORDS * 4, stream);
    Args a{};
    for (int i = 0; i < 34; ++i) a.in[i] = d_in[i];
    a.out = (float*)d_out; a.ws = (unsigned char*)d_ws; a.ph_lo = 0; a.ph_hi = NLAYER * NPH_LAYER; a.nosync = 0; a.sub = 7;
#ifdef PROBE_SPLIT
    { Args p = a; p.ph_hi = PROBE_SPLIT + 1; void* pa[] = {&p};
      hipLaunchCooperativeKernel((void*)hybrid_fwd, dim3(grid_blocks), dim3(512), pa, LDS_BYTES, stream);
      Args q = a; q.ph_lo = PROBE_SPLIT; q.ph_hi = PROBE_SPLIT + 1; q.nosync = 1; q.sub = PROBE_SUB;
      for (int r = 0; r < PROBE_N; ++r) hipLaunchKernelGGL(hybrid_fwd, dim3(grid_blocks), dim3(512), LDS_BYTES, stream, q);
      Args t = a; t.ph_lo = PROBE_SPLIT + 1; t.nosync = 1;
      hipMemsetAsync(d_ws, 0, XCD_BAR_WORDS * 4, stream);
      hipLaunchKernelGGL(hybrid_fwd, dim3(grid_blocks), dim3(512), LDS_BYTES, stream, t); }
    return;
#endif
    void* args[] = {&a};
    hipError_t e = hipLaunchCooperativeKernel((void*)hybrid_fwd, dim3(grid_blocks), dim3(512), args, LDS_BYTES, stream);
    if (e != hipSuccess) fprintf(stderr, "cooperative launch failed: %s (grid %d)\n", hipGetErrorString(e), grid_blocks);
#ifdef PROBE_PH
    { Args p = a; p.out = (float*)((unsigned char*)d_ws + OFF_RB + 32 * MiB); p.ph_lo = PROBE_PH; p.ph_hi = PROBE_PH + 1; p.nosync = 1; p.sub = PROBE_SUB;
      for (int r = 0; r < PROBE_N; ++r) hipLaunchKernelGGL(hybrid_fwd, dim3(grid_blocks), dim3(512), LDS_BYTES, stream, p); }
#endif
}
```

```cpp
#include <hip/hip_runtime.h>
#include <hip/hip_cooperative_groups.h>
#include <cstdio>
#include <cstdint>
namespace cg = cooperative_groups;

#define LAS __attribute__((address_space(3)))
typedef unsigned short bf16_t;
typedef short bf16x8 __attribute__((ext_vector_type(8)));
typedef float f32x4 __attribute__((ext_vector_type(4)));
typedef float f32x16 __attribute__((ext_vector_type(16)));
typedef unsigned u32x4 __attribute__((ext_vector_type(4)));
typedef unsigned u32x2 __attribute__((ext_vector_type(2)));

constexpr int T_TOK = 16384, SEQ = 8192, DM = 1024, DFF = 2816, DIN = 5708, NLAYER = 2;
constexpr float NORM_EPS = 1e-6f;
constexpr int PA_LD = 3328;
constexpr int PB_LD = 1792;
constexpr int U_LD = 384;
constexpr int S5Q = 16;
constexpr int NCHUNK = T_TOK / S5Q;

typedef __bf16 hwbf2 __attribute__((ext_vector_type(2)));
typedef float f32x2_t __attribute__((ext_vector_type(2)));
__device__ __forceinline__ unsigned pack_bf16(float lo, float hi) { const f32x2_t v = {lo, hi}; return __builtin_bit_cast(unsigned, __builtin_convertvector(v, hwbf2)); }
__device__ __forceinline__ bf16_t f2bf(float f) { return (bf16_t)(pack_bf16(f, 0.f) & 0xffffu); }
__device__ __forceinline__ float bf2f(bf16_t h) { return __uint_as_float(((unsigned)h) << 16); }
__device__ __forceinline__ float bflo(unsigned w) { return __uint_as_float(w << 16); }
__device__ __forceinline__ float bfhi(unsigned w) { return __uint_as_float(w & 0xffff0000u); }
__device__ __forceinline__ float fast_exp2(float x) { return __builtin_amdgcn_exp2f(x); }
__device__ __forceinline__ float fast_rcp(float x) { return __builtin_amdgcn_rcpf(x); }
__device__ __forceinline__ float sigmoid_f(float x) { return fast_rcp(1.0f + fast_exp2(-1.4426950408889634f * x)); }
__device__ __forceinline__ float silu_f(float x) { return x * sigmoid_f(x); }
__device__ __forceinline__ float gelu_tanh_f(float x) { const float u = 0.7978845608028654f * (x + 0.044715f * x * x * x); return x * sigmoid_f(2.0f * u); }
__device__ __forceinline__ float fast_exp(float x) { return __builtin_amdgcn_exp2f(1.4426950408889634f * x); }
__device__ __forceinline__ float fast_rsq(float x) { return __builtin_amdgcn_rsqf(x); }
__device__ __forceinline__ float softplus_f(float x) {
    if (x > 20.f) return x;
    const float e = fast_exp(x);
    if (e < 0.03125f) return e * (1.0f - e * (0.5f - e * (0.33333333f - 0.25f * e)));
    return 0.6931471805599453f * __builtin_amdgcn_logf(1.0f + e);
}
__device__ __forceinline__ void sincos_rev(float ang, float& sn, float& cs) {
    double rd = (double)ang * 0.15915494309189535; rd -= __builtin_floor(rd);
    const float r = (float)rd; sn = __builtin_amdgcn_sinf(r); cs = __builtin_amdgcn_cosf(r);
}
constexpr int TID_TAB_OFF = 160 * 1024 - 256;
__device__ __forceinline__ unsigned hw_wave_slot() { return __builtin_amdgcn_s_getreg((5 << 11) | 4) & 63u; }
__device__ __forceinline__ void tid_tab_init() { ((LAS int*)(LAS char*)TID_TAB_OFF)[hw_wave_slot()] = (int)(threadIdx.x >> 6); __syncthreads(); }
__device__ __forceinline__ int tid_fresh() {
    unsigned off = (unsigned)TID_TAB_OFF + hw_wave_slot() * 4u; asm volatile("" : "+s"(off));
    const int w = *(const LAS int*)(LAS char*)(uintptr_t)off;
    unsigned z_ = 0u; asm volatile("" : "+v"(z_));
    int t = w * 64 + (int)__builtin_amdgcn_mbcnt_hi(~0u, __builtin_amdgcn_mbcnt_lo(~0u, z_)); asm volatile("" : "+v"(t)); return t; }
__device__ __forceinline__ int sgpr_fresh(int v) { asm volatile("" : "+s"(v)); return v; }
template <int M> __device__ __forceinline__ float swz_xor(float x) { return __builtin_bit_cast(float, __builtin_amdgcn_ds_swizzle(__builtin_bit_cast(int, x), (M << 10) | 0x1f)); }
__device__ __forceinline__ void swap32(unsigned u, unsigned& r0, unsigned& r1) { const auto r = __builtin_amdgcn_permlane32_swap(u, u, false, false); r0 = r[0]; r1 = r[1]; asm volatile("" : "+v"(r0), "+v"(r1)); }
__device__ __forceinline__ float sum32(float x) { unsigned r0, r1; swap32(__builtin_bit_cast(unsigned, x), r0, r1); return __builtin_bit_cast(float, r0) + __builtin_bit_cast(float, r1); }
__device__ __forceinline__ float max32(float x) { unsigned r0, r1; swap32(__builtin_bit_cast(unsigned, x), r0, r1); return fmaxf(__builtin_bit_cast(float, r0), __builtin_bit_cast(float, r1)); }
__device__ __forceinline__ unsigned or32(unsigned u) { unsigned r0, r1; swap32(u, r0, r1); return r0 | r1; }
__device__ __forceinline__ float sum_lo32(float x) { x += swz_xor<16>(x); x += swz_xor<8>(x); x += swz_xor<4>(x); x += swz_xor<2>(x); x += swz_xor<1>(x); return x; }
__device__ __forceinline__ float wave_allsum(float x) { return sum32(sum_lo32(x)); }
namespace pg8 {
constexpr int BM = 256, BK = 64, HALF = 128, HTB = HALF * BK * 2  , STAGE_BYTES = 8 * HTB, NXCD = 8, WGM = 8;
__host__ __device__ __forceinline__ int lds_byte(int r, int c) { const int st = (r >> 4) * 2 + (c >> 5), rr = r & 15, cc = c & 31, ob = rr * 64 + cc * 2; return st * 1024 + (ob ^ (((ob >> 9) & 1) << 5)); }
__host__ __device__ __forceinline__ void stage_rc(int b, int& R, int& C) { const int st = b / 1024, sb = b % 1024, swz = sb ^ (((sb >> 9) & 1) << 5); R = (st >> 1) * 16 + swz / 64; C = (st & 1) * 32 + (swz % 64) / 2; }
__host__ __device__ __forceinline__ int perm32(int rho) { const int n = rho >> 4, i = rho & 15; return 8 * (i >> 2) + 4 * n + (i & 3); }

struct Unit { int pm, pn; };
struct Gemm { const bf16_t* A; const bf16_t* Bt; int lda, ldb, K; };

struct StaticOrder {
    int nM, nN, nwg, G, c;
    __device__ void init(int nM_, int nN_, int G_, int c_) { nM = nM_; nN = nN_; nwg = nM * nN; G = G_; c = c_; }
    __device__ bool next(int i, Unit& u) const {
        const long L = (long)i * G + c; if (L >= nwg) return false;
        int wgid = (int)L; { const int q = nwg / NXCD, r = nwg % NXCD, xcd = wgid % NXCD, off = wgid / NXCD; wgid = (xcd < r ? xcd * (q + 1) : r * (q + 1) + (xcd - r) * q) + off; }
        const int nig = WGM * nN, gid = wgid / nig, fm = gid * WGM, gsz = (nM - fm) < WGM ? (nM - fm) : WGM;
        u.pm = fm + ((wgid % nig) % gsz); u.pn = (wgid % nig) / gsz; return true;
    }
};
struct GroupOrder {
    int ng, nMg, nNg, tot, G, c;
    __device__ void init(int ng_, int nMg_, int nNg_, int G_, int c_) { ng = ng_; nMg = nMg_; nNg = nNg_; tot = ng * nMg * nNg; G = G_; c = c_; }
    __device__ bool next(int i, Unit& u) const {
        const int L = i * G + c; if (L >= tot) return false;
        const int per = nMg * nNg, g = L / per, r = L % per; u.pm = g * nMg + r % nMg; u.pn = g * nNg + r / nMg; return true;
    }
};

template <class E, class = void> struct epi_has_init { static constexpr bool value = false; };
template <class E> struct epi_has_init<E, decltype((void)E::HAS_INIT)> { static constexpr bool value = true; };
template <class Epi, class Sched, bool ALIGN_EPI, bool SP2>
__device__ __forceinline__ void gemm_phase(LAS unsigned char* lds, const Gemm g, const Sched& S, const Epi& E) {
    const int tid = tid_fresh(), wid = __builtin_amdgcn_readfirstlane(tid >> 6), lane = tid & 63, wr = wid >> 2, wc = wid & 3, fr = lane & 15, fq = lane >> 4;
    const int K = g.K, nt = K / BK;
    unsigned voffA[2], voffB[2];
#pragma unroll
    for (int i = 0; i < 2; ++i) { int R, C; stage_rc(tid * 16 + i * 8192, R, C); const int Rb = Epi::PERM ? ((R & ~31) + perm32(R & 31)) : R;
        voffA[i] = (unsigned)(R * g.lda + C) * 2u; voffB[i] = (unsigned)(Rb * g.ldb + C) * 2u; }
    const size_t kstep = (size_t)(BK * 2);
    const size_t hstepA = (size_t)HALF * g.lda * 2, hstepB = (size_t)HALF * g.ldb * 2;
    const size_t tstepA = 2 * hstepA, tstepB = 2 * hstepB;
    const unsigned ldsw = (unsigned)wid * 1024u, ldsbase = (unsigned)(uintptr_t)lds;
    const int aoff = lds_byte(wr * 64 + fr, fq * 8), boff = lds_byte(wc * 32 + fr, fq * 8);
#define PG8_SA(b, h) (((b) * 2 + (h)) * HTB)
#define PG8_SB(b, h) ((4 + (b) * 2 + (h)) * HTB)
#define PG8_STAGE(bufoff, gbase, voff) do { _Pragma("unroll") for (int _i = 0; _i < 2; ++_i) { unsigned _keep; const unsigned _dst = ldsbase + (unsigned)(bufoff) + ldsw + (unsigned)_i * 8192u; \
        asm volatile("s_mov_b32 %0, m0\n\ts_mov_b32 m0, %3\n\ts_nop 0\n\tglobal_load_lds_dwordx4 %1, %2\n\ts_mov_b32 m0, %0" : "=&s"(_keep) : "v"((voff)[_i]), "s"(gbase), "s"(_dst) : "memory"); } } while (0)
#define PG8_LDA(dst, b, h) do { _Pragma("unroll") for (int m = 0; m < 4; ++m) _Pragma("unroll") for (int k = 0; k < 2; ++k) dst[m][k] = *(const LAS bf16x8*)(lds + PG8_SA(b, h) + aoff + m * 2048 + k * 1024); } while (0)
#define PG8_LDB(dst, b, h) do { _Pragma("unroll") for (int n = 0; n < 2; ++n) _Pragma("unroll") for (int k = 0; k < 2; ++k) dst[n][k] = *(const LAS bf16x8*)(lds + PG8_SB(b, h) + boff + n * 2048 + k * 1024); } while (0)
#define PG8_MMA(ai, bj, At, Bt) do { __builtin_amdgcn_s_setprio(1); _Pragma("unroll") for (int m = 0; m < 4; ++m) _Pragma("unroll") for (int n = 0; n < 2; ++n) _Pragma("unroll") for (int k = 0; k < 2; ++k) \
        acc[ai][bj][m][n] = __builtin_amdgcn_mfma_f32_16x16x32_bf16(Bt[n][k], At[m][k], acc[ai][bj][m][n], 0, 0, 0); __builtin_amdgcn_s_setprio(0); } while (0)
#define PG8_WAIT_V(n) asm volatile("s_waitcnt vmcnt(" #n ")" ::: "memory")
#define PG8_WAIT_L(n) asm volatile("s_waitcnt lgkmcnt(" #n ")" ::: "memory")
#define PG8_BAR __builtin_amdgcn_s_barrier()
#define PG8_SCHED __builtin_amdgcn_sched_barrier(0)
    Unit cur, nxt; int ui = 0;
    if (!S.next(0, cur)) return;
    f32x4 acc[2][2][4][2];
    if constexpr (epi_has_init<Epi>::value) E.init(acc, cur, wr, wc, fr, fq);
    else {
#pragma unroll
    for (int a = 0; a < 2; ++a)
#pragma unroll
        for (int b = 0; b < 2; ++b)
#pragma unroll
            for (int m = 0; m < 4; ++m)
#pragma unroll
                for (int n = 0; n < 2; ++n) acc[a][b][m][n] = (f32x4){0.f, 0.f, 0.f, 0.f};
    }
    bf16x8 At[4][2], B0[2][2], B1[2][2];
    const char* cA = (const char*)g.A + (size_t)cur.pm * tstepA; const char* cB = (const char*)g.Bt + (size_t)cur.pn * tstepB;
    if constexpr (SP2) {
        PG8_STAGE(PG8_SB(0, 0), cB, voffB); PG8_STAGE(PG8_SB(0, 1), cB + hstepB, voffB); PG8_STAGE(PG8_SA(0, 0), cA, voffA); PG8_STAGE(PG8_SA(0, 1), cA + hstepA, voffA);
        if (wr == 1) PG8_BAR;
        PG8_WAIT_V(2); PG8_BAR;
        PG8_STAGE(PG8_SB(1, 0), cB + kstep, voffB); PG8_STAGE(PG8_SA(1, 0), cA + kstep, voffA); PG8_STAGE(PG8_SB(1, 1), cB + hstepB + kstep, voffB);
        PG8_WAIT_V(6); PG8_BAR;
    } else {
        PG8_STAGE(PG8_SB(0, 0), cB, voffB); PG8_STAGE(PG8_SA(0, 0), cA, voffA); PG8_STAGE(PG8_SB(0, 1), cB + hstepB, voffB); PG8_STAGE(PG8_SA(0, 1), cA + hstepA, voffA);
        if (wr == 1) PG8_BAR;
        PG8_WAIT_V(4); PG8_BAR;
        PG8_STAGE(PG8_SB(1, 0), cB + kstep, voffB); PG8_STAGE(PG8_SA(1, 0), cA + kstep, voffA); PG8_STAGE(PG8_SB(1, 1), cB + hstepB + kstep, voffB);
        PG8_WAIT_V(6); PG8_BAR;
    }
    for (;;) {
        const bool has_next = S.next(ui + 1, nxt);
        const char* nA = has_next ? (const char*)g.A + (size_t)nxt.pm * tstepA : cA; const char* nB = has_next ? (const char*)g.Bt + (size_t)nxt.pn * tstepB : cB;
        for (int t = 0; t < nt; t += 2) {
            const bool last = (t == nt - 2);
            const char* a1 = cA + (size_t)(t + 1) * kstep;
            const char* a2 = last ? nA : cA + (size_t)(t + 2) * kstep; const char* b2 = last ? nB : cB + (size_t)(t + 2) * kstep;
            const char* a3 = a2 + kstep; const char* b3 = b2 + kstep;
            if constexpr (SP2) {
            PG8_LDB(B0, 0, 0); PG8_LDB(B1, 0, 1); PG8_SCHED; PG8_LDA(At, 0, 0); PG8_STAGE(PG8_SA(1, 1), a1 + hstepA, voffA);
            PG8_WAIT_V(8); PG8_WAIT_L(0); PG8_BAR; PG8_MMA(0, 0, At, B0); PG8_MMA(0, 1, At, B1); PG8_BAR; PG8_SCHED;
            PG8_LDA(At, 0, 1); PG8_STAGE(PG8_SB(0, 0), b2, voffB); PG8_STAGE(PG8_SB(0, 1), b2 + hstepB, voffB); PG8_STAGE(PG8_SA(0, 0), a2, voffA);
            PG8_WAIT_V(8); PG8_WAIT_L(0); PG8_BAR; PG8_MMA(1, 0, At, B0); PG8_MMA(1, 1, At, B1); PG8_BAR; PG8_SCHED;
            PG8_LDB(B0, 1, 0); PG8_LDB(B1, 1, 1); PG8_SCHED; PG8_LDA(At, 1, 0); PG8_STAGE(PG8_SA(0, 1), a2 + hstepA, voffA);
            PG8_WAIT_V(8); PG8_WAIT_L(0); PG8_BAR; PG8_MMA(0, 0, At, B0); PG8_MMA(0, 1, At, B1); PG8_BAR; PG8_SCHED;
            PG8_LDA(At, 1, 1); PG8_STAGE(PG8_SB(1, 0), b3, voffB); PG8_STAGE(PG8_SB(1, 1), b3 + hstepB, voffB); PG8_STAGE(PG8_SA(1, 0), a3, voffA);
            PG8_WAIT_V(8); PG8_WAIT_L(0); PG8_BAR; PG8_MMA(1, 0, At, B0); PG8_MMA(1, 1, At, B1); PG8_BAR; PG8_SCHED;
            } else {
            PG8_LDB(B0, 0, 0); PG8_SCHED; PG8_LDA(At, 0, 0); PG8_STAGE(PG8_SA(1, 1), a1 + hstepA, voffA);
            PG8_WAIT_L(8); PG8_BAR; PG8_WAIT_L(0); PG8_MMA(0, 0, At, B0); PG8_BAR; PG8_SCHED;
            PG8_LDB(B1, 0, 1); PG8_STAGE(PG8_SB(0, 0), b2, voffB);
            PG8_BAR; PG8_WAIT_L(0); PG8_MMA(0, 1, At, B1); PG8_BAR;
            PG8_LDA(At, 0, 1); PG8_STAGE(PG8_SA(0, 0), a2, voffA);
            PG8_BAR; PG8_WAIT_L(0); PG8_MMA(1, 0, At, B0); PG8_BAR; PG8_SCHED;
            PG8_STAGE(PG8_SB(0, 1), b2 + hstepB, voffB);
            PG8_WAIT_V(6); PG8_BAR; PG8_MMA(1, 1, At, B1); PG8_BAR;
            PG8_LDB(B0, 1, 0); PG8_SCHED; PG8_LDA(At, 1, 0); PG8_STAGE(PG8_SA(0, 1), a2 + hstepA, voffA);
            PG8_WAIT_L(8); PG8_BAR; PG8_WAIT_L(0); PG8_MMA(0, 0, At, B0); PG8_BAR; PG8_SCHED;
            PG8_LDB(B1, 1, 1); PG8_STAGE(PG8_SB(1, 0), b3, voffB);
            PG8_BAR; PG8_WAIT_L(0); PG8_MMA(0, 1, At, B1); PG8_BAR;
            PG8_LDA(At, 1, 1); PG8_STAGE(PG8_SA(1, 0), a3, voffA);
            PG8_BAR; PG8_WAIT_L(0); PG8_MMA(1, 0, At, B0); PG8_BAR; PG8_SCHED;
            PG8_STAGE(PG8_SB(1, 1), b3 + hstepB, voffB);
            PG8_WAIT_V(6); PG8_BAR; PG8_MMA(1, 1, At, B1); PG8_BAR;
            }
        }
        if constexpr (ALIGN_EPI) { if (wr == 0) PG8_BAR; }
        { unsigned z_ = 0u; asm volatile("" : "+v"(z_)); const unsigned ln_ = __builtin_amdgcn_mbcnt_hi(~0u, __builtin_amdgcn_mbcnt_lo(~0u, z_)); int efr = (int)(ln_ & 15u), efq = (int)(ln_ >> 4); asm volatile("" : "+v"(efr), "+v"(efq)); E(acc, cur, wr, wc, efr, efq); }
        if (!has_next) break;
        if constexpr (epi_has_init<Epi>::value) { unsigned z_ = 0u; asm volatile("" : "+v"(z_)); const unsigned ln_ = __builtin_amdgcn_mbcnt_hi(~0u, __builtin_amdgcn_mbcnt_lo(~0u, z_)); E.init(acc, nxt, wr, wc, (int)(ln_ & 15u), (int)(ln_ >> 4)); }
        else {
#pragma unroll
        for (int a = 0; a < 2; ++a)
#pragma unroll
            for (int b = 0; b < 2; ++b)
#pragma unroll
                for (int m = 0; m < 4; ++m)
#pragma unroll
                    for (int n = 0; n < 2; ++n) acc[a][b][m][n] = (f32x4){0.f, 0.f, 0.f, 0.f};
        }
        cur = nxt; cA = nA; cB = nB; ++ui;
        if constexpr (ALIGN_EPI) { if (wr == 1) PG8_BAR; }
    }
    PG8_WAIT_V(0);
    if constexpr (!ALIGN_EPI) { if (wr == 0) PG8_BAR; }
    PG8_BAR;
#undef PG8_SA
#undef PG8_SB
#undef PG8_STAGE
#undef PG8_LDA
#undef PG8_LDB
#undef PG8_MMA
#undef PG8_WAIT_V
#undef PG8_WAIT_L
#undef PG8_BAR
#undef PG8_SCHED
}

typedef f32x4 Acc[2][2][4][2];

__device__ __forceinline__ float row_rstd16(const float* SS, unsigned row, int fq) {
    const f32x4 a = *(const f32x4*)(SS + row * 16u + (unsigned)fq * 4u);
    float s = (a[0] + a[1]) + (a[2] + a[3]);
    s += swz_xor<16>(s); s = sum32(s);
    return fast_rsq(s * (1.0f / 1024.0f) + NORM_EPS);
}
__device__ __forceinline__ u32x4 pack8(const f32x4 v0, const f32x4 v1) { u32x4 w; w.x = pack_bf16(v0[0], v0[1]); w.y = pack_bf16(v0[2], v0[3]); w.z = pack_bf16(v1[0], v1[1]); w.w = pack_bf16(v1[2], v1[3]); return w; }

#define EPI_SB __builtin_amdgcn_sched_barrier(0)
#define EPI_RSTD(rs, SS, rowbase) float rs[2][4]; _Pragma("unroll") for (int ai = 0; ai < 2; ++ai) _Pragma("unroll") for (int m = 0; m < 4; ++m) rs[ai][m] = row_rstd16(SS, (unsigned)((rowbase) + ai * HALF + m * 16), fq); EPI_SB;
struct EpiSwiGLU {
    static constexpr bool PERM = true;
    bf16_t* H; int ldh; const float* SS;
    __device__ __forceinline__ void operator()(const Acc& acc, const Unit& u, int wr, int wc, int fr, int fq) const {
        const int row0 = u.pm * BM + wr * 64 + fr, col0 = u.pn * HALF + wc * 32 + 8 * fq;
        EPI_RSTD(rs, SS, row0)
#pragma unroll
        for (int ai = 0; ai < 2; ++ai)
#pragma unroll
            for (int m = 0; m < 4; ++m) { const int row = row0 + ai * HALF + m * 16; const float r = rs[ai][m];
                f32x4 o[2];
#pragma unroll
                for (int n = 0; n < 2; ++n)
#pragma unroll
                    for (int e = 0; e < 4; ++e) o[n][e] = silu_f(r * acc[ai][0][m][n][e]) * (r * acc[ai][1][m][n][e]);
                *(u32x4*)(H + (unsigned)row * (unsigned)ldh + col0) = pack8(o[0], o[1]); EPI_SB; }
    }
};
struct EpiGLU {
    static constexpr bool PERM = true;
    bf16_t* Y; int ldy;
    __device__ __forceinline__ void operator()(const Acc& acc, const Unit& u, int wr, int wc, int fr, int fq) const {
        const int row0 = u.pm * BM + wr * 64 + fr, col0 = u.pn * HALF + wc * 32 + 8 * fq;
#pragma unroll
        for (int ai = 0; ai < 2; ++ai)
#pragma unroll
            for (int m = 0; m < 4; ++m) { const int row = row0 + ai * HALF + m * 16;
                f32x4 o[2];
#pragma unroll
                for (int n = 0; n < 2; ++n)
#pragma unroll
                    for (int e = 0; e < 4; ++e) o[n][e] = acc[ai][0][m][n][e] * sigmoid_f(acc[ai][1][m][n][e]);
                *(u32x4*)(Y + (unsigned)row * (unsigned)ldy + col0) = pack8(o[0], o[1]); EPI_SB; }
    }
};
template <int MODE> struct EpiResid {
    static constexpr bool PERM = true;
    static constexpr bool HAS_INIT = true;
    const float* Xs; float* Xo; bf16_t* XB; float* SS; float scale;
    __device__ __forceinline__ void init(f32x4 (&acc)[2][2][4][2], const Unit& u, int wr, int wc, int fr, int fq) const {
        const int row0 = u.pm * BM + wr * 64 + fr, col0 = u.pn * BM + wc * 32 + 8 * fq; const float is = 1.0f / scale;
#pragma unroll
        for (int ai = 0; ai < 2; ++ai)
#pragma unroll
            for (int m = 0; m < 4; ++m)
#pragma unroll
                for (int bj = 0; bj < 2; ++bj) { const unsigned off = (unsigned)(row0 + ai * HALF + m * 16) * DM + col0 + bj * HALF;
                    if constexpr (MODE == 0) { acc[ai][bj][m][0] = *(const f32x4*)(Xs + off) * is; acc[ai][bj][m][1] = *(const f32x4*)(Xs + off + 4) * is; }
                    else { const u32x4 w = *(const u32x4*)(XB + off);
                        acc[ai][bj][m][0] = (f32x4){bflo(w.x), bfhi(w.x), bflo(w.y), bfhi(w.y)} * is; acc[ai][bj][m][1] = (f32x4){bflo(w.z), bfhi(w.z), bflo(w.w), bfhi(w.w)} * is; } }
    }
    __device__ __forceinline__ void operator()(const Acc& acc, const Unit& u, int wr, int wc, int fr, int fq) const {
        const int row0 = u.pm * BM + wr * 64 + fr, col0 = u.pn * BM + wc * 32 + 8 * fq;
#pragma unroll
        for (int ai = 0; ai < 2; ++ai) {
#pragma unroll
            for (int m = 0; m < 4; ++m) { const int row = row0 + ai * HALF + m * 16; float ssq = 0.f;
#pragma unroll
                for (int bj = 0; bj < 2; ++bj) { const unsigned off = (unsigned)row * DM + col0 + bj * HALF;
                    const f32x4 x0 = acc[ai][bj][m][0] * scale, x1 = acc[ai][bj][m][1] * scale;
                    if constexpr (MODE == 2) { *(f32x4*)(Xo + off) = x0; *(f32x4*)(Xo + off + 4) = x1; }
                    else { *(u32x4*)(XB + off) = pack8(x0, x1);
                        ssq += ((x0[0] * x0[0] + x0[1] * x0[1]) + (x0[2] * x0[2] + x0[3] * x0[3])) + ((x1[0] * x1[0] + x1[1] * x1[1]) + (x1[2] * x1[2] + x1[3] * x1[3])); } }
                if constexpr (MODE != 2) { ssq += swz_xor<16>(ssq); ssq = sum32(ssq);
                    if (fq == 0) SS[(unsigned)row * 16 + u.pn * 4 + wc] = ssq; } }
            EPI_SB; }
    }
};
struct EpiInA {
    static constexpr bool PERM = true;
    bf16_t* PA; bf16_t* U; float* MISCA; const float* SS;
    __device__ __forceinline__ void operator()(const Acc& acc, const Unit& u, int wr, int wc, int fr, int fq) const {
        const int row0 = u.pm * BM + wr * 64 + fr, tile = u.pn;
        EPI_RSTD(rs, SS, row0)
#pragma unroll
        for (int ai = 0; ai < 2; ++ai)
#pragma unroll
            for (int m = 0; m < 4; ++m) { const int row = row0 + ai * HALF + m * 16; const float r = rs[ai][m];
#pragma unroll
                for (int bj = 0; bj < 2; ++bj) { const int lc = bj * HALF + wc * 32 + 8 * fq; const f32x4 v0 = acc[ai][bj][m][0] * r, v1 = acc[ai][bj][m][1] * r;
                    if (tile < 13) *(u32x4*)(PA + (unsigned)row * PA_LD + tile * BM + lc) = pack8(v0, v1);
                    else if (tile < 15) { const int ch = (tile - 13) * BM + lc, grp = ch >> 4, k0 = ch & 15, chunk = row >> 4, tau = row & 15;
                        *(u32x4*)(U + ((unsigned)(grp * NCHUNK + chunk)) * U_LD + tau * 16 + k0) = pack8(v0, v1); }
                    else if (lc == 0) { *(f32x4*)(MISCA + (unsigned)row * 8) = v0; *(f32x4*)(MISCA + (unsigned)row * 8 + 4) = v1; } }
                EPI_SB; }
    }
};
struct EpiInB {
    static constexpr bool PERM = true;
    bf16_t* PB; bf16_t* KIB; float* WI; const float* SS;
    __device__ __forceinline__ void operator()(const Acc& acc, const Unit& u, int wr, int wc, int fr, int fq) const {
        const int row0 = u.pm * BM + wr * 64 + fr, tile = u.pn;
        EPI_RSTD(rs, SS, row0)
#pragma unroll
        for (int ai = 0; ai < 2; ++ai)
#pragma unroll
            for (int m = 0; m < 4; ++m) { const int row = row0 + ai * HALF + m * 16; const float r = rs[ai][m];
#pragma unroll
                for (int bj = 0; bj < 2; ++bj) { const int lc = bj * HALF + wc * 32 + 8 * fq; const f32x4 v0 = acc[ai][bj][m][0] * r, v1 = acc[ai][bj][m][1] * r;
                    if (tile < 7) *(u32x4*)(PB + (unsigned)row * PB_LD + tile * BM + lc) = pack8(v0, v1);
                    else if (lc < 64) *(u32x4*)(KIB + (unsigned)row * 64 + lc) = pack8(v0, v1);
                    else if (lc == 64) *(f32x4*)(WI + (unsigned)row * 4) = v0; }
                EPI_SB; }
    }
};
struct EpiGate {
    static constexpr bool PERM = true;
    bf16_t* G; const float* SS;
    __device__ __forceinline__ void operator()(const Acc& acc, const Unit& u, int wr, int wc, int fr, int fq) const {
        const int lr0 = wr * 64 + fr;
        EPI_RSTD(rs, SS, u.pm * BM + lr0)
#pragma unroll
        for (int ai = 0; ai < 2; ++ai)
#pragma unroll
            for (int m = 0; m < 4; ++m) { const int lr = lr0 + ai * HALF + m * 16; const float r = rs[ai][m];
#pragma unroll
                for (int bj = 0; bj < 2; ++bj) { const int lc = bj * HALF + wc * 32 + 8 * fq; f32x4 v0, v1;
#pragma unroll
                    for (int e = 0; e < 4; ++e) { v0[e] = sigmoid_f(r * acc[ai][bj][m][0][e]); v1[e] = sigmoid_f(r * acc[ai][bj][m][1][e]); }
                    *(u32x4*)(G + lr * BM + lc) = pack8(v0, v1); }
                EPI_SB; }
    }
};
struct EpiBranch {
    static constexpr bool PERM = true;
    const bf16_t* G; bf16_t* MG; const float* SSA; int first;
    __device__ __forceinline__ void operator()(const Acc& acc, const Unit& u, int wr, int wc, int fr, int fq) const {
        const int lr0 = wr * 64 + fr;
        float rs[2][4];
#pragma unroll
        for (int ai = 0; ai < 2; ++ai)
#pragma unroll
            for (int m = 0; m < 4; ++m) { rs[ai][m] = 1.0f;
                if (SSA) { const unsigned row = (unsigned)(u.pm * BM + lr0 + ai * HALF + m * 16); const f32x4* p = (const f32x4*)(SSA + row * 8u); const f32x4 a = p[0], b = p[1];
                    rs[ai][m] = fast_rsq((((a[0] + a[1]) + (a[2] + a[3])) + ((b[0] + b[1]) + (b[2] + b[3]))) * (1.0f / 512.0f) + NORM_EPS); } }
        EPI_SB;
#pragma unroll
        for (int ai = 0; ai < 2; ++ai)
#pragma unroll
            for (int m = 0; m < 4; ++m) { const int lr = lr0 + ai * HALF + m * 16, row = u.pm * BM + lr; const float r = rs[ai][m];
#pragma unroll
                for (int bj = 0; bj < 2; ++bj) { const int lc = bj * HALF + wc * 32 + 8 * fq;
                    const u32x4 gw = *(const u32x4*)(G + lr * BM + lc); bf16_t* mp = MG + (unsigned)row * DM + u.pn * BM + lc;
                    u32x4 pw = (u32x4){0u, 0u, 0u, 0u}; if (!first) pw = *(const u32x4*)mp;
                    f32x4 v0, v1;
                    v0[0] = bflo(pw.x) + bflo(gw.x) * r * acc[ai][bj][m][0][0]; v0[1] = bfhi(pw.x) + bfhi(gw.x) * r * acc[ai][bj][m][0][1];
                    v0[2] = bflo(pw.y) + bflo(gw.y) * r * acc[ai][bj][m][0][2]; v0[3] = bfhi(pw.y) + bfhi(gw.y) * r * acc[ai][bj][m][0][3];
                    v1[0] = bflo(pw.z) + bflo(gw.z) * r * acc[ai][bj][m][1][0]; v1[1] = bfhi(pw.z) + bfhi(gw.z) * r * acc[ai][bj][m][1][1];
                    v1[2] = bflo(pw.w) + bflo(gw.w) * r * acc[ai][bj][m][1][2]; v1[3] = bfhi(pw.w) + bfhi(gw.w) * r * acc[ai][bj][m][1][3];
                    *(u32x4*)mp = pack8(v0, v1); }
                if (m & 1) EPI_SB; }
    }
};
struct EpiS5State {
    static constexpr bool PERM = false;
    float* SC;
    __device__ __forceinline__ void operator()(const Acc& acc, const Unit& u, int wr, int wc, int fr, int fq) const {
        const int row0 = u.pm * BM + wr * 64 + fr, col0 = wc * 32 + 4 * fq;
#pragma unroll
        for (int ai = 0; ai < 2; ++ai)
#pragma unroll
            for (int m = 0; m < 4; ++m) { const int row = row0 + ai * HALF + m * 16;
#pragma unroll
                for (int n = 0; n < 2; ++n) *(f32x4*)(SC + (unsigned)row * 128 + col0 + n * 16) = acc[ai][0][m][n]; }
    }
};
struct EpiS5Y {
    static constexpr bool PERM = true;
    bf16_t* S5Y;
    __device__ __forceinline__ void operator()(const Acc& acc, const Unit& u, int wr, int wc, int fr, int fq) const {
        const int row0 = u.pm * BM + wr * 64 + fr;
#pragma unroll
        for (int ai = 0; ai < 2; ++ai)
#pragma unroll
            for (int m = 0; m < 4; ++m) { const int grow = row0 + ai * HALF + m * 16, grp = grow / NCHUNK, chunk = grow % NCHUNK;
#pragma unroll
                for (int bj = 0; bj < 2; ++bj) { const int lc = bj * HALF + wc * 32 + 8 * fq, tau = lc >> 4, i0 = lc & 15; f32x4 v0, v1;
#pragma unroll
                    for (int e = 0; e < 4; ++e) { v0[e] = gelu_tanh_f(acc[ai][bj][m][0][e]); v1[e] = gelu_tanh_f(acc[ai][bj][m][1][e]); }
                    *(u32x4*)(S5Y + (unsigned)(chunk * 16 + tau) * 512 + grp * 16 + i0) = pack8(v0, v1); }
                EPI_SB; }
    }
};
#undef EPI_SB
#undef EPI_RSTD
}
enum { MAP_PLAIN = 0, MAP_IL2 = 1, MAP_INA = 2, MAP_INB = 3 };
struct CvtJob { const float* s0; const float* s1; const float* gain; bf16_t* dst; int ld, R, K, kind, half_off; };
__device__ __forceinline__ void cvt_map(const CvtJob& j, int r, const float*& base, int& col) {
    base = j.s0; col = r;
    if (j.kind == MAP_IL2) { const int pn = r >> 8, w = r & 255; if (w < 128) col = pn * 128 + w; else { base = j.s1; col = j.half_off + pn * 128 + (w - 128); } }
    else if (j.kind == MAP_INA) { if (r < 1280) col = r; else if (r < 3328) col = 3660 + (r - 1280); else if (r < 3840) col = 1288 + (r - 3328); else if (r < 3848) col = 1280 + (r - 3840); else base = nullptr; }
    else if (j.kind == MAP_INB) { if (r < 1792) col = 1800 + r; else if (r < 1860) col = 3592 + (r - 1792); else base = nullptr; }
}
__device__ __forceinline__ void cvt_run(LAS unsigned char* lds, const CvtJob& j, int bid, int nb, int& rot) {
    LAS float* tile = (LAS float*)lds;
    const int tid = tid_fresh(), wid = tid >> 6, lane = tid & 63, ntk = j.K / 64, ntr = j.R / 256, ntiles = ntk * ntr;
    const int first = (bid - rot % nb + nb) % nb;
    const int has_gain = __builtin_amdgcn_readfirstlane(j.gain != nullptr ? 1 : 0);
    f32x4 v[8];
#define CVT_LOAD(T) { const int tr_ = (T) / ntk, tk_ = (T) % ntk; const float* base; int col; cvt_map(j, tr_ * 256 + lane * 4, base, col); \
        _Pragma("unroll") for (int i = 0; i < 8; ++i) { const int kk = wid + 8 * i; float z_ = 0.f; asm volatile("" : "+v"(z_)); v[i] = (f32x4){z_, z_, z_, z_}; \
            if (base) v[i] = *(const f32x4*)(base + (size_t)(tk_ * 64 + kk) * j.ld + col); } }
    if (first < ntiles) CVT_LOAD(first)
    for (int t = first; t < ntiles; t += nb) {
        const int tr = t / ntk, tk = t % ntk, r0 = tr * 256, k0 = tk * 64;
#pragma unroll
        for (int i = 0; i < 8; ++i) { const int kk = wid + 8 * i; f32x4 x = v[i]; if (has_gain) x = x * j.gain[k0 + kk];
            *(LAS f32x4*)(tile + kk * 260 + 4 * (lane ^ ((kk >> 3) & 7))) = x; }
        if (t + nb < ntiles) CVT_LOAD(t + nb)
        __syncthreads();
        { const int kc = (tid & 7) * 8;
#pragma unroll
          for (int i = 0; i < 4; ++i) { const int rr = (tid >> 3) + 64 * i; float e8[8];
#pragma unroll
              for (int e = 0; e < 8; ++e) e8[e] = tile[(kc + e) * 260 + (rr ^ ((tid & 7) << 2))];
              u32x4 w; w.x = pack_bf16(e8[0], e8[1]); w.y = pack_bf16(e8[2], e8[3]); w.z = pack_bf16(e8[4], e8[5]); w.w = pack_bf16(e8[6], e8[7]);
              *(u32x4*)(j.dst + (size_t)(r0 + rr) * j.K + k0 + kc) = w; } }
        __syncthreads();
    }
#undef CVT_LOAD
    rot += ntiles;
}

__device__ __forceinline__ void s5_tables(LAS unsigned char* lds, int g, int part, const float* lam_re, const float* lam_im, const float* b_re, const float* b_im,
                          const float* c_re, const float* c_im, const float* dsk, const float* log_dt, bf16_t* TY, bf16_t* WST, float* AQ) {
    LAS float* ap_re = (LAS float*)lds;
    LAS float* ap_im = ap_re + 17 * 64;
    LAS float* bb_re = ap_im + 17 * 64;
    LAS float* bb_im = bb_re + 1024;
    LAS float* km = bb_im + 1024;
    LAS float* cl_re = km + 4096;
    LAS float* cl_im = cl_re + 1024;
    const int tid = tid_fresh();
    for (int idx = tid; idx < 1024; idx += 512) { cl_re[idx] = c_re[(size_t)g * 1024 + idx]; cl_im[idx] = c_im[(size_t)g * 1024 + idx]; }
    const float step = fast_exp(log_dt[g]);
    for (int idx = tid; idx < 17 * 64; idx += 512) { const int m = idx / 64, p = idx % 64; const float lr = lam_re[g * 64 + p] * step, li = lam_im[g * 64 + p] * step;
        const float mag = fast_exp(lr * (float)m); float sn, cs; sincos_rev(li * (float)m, sn, cs); ap_re[idx] = mag * cs; ap_im[idx] = mag * sn; }
    __syncthreads();
    for (int idx = tid; idx < 1024; idx += 512) { const int p = idx / 16; const float lr = lam_re[g * 64 + p], li = lam_im[g * 64 + p], den = lr * lr + li * li;
        const float ar = ap_re[64 + p], ai = ap_im[64 + p];
        const float rden = fast_rcp(den); const float qr = ((ar - 1.0f) * lr + ai * li) * rden, qi = (ai * lr - (ar - 1.0f) * li) * rden;
        const float br = b_re[(size_t)g * 1024 + idx], bi = b_im[(size_t)g * 1024 + idx];
        bb_re[idx] = qr * br - qi * bi; bb_im[idx] = qr * bi + qi * br; }
    __syncthreads();
    { const int i = (tid >> 4) & 15, k = tid & 15, mg = tid >> 8;
      float s[8];
#pragma unroll
      for (int mm = 0; mm < 8; ++mm) s[mm] = 0.f;
#pragma unroll 4
      for (int p = 0; p < 64; ++p) { const float cr = cl_re[i * 64 + p], ci = cl_im[i * 64 + p], br = bb_re[p * 16 + k], bi = bb_im[p * 16 + k];
          const float ur = cr * br - ci * bi, ui = cr * bi + ci * br;
#pragma unroll
          for (int mm = 0; mm < 8; ++mm) { const int m = mg * 8 + mm; s[mm] += ap_re[m * 64 + p] * ur - ap_im[m * 64 + p] * ui; } }
#pragma unroll
      for (int mm = 0; mm < 8; ++mm) { const int m = mg * 8 + mm; float v = s[mm]; if (m == 0 && i == k) v += dsk[g * 16 + i]; km[(m << 8) + (i << 4) + k] = v; } }
    __syncthreads();
    for (int idx = tid; idx < 32 * 384; idx += 512) { const int rr = part * 32 + idx / 384, cc = idx % 384, tau = rr >> 4, i = rr & 15; float v;
        if (cc < 256) { const int jj = cc >> 4, k = cc & 15; v = (jj <= tau) ? km[((tau - jj) << 8) + (i << 4) + k] : 0.f; }
        else { const int p = (cc - 256) & 63; const float cr = cl_re[i * 64 + p], ci = cl_im[i * 64 + p];
            const float ar = ap_re[(tau + 1) * 64 + p], ai = ap_im[(tau + 1) * 64 + p];
            v = (cc < 320) ? (cr * ar - ci * ai) : -(cr * ai + ci * ar); }
        TY[((size_t)g * 256 + rr) * 384 + cc] = f2bf(v); }
    for (int idx = tid; idx < 32 * 256; idx += 512) { const int rr = part * 32 + idx / 256, cc = idx % 256, jj = cc >> 4, k = cc & 15; float v = 0.f;
        if (rr < 128) { const int p = rr & 63; const float ar = ap_re[(15 - jj) * 64 + p], ai = ap_im[(15 - jj) * 64 + p], br = bb_re[p * 16 + k], bi = bb_im[p * 16 + k];
            v = (rr < 64) ? (ar * br - ai * bi) : (ar * bi + ai * br); }
        WST[((size_t)g * 256 + rr) * 256 + cc] = f2bf(v); }
    if (part == 0 && tid < 128) AQ[g * 128 + tid] = (tid < 64) ? ap_re[16 * 64 + tid] : ap_im[16 * 64 + (tid - 64)];
    __syncthreads();
}

__device__ __forceinline__ void x_prologue(const float* xin, float* X, bf16_t* XB, float* SS, int bid, int nb) {
    const int tid_ = tid_fresh(), wid = tid_ >> 6, lane = tid_ & 63;
    for (int row0 = (bid * 8 + wid) * 2; row0 < T_TOK; row0 += nb * 16) {
        f32x4 v[2][4];
#pragma unroll
        for (int r = 0; r < 2; ++r)
#pragma unroll
            for (int i = 0; i < 4; ++i) v[r][i] = *(const f32x4*)(xin + (size_t)(row0 + r) * DM + i * 256 + lane * 4);
#pragma unroll
        for (int r = 0; r < 2; ++r) { const int row = row0 + r; float ssq = 0.f;
#pragma unroll
            for (int i = 0; i < 4; ++i) { const size_t off = (size_t)row * DM + i * 256 + lane * 4; const f32x4 x = v[r][i];
                u32x2 w; w.x = pack_bf16(x[0], x[1]); w.y = pack_bf16(x[2], x[3]); *(u32x2*)(XB + off) = w; ssq += (x[0] * x[0] + x[1] * x[1]) + (x[2] * x[2] + x[3] * x[3]); }
            ssq = wave_allsum(ssq);
            if (lane < 16) SS[(size_t)row * 16 + lane] = (lane == 0) ? ssq : 0.f; }
    }
}
struct M2Params { const float* conv_w; const float* conv_b; const float* dt_bias; const float* a_log; const float* dskip; };
__device__ __forceinline__ void m2_scan(float* ST, const float* DEC, int e) {
    const int bh = e >> 12, pn = e & 4095; float he[32], dc[32];
#pragma unroll
    for (int seg = 0; seg < 32; ++seg) { he[seg] = ST[(size_t)(bh * 32 + seg) * 4096 + pn]; dc[seg] = DEC[bh * 32 + seg]; }
    float s = 0.f;
#pragma unroll
    for (int seg = 0; seg < 32; ++seg) { ST[(size_t)(bh * 32 + seg) * 4096 + pn] = s; s = dc[seg] * s + he[seg]; }
}

struct HgParams { const float* gamma0; const float* gamma1; const float* norm_g; int layer; };
__device__ __forceinline__ void hg_scan(float* ST, const float* DECK, int e) {
    const int bh = e >> 14, kv = e & 16383, k = kv >> 7; float se[32], dc[32];
#pragma unroll
    for (int seg = 0; seg < 32; ++seg) { se[seg] = ST[(size_t)(bh * 32 + seg) * 16384 + kv]; dc[seg] = DECK[(bh * 32 + seg) * 128 + k]; }
    float s = 0.f;
#pragma unroll
    for (int seg = 0; seg < 32; ++seg) { ST[(size_t)(bh * 32 + seg) * 16384 + kv] = s; s = dc[seg] * s + se[seg]; }
}

__device__ __forceinline__ void s5_scan(LAS unsigned char* lds, int bg, const float* SC, const float* AQ, bf16_t* U) {
    LAS float* Ere = (LAS float*)lds;
    LAS float* Eim = Ere + 512;
    const int tid = tid_fresh(), p = tid & 63, blk = __builtin_amdgcn_readfirstlane(tid >> 6), b = bg >> 5, g = bg & 31;
    const float ar = AQ[g * 128 + p], ai = AQ[g * 128 + 64 + p];
    const size_t row0 = (size_t)g * NCHUNK + b * 512 + blk * 64;
    const float* scb = SC + row0 * 128;
    float xr[32], xi[32];
    float er = 0.f, ei = 0.f, pr = 1.f, pi = 0.f;
#pragma unroll
    for (int hf = 0; hf < 2; ++hf) {
#pragma unroll
        for (int i0 = 0; i0 < 32; i0 += 8) { const float* pb = scb + (32 * hf + i0) * 128 + p; asm volatile("" : "+v"(pb));
#pragma unroll
            for (int i = 0; i < 8; ++i) { xr[i0 + i] = pb[i * 128]; xi[i0 + i] = pb[i * 128 + 64]; } }
        asm volatile("" ::: "memory");
#pragma unroll
        for (int i = 0; i < 32; ++i) { const float nr = ar * er - ai * ei + xr[i], ni = ar * ei + ai * er + xi[i]; er = nr; ei = ni; const float qr = ar * pr - ai * pi, qi = ar * pi + ai * pr; pr = qr; pi = qi; } }
    Ere[blk * 64 + p] = er; Eim[blk * 64 + p] = ei;
    __syncthreads();
    float sr = 0.f, si = 0.f;
    for (int bb = 0; bb < blk; ++bb) { const float nr = pr * sr - pi * si + Ere[bb * 64 + p], ni = pr * si + pi * sr + Eim[bb * 64 + p]; sr = nr; si = ni; }
#pragma unroll
    for (int hf = 0; hf < 2; ++hf) {
#pragma unroll
        for (int i0 = 0; i0 < 32; i0 += 8) { const float* pb = scb + (32 * hf + i0) * 128 + p; asm volatile("" : "+v"(pb));
#pragma unroll
            for (int i = 0; i < 8; ++i) { xr[i0 + i] = pb[i * 128]; xi[i0 + i] = pb[i * 128 + 64]; } }
        asm volatile("" ::: "memory");
#pragma unroll
        for (int i = 0; i < 32; ++i) { bf16_t* up = U + (row0 + 32 * hf + i) * U_LD + 256; up[p] = f2bf(sr); up[64 + p] = f2bf(si);
            const float nr = ar * sr - ai * si + xr[i], ni = ar * si + ai * sr + xi[i]; sr = nr; si = ni; } }
    __syncthreads();
}
__device__ __forceinline__ bf16x8 tr8(const LAS bf16_t* p, int second_off) {
    typedef short v4i16_t_ __attribute__((ext_vector_type(4)));
    const v4i16_t_ lo = __builtin_amdgcn_ds_read_tr16_b64_v4i16((LAS v4i16_t_*)p), hi = __builtin_amdgcn_ds_read_tr16_b64_v4i16((LAS v4i16_t_*)(p + second_off));
    return __builtin_shufflevector(lo, hi, 0, 1, 2, 3, 4, 5, 6, 7);
}
constexpr int HG_RS = 136;
constexpr int HG_TS = 160;

__device__ __forceinline__ void hg1_mfma(LAS unsigned char* lds, int item, const bf16_t* PA, float* ST, float* DECK, const HgParams P) {
    LAS bf16_t* Ke = (LAS bf16_t*)lds;
    LAS bf16_t* Vs = Ke + 128 * HG_TS;
    LAS float* tot = (LAS float*)(Vs + 128 * HG_TS);
    const int tid = tid_fresh(), k = tid & 127, part = tid >> 7, wid = __builtin_amdgcn_readfirstlane(tid >> 6), lane = tid & 63, hl = lane >> 5;
    const int b = item >> 7, hh = (item >> 5) & 3, seg = item & 31;
    const size_t t_base = (size_t)b * SEQ + seg * 256;
    const float lb = (P.layer == 0) ? 0.f : sigmoid_f(P.gamma1[hh * 128 + k] - P.gamma0[hh * 128 + k]);
    const bf16_t* fbase = PA + t_base * PA_LD + 1792 + hh * 128;
#define fcol(OFF) fbase[(unsigned)k + (unsigned)(OFF)]
    float fr[2][32];
#pragma unroll
    for (int bb = 0; bb < 2; ++bb)
#pragma unroll
        for (int i0 = 0; i0 < 32; i0 += 16) {
#pragma unroll
            for (int i = i0; i < i0 + 16; ++i) fr[bb][i] = bf2f(fcol((128 * bb + 32 * part + i) * PA_LD));
            asm volatile("" ::: "memory"); }
#pragma unroll
    for (int bb = 0; bb < 2; ++bb) { float s = 0.f;
#pragma unroll
        for (int i = 0; i < 32; ++i) { const float sg = sigmoid_f(fr[bb][i]); s += 0.6931471805599453f * __builtin_amdgcn_logf(lb + (1.0f - lb) * sg); }
        tot[(4 * bb + part) * 128 + k] = s; }
    __syncthreads();
    f32x16 acc[2];
#pragma unroll
    for (int r = 0; r < 16; ++r) { acc[0][r] = 0.f; acc[1][r] = 0.f; }
    const int kb = wid >> 1, vb0 = 2 * (wid & 1);
    const int troff = (8 * hl + ((lane & 15) >> 2)) * HG_TS + 16 * ((lane >> 4) & 1) + 4 * (lane & 3);
#pragma unroll
    for (int half = 0; half < 2; ++half) {
        { const int blk = 4 * half + part; float sfx = 0.f;
          for (int j = blk + 1; j < 8; ++j) sfx += tot[j * 128 + k];
          bf16_t vv[32];
#pragma unroll
          for (int i0 = 0; i0 < 32; i0 += 16) {
#pragma unroll
              for (int i = i0; i < i0 + 16; ++i) vv[i] = fcol((128 * half + 32 * part + i) * PA_LD + 512);
              asm volatile("" ::: "memory"); }
#pragma unroll
          for (int i = 31; i >= 0; --i) { const int sl = 32 * part + i; const float sg = sigmoid_f(fr[half][i]);
              Ke[sl * HG_TS + k] = f2bf((1.0f - lb) * (1.0f - sg) * fast_exp(sfx)); Vs[sl * HG_TS + k] = vv[i];
              sfx += 0.6931471805599453f * __builtin_amdgcn_logf(lb + (1.0f - lb) * sg); } }
        __syncthreads();
#pragma unroll
        for (int ks = 0; ks < 8; ++ks) {
            const bf16x8 a = tr8(Ke + ks * 16 * HG_TS + kb * 32 + troff, 4 * HG_TS);
            const bf16x8 b0 = tr8(Vs + ks * 16 * HG_TS + vb0 * 32 + troff, 4 * HG_TS), b1 = tr8(Vs + ks * 16 * HG_TS + vb0 * 32 + 32 + troff, 4 * HG_TS);
            acc[0] = __builtin_amdgcn_mfma_f32_32x32x16_bf16(a, b0, acc[0], 0, 0, 0); acc[1] = __builtin_amdgcn_mfma_f32_32x32x16_bf16(a, b1, acc[1], 0, 0, 0); }
        __syncthreads();
    }
    float* sp = ST + (size_t)item * 16384;
#pragma unroll
    for (int j = 0; j < 2; ++j)
#pragma unroll
        for (int r = 0; r < 16; ++r) sp[(kb * 32 + (r & 3) + 8 * (r >> 2) + 4 * hl) * 128 + (vb0 + j) * 32 + (lane & 31)] = acc[j][r];
    if (part == 0) { float s = 0.f; for (int j = 0; j < 8; ++j) s += tot[j * 128 + k]; DECK[item * 128 + k] = fast_exp(s); }
    __syncthreads();
#undef fcol
}

__device__ __forceinline__ void hg3_mfma(LAS unsigned char* lds, int item, bf16_t* PA, const float* ST, const HgParams P) {
    LAS bf16_t* Qd = (LAS bf16_t*)lds;
    LAS bf16_t* Kd = Qd + 32 * HG_RS;
    LAS bf16_t* Ke = Kd + 32 * HG_RS;
    LAS bf16_t* Vs = Ke + 32 * HG_TS;
    LAS bf16_t* At = Vs + 32 * HG_TS;
    LAS bf16_t* St = At + 32 * 40;
    LAS float* tot = (LAS float*)(St + 128 * HG_RS);
    LAS float* dk = tot + 512;
    LAS float* ssq = dk + 128;
    const int tid = tid_fresh(), k = tid & 127, part = tid >> 7, wid = __builtin_amdgcn_readfirstlane(tid >> 6), lane = tid & 63, hl = lane >> 5, lc = lane & 31;
    const int b = item >> 7, hh = (item >> 5) & 3, seg = item & 31;
    const size_t t_base = (size_t)b * SEQ + seg * 256;
    const float lb = (P.layer == 0) ? 0.f : sigmoid_f(P.gamma1[hh * 128 + k] - P.gamma0[hh * 128 + k]);
    const int kb = wid >> 1, vb0 = 2 * (wid & 1);
    const int troff = (8 * hl + ((lane & 15) >> 2)) * HG_TS + 16 * ((lane >> 4) & 1) + 4 * (lane & 3);
    f32x16 acc[2];
    { const float* sp = ST + (size_t)item * 16384;
#pragma unroll
      for (int j = 0; j < 2; ++j)
#pragma unroll
        for (int r = 0; r < 16; ++r) acc[j][r] = sp[(kb * 32 + (r & 3) + 8 * (r >> 2) + 4 * hl) * 128 + (vb0 + j) * 32 + lc]; }
    bf16_t rq[8], rf[8], ri[8];
#define HG3_LOAD(C) { const bf16_t* rp_ = PA + (t_base + (C) * 32 + 8 * part) * PA_LD + 1280 + hh * 128 + k; \
        _Pragma("unroll") for (int i = 0; i < 8; ++i) { rq[i] = rp_[(size_t)i * PA_LD]; rf[i] = rp_[(size_t)i * PA_LD + 512]; ri[i] = rp_[(size_t)i * PA_LD + 1024]; } }
    HG3_LOAD(0)
    f32x4 gnv[4];
#pragma unroll
    for (int g4 = 0; g4 < 4; ++g4) gnv[g4] = *(const f32x4*)(P.norm_g + hh * 128 + (wid & 3) * 32 + 8 * g4 + 4 * hl);
    for (int c = 0; c < 8; ++c) {
        const size_t t0 = t_base + c * 32;
        float qv[8], kv[8], cl[8]; bf16_t vv[8];
        { float run = 0.f;
#pragma unroll
          for (int i = 0; i < 8; ++i) { const float sg = sigmoid_f(bf2f(rf[i])); const float fg = lb + (1.0f - lb) * sg;
              run += 0.6931471805599453f * __builtin_amdgcn_logf(fg); cl[i] = run; kv[i] = (1.0f - lb) * (1.0f - sg); qv[i] = silu_f(bf2f(rq[i])); vv[i] = ri[i]; }
          tot[part * 128 + k] = run; }
        if (c + 1 < 8) HG3_LOAD(c + 1)
        u32x2 gwv[4];
        if (wid < 4) { const bf16_t* gp_ = PA + (t0 + lc) * PA_LD + 2816 + hh * 128 + wid * 32;
#pragma unroll
            for (int g4 = 0; g4 < 4; ++g4) gwv[g4] = *(const u32x2*)(gp_ + 8 * g4 + 4 * hl); }
        __syncthreads();
        { float off = 0.f, all = 0.f;
#pragma unroll
          for (int p = 0; p < 4; ++p) { const float tp = tot[p * 128 + k]; all += tp; if (p < part) off += tp; }
#pragma unroll
          for (int i = 0; i < 8; ++i) { const int t = 8 * part + i; const float cu = off + cl[i];
              Qd[t * HG_RS + k] = f2bf(qv[i] * fast_exp(cu)); Kd[t * HG_RS + k] = f2bf(kv[i] * fast_exp(-cu)); Ke[t * HG_TS + k] = f2bf(kv[i] * fast_exp(all - cu)); Vs[t * HG_TS + k] = vv[i]; }
          if (part == 0) dk[k] = fast_exp(all); }
#pragma unroll
        for (int j = 0; j < 2; ++j)
#pragma unroll
            for (int g4 = 0; g4 < 4; ++g4) { u32x2 w; w.x = pack_bf16(acc[j][4 * g4], acc[j][4 * g4 + 1]); w.y = pack_bf16(acc[j][4 * g4 + 2], acc[j][4 * g4 + 3]);
                *(LAS u32x2*)(St + ((vb0 + j) * 32 + lc) * HG_RS + kb * 32 + 8 * g4 + 4 * hl) = w; }
        __syncthreads();
        if (wid == 0) {
            f32x16 d;
#pragma unroll
            for (int r = 0; r < 16; ++r) d[r] = 0.f;
#pragma unroll
            for (int ks = 0; ks < 8; ++ks) { const bf16x8 a = *(const LAS bf16x8*)(Kd + lc * HG_RS + ks * 16 + 8 * hl), bq = *(const LAS bf16x8*)(Qd + lc * HG_RS + ks * 16 + 8 * hl);
                d = __builtin_amdgcn_mfma_f32_32x32x16_bf16(a, bq, d, 0, 0, 0); }
#pragma unroll
            for (int g4 = 0; g4 < 4; ++g4) { float e[4];
#pragma unroll
                for (int i = 0; i < 4; ++i) { const int s = 8 * g4 + 4 * hl + i; e[i] = (s <= lc) ? d[4 * g4 + i] : 0.f; }
                u32x2 w; w.x = pack_bf16(e[0], e[1]); w.y = pack_bf16(e[2], e[3]); *(LAS u32x2*)(At + lc * 40 + 8 * g4 + 4 * hl) = w; }
        }
        __syncthreads();
        f32x16 o;
        if (wid < 4) {
#pragma unroll
            for (int r = 0; r < 16; ++r) o[r] = 0.f;
#pragma unroll
            for (int ks = 0; ks < 2; ++ks) { const bf16x8 a = tr8(Vs + ks * 16 * HG_TS + wid * 32 + troff, 4 * HG_TS), bt = *(const LAS bf16x8*)(At + lc * 40 + ks * 16 + 8 * hl);
                o = __builtin_amdgcn_mfma_f32_32x32x16_bf16(a, bt, o, 0, 0, 0); }
#pragma unroll
            for (int ks = 0; ks < 8; ++ks) { const bf16x8 a = *(const LAS bf16x8*)(St + (wid * 32 + lc) * HG_RS + ks * 16 + 8 * hl), bq = *(const LAS bf16x8*)(Qd + lc * HG_RS + ks * 16 + 8 * hl);
                o = __builtin_amdgcn_mfma_f32_32x32x16_bf16(a, bq, o, 0, 0, 0); }
            float s2 = 0.f;
#pragma unroll
            for (int r = 0; r < 16; ++r) s2 += o[r] * o[r];
            s2 = sum32(s2); if (hl == 0) ssq[wid * 32 + lc] = s2;
        }
        { const f32x4* dp = (const f32x4*)0; (void)dp;
#pragma unroll
          for (int g4 = 0; g4 < 4; ++g4) { const f32x4 d4 = *(const LAS f32x4*)(dk + kb * 32 + 8 * g4 + 4 * hl);
#pragma unroll
              for (int i = 0; i < 4; ++i) { acc[0][4 * g4 + i] *= d4[i]; acc[1][4 * g4 + i] *= d4[i]; } }
#pragma unroll
          for (int ks = 0; ks < 2; ++ks) { const bf16x8 a = tr8(Ke + ks * 16 * HG_TS + kb * 32 + troff, 4 * HG_TS);
              const bf16x8 b0 = tr8(Vs + ks * 16 * HG_TS + vb0 * 32 + troff, 4 * HG_TS), b1 = tr8(Vs + ks * 16 * HG_TS + vb0 * 32 + 32 + troff, 4 * HG_TS);
              acc[0] = __builtin_amdgcn_mfma_f32_32x32x16_bf16(a, b0, acc[0], 0, 0, 0); acc[1] = __builtin_amdgcn_mfma_f32_32x32x16_bf16(a, b1, acc[1], 0, 0, 0); } }
        __syncthreads();
        if (wid < 4) {
            const float tq = (ssq[lc] + ssq[32 + lc]) + (ssq[64 + lc] + ssq[96 + lc]);
            const float rr = fast_rsq(tq * (1.0f / 128.0f) + NORM_EPS);
            bf16_t* gp = PA + (t0 + lc) * PA_LD + 2816 + hh * 128 + wid * 32;
#pragma unroll
            for (int g4 = 0; g4 < 4; ++g4) { const int v0 = 8 * g4 + 4 * hl; const u32x2 gw = gwv[g4]; const f32x4 gn = gnv[g4];
                const float y0 = o[4 * g4] * rr * gn[0] * sigmoid_f(bflo(gw.x)), y1 = o[4 * g4 + 1] * rr * gn[1] * sigmoid_f(bfhi(gw.x));
                const float y2 = o[4 * g4 + 2] * rr * gn[2] * sigmoid_f(bflo(gw.y)), y3 = o[4 * g4 + 3] * rr * gn[3] * sigmoid_f(bfhi(gw.y));
                u32x2 w; w.x = pack_bf16(y0, y1); w.y = pack_bf16(y2, y3); *(u32x2*)(gp + v0) = w; }
        }
    }
    __syncthreads();
#undef HG3_LOAD
}

constexpr int M2_TS = 96;
__device__ __forceinline__ void m2s1_mfma(LAS unsigned char* lds, int item, const bf16_t* PA, const float* MISCA, float* ST, float* DEC, const M2Params P) {
    LAS bf16_t* raw = (LAS bf16_t*)lds;
    LAS bf16_t* Xc = raw + 131 * 128;
    LAS bf16_t* Bw = Xc + 128 * M2_TS;
    LAS float* wsl = (LAS float*)(Bw + 128 * M2_TS);
    LAS float* wtot = wsl + 256;
    const int tid = tid_fresh(), wid = __builtin_amdgcn_readfirstlane(tid >> 6), lane = tid & 63, hl = lane >> 5;
    const int b = item >> 8, h = (item >> 5) & 7, seg = item & 31, grp = h >> 2;
    const int t_base = b * SEQ + seg * 256, tl_base = seg * 256;
    const float a_h = -fast_exp(P.a_log[h]), dtb = P.dt_bias[h];
    float dtv = 0.f, incl = 0.f;
    if (tid < 256) { dtv = softplus_f(MISCA[(size_t)(t_base + tid) * 8 + h] + dtb); incl = dtv;
#pragma unroll
        for (int o = 1; o < 64; o <<= 1) { const float t = __builtin_bit_cast(float, __builtin_amdgcn_ds_bpermute((lane - o) << 2, __builtin_bit_cast(int, incl))); if (lane >= o) incl += t; }
        if (lane == 63) wtot[wid] = incl; }
    __syncthreads();
    if (tid < 256) { float after = 0.f, all = 0.f;
#pragma unroll
        for (int w = 0; w < 4; ++w) { const float tw = wtot[w]; all += tw; if (w > wid) after += tw; }
        const float wave_tot = wtot[wid];
        wsl[tid] = dtv * fast_exp(a_h * (after + (wave_tot - incl)));
        if (tid == 0) DEC[item] = fast_exp(a_h * all); }
    f32x16 acc;
#pragma unroll
    for (int r = 0; r < 16; ++r) acc[r] = 0.f;
    const int nb_ = wid >> 1, pb_ = wid & 1;
    const int troff = (8 * hl + ((lane & 15) >> 2)) * M2_TS + 16 * ((lane >> 4) & 1) + 4 * (lane & 3);
    for (int half = 0; half < 2; ++half) {
        const int t0 = t_base + half * 128, tl0 = tl_base + half * 128;
        for (int idx = tid; idx < 131 * 16; idx += 512) { const int r = idx >> 4, piece = idx & 15, arr = piece >> 3, pc = piece & 7;
            const int col = (arr == 0 ? 512 + h * 64 : 1024 + grp * 64) + pc * 8;
            u32x4 v = {0u, 0u, 0u, 0u}; if (tl0 - 3 + r >= 0) v = *(const u32x4*)(PA + (size_t)(t0 - 3 + r) * PA_LD + col);
            *(LAS u32x4*)(raw + r * 128 + arr * 64 + pc * 8) = v; }
        __syncthreads();
        { const int g4 = tid & 31, run = tid >> 5, ch0 = 4 * g4, arr = ch0 >> 6, cc0 = ch0 & 63;
          const int cbase = (arr == 0 ? h * 64 : 512 + grp * 64) + cc0;
          f32x4 wt[5];
#pragma unroll
          for (int w = 0; w < 4; ++w) wt[w] = *(const f32x4*)(P.conv_w + w * 768 + cbase);
          wt[4] = *(const f32x4*)(P.conv_b + cbase);
          f32x4 xr[11];
#pragma unroll
          for (int r = 0; r < 11; ++r) { const u32x2 u = *(const LAS u32x2*)(raw + (8 * run + r) * 128 + ch0); xr[r] = (f32x4){bflo(u.x), bfhi(u.x), bflo(u.y), bfhi(u.y)}; }
#pragma unroll
          for (int i = 0; i < 8; ++i) { const int tl = 8 * run + i; f32x4 a = wt[4];
#pragma unroll
              for (int w = 0; w < 4; ++w) a = a + wt[w] * xr[i + w];
              const float sc = (arr == 0) ? 1.0f : wsl[half * 128 + tl];
#pragma unroll
              for (int e = 0; e < 4; ++e) a[e] = silu_f(a[e]) * sc;
              u32x2 o; o.x = pack_bf16(a[0], a[1]); o.y = pack_bf16(a[2], a[3]);
              if (arr == 0) *(LAS u32x2*)(Xc + tl * M2_TS + cc0) = o; else *(LAS u32x2*)(Bw + tl * M2_TS + cc0) = o; } }
        __syncthreads();
        if (wid < 4) {
#pragma unroll
            for (int ks = 0; ks < 8; ++ks) { const bf16x8 a = tr8(Bw + ks * 16 * M2_TS + nb_ * 32 + troff, 4 * M2_TS), bx = tr8(Xc + ks * 16 * M2_TS + pb_ * 32 + troff, 4 * M2_TS);
                acc = __builtin_amdgcn_mfma_f32_32x32x16_bf16(a, bx, acc, 0, 0, 0); } }
        __syncthreads();
    }
    if (wid < 4) { float* sp = ST + (size_t)item * 4096 + (pb_ * 32 + (lane & 31)) * 64 + nb_ * 32 + 4 * hl;
#pragma unroll
        for (int g4 = 0; g4 < 4; ++g4) { f32x4 v = {acc[4 * g4], acc[4 * g4 + 1], acc[4 * g4 + 2], acc[4 * g4 + 3]}; *(f32x4*)(sp + 8 * g4) = v; } }
}

__device__ __forceinline__ void m2s3_mfma(LAS unsigned char* lds, int item, bf16_t* PA, const float* MISCA, const float* ST, float* SSA, const M2Params P) {
    LAS bf16_t* raw = (LAS bf16_t*)lds;
    LAS bf16_t* Xc = raw + 67 * 256;
    LAS bf16_t* Bw = Xc + 64 * 96;
    LAS bf16_t* Bc = Bw + 64 * 96;
    LAS bf16_t* Cc = Bc + 64 * 72;
    LAS bf16_t* Cd = Cc + 64 * 72;
    LAS bf16_t* Sm = Cd + 64 * 72;
    LAS bf16_t* Hs = Sm + 64 * 72;
    LAS float* cwl = (LAS float*)(Hs + 64 * 72);
    LAS float* dtl = cwl + 5 * 192;
    LAS float* acl = dtl + 64;
    LAS float* ssq = acl + 64;
    const int tid = tid_fresh(), wid = __builtin_amdgcn_readfirstlane(tid >> 6), lane = tid & 63, hl = lane >> 5, lc = lane & 31;
    const int b = item >> 8, h = (item >> 5) & 7, seg = item & 31, grp = h >> 2;
    const int t_base = b * SEQ + seg * 256, tl_base = seg * 256;
    const float a_h = -fast_exp(P.a_log[h]), dtb = P.dt_bias[h], dsk = P.dskip[h];
    for (int i = tid; i < 5 * 192; i += 512) { const int w = i / 192, c = i % 192; const int cc = (c < 64) ? h * 64 + c : (c < 128) ? 512 + grp * 64 + (c - 64) : 640 + grp * 64 + (c - 128);
        cwl[i] = (w < 4) ? P.conv_w[w * 768 + cc] : P.conv_b[cc]; }
    const int w4 = wid & 3, nb_ = w4 >> 1, pb_ = w4 & 1;
    const int troff = (8 * hl + ((lane & 15) >> 2)) * 96 + 16 * ((lane >> 4) & 1) + 4 * (lane & 3);
    f32x16 hacc;
#pragma unroll
    for (int r = 0; r < 16; ++r) hacc[r] = 0.f;
    if (wid >= 4) { const float* sp = ST + (size_t)item * 4096 + (pb_ * 32 + lc) * 64 + nb_ * 32 + 4 * hl;
#pragma unroll
        for (int g4 = 0; g4 < 4; ++g4) { const f32x4 v = *(const f32x4*)(sp + 8 * g4); hacc[4 * g4] = v[0]; hacc[4 * g4 + 1] = v[1]; hacc[4 * g4 + 2] = v[2]; hacc[4 * g4 + 3] = v[3]; } }
    u32x4 rv[5]; float dtraw;
#define M2S3_LOAD(C) { const int t0_ = t_base + (C) * 64, tl0_ = tl_base + (C) * 64; \
        _Pragma("unroll") for (int q = 0; q < 5; ++q) { const int idx = tid + 512 * q; rv[q] = (u32x4){0u, 0u, 0u, 0u}; \
            if (idx < 67 * 32) { const int r = idx >> 5, piece = idx & 31, arr = piece >> 3, pc = piece & 7; \
                const int col = (arr == 0 ? 512 + h * 64 : arr == 1 ? 1024 + grp * 64 : arr == 2 ? 1152 + grp * 64 : h * 64) + pc * 8; \
                if (tl0_ - 3 + r >= 0) rv[q] = *(const u32x4*)(PA + (size_t)(t0_ - 3 + r) * PA_LD + col); } } \
        dtraw = (wid == 0) ? MISCA[(size_t)(t0_ + lane) * 8 + h] : 0.f; }
    M2S3_LOAD(0)
    for (int c = 0; c < 4; ++c) {
        const int t0 = t_base + c * 64;
#pragma unroll
        for (int q = 0; q < 5; ++q) { const int idx = tid + 512 * q; if (idx < 67 * 32) { const int r = idx >> 5, piece = idx & 31; *(LAS u32x4*)(raw + r * 256 + (piece >> 3) * 64 + (piece & 7) * 8) = rv[q]; } }
        const float dtraw_c = dtraw;
        if (c + 1 < 4) M2S3_LOAD(c + 1)
        if (wid == 0) { const float dtv = softplus_f(dtraw_c + dtb); float incl = dtv * a_h;
#pragma unroll
            for (int o = 1; o < 64; o <<= 1) { const float t = __builtin_bit_cast(float, __builtin_amdgcn_ds_bpermute((lane - o) << 2, __builtin_bit_cast(int, incl))); if (lane >= o) incl += t; }
            dtl[lane] = dtv; acl[lane] = incl; }
        __syncthreads();
        { const float ac63 = acl[63];
          if (tid < 384) {
            const int g4 = tid % 48, run = tid / 48, ch0 = 4 * g4, arr = ch0 >> 6, cc0 = ch0 & 63;
            f32x4 wt[5];
#pragma unroll
            for (int w = 0; w < 5; ++w) wt[w] = *(const LAS f32x4*)(cwl + w * 192 + ch0);
            f32x4 xr[11];
#pragma unroll
            for (int r = 0; r < 11; ++r) { const u32x2 u = *(const LAS u32x2*)(raw + (8 * run + r) * 256 + ch0); xr[r] = (f32x4){bflo(u.x), bfhi(u.x), bflo(u.y), bfhi(u.y)}; }
            const f32x4 ac0 = *(const LAS f32x4*)(acl + 8 * run), ac1 = *(const LAS f32x4*)(acl + 8 * run + 4), dt0 = *(const LAS f32x4*)(dtl + 8 * run), dt1 = *(const LAS f32x4*)(dtl + 8 * run + 4);
#pragma unroll
            for (int i = 0; i < 8; ++i) { const int s = 8 * run + i; f32x4 a = wt[4];
#pragma unroll
                for (int w = 0; w < 4; ++w) a = a + wt[w] * xr[i + w];
#pragma unroll
                for (int e = 0; e < 4; ++e) a[e] = silu_f(a[e]);
                u32x2 o; o.x = pack_bf16(a[0], a[1]); o.y = pack_bf16(a[2], a[3]);
                if (arr == 0) *(LAS u32x2*)(Xc + s * 96 + cc0) = o;
                else { const float acs = i < 4 ? ac0[i & 3] : ac1[i & 3], dts = i < 4 ? dt0[i & 3] : dt1[i & 3];
                    const float sc = (arr == 1) ? dts * fast_exp(ac63 - acs) : fast_exp(acs);
                    u32x2 o2; o2.x = pack_bf16(a[0] * sc, a[1] * sc); o2.y = pack_bf16(a[2] * sc, a[3] * sc);
                    if (arr == 1) { *(LAS u32x2*)(Bc + s * 72 + cc0) = o; *(LAS u32x2*)(Bw + s * 96 + cc0) = o2; }
                    else { *(LAS u32x2*)(Cc + s * 72 + cc0) = o; *(LAS u32x2*)(Cd + s * 72 + cc0) = o2; } } } }
          if (wid >= 4) {
#pragma unroll
            for (int g4 = 0; g4 < 4; ++g4) { u32x2 w; w.x = pack_bf16(hacc[4 * g4], hacc[4 * g4 + 1]); w.y = pack_bf16(hacc[4 * g4 + 2], hacc[4 * g4 + 3]);
                *(LAS u32x2*)(Hs + (pb_ * 32 + lc) * 72 + nb_ * 32 + 8 * g4 + 4 * hl) = w; }
            const float dch = fast_exp(ac63);
#pragma unroll
            for (int r = 0; r < 16; ++r) hacc[r] *= dch; } }
        __syncthreads();
        if (wid < 3) {
            const int sb = wid >> 1, tb = (wid + 1) >> 1; f32x16 d;
#pragma unroll
            for (int r = 0; r < 16; ++r) d[r] = 0.f;
#pragma unroll
            for (int ks = 0; ks < 4; ++ks) { const bf16x8 a = *(const LAS bf16x8*)(Bc + (sb * 32 + lc) * 72 + ks * 16 + 8 * hl), bq = *(const LAS bf16x8*)(Cc + (tb * 32 + lc) * 72 + ks * 16 + 8 * hl);
                d = __builtin_amdgcn_mfma_f32_32x32x16_bf16(a, bq, d, 0, 0, 0); }
            const int t = tb * 32 + lc; const float act = acl[t];
#pragma unroll
            for (int g4 = 0; g4 < 4; ++g4) { float e[4];
#pragma unroll
                for (int i = 0; i < 4; ++i) { const int s = sb * 32 + 8 * g4 + 4 * hl + i; e[i] = (s <= t) ? d[4 * g4 + i] * dtl[s] * fast_exp(act - acl[s]) : 0.f; }
                u32x2 w; w.x = pack_bf16(e[0], e[1]); w.y = pack_bf16(e[2], e[3]); *(LAS u32x2*)(Sm + t * 72 + sb * 32 + 8 * g4 + 4 * hl) = w; }
        } else if (wid == 3) {
            const u32x2 z2 = {0u, 0u};
#pragma unroll
            for (int g4 = 0; g4 < 4; ++g4) *(LAS u32x2*)(Sm + lc * 72 + 32 + 8 * g4 + 4 * hl) = z2;
        } else {
#pragma unroll
            for (int ks = 0; ks < 4; ++ks) { const bf16x8 a = tr8(Bw + ks * 16 * 96 + nb_ * 32 + troff, 4 * 96), bx = tr8(Xc + ks * 16 * 96 + pb_ * 32 + troff, 4 * 96);
                hacc = __builtin_amdgcn_mfma_f32_32x32x16_bf16(a, bx, hacc, 0, 0, 0); }
        }
        __syncthreads();
        if (wid < 4) {
            const int pb = wid >> 1, tb = wid & 1, t = tb * 32 + lc; f32x16 y;
#pragma unroll
            for (int r = 0; r < 16; ++r) y[r] = 0.f;
#pragma unroll
            for (int ks = 0; ks < 4; ++ks) { const bf16x8 a = tr8(Xc + ks * 16 * 96 + pb * 32 + troff, 4 * 96), bs = *(const LAS bf16x8*)(Sm + t * 72 + ks * 16 + 8 * hl);
                y = __builtin_amdgcn_mfma_f32_32x32x16_bf16(a, bs, y, 0, 0, 0); }
#pragma unroll
            for (int ks = 0; ks < 4; ++ks) { const bf16x8 a = *(const LAS bf16x8*)(Hs + (pb * 32 + lc) * 72 + ks * 16 + 8 * hl), bc = *(const LAS bf16x8*)(Cd + t * 72 + ks * 16 + 8 * hl);
                y = __builtin_amdgcn_mfma_f32_32x32x16_bf16(a, bc, y, 0, 0, 0); }
            float s2 = 0.f; bf16_t* yp = PA + (size_t)(t0 + t) * PA_LD + h * 64 + pb * 32;
#pragma unroll
            for (int g4 = 0; g4 < 4; ++g4) { const int p0 = 8 * g4 + 4 * hl; float o[4];
#pragma unroll
                for (int i = 0; i < 4; ++i) { const int p = pb * 32 + p0 + i; o[i] = (y[4 * g4 + i] + dsk * bf2f(Xc[t * 96 + p])) * silu_f(bf2f(raw[(t + 3) * 256 + 192 + p])); s2 += o[i] * o[i]; }
                u32x2 w; w.x = pack_bf16(o[0], o[1]); w.y = pack_bf16(o[2], o[3]); *(u32x2*)(yp + p0) = w; }
            s2 = sum32(s2); if (hl == 0) ssq[pb * 64 + t] = s2;
        }
        __syncthreads();
        if (tid < 64) SSA[(size_t)(t0 + tid) * 8 + h] = ssq[tid] + ssq[64 + tid];
    }
    __syncthreads();
}
__device__ __forceinline__ void dsa_prep(bf16_t* PB, const int* positions, const float* qn, const float* kn, int bid, int nb) {
    const int tid_ = tid_fresh(), wid = tid_ >> 6, lane = tid_ & 63, j = lane & 31, half = lane >> 5;
    const float inv_freq = fast_exp2(-(float)j * (13.287712379549449f / 32.0f));
    for (int tok = bid * 8 + wid; tok < T_TOK; tok += nb * 8) {
        const float ang = (float)positions[tok] * inv_freq; float sn, cs; sincos_rev(ang, sn, cs);
#pragma unroll
        for (int i = 4; i < 8; ++i) { const int vec = 2 * i + half; const bool isq = vec < 8;
            bf16_t* p = PB + (size_t)tok * PB_LD + (isq ? vec * 64 : 512 + (vec - 8) * 64);
            const float x1 = bf2f(p[j]), x2 = bf2f(p[j + 32]); float ss = x1 * x1 + x2 * x2;
            ss = sum_lo32(ss);
            const float r = fast_rsq(ss * (1.0f / 64.0f) + NORM_EPS); const float* gn = isq ? qn : kn;
            const float y1 = x1 * r * gn[j], y2 = x2 * r * gn[j + 32];
            float o1 = y1 * cs - y2 * sn, o2 = y2 * cs + y1 * sn;
            if (isq) { o1 *= 0.125f * 1.4426950408889634f; o2 *= 0.125f * 1.4426950408889634f; }
            p[j] = f2bf(o1); p[j + 32] = f2bf(o2); }
    }
}

constexpr int HS = 1028;
#ifndef TK_PROBE
#define TK_PROBE 0
#endif
#ifndef TK_FORCE_FAST
#define TK_FORCE_FAST 0
#endif
constexpr int TK_SS = 3;
constexpr int TK_CAP = 640, TK_NR = 10;
constexpr int TK_SCO = 0, TK_IDX = 32 * TK_CAP * 4, TK_MASKL = TK_IDX + 32 * TK_CAP * 2, TK_ARR = TK_MASKL + 32 * 256 * 4;
__device__ __forceinline__ float relu_i(float x) { const int i = __builtin_bit_cast(int, x); return __builtin_bit_cast(float, i > 0 ? i : 0); }
__device__ __forceinline__ unsigned sk20_of(float s) { const int u = __builtin_bit_cast(int, s + 0.0f); return ((unsigned)u ^ ((unsigned)(u >> 31) | 0x80000000u)) >> 12; }
__device__ __forceinline__ unsigned fine_bin(float s) { const unsigned u = __float_as_uint(s + 0.0f); const int v = (int)((u >> 19) & 0xfffu) - (96 << 4);
    const int t = (v < -1 ? -1 : (v > 1022 ? 1022 : v)) + 1; return (u >> 31) ? (unsigned)(1023 - t) : (unsigned)(1024 + t); }
__device__ __forceinline__ void idx_load(const bf16_t* KIBb, int key0, int lane, bf16x8 (&kf)[4]) {
    const bf16_t* kp = KIBb + (size_t)(key0 + (lane & 31)) * 64 + 8 * (lane >> 5);
#pragma unroll
    for (int ks = 0; ks < 4; ++ks) kf[ks] = *(const bf16x8*)(kp + ks * 16);
}
__device__ __forceinline__ void idx_load_sample(const bf16_t* KIBb, int j, int lane, bf16x8 (&kf)[4]) {
    const bf16_t* kp = KIBb + (size_t)(TK_SS * (32 * j + (lane & 31)) + TK_SS - 1) * 64 + 8 * (lane >> 5);
#pragma unroll
    for (int ks = 0; ks < 4; ++ks) kf[ks] = *(const bf16x8*)(kp + ks * 16);
}
__device__ __forceinline__ void idx_scores(const bf16x8 (&kf)[4], const bf16x8 (&qf)[4][4], const float (&wsc)[4], float (&sc)[16]) {
    f32x16 d[4];
#pragma unroll
    for (int hd = 0; hd < 4; ++hd)
#pragma unroll
        for (int r = 0; r < 16; ++r) d[hd][r] = 0.f;
    __builtin_amdgcn_s_setprio(1);
#pragma unroll
    for (int ks = 0; ks < 4; ++ks)
#pragma unroll
        for (int hd = 0; hd < 4; ++hd) d[hd] = __builtin_amdgcn_mfma_f32_32x32x16_bf16(kf[ks], qf[hd][ks], d[hd], 0, 0, 0);
    __builtin_amdgcn_s_setprio(0);
#pragma unroll
    for (int r = 0; r < 16; ++r) { float s = wsc[0] * relu_i(d[0][r]); s += wsc[1] * relu_i(d[1][r]); s += wsc[2] * relu_i(d[2][r]); s += wsc[3] * relu_i(d[3][r]); sc[r] = s; }
}
__device__ __forceinline__ void tk_boundary(const LAS unsigned* hrow, unsigned need, int lane, unsigned& bb, unsigned& above, unsigned& inbin) {
    unsigned wv[16]; unsigned s = 0;
#pragma unroll
    for (int i = 0; i < 4; ++i) { const u32x4 q = *(const LAS u32x4*)(hrow + 1008 - 16 * lane + 4 * i); wv[4 * i] = q.x; wv[4 * i + 1] = q.y; wv[4 * i + 2] = q.z; wv[4 * i + 3] = q.w; }
#pragma unroll
    for (int i = 0; i < 16; ++i) s += (wv[i] & 0xffffu) + (wv[i] >> 16);
    unsigned pre = s;
#pragma unroll
    for (int o = 1; o < 64; o <<= 1) { const unsigned t = (unsigned)__builtin_amdgcn_ds_bpermute((lane - o) << 2, (int)pre); if (lane >= o) pre += t; }
    const unsigned long long bal = __ballot(pre >= need);
    const int lstar = bal ? (int)__builtin_ctzll(bal) : 63;
    unsigned cum = pre - s, rb = 0, ra = cum, rc = 0; bool found = false;
#pragma unroll
    for (int i = 31; i >= 0; --i) { const unsigned w = wv[i >> 1], c = (i & 1) ? (w >> 16) : (w & 0xffffu);
        const bool hit = !found && (cum + c >= need); if (hit) { rb = (unsigned)(2016 - 32 * lane + i); ra = cum; rc = c; } found = found || hit; cum += c; }
    bb = (unsigned)__builtin_amdgcn_readlane((int)rb, lstar); above = (unsigned)__builtin_amdgcn_readlane((int)ra, lstar); inbin = (unsigned)__builtin_amdgcn_readlane((int)rc, lstar);
}
__device__ __forceinline__ void tk_bracket(const LAS unsigned* hrow, unsigned needLo, unsigned needHi, int lane, unsigned& bLo, unsigned& bHi) {
    unsigned wv[16]; unsigned s = 0;
#pragma unroll
    for (int i = 0; i < 4; ++i) { const u32x4 q = *(const LAS u32x4*)(hrow + 1008 - 16 * lane + 4 * i); wv[4 * i] = q.x; wv[4 * i + 1] = q.y; wv[4 * i + 2] = q.z; wv[4 * i + 3] = q.w; }
#pragma unroll
    for (int i = 0; i < 16; ++i) s += (wv[i] & 0xffffu) + (wv[i] >> 16);
    unsigned pre = s;
#pragma unroll
    for (int o = 1; o < 64; o <<= 1) { const unsigned t = (unsigned)__builtin_amdgcn_ds_bpermute((lane - o) << 2, (int)pre); if (lane >= o) pre += t; }
    unsigned cum = pre - s, rl = 0, rh = 0; bool fl = false, fh = false;
#pragma unroll
    for (int i = 31; i >= 0; --i) { const unsigned w = wv[i >> 1], c = (i & 1) ? (w >> 16) : (w & 0xffffu);
        const unsigned b = (unsigned)(2016 - 32 * lane + i);
        if (!fl && cum + c >= needLo) { rl = b; fl = true; }
        if (!fh && cum + c >= needHi) { rh = b; fh = true; }
        cum += c; }
    const unsigned long long balL = __ballot(pre >= needLo), balH = __ballot(pre >= needHi);
    bLo = (unsigned)__builtin_amdgcn_readlane((int)rl, balL ? (int)__builtin_ctzll(balL) : 63);
    bHi = needHi ? (unsigned)__builtin_amdgcn_readlane((int)rh, balH ? (int)__builtin_ctzll(balH) : 63) : 2047u;
}
__device__ __forceinline__ float fine_edge(unsigned B) {
    if (B >= 2048u) return __builtin_inff();
    if (B >= 1025u) return __uint_as_float((B - 1025u + (96u << 4)) << 19);
    if (B == 1024u) return 0.0f;
    return -__uint_as_float(((1023u - B + (96u << 4)) << 19) - 1u);
}
__device__ __forceinline__ unsigned skey_of(float s) { const int u = __builtin_bit_cast(int, s + 0.0f); return (unsigned)u ^ ((unsigned)(u >> 31) | 0x80000000u); }

template <int NR> __device__ __forceinline__ void tk_select(const LAS unsigned* lq, LAS unsigned* mq, unsigned n, unsigned need, int lane) {
    unsigned cv[NR]; bool vd[NR];
#pragma unroll
    for (int i = 0; i < NR; ++i) { const unsigned p = (unsigned)(i * 64 + lane); vd[i] = p < n; cv[i] = vd[i] ? lq[p] : 0u; }
    unsigned T = 0u;
#pragma unroll 1
    for (int bit = 31; bit >= 0; --bit) { const unsigned cand = T | (1u << bit); unsigned c = 0;
#pragma unroll
        for (int i = 0; i < NR; ++i) c += (unsigned)__builtin_popcountll(__ballot(vd[i] && cv[i] >= cand));
        if (c >= need) T = cand; }
#pragma unroll
    for (int i = 0; i < NR; ++i) if (vd[i] && cv[i] >= T) { const unsigned key = 8191u - (cv[i] & 8191u);
        __hip_atomic_fetch_or(mq + (key >> 5), 1u << (key & 31u), __ATOMIC_RELAXED, __HIP_MEMORY_SCOPE_WORKGROUP); }
}
template <int NR> __device__ __forceinline__ void tk_pick(const LAS unsigned* sq, const LAS unsigned short* iq, LAS unsigned* mq, unsigned n, unsigned nz, unsigned need, unsigned T0, int bit0, int lane, unsigned& zsel) {
    unsigned cs[NR], ck[NR];
#pragma unroll
    for (int i = 0; i < NR; ++i) { const unsigned p = (unsigned)(i * 64 + lane); cs[i] = 0u; ck[i] = 0u;
        if (p < n) { cs[i] = skey_of(__builtin_bit_cast(float, sq[p])); ck[i] = (unsigned)iq[p]; } }
    unsigned T = T0; bool exact = false;
#pragma unroll 1
    for (int bit = bit0; bit >= 0; --bit) { const unsigned cand = T | (1u << bit); unsigned c = cand <= 0x80000000u ? nz : 0u;
#pragma unroll
        for (int i = 0; i < NR; ++i) c += (unsigned)__builtin_popcountll(__ballot(cs[i] >= cand));
        if (c >= need) { T = cand; if (c == need) { exact = true; break; } } }
    unsigned U = 0u, zs = T <= 0x80000000u ? nz : 0u;
    if (!exact) {
        unsigned cgt = T < 0x80000000u ? nz : 0u, ceq = 0;
#pragma unroll
        for (int i = 0; i < NR; ++i) { cgt += (unsigned)__builtin_popcountll(__ballot(cs[i] > T)); ceq += (unsigned)__builtin_popcountll(__ballot(cs[i] == T)); }
        const unsigned need_eq = need - cgt;
        if (T == 0x80000000u) zs = need_eq;
        else if (need_eq < ceq) {
#pragma unroll 1
            for (int bit = 12; bit >= 0; --bit) { const unsigned cand = U | (1u << bit); unsigned c = 0;
#pragma unroll
                for (int i = 0; i < NR; ++i) c += (unsigned)__builtin_popcountll(__ballot(cs[i] == T && 8191u - ck[i] >= cand));
                if (c >= need_eq) U = cand; } } }
#pragma unroll
    for (int i = 0; i < NR; ++i) if (cs[i] > T || (cs[i] == T && 8191u - ck[i] >= U))
        __hip_atomic_fetch_or(mq + (ck[i] >> 5), 1u << (ck[i] & 31u), __ATOMIC_RELAXED, __HIP_MEMORY_SCOPE_WORKGROUP);
    zsel = zs;
}
__device__ __forceinline__ void dsa_topk_tile(LAS unsigned char* lds, int b, int qt, const bf16_t* PB, const bf16_t* KIB, const float* WI, unsigned* MASK, unsigned* ZM, int abl) {
    LAS unsigned* hist = (LAS unsigned*)lds;
    LAS unsigned* sco = (LAS unsigned*)(lds + TK_SCO);
    LAS unsigned short* cidx = (LAS unsigned short*)(lds + TK_IDX);
    LAS unsigned* maskl = (LAS unsigned*)(lds + TK_MASKL);
    LAS unsigned* B1 = (LAS unsigned*)(lds + TK_ARR);
    LAS unsigned* NEED = B1 + 32;
    LAS unsigned* CNT = NEED + 32;
    LAS unsigned* FLAG = CNT + 32;
    LAS unsigned* NHI = B1 + 256;
    LAS float* TLO = (LAS float*)(B1 + 288);
    LAS float* THI = (LAS float*)(B1 + 320);
    LAS unsigned* NZ = B1 + 352;
    const int tid = tid_fresh(), wid = __builtin_amdgcn_readfirstlane(tid >> 6), lane = tid & 63, qc = lane & 31, hl = lane >> 5;
    const int ql = qt * 32 + qc; const size_t row = (size_t)b * SEQ + ql;
    const bf16_t* KIBb = KIB + (size_t)b * SEQ * 64;
    const int nkt = qt + 1;
    if (qt < 8) {
        for (int kt = wid; kt < nkt; kt += 8) { unsigned word = 0u;
#pragma unroll
            for (int r = 0; r < 16; ++r) { const int rho = (r & 3) + 8 * (r >> 2) + 4 * hl; word |= ((kt * 32 + rho <= ql) ? 1u : 0u) << rho; }
            word = or32(word); if (hl == 0) MASK[row * 256 + kt] = word; }
        return;
    }
    bf16x8 qf[4][4]; float wsc[4];
    { const f32x4 wv = *(const f32x4*)(WI + row * 4);
#pragma unroll
      for (int hd = 0; hd < 4; ++hd) { wsc[hd] = wv[hd] * 0.0625f;
#pragma unroll
        for (int ks = 0; ks < 4; ++ks) qf[hd][ks] = *(const bf16x8*)(PB + row * PB_LD + 1536 + hd * 64 + ks * 16 + 8 * hl); } }
    {
      if (tid == 0) FLAG[0] = 0u;
      if (qt < 16) {
        if (tid < 32) { TLO[tid] = -__builtin_inff(); THI[tid] = __builtin_inff(); CNT[tid] = 0u; NHI[tid] = 0u; NZ[tid] = 0u; }
      } else {
        for (int i = tid; i < 32 * HS; i += 512) hist[i] = 0u;
        __syncthreads();
        const int ns = qt / TK_SS;
        if (wid < ns) {
            bf16x8 kf[4], kn[4]; idx_load_sample(KIBb, wid, lane, kf);
#pragma unroll 1
            for (int j = wid; j < ns; j += 8) {
                const int jn = j + 8 < ns ? j + 8 : j; idx_load_sample(KIBb, jn, lane, kn);
                float sc[16]; idx_scores(kf, qf, wsc, sc);
#pragma unroll
                for (int r = 0; r < 16; ++r) { const unsigned bin = fine_bin(sc[r]);
                    __hip_atomic_fetch_add(hist + qc * HS + (bin >> 1), 1u << (16 * (bin & 1u)), __ATOMIC_RELAXED, __HIP_MEMORY_SCOPE_WORKGROUP); }
#pragma unroll
                for (int ks = 0; ks < 4; ++ks) kf[ks] = kn[ks]; } }
        __syncthreads();
        if (abl & 1) return;
#pragma unroll 1
        for (int qq = 0; qq < 4; ++qq) { const int q = wid * 4 + qq;
            const float nsf = (float)(32 * ns), f = nsf * fast_rcp((float)(qt * 32 + q + 1)), m = 256.0f * f, sd5 = 5.3f * __builtin_amdgcn_sqrtf(m * (1.0f - f));
            const unsigned k_lo = (unsigned)(m + sd5) + 2u; const int k_hi = (int)(m - sd5) - 1;
            unsigned blo, bhi; tk_bracket(hist + q * HS, k_lo, k_hi >= 1 ? (unsigned)k_hi : 0u, lane, blo, bhi);
            if (lane == 0) { TLO[q] = blo <= 1u ? -__builtin_inff() : fine_edge(blo); THI[q] = fine_edge(bhi + 1u); CNT[q] = 0u; NHI[q] = 0u; NZ[q] = 0u;
                if (k_lo >= (unsigned)(32 * ns)) FLAG[0] = 1u; } }
      }
        __syncthreads();
        const bool bad = FLAG[0] != 0u;
        const float th_lo = TLO[qc], th_hi = THI[qc];
        __syncthreads();
        if (!bad) {
            unsigned nhi = 0u, nzl = 0u;
            const unsigned srow = (unsigned)(TK_SCO + qc * TK_CAP * 4), irow = (unsigned)(TK_IDX + qc * TK_CAP * 2);
            { bf16x8 kf[4], kn[4]; idx_load(KIBb, wid * 32, lane, kf);
#pragma unroll 1
              for (int kt = wid; kt < nkt; kt += 8) {
                const int ktn = kt + 8 < nkt ? kt + 8 : kt; idx_load(KIBb, ktn * 32, lane, kn);
                float sc[16]; idx_scores(kf, qf, wsc, sc);
                if (kt == qt) {
#pragma unroll
                    for (int r = 0; r < 16; ++r) if ((r & 3) + 8 * (r >> 2) + 4 * hl > qc) sc[r] = __builtin_nanf(""); }
                unsigned word = 0u, cm = 0u, zw = 0u;
#pragma unroll
                for (int r = 0; r < 16; ++r) { const float s = sc[r]; const unsigned hi = s >= th_hi ? 1u : 0u, lo = s >= th_lo ? 1u : 0u, z = s == 0.0f ? 1u : 0u;
                    word |= hi << ((r & 3) + 8 * (r >> 2)); zw |= (lo & ~hi & z) << ((r & 3) + 8 * (r >> 2)); cm |= (lo & ~hi & ~z) << r; }
                nhi += (unsigned)__builtin_popcount(word); nzl += (unsigned)__builtin_popcount(zw);
                word <<= 4 * hl; zw <<= 4 * hl;
                zw = or32(zw); if (hl == 0) ZM[qc * 256 + kt] = zw;
                if (cm) { unsigned pos = __hip_atomic_fetch_add(CNT + qc, (unsigned)__builtin_popcount(cm), __ATOMIC_RELAXED, __HIP_MEMORY_SCOPE_WORKGROUP);
                    const unsigned key0 = (unsigned)(kt * 32 + 4 * hl);
#pragma unroll
                    for (int r = 0; r < 16; ++r) if ((cm >> r) & 1u) { const unsigned pc = pos < (unsigned)(TK_CAP - 1) ? pos : (unsigned)(TK_CAP - 1);
                        *(LAS unsigned*)(lds + srow + pc * 4u) = __builtin_bit_cast(unsigned, sc[r]); *(LAS unsigned short*)(lds + irow + pc * 2u) = (unsigned short)(key0 + (unsigned)((r & 3) + 8 * (r >> 2))); ++pos; } }
                word = or32(word); if (hl == 0) maskl[qc * 256 + kt] = word;
#pragma unroll
                for (int ks = 0; ks < 4; ++ks) kf[ks] = kn[ks]; } }
            if (nhi) __hip_atomic_fetch_add(NHI + qc, nhi, __ATOMIC_RELAXED, __HIP_MEMORY_SCOPE_WORKGROUP);
            if (nzl) __hip_atomic_fetch_add(NZ + qc, nzl, __ATOMIC_RELAXED, __HIP_MEMORY_SCOPE_WORKGROUP);
            __syncthreads();
#pragma unroll 1
            for (int qq = 0; qq < 4; ++qq) { const int q = wid * 4 + qq;
                const unsigned n = (unsigned)__builtin_amdgcn_readfirstlane((int)CNT[q]), nh = (unsigned)__builtin_amdgcn_readfirstlane((int)NHI[q]), nz = (unsigned)__builtin_amdgcn_readfirstlane((int)NZ[q]);
                if (n > (unsigned)TK_CAP || nh > 256u || nh + n + nz < 256u) { if (lane == 0) FLAG[0] = 1u; continue; }
                const unsigned need = 256u - nh;
                if (need == 0u) continue;
                u32x4 zr = {0u, 0u, 0u, 0u};
                if (nz != 0u) zr = *(const u32x4*)(ZM + q * 256 + 4 * lane);
                unsigned zsel; int bit0; unsigned T0;
                { const unsigned klo = skey_of(TLO[q]), khi = skey_of(THI[q]), x = (unsigned)__builtin_amdgcn_readfirstlane((int)(klo ^ khi));
                  bit0 = x ? 31 - __builtin_clz(x) : 0; T0 = bit0 >= 31 ? 0u : ((unsigned)__builtin_amdgcn_readfirstlane((int)klo) & ~((2u << bit0) - 1u)); }
                if (n <= 256u) tk_pick<4>(sco + q * TK_CAP, cidx + q * TK_CAP, maskl + q * 256, n, nz, need, T0, bit0, lane, zsel);
                else if (n <= 320u) tk_pick<5>(sco + q * TK_CAP, cidx + q * TK_CAP, maskl + q * 256, n, nz, need, T0, bit0, lane, zsel);
                else if (n <= 384u) tk_pick<6>(sco + q * TK_CAP, cidx + q * TK_CAP, maskl + q * 256, n, nz, need, T0, bit0, lane, zsel);
                else tk_pick<TK_NR>(sco + q * TK_CAP, cidx + q * TK_CAP, maskl + q * 256, n, nz, need, T0, bit0, lane, zsel);
                if (zsel != 0u) {
                    unsigned w[4] = {zr.x, zr.y, zr.z, zr.w};
#pragma unroll
                    for (int j = 0; j < 4; ++j) if (4 * lane + j >= nkt) w[j] = 0u;
                    if (zsel < nz) {
                        const unsigned s4 = (unsigned)(__builtin_popcount(w[0]) + __builtin_popcount(w[1]) + __builtin_popcount(w[2]) + __builtin_popcount(w[3])); unsigned pre = s4;
#pragma unroll
                        for (int o = 1; o < 64; o <<= 1) { const unsigned t = (unsigned)__builtin_amdgcn_ds_bpermute((lane - o) << 2, (int)pre); if (lane >= o) pre += t; }
                        unsigned before = pre - s4;
#pragma unroll
                        for (int j = 0; j < 4; ++j) { const unsigned pc = (unsigned)__builtin_popcount(w[j]);
                            if (before >= zsel) w[j] = 0u;
                            else if (before + pc > zsel) { unsigned keep = 0u, rest = w[j];
                                for (unsigned t = before; t < zsel; ++t) { keep |= rest & (0u - rest); rest &= rest - 1u; }
                                w[j] = keep; }
                            before += pc; } }
#pragma unroll
                    for (int j = 0; j < 4; ++j) if (w[j]) __hip_atomic_fetch_or(maskl + q * 256 + 4 * lane + j, w[j], __ATOMIC_RELAXED, __HIP_MEMORY_SCOPE_WORKGROUP); } }
            __syncthreads();
            if (FLAG[0] == 0u) {
                for (int i = tid; i < 32 * 256; i += 512) { const int q = i >> 8, kt = i & 255; if (kt < nkt) MASK[((size_t)b * SEQ + qt * 32 + q) * 256 + kt] = maskl[i]; }
                __syncthreads();
                return; }
        }
        __syncthreads();
    }
    LAS unsigned* BND = B1 + 128;
    unsigned c1 = 0, c2 = 0;
#pragma unroll 1
    for (int level = 0; level < 3; ++level) {
        for (int i = tid; i < 32 * HS; i += 512) hist[i] = 0u;
        if (level == 0 && tid < 32) NEED[tid] = 256u;
        __syncthreads();
        if (level >= 1) c1 = BND[qc]; if (level >= 2) c2 = BND[32 + qc];
#pragma unroll 1
        for (int kt = wid; kt < nkt; kt += 8) { bf16x8 kf[4]; idx_load(KIBb, kt * 32, lane, kf); float sc[16]; idx_scores(kf, qf, wsc, sc);
#pragma unroll
            for (int r = 0; r < 16; ++r) { const int key = kt * 32 + (r & 3) + 8 * (r >> 2) + 4 * hl; const unsigned sk = sk20_of(sc[r]), inv = 8191u - (unsigned)key;
                const unsigned L1 = sk >> 9, L2 = ((sk & 511u) << 2) | (inv >> 11), L3 = inv & 2047u;
                bool ok = key <= ql; unsigned bin = L1;
                if (level == 1) { ok = ok && (L1 == c1); bin = L2; } else if (level == 2) { ok = ok && (L1 == c1) && (L2 == c2); bin = L3; }
                if (ok) __hip_atomic_fetch_add(hist + qc * HS + (bin >> 1), 1u << (16 * (bin & 1u)), __ATOMIC_RELAXED, __HIP_MEMORY_SCOPE_WORKGROUP); } }
        __syncthreads();
#pragma unroll 1
        for (int qq = 0; qq < 4; ++qq) { const int q = wid * 4 + qq; unsigned bb, above, inbin; const unsigned need = NEED[q]; tk_boundary(hist + q * HS, need, lane, bb, above, inbin);
            if (lane == 0) { BND[level * 32 + q] = bb; NEED[q] = need - above; } }
        __syncthreads();
    }
    { const unsigned d1 = BND[qc], d2 = BND[32 + qc], d3 = BND[64 + qc]; const unsigned thi = (d1 << 9) | (d2 >> 2), tlo = ((d2 & 3u) << 11) | d3;
#pragma unroll 1
      for (int kt = wid; kt < nkt; kt += 8) { bf16x8 kf[4]; idx_load(KIBb, kt * 32, lane, kf); float sc[16]; idx_scores(kf, qf, wsc, sc); unsigned word = 0u;
#pragma unroll
        for (int r = 0; r < 16; ++r) { const int rho = (r & 3) + 8 * (r >> 2) + 4 * hl, key = kt * 32 + rho; const unsigned sk = sk20_of(sc[r]), inv = 8191u - (unsigned)key;
            const bool sel = (key <= ql) && (sk > thi || (sk == thi && inv >= tlo)); word |= (sel ? 1u : 0u) << rho; }
        word = or32(word); if (hl == 0) MASK[row * 256 + kt] = word; } }
    __syncthreads();
}

typedef short v4i16_t __attribute__((ext_vector_type(4)));
__device__ __forceinline__ bf16x8 vtr2(const LAS bf16_t* p, int second_off) {
    const v4i16_t lo = __builtin_amdgcn_ds_read_tr16_b64_v4i16((LAS v4i16_t*)p), hi = __builtin_amdgcn_ds_read_tr16_b64_v4i16((LAS v4i16_t*)(p + second_off));
    return __builtin_shufflevector(lo, hi, 0, 1, 2, 3, 4, 5, 6, 7);
}
constexpr int ATT_KS = 72, ATT_VS = 96, ATT_BUF = (64 * ATT_KS + 64 * ATT_VS) * 2;
__device__ __forceinline__ void dsa_attn_item(LAS unsigned char* lds, int b, int hd, int qb, const bf16_t* PB, const unsigned* MASK, bf16_t* YC, const float* qn, const float* kn, const int* positions) {
    const int tid = tid_fresh(), wid = __builtin_amdgcn_readfirstlane(tid >> 6), lane = tid & 63, qc = lane & 31, hl = lane >> 5;
    const int q0 = qb * 256 + wid * 32, ql = q0 + qc; const size_t row = (size_t)b * SEQ + ql;
    const int my_sb_max = q0 >> 5;
    float negC;
    { float gq = fabsf(qn[lane]), gk = fabsf(kn[lane]);
      gq = fmaxf(gq, swz_xor<16>(gq)); gq = fmaxf(gq, swz_xor<8>(gq)); gq = fmaxf(gq, swz_xor<4>(gq)); gq = fmaxf(gq, swz_xor<2>(gq)); gq = fmaxf(gq, swz_xor<1>(gq)); gq = max32(gq);
      gk = fmaxf(gk, swz_xor<16>(gk)); gk = fmaxf(gk, swz_xor<8>(gk)); gk = fmaxf(gk, swz_xor<4>(gk)); gk = fmaxf(gk, swz_xor<2>(gk)); gk = fmaxf(gk, swz_xor<1>(gk)); gk = max32(gk);
      negC = -(8.0f * 1.4426950408889634f * 1.001f) * gq * gk; }
    const int negCi = __builtin_bit_cast(int, negC);
    bf16x8 qf[4];
    {
        float qv[4][8]; float ss = 0.f;
#pragma unroll
        for (int ks = 0; ks < 4; ++ks) { const u32x4 w = *(const u32x4*)(PB + row * PB_LD + hd * 64 + ks * 16 + 8 * hl);
            qv[ks][0] = bflo(w.x); qv[ks][1] = bfhi(w.x); qv[ks][2] = bflo(w.y); qv[ks][3] = bfhi(w.y); qv[ks][4] = bflo(w.z); qv[ks][5] = bfhi(w.z); qv[ks][6] = bflo(w.w); qv[ks][7] = bfhi(w.w);
#pragma unroll
            for (int e = 0; e < 8; ++e) ss += qv[ks][e] * qv[ks][e]; }
        ss = sum32(ss);
        const float rq = fast_rsq(ss * (1.0f / 64.0f) + NORM_EPS) * (0.125f * 1.4426950408889634f); const float posf = (float)positions[row];
#pragma unroll
        for (int ks = 0; ks < 2; ++ks)
#pragma unroll
            for (int e = 0; e < 8; ++e) { const int dj = ks * 16 + 8 * hl + e;
                const float ang = posf * fast_exp2(-(float)dj * (13.287712379549449f / 32.0f)); float sn, cs; sincos_rev(ang, sn, cs);
                const float y1 = qv[ks][e] * rq * qn[dj], y2 = qv[ks + 2][e] * rq * qn[dj + 32];
                qv[ks][e] = y1 * cs - y2 * sn; qv[ks + 2][e] = y2 * cs + y1 * sn; }
#pragma unroll
        for (int ks = 0; ks < 4; ++ks) { u32x4 w; w.x = pack_bf16(qv[ks][0], qv[ks][1]); w.y = pack_bf16(qv[ks][2], qv[ks][3]); w.z = pack_bf16(qv[ks][4], qv[ks][5]); w.w = pack_bf16(qv[ks][6], qv[ks][7]); qf[ks] = __builtin_bit_cast(bf16x8, w); }
    }
    f32x16 o0, o1;
#pragma unroll
    for (int r = 0; r < 16; ++r) { o0[r] = 0.f; o1[r] = 0.f; }
    float l = 0.f;
    const int nkt = 4 * (qb + 1);
    const int skey = tid >> 3, sd = (tid & 7) * 8;
    const int vtr_off = (4 * hl + ((lane & 15) >> 2)) * ATT_VS + 16 * ((lane >> 4) & 1) + 4 * (lane & 3);
    const bf16_t* kbase = PB + ((size_t)b * SEQ + skey) * PB_LD + 512 + hd * 64 + sd;
    u32x4 kw = *(const u32x4*)kbase, vw = *(const u32x4*)(kbase + 512);
    __syncthreads();
    const unsigned* mrow = MASK + row * 256;
    u32x4 mq0 = *(const u32x4*)mrow, mq1 = *(const u32x4*)(mrow + 4);
#define ATT_TILE(J, MW0, MW1) { const int kt = kt0 + (J); \
        LAS bf16_t* Ks = (LAS bf16_t*)(lds + ((J) & 1) * ATT_BUF); LAS bf16_t* Vs = Ks + 64 * ATT_KS; \
        *(LAS u32x4*)(Ks + skey * ATT_KS + sd) = kw; *(LAS u32x4*)(Vs + skey * ATT_VS + sd) = vw; \
        if (kt + 1 < nkt) { const bf16_t* kp = kbase + (size_t)(kt + 1) * 64 * PB_LD; kw = *(const u32x4*)kp; vw = *(const u32x4*)(kp + 512); } \
        asm volatile("s_waitcnt lgkmcnt(0)" ::: "memory"); __builtin_amdgcn_s_barrier(); asm volatile("" ::: "memory");     \
        if (2 * kt <= my_sb_max) { \
            f32x16 s[2]; int mwh[2]; \
            mwh[0] = (int)((MW0) >> (4 * hl)); mwh[1] = (int)(((2 * kt + 1 <= my_sb_max) ? (MW1) : 0u) >> (4 * hl)); \
            _Pragma("unroll") for (int sbi = 0; sbi < 2; ++sbi) _Pragma("unroll") for (int r = 0; r < 16; ++r) { const int sel = __builtin_amdgcn_sbfe(mwh[sbi], (r & 3) + 8 * (r >> 2), 1);     \
                s[sbi][r] = __builtin_bit_cast(float, (negCi & sel) | (0xF149F2CA & ~sel)); } \
            __builtin_amdgcn_s_setprio(1); _Pragma("unroll") for (int ks = 0; ks < 4; ++ks) _Pragma("unroll") for (int sbi = 0; sbi < 2; ++sbi) { const bf16x8 kf = *(const LAS bf16x8*)(Ks + (sbi * 32 + qc) * ATT_KS + ks * 16 + 8 * hl); \
                    s[sbi] = __builtin_amdgcn_mfma_f32_32x32x16_bf16(kf, qf[ks], s[sbi], 0, 0, 0); } __builtin_amdgcn_s_setprio(0); \
            float ps = 0.f; bf16x8 pf[2][2]; \
            _Pragma("unroll") for (int sbi = 0; sbi < 2; ++sbi) { float pv[16]; \
                _Pragma("unroll") for (int r = 0; r < 16; ++r) { const float p = fast_exp2(s[sbi][r]); pv[r] = p; ps += p; } \
                _Pragma("unroll") for (int s2 = 0; s2 < 2; ++s2) { u32x4 w; w.x = pack_bf16(pv[8 * s2 + 0], pv[8 * s2 + 1]); w.y = pack_bf16(pv[8 * s2 + 2], pv[8 * s2 + 3]); \
                    w.z = pack_bf16(pv[8 * s2 + 4], pv[8 * s2 + 5]); w.w = pack_bf16(pv[8 * s2 + 6], pv[8 * s2 + 7]); pf[sbi][s2] = __builtin_bit_cast(bf16x8, w); } } \
            l += ps; __builtin_amdgcn_s_setprio(1); \
            _Pragma("unroll") for (int sbi = 0; sbi < 2; ++sbi) _Pragma("unroll") for (int s2 = 0; s2 < 2; ++s2) { const LAS bf16_t* vp = Vs + (sbi * 32 + s2 * 16) * ATT_VS + vtr_off; \
                    const bf16x8 v0 = vtr2(vp, 8 * ATT_VS), v1 = vtr2(vp + 32, 8 * ATT_VS); \
                    o0 = __builtin_amdgcn_mfma_f32_32x32x16_bf16(v0, pf[sbi][s2], o0, 0, 0, 0); \
                    o1 = __builtin_amdgcn_mfma_f32_32x32x16_bf16(v1, pf[sbi][s2], o1, 0, 0, 0); } __builtin_amdgcn_s_setprio(0); \
        } }
    for (int kt0 = 0; kt0 < nkt; kt0 += 4) {
        u32x4 nq0 = mq0, nq1 = mq1;
        if (kt0 + 4 < nkt) { nq0 = *(const u32x4*)(mrow + 2 * kt0 + 8); nq1 = *(const u32x4*)(mrow + 2 * kt0 + 12); }
        ATT_TILE(0, mq0.x, mq0.y) ATT_TILE(1, mq0.z, mq0.w) ATT_TILE(2, mq1.x, mq1.y) ATT_TILE(3, mq1.z, mq1.w)
        mq0 = nq0; mq1 = nq1;
    }
#undef ATT_TILE
    l = sum32(l);
    const float inv = fast_rcp(l);
    bf16_t* op = YC + row * 512 + hd * 64;
#pragma unroll
    for (int r4 = 0; r4 < 4; ++r4) { const int d = 8 * r4 + 4 * hl;
        u32x2 w0, w1; w0.x = pack_bf16(o0[4 * r4] * inv, o0[4 * r4 + 1] * inv); w0.y = pack_bf16(o0[4 * r4 + 2] * inv, o0[4 * r4 + 3] * inv);
        w1.x = pack_bf16(o1[4 * r4] * inv, o1[4 * r4 + 1] * inv); w1.y = pack_bf16(o1[4 * r4 + 2] * inv, o1[4 * r4 + 3] * inv);
        *(u32x2*)(op + d) = w0; *(u32x2*)(op + 32 + d) = w1; }
    __syncthreads();
}
#define XB_TMO      128
#define XB_XCNT(j)  (256  + 64 * (j))
#define XB_XSUB(j)  (1280 + 64 * (j))
#define XB_XGEN(j)  (2304 + 64 * (j))
#define XB_TOP      3328
#define XB_TOPGEN   3392
#define XCD_BAR_WORDS 3456
#define XB_SPIN_CAP (1u << 22)
__device__ __forceinline__ unsigned xb_ld(unsigned* p)              { return __hip_atomic_load(p, __ATOMIC_RELAXED, __HIP_MEMORY_SCOPE_AGENT); }
__device__ __forceinline__ unsigned xb_add(unsigned* p, unsigned v) { return __hip_atomic_fetch_add(p, v, __ATOMIC_RELAXED, __HIP_MEMORY_SCOPE_AGENT); }
__device__ __forceinline__ unsigned xb_xcc_id() { return (unsigned)__builtin_amdgcn_s_getreg((3 << 11) | 20) & 0xFu; }
#define XB_SPIN(cond, bar) do { unsigned _sp = 0; while (cond) { __builtin_amdgcn_s_sleep(1); \
    if ((++_sp & 255u) == 0u) { if (xb_ld(&(bar)[XB_TMO])) break; if (_sp > XB_SPIN_CAP) { atomicAdd(&(bar)[XB_TMO], 1u); break; } } } } while (0)
constexpr int XB_ST_OFF = TID_TAB_OFF - 16;
__device__ __forceinline__ void xcd_barrier_post(unsigned* bar) { if (tid_fresh() == 0) (void)xb_add(&bar[XB_XCNT(xb_xcc_id())], 1u); }
__device__ __forceinline__ void xcd_barrier_complete(unsigned* bar, unsigned x, unsigned G, unsigned& nloc, unsigned& nx) {
    unsigned sum, cnt, mine, sp = 0u;
    for (;;) {
        sum = 0u; cnt = 0u; mine = 0u;
#pragma unroll
        for (unsigned j = 0; j < 16; ++j) { const unsigned c = xb_ld(&bar[XB_XCNT(j)]); sum += c; cnt += (c > 0u) ? 1u : 0u; mine = (j == x) ? c : mine; }
        if (sum == G) break;
        __builtin_amdgcn_s_sleep(1);
        if ((++sp & 255u) == 0u) { if (xb_ld(&bar[XB_TMO])) break; if (sp > XB_SPIN_CAP) { atomicAdd(&bar[XB_TMO], 1u); break; } }
    }
    nloc = mine > 0u ? mine : 1u; nx = cnt > 0u ? cnt : 1u;
}
__device__ __forceinline__ void xcd_barrier(unsigned* bar, unsigned G) {
    asm volatile("s_waitcnt vmcnt(0)" ::: "memory");
    __syncthreads();
    if (tid_fresh() == 0) {
        volatile LAS unsigned* st = (volatile LAS unsigned*)(LAS char*)XB_ST_OFF;
        const unsigned x = xb_xcc_id();
        __builtin_amdgcn_s_waitcnt(0);
        unsigned nloc = st[0], nx = st[1];
        if (nloc == 0u) { xcd_barrier_complete(bar, x, G, nloc, nx); st[0] = nloc; st[1] = nx; }
        const unsigned old = xb_add(&bar[XB_XSUB(x)], 1u);
        const unsigned gen = old / nloc;
        if (old + 1u == (gen + 1u) * nloc) {
            __builtin_amdgcn_fence(__ATOMIC_RELEASE, "agent");
            asm volatile("s_waitcnt vmcnt(0)" ::: "memory");
            const unsigned og = xb_add(&bar[XB_TOP], 1u);
            const unsigned target = (og / nx + 1u) * nx;
            if (og + 1u != target) XB_SPIN(xb_ld(&bar[XB_TOP]) < target, bar);
            xb_add(&bar[XB_XGEN(x)], 1u);
            __builtin_amdgcn_fence(__ATOMIC_ACQUIRE, "agent");
            asm volatile("s_waitcnt vmcnt(0)" ::: "memory");
        } else {
            XB_SPIN(xb_ld(&bar[XB_XGEN(x)]) == gen, bar);
            __builtin_amdgcn_fence(__ATOMIC_ACQUIRE, "agent");
            asm volatile("s_waitcnt vmcnt(0)" ::: "memory");
        }
    }
    __syncthreads();
}
constexpr size_t MiB = 1u << 20;
constexpr size_t OFF_CTL = 0, OFF_AQ = 16384, OFF_DEC = 65536, OFF_DECK = 131072;
constexpr size_t OFF_SS = 1 * MiB, OFF_XB = 2 * MiB, OFF_RW = 34 * MiB, OFF_RA = 70 * MiB, OFF_RB = 174 * MiB, WS_NEED = 272 * MiB, WS_BIG = 289 * MiB;
constexpr size_t W_GLU = 0, W_E13 = 1 * MiB, W_E2 = 12 * MiB, W_EINA = 17 * MiB + 512 * 1024, W_ETY = 25 * MiB + 512 * 1024, W_EWST = 31 * MiB + 512 * 1024;
constexpr size_t W_X13 = 238 * MiB, W_X2 = 249 * MiB;
constexpr size_t W_LINB = 1 * MiB, W_LG = 5 * MiB, W_LB = 13 * MiB, W_LO = 17 * MiB, W_L13 = 19 * MiB, W_L2 = 30 * MiB;
constexpr size_t A_H1 = 0, A_PA = 0, A_PB = 0, A_MISCB = 56 * MiB, A_MASK = 64 * MiB, A_YC = 80 * MiB;
constexpr size_t B_U = 0, B_SC = 24 * MiB, B_S5Y = 40 * MiB, B_M2ST = 56 * MiB, B_HGST = 64 * MiB, B_MISCA = 80 * MiB, B_SSA = 81 * MiB, B_YB = 82 * MiB;
constexpr size_t B_GSCR = 0, B_MERGED = 32 * MiB;
constexpr int LDS_BYTES = 160 * 1024;
constexpr int NPH_LAYER = 16;
#if defined(PROBE_PH) || defined(PROBE_SPLIT)
#define TK_ABL (A.sub >> 8)
#else
#define TK_ABL 0
#endif
#ifndef SUBMASK
#define SUBMASK 0xffu
#endif
#ifndef P4SEL
#define P4SEL 7
#endif
#ifndef REPMASK
#define REPMASK 0u
#endif
#ifndef PHMASK
#define PHMASK 0xffffu
#endif

struct Args { const void* in[34]; float* out; unsigned char* ws; int ph_lo, ph_hi, nosync, sub, big; };

template <int L, int SP> __device__ __forceinline__ void do_phase(LAS unsigned char* lds) {
    typedef const __attribute__((address_space(4))) Args* KArgsPtr;
    KArgsPtr kargs = (KArgsPtr)__builtin_amdgcn_kernarg_segment_ptr();
    asm volatile("" : "+s"(kargs));
#define A (*kargs)
    unsigned char* ws = A.ws;
    const int bid = sgpr_fresh(blockIdx.x), nb = sgpr_fresh(gridDim.x);
#define X ((float*)A.out)
#define SS ((float*)(ws + OFF_SS))
#define XB ((bf16_t*)(ws + OFF_XB))
#define RW (ws + OFF_RW)
#define RA (ws + OFF_RA)
#define RB (ws + OFF_RB)
#define AQ ((float*)(ws + OFF_AQ))
#define DEC ((float*)(ws + OFF_DEC))
#define DECK ((float*)(ws + OFF_DECK))
#define H1 ((bf16_t*)(RA + A_H1))
#define PA ((bf16_t*)(RA + A_PA))
#define PB ((bf16_t*)(RA + A_PB))
#define KIB ((bf16_t*)(RA + A_MISCB))
#define WI ((float*)(RA + A_MISCB + 2 * MiB))
#define MASK ((unsigned*)(RA + A_MASK))
#define YC ((bf16_t*)(RA + A_YC))
#define U ((bf16_t*)(RB + B_U))
#define SC ((float*)(RB + B_SC))
#define S5Y ((bf16_t*)(RB + B_S5Y))
#define M2ST ((float*)(RB + B_M2ST))
#define HGST ((float*)(RB + B_HGST))
#define MISCA ((float*)(RB + B_MISCA))
#define SSA ((float*)(RB + B_SSA))
#define YB ((bf16_t*)(RB + B_YB))
#define GSCR ((bf16_t*)(RB + B_GSCR) + (size_t)bid * 65536)
#define MERGED ((bf16_t*)(RB + B_MERGED))
    {
        constexpr int l = L, sp = SP;
#define INF(i, per) (((const float*)A.in[i]) + (size_t)l * (per))
        constexpr int rep = 0;
        {
        switch (sp) {
        case 0: if constexpr (PHMASK & (1u<<0)) {
            int rot = 0; CvtJob j;
            if (!(l > 0 && nb == 256)) {
            j = CvtJob{INF(3, DM * DFF), INF(4, DM * DFF), INF(2, DM), (bf16_t*)(RW + W_E13), DFF, 2 * DFF, DM, MAP_IL2, 0}; cvt_run(lds, j, bid, nb, rot);
            j = CvtJob{INF(5, DFF * DM), nullptr, nullptr, (bf16_t*)(RW + W_E2), DM, DM, DFF, MAP_PLAIN, 0}; cvt_run(lds, j, bid, nb, rot);
            }
            j = CvtJob{INF(7, DM * DIN), nullptr, INF(6, DM), (bf16_t*)(RW + W_EINA), DIN, 4096, DM, MAP_INA, 0}; cvt_run(lds, j, bid, nb, rot);
            j = CvtJob{INF(25, 512 * 1024), INF(25, 512 * 1024), nullptr, (bf16_t*)(RW + W_GLU), 1024, 1024, 512, MAP_IL2, 512}; cvt_run(lds, j, bid, nb, rot);
            for (int it = bid; it < 256; it += nb) s5_tables(lds, it >> 3, it & 7, INF(17, 2048), INF(18, 2048), INF(19, 32768), INF(20, 32768), INF(21, 32768), INF(22, 32768), INF(23, 512), INF(24, 32),
                                                             (bf16_t*)(RW + W_ETY), (bf16_t*)(RW + W_EWST), AQ);
            if (l == 0) x_prologue((const float*)A.in[0], X, XB, SS, bid, nb);
        } break;
        case 1: case 14: if constexpr (PHMASK & (1u<<1)) {
            const bool early2 = A.big && nb == 256;
            pg8::Gemm g{XB, (const bf16_t*)(RW + (sp == 1 ? W_E13 : (early2 ? W_X13 : W_L13))), DM, DM, DM}; pg8::StaticOrder S; S.init(64, 22, nb, bid);
            pg8::EpiSwiGLU E{H1, DFF, SS}; pg8::gemm_phase<pg8::EpiSwiGLU, pg8::StaticOrder, true, true>(lds, g, S, E);
            if constexpr (sp == 1) {
                if (early2 && bid >= 128) { int rot = 0; CvtJob j;
                    j = CvtJob{INF(31, DM * DFF), INF(32, DM * DFF), INF(30, DM), (bf16_t*)(RW + W_X13), DFF, 2 * DFF, DM, MAP_IL2, 0}; cvt_run(lds, j, bid - 128, 128, rot);
                    j = CvtJob{INF(33, DFF * DM), nullptr, nullptr, (bf16_t*)(RW + W_X2), DM, DM, DFF, MAP_PLAIN, 0}; cvt_run(lds, j, bid - 128, 128, rot); } }
            if constexpr (sp == 14 && l + 1 < NLAYER) {
                if (nb == 256 && bid >= 128) {
                    int rot = 0; CvtJob j;
                    j = CvtJob{INF(3, DM * DFF) + (size_t)DM * DFF, INF(4, DM * DFF) + (size_t)DM * DFF, INF(2, DM) + DM, (bf16_t*)(RW + W_E13), DFF, 2 * DFF, DM, MAP_IL2, 0}; cvt_run(lds, j, bid - 128, 128, rot);
                    j = CvtJob{INF(5, DFF * DM) + (size_t)DFF * DM, nullptr, nullptr, (bf16_t*)(RW + W_E2), DM, DM, DFF, MAP_PLAIN, 0}; cvt_run(lds, j, bid - 128, 128, rot); } }
        } break;
        case 2: case 15: if constexpr (PHMASK & (1u<<2)) {
            pg8::Gemm g{H1, (const bf16_t*)(RW + (sp == 2 ? W_E2 : ((A.big && nb == 256) ? W_X2 : W_L2))), DFF, DFF, DFF}; pg8::StaticOrder S; S.init(64, 4, nb, bid);
            constexpr int RM = (l == 0 && sp == 2) ? 0 : ((l == NLAYER - 1 && sp == 15) ? 2 : 1);
            pg8::EpiResid<RM> E{(const float*)A.in[0], X, XB, SS, 0.5f}; pg8::gemm_phase<pg8::EpiResid<RM>, pg8::StaticOrder, true, true>(lds, g, S, E);
        } break;
        case 3: if constexpr (PHMASK & (1u<<3)) {
            pg8::Gemm g{XB, (const bf16_t*)(RW + W_EINA), DM, DM, DM}; pg8::StaticOrder S; S.init(64, 16, nb, bid);
            pg8::EpiInA E{PA, U, MISCA, SS}; pg8::gemm_phase<pg8::EpiInA, pg8::StaticOrder, true, true>(lds, g, S, E);
        } break;
        case 4: if constexpr (PHMASK & (1u<<4)) {
            if (rep == 0 || (P4SEL & 1)) { pg8::Gemm g{U, (const bf16_t*)(RW + W_EWST), U_LD, 256, 256}; pg8::GroupOrder S; S.init(32, 4, 1, nb, bid);
              pg8::EpiS5State E{SC}; pg8::gemm_phase<pg8::EpiS5State, pg8::GroupOrder, true, true>(lds, g, S, E); }
            if (rep == 0 || (P4SEL & 2)) { const HgParams hp{(const float*)A.in[28], (const float*)A.in[28] + 512, INF(29, 512), l};
              for (int it = bid; it < 256; it += nb) hg1_mfma(lds, it, PA, HGST, DECK, hp); }
            if (rep == 0 || (P4SEL & 4)) { const M2Params mp{INF(11, 4 * 768), INF(12, 768), INF(13, 8), INF(14, 8), INF(15, 8)};
              for (int it = bid; it < 512; it += nb) m2s1_mfma(lds, it, PA, MISCA, M2ST, DEC, mp); }
            if (nb == 256 && bid >= 128) {
                int rot = 0; CvtJob j = CvtJob{INF(8, DM * 4096), nullptr, INF(6, DM), (bf16_t*)(RW + W_LG), 4096, 4096, DM, MAP_PLAIN, 0}; cvt_run(lds, j, bid - 128, 128, rot); }
        } break;
        case 5: if constexpr (PHMASK & (1u<<5)) {
            for (int it = bid; it < 64; it += nb) s5_scan(lds, it, SC, AQ, U);
            const int tid = tid_fresh();
            if (rep == 0) for (int e = bid * 512 + tid; e < 131072; e += nb * 512) hg_scan(HGST, DECK, e);
            if (rep == 0) for (int e = (nb - 1 - bid) * 512 + tid; e < 65536; e += nb * 512) m2_scan(M2ST, DEC, e);
        } break;
        case 6: if constexpr (PHMASK & (1u<<6)) {
            if (A.sub & 4) { pg8::Gemm g{U, (const bf16_t*)(RW + W_ETY), U_LD, U_LD, U_LD}; pg8::GroupOrder S; S.init(32, 4, 1, nb, bid);
              pg8::EpiS5Y E{S5Y}; pg8::gemm_phase<pg8::EpiS5Y, pg8::GroupOrder, true, true>(lds, g, S, E); }
            if (A.sub & 2) { const HgParams hp{(const float*)A.in[28], (const float*)A.in[28] + 512, INF(29, 512), l};
              for (int it = bid; it < 256; it += nb) hg3_mfma(lds, it, PA, HGST, hp); }
            if (A.sub & 1) { const M2Params mp{INF(11, 4 * 768), INF(12, 768), INF(13, 8), INF(14, 8), INF(15, 8)};
              for (int it = bid; it < 512; it += nb) m2s3_mfma(lds, it, PA, MISCA, M2ST, SSA, mp); }
            if (nb == 256 && bid >= 128) {
                int rot = 0; CvtJob j = CvtJob{INF(7, DM * DIN), nullptr, INF(6, DM), (bf16_t*)(RW + W_LINB), DIN, 2048, DM, MAP_INB, 0}; cvt_run(lds, j, bid - 128, 128, rot);
                for (int gi = 0; gi < 4; ++gi) { j = CvtJob{INF(9, 4 * 512 * 1024) + (size_t)gi * 512 * 1024, nullptr, gi == 0 ? INF(16, 512) : nullptr, (bf16_t*)(RW + W_LB) + (size_t)gi * 1024 * 512, 1024, 1024, 512, MAP_PLAIN, 0}; cvt_run(lds, j, bid - 128, 128, rot); }
                j = CvtJob{INF(10, DM * DM), nullptr, nullptr, (bf16_t*)(RW + W_LO), DM, DM, DM, MAP_PLAIN, 0}; cvt_run(lds, j, bid - 128, 128, rot); }
        } break;
        case 7: if constexpr (PHMASK & (1u<<7)) {
            { pg8::Gemm g{S5Y, (const bf16_t*)(RW + W_GLU), 512, 512, 512}; pg8::StaticOrder S; S.init(64, 4, nb, bid);
              pg8::EpiGLU E{YB, 512}; pg8::gemm_phase<pg8::EpiGLU, pg8::StaticOrder, true, true>(lds, g, S, E); }
            int rot = 0; CvtJob j;
            if (nb != 256) {
            j = CvtJob{INF(7, DM * DIN), nullptr, INF(6, DM), (bf16_t*)(RW + W_LINB), DIN, 2048, DM, MAP_INB, 0}; cvt_run(lds, j, bid, nb, rot);
            j = CvtJob{INF(8, DM * 4096), nullptr, INF(6, DM), (bf16_t*)(RW + W_LG), 4096, 4096, DM, MAP_PLAIN, 0}; cvt_run(lds, j, bid, nb, rot);
            for (int gi = 0; gi < 4; ++gi) { j = CvtJob{INF(9, 4 * 512 * 1024) + (size_t)gi * 512 * 1024, nullptr, gi == 0 ? INF(16, 512) : nullptr, (bf16_t*)(RW + W_LB) + (size_t)gi * 1024 * 512, 1024, 1024, 512, MAP_PLAIN, 0}; cvt_run(lds, j, bid, nb, rot); }
            j = CvtJob{INF(10, DM * DM), nullptr, nullptr, (bf16_t*)(RW + W_LO), DM, DM, DM, MAP_PLAIN, 0}; cvt_run(lds, j, bid, nb, rot); }
            if (!(A.big && nb == 256)) {
            j = CvtJob{INF(31, DM * DFF), INF(32, DM * DFF), INF(30, DM), (bf16_t*)(RW + W_L13), DFF, 2 * DFF, DM, MAP_IL2, 0}; cvt_run(lds, j, bid, nb, rot);
            j = CvtJob{INF(33, DFF * DM), nullptr, nullptr, (bf16_t*)(RW + W_L2), DM, DM, DFF, MAP_PLAIN, 0}; cvt_run(lds, j, bid, nb, rot); }
        } break;
        case 8: case 12: if constexpr (PHMASK & (1u<<8)) {
            pg8::StaticOrder S; S.init(64, 4, nb, bid);
            for (int gi = 0; gi < 4; ++gi) { if ((sp == 8) == (gi == 2)) continue;
                { pg8::Gemm g{XB, (const bf16_t*)(RW + W_LG) + (size_t)gi * 1024 * 1024, DM, DM, DM}; pg8::EpiGate E{GSCR, SS}; pg8::gemm_phase<pg8::EpiGate, pg8::StaticOrder, true, true>(lds, g, S, E); }
                const bf16_t* Ag = gi == 0 ? PA : gi == 1 ? YB : gi == 2 ? YC : PA + 2816; const int lda = (gi == 1 || gi == 2) ? 512 : PA_LD;
                { pg8::Gemm g{Ag, (const bf16_t*)(RW + W_LB) + (size_t)gi * 1024 * 512, lda, 512, 512}; pg8::EpiBranch E{GSCR, MERGED, gi == 0 ? SSA : nullptr, gi == 0 ? 1 : 0};
                  pg8::gemm_phase<pg8::EpiBranch, pg8::StaticOrder, true, true>(lds, g, S, E); } }
        } break;
        case 9: if constexpr (PHMASK & (1u<<9)) {
            pg8::Gemm g{XB, (const bf16_t*)(RW + W_LINB), DM, DM, DM}; pg8::StaticOrder S; S.init(64, 8, nb, bid);
            pg8::EpiInB E{PB, KIB, WI, SS}; pg8::gemm_phase<pg8::EpiInB, pg8::StaticOrder, true, true>(lds, g, S, E);
        } break;
        case 10: if constexpr (PHMASK & (1u<<10)) {
            if (A.sub & 1) dsa_prep(PB, (const int*)A.in[1], INF(26, 64), INF(27, 64), bid, nb);
            if (A.sub & 2) for (int it = bid; it < 512; it += nb) { const int c = it & 255, bb = it >> 8; dsa_topk_tile(lds, bb, bb == 0 ? c : 255 - c, PB, KIB, WI, TK_ABL ? (unsigned*)YC : MASK, (unsigned*)GSCR, TK_ABL); }
        } break;
        case 11: if constexpr (PHMASK & (1u<<11)) {
            for (int it = bid; it < 512; it += nb) { const int c = it & 255, second = it >> 8, pair = (c & 7) * 2 + (c >> 7), bb = pair >> 3, hd = pair & 7, jq = (c >> 3) & 15;     dsa_attn_item(lds, bb, hd, second ? 31 - jq : jq, PB, MASK, YC, INF(26, 64), INF(27, 64), (const int*)A.in[1]); }
        } break;
        case 13: if constexpr (PHMASK & (1u<<13)) {
            pg8::Gemm g{MERGED, (const bf16_t*)(RW + W_LO), DM, DM, DM}; pg8::StaticOrder S; S.init(64, 4, nb, bid);
            pg8::EpiResid<1> E{nullptr, X, XB, SS, 1.0f}; pg8::gemm_phase<pg8::EpiResid<1>, pg8::StaticOrder, true, true>(lds, g, S, E);
        } break;
        }
        }
    }
#undef INF
}
#undef A

__global__ void __launch_bounds__(512) hybrid_fwd(Args a) {
    cg::grid_group grid = cg::this_grid();
    extern __shared__ __attribute__((aligned(16))) unsigned char lds_raw[];
    LAS unsigned char* lds = (LAS unsigned char*)lds_raw;
    const int ph_lo = a.ph_lo, ph_hi = a.ph_hi;
    tid_tab_init();
    if (threadIdx.x < 4) ((LAS unsigned*)(LAS char*)XB_ST_OFF)[threadIdx.x] = 0u;
    __syncthreads();
    if (a.nosync) xcd_barrier_post((unsigned*)a.ws);
    else if (blockIdx.x == 0) { for (int i = (int)threadIdx.x; i < XCD_BAR_WORDS; i += 512) ((unsigned*)a.ws)[i] = 0u; }
#define STEP(L_, SP_) { constexpr int PH_ = (L_) * NPH_LAYER + (SP_); if (ph_lo <= PH_ && PH_ < ph_hi) { do_phase<L_, SP_>(lds); if (PH_ + 1 < ph_hi) { if (PH_ == 0 && !a.nosync) { __syncthreads(); grid.sync(); xcd_barrier_post((unsigned*)a.ws); } else xcd_barrier((unsigned*)a.ws, gridDim.x); } } }
#define LAYER(L_) STEP(L_, 0) STEP(L_, 1) STEP(L_, 2) STEP(L_, 3) STEP(L_, 4) STEP(L_, 5) STEP(L_, 6) STEP(L_, 7) STEP(L_, 8) STEP(L_, 9) STEP(L_, 10) STEP(L_, 11) STEP(L_, 12) STEP(L_, 13) STEP(L_, 14) STEP(L_, 15)
    LAYER(0) LAYER(1)
#undef LAYER
#undef STEP
}
extern "C" void kernel_launch(void* const* d_in, const int* in_sizes, int n_in, void* d_out, int out_size, void* d_ws, size_t ws_size, hipStream_t stream) {
    static int grid_blocks = 0;
    if (!grid_blocks) {
        int dev = 0, cus = 0, per_cu = 0;
        hipGetDevice(&dev);
        hipDeviceGetAttribute(&cus, hipDeviceAttributeMultiprocessorCount, dev);
        hipFuncSetAttribute((const void*)hybrid_fwd, hipFuncAttributeMaxDynamicSharedMemorySize, LDS_BYTES);
        hipOccupancyMaxActiveBlocksPerMultiprocessor(&per_cu, hybrid_fwd, 512, LDS_BYTES);
        if (per_cu < 1) { fprintf(stderr, "occupancy query returned %d\n", per_cu); per_cu = 1; }
        grid_blocks = cus * 1;
        if (grid_blocks > 256) grid_blocks = 256;
        fprintf(stderr, "grid_blocks=%d cus=%d per_cu=%d ws_size=%zu need=%zu\n", grid_blocks, cus, per_cu, ws_size, (size_t)WS_NEED);
    }
    if (ws_size < WS_NEED || n_in < 34) { fprintf(stderr, "workspace too small or bad inputs\n"); return; }
#if defined(PROBE_SPLIT) || defined(PROBE_PH)
    hipMemsetAsync(d_ws, 0, XCD_BAR_WORDS * 4, stream);
#endif
    Args a{};
    for (int i = 0; i < 34; ++i) a.in[i] = d_in[i];
    a.out = (float*)d_out; a.ws = (unsigned char*)d_ws; a.ph_lo = 0; a.ph_hi = NLAYER * NPH_LAYER; a.nosync = 0; a.sub = 7; a.big = (ws_size >= WS_BIG) ? 1 : 0;
#ifdef PROBE_SPLIT
    { Args p = a; p.ph_hi = PROBE_SPLIT + 1; void* pa[] = {&p};
      hipLaunchCooperativeKernel((void*)hybrid_fwd, dim3(grid_blocks), dim3(512), pa, LDS_BYTES, stream);
      Args q = a; q.ph_lo = PROBE_SPLIT; q.ph_hi = PROBE_SPLIT + 1; q.nosync = 1; q.sub = PROBE_SUB;
      for (int r = 0; r < PROBE_N; ++r) hipLaunchKernelGGL(hybrid_fwd, dim3(grid_blocks), dim3(512), LDS_BYTES, stream, q);
      Args t = a; t.ph_lo = PROBE_SPLIT + 1; t.nosync = 1;
      hipMemsetAsync(d_ws, 0, XCD_BAR_WORDS * 4, stream);
      hipLaunchKernelGGL(hybrid_fwd, dim3(grid_blocks), dim3(512), LDS_BYTES, stream, t); }
    return;
#endif
    void* args[] = {&a};
    hipError_t e = hipLaunchCooperativeKernel((void*)hybrid_fwd, dim3(grid_blocks), dim3(512), args, LDS_BYTES, stream);
    if (e != hipSuccess) fprintf(stderr, "cooperative launch failed: %s (grid %d)\n", hipGetErrorString(e), grid_blocks);
#ifdef PROBE_PH
    { Args p = a; p.out = (float*)((unsigned char*)d_ws + OFF_RB + 32 * MiB); p.ph_lo = PROBE_PH; p.ph_hi = PROBE_PH + 1; p.nosync = 1; p.sub = PROBE_SUB;
      for (int r = 0; r < PROBE_N; ++r) hipLaunchKernelGGL(hybrid_fwd, dim3(grid_blocks), dim3(512), LDS_BYTES, stream, p); }
#endif
}
```
